# Optimizing an MI355X kernel written in HIP

```python
import math
import jax, jax.numpy as jnp
from jax import lax
import numpy as np

D_MODEL = 1024
BATCH = 16
SEQ = 4096
DEPTH = 1

ATTN_HEADS = 8
ATTN_HEAD_DIM = 64
ATTN_W = ATTN_HEADS * ATTN_HEAD_DIM
ROT_DIM = ATTN_HEAD_DIM // 4
ROPE_THETA = 500000.0
MOBA_BLOCK = 256
MOBA_TOPK = 3
MOBA_Q_CHUNK = 32
MLSTM_HEADS = 4
MLSTM_HEAD_DIM = 128
MLSTM_W = MLSTM_HEADS * MLSTM_HEAD_DIM
MLSTM_CHUNK = 64
CONV_WIDTH = 4
PEER_HEADS = 8
PEER_N_KEYS = 128
PEER_N_EXPERTS = PEER_N_KEYS * PEER_N_KEYS
PEER_KEY_DIM = 256
PEER_HALF = PEER_KEY_DIM // 2
PEER_TOPK = 16
PEER_TOKEN_CHUNK = 128
EPS = 1e-6

IN_SPLITS = (ATTN_W, ATTN_W, ATTN_W, MLSTM_W, MLSTM_W, MLSTM_W, MLSTM_W,
             MLSTM_HEADS, MLSTM_HEADS, D_MODEL, D_MODEL)
IN_COLS = sum(IN_SPLITS)

kernel_name = "hybrid_moba_mlstm_peer_block"


def rms_norm(x, w):
    xf = x.astype(jnp.float32)
    xf = xf * lax.rsqrt(jnp.mean(xf * xf, axis=-1, keepdims=True) + EPS)
    return (xf * w.astype(jnp.float32)).astype(x.dtype)


def apply_partial_rope(t):
    S = t.shape[2]
    pos = jnp.arange(S, dtype=jnp.float32)
    inv_freq = ROPE_THETA ** (-jnp.arange(0, ROT_DIM, 2, dtype=jnp.float32) / ROT_DIM)
    ang = pos[:, None] * inv_freq[None, :]
    cos, sin = jnp.cos(ang), jnp.sin(ang)
    tf = t.astype(jnp.float32)
    half = ROT_DIM // 2
    x1, x2, rest = tf[..., :half], tf[..., half:ROT_DIM], tf[..., ROT_DIM:]
    out = jnp.concatenate([x1 * cos - x2 * sin, x2 * cos + x1 * sin, rest], axis=-1)
    return out.astype(t.dtype)


def causal_depthwise_conv(u, w, b):
    S = u.shape[1]
    up = jnp.pad(u, ((0, 0), (CONV_WIDTH - 1, 0), (0, 0)))
    y = sum(up[:, j:j + S] * w[j] for j in range(CONV_WIDTH))
    return y + b


def moba_attention(q, k, v):
    B, H, S, hd = q.shape
    n_blocks = -(-S // MOBA_BLOCK)
    s_pad = n_blocks * MOBA_BLOCK
    pad = ((0, 0), (0, 0), (0, s_pad - S), (0, 0))
    q, k, v = jnp.pad(q, pad), jnp.pad(k, pad), jnp.pad(v, pad)
    k_blocks = k.reshape(B, H, n_blocks, MOBA_BLOCK, hd)
    v_blocks = v.reshape(B, H, n_blocks, MOBA_BLOCK, hd)
    k_mean = jnp.mean(k_blocks.astype(jnp.float32), axis=3)
    topk = min(MOBA_TOPK, n_blocks)
    scale = hd ** -0.5
    b_idx = jnp.arange(B)[:, None, None, None]
    h_idx = jnp.arange(H)[None, :, None, None]
    block_ids = jnp.arange(n_blocks)

    def one_chunk(ci):
        start = ci * MOBA_Q_CHUNK
        blk = start // MOBA_BLOCK
        qc = lax.dynamic_slice_in_dim(q, start, MOBA_Q_CHUNK, axis=2).astype(jnp.float32)
        k_own = lax.dynamic_slice_in_dim(k, blk * MOBA_BLOCK, MOBA_BLOCK, axis=2).astype(jnp.float32)
        v_own = lax.dynamic_slice_in_dim(v, blk * MOBA_BLOCK, MOBA_BLOCK, axis=2).astype(jnp.float32)
        q_pos = start + jnp.arange(MOBA_Q_CHUNK)
        k_pos = blk * MOBA_BLOCK + jnp.arange(MOBA_BLOCK)
        s_own = jnp.einsum('bhqd,bhkd->bhqk', qc, k_own) * scale
        s_own = jnp.where(k_pos[None, :] <= q_pos[:, None], s_own, -jnp.inf)
        gate = jnp.einsum('bhqd,bhnd->bhqn', qc, k_mean)
        gate = jnp.where(block_ids < blk, gate, -jnp.inf)
        _, sel = lax.top_k(gate, topk)
        valid = sel < blk
        k_sel = k_blocks[b_idx, h_idx, sel].astype(jnp.float32)
        v_sel = v_blocks[b_idx, h_idx, sel].astype(jnp.float32)
        s_sel = jnp.einsum('bhqd,bhqjkd->bhqjk', qc, k_sel) * scale
        s_sel = jnp.where(valid[..., None], s_sel, -jnp.inf)
        s_sel = s_sel.reshape(B, H, MOBA_Q_CHUNK, topk * MOBA_BLOCK)
        p = jax.nn.softmax(jnp.concatenate([s_sel, s_own], axis=-1), axis=-1)
        p_sel = p[..., :topk * MOBA_BLOCK].reshape(B, H, MOBA_Q_CHUNK, topk, MOBA_BLOCK)
        p_own = p[..., topk * MOBA_BLOCK:]
        out = (jnp.einsum('bhqjk,bhqjkd->bhqd', p_sel, v_sel)
               + jnp.einsum('bhqk,bhkd->bhqd', p_own, v_own))
        return out.astype(q.dtype)

    n_chunks = s_pad // MOBA_Q_CHUNK
    out = lax.map(one_chunk, jnp.arange(n_chunks))
    out = jnp.moveaxis(out, 0, 2).reshape(B, H, s_pad, hd)[:, :, :S]
    return out


def mlstm_chunkwise(q, k, v, i_pre, f_pre):
    B, H, S, d = q.shape
    L = MLSTM_CHUNK
    nc = S // L
    log_f = jax.nn.log_sigmoid(f_pre)

    def to_chunks(t):
        return jnp.moveaxis(t.reshape((B, H, nc, L) + t.shape[3:]), 2, 0)

    causal = jnp.tril(jnp.ones((L, L), dtype=bool))

    def step(carry, inp):
        C, n, m = carry
        qc, kc, vc, ig, lf = inp
        b = jnp.cumsum(lf, axis=-1)
        log_d = b[..., :, None] - b[..., None, :] + ig[..., None, :]
        log_d = jnp.where(causal, log_d, -jnp.inf)
        m_inter = b + m[..., None]
        m_t = jnp.maximum(m_inter, jnp.max(log_d, axis=-1))
        A = jnp.exp(log_d - m_t[..., None]) * jnp.einsum('bhtd,bhsd->bhts', qc, kc)
        w_inter = jnp.exp(m_inter - m_t)
        num = (jnp.einsum('bhts,bhsv->bhtv', A, vc)
               + w_inter[..., None] * jnp.einsum('bhtd,bhdv->bhtv', qc, C))
        den = jnp.sum(A, axis=-1) + w_inter * jnp.einsum('bhtd,bhd->bht', qc, n)
        h = num / jnp.maximum(jnp.abs(den), jnp.exp(-m_t))[..., None]
        m_new = m_t[..., -1]
        w_s = jnp.exp(b[..., -1:] - b + ig - m_new[..., None])
        decay = jnp.exp(b[..., -1] + m - m_new)
        C_new = decay[..., None, None] * C + jnp.einsum('bhs,bhsd,bhsv->bhdv', w_s, kc, vc)
        n_new = decay[..., None] * n + jnp.einsum('bhs,bhsd->bhd', w_s, kc)
        return (C_new, n_new, m_new), h

    init = (jnp.zeros((B, H, d, d), jnp.float32),
            jnp.zeros((B, H, d), jnp.float32),
            jnp.zeros((B, H), jnp.float32))
    _, h = lax.scan(step, init, (to_chunks(q), to_chunks(k), to_chunks(v),
                                 to_chunks(i_pre), to_chunks(log_f)))
    return jnp.moveaxis(h, 0, 2).reshape(B, H, S, d)


def peer_ffn(h, w_query, keys_1, keys_2, w_down, w_up):
    B, S, D = h.shape
    T = B * S
    hf = h.reshape(T, D)
    q = (hf @ w_query).reshape(T, PEER_HEADS, PEER_KEY_DIM)
    q1, q2 = q[..., :PEER_HALF], q[..., PEER_HALF:]
    s1 = jnp.einsum('thd,hnd->thn', q1, keys_1).astype(jnp.float32)
    s2 = jnp.einsum('thd,hnd->thn', q2, keys_2).astype(jnp.float32)
    v1, i1 = lax.top_k(s1, PEER_TOPK)
    v2, i2 = lax.top_k(s2, PEER_TOPK)
    cand = (v1[..., :, None] + v2[..., None, :]).reshape(T, PEER_HEADS, PEER_TOPK * PEER_TOPK)
    sc, ci = lax.top_k(cand, PEER_TOPK)
    e1 = jnp.take_along_axis(i1, ci // PEER_TOPK, axis=-1)
    e2 = jnp.take_along_axis(i2, ci % PEER_TOPK, axis=-1)
    expert = e1 * PEER_N_KEYS + e2
    g = jax.nn.softmax(sc, axis=-1).astype(h.dtype)

    def one_chunk(args):
        xc, ec, gc = args
        u = w_down[ec]
        a = jax.nn.gelu(jnp.einsum('cd,chkd->chk', xc, u), approximate=False)
        vv = w_up[ec]
        return jnp.einsum('chk,chkd->cd', gc * a, vv)

    nc = T // PEER_TOKEN_CHUNK
    out = lax.map(one_chunk, (hf.reshape(nc, PEER_TOKEN_CHUNK, D),
                              expert.reshape(nc, PEER_TOKEN_CHUNK, PEER_HEADS, PEER_TOPK),
                              g.reshape(nc, PEER_TOKEN_CHUNK, PEER_HEADS, PEER_TOPK)))
    return out.reshape(B, S, D)


def setup_inputs(seed: int = 0) -> dict:
    key = jax.random.key(seed)
    ks = jax.random.split(key, 24)
    D = D_MODEL
    nrm = lambda k, shape, s: jax.random.normal(k, shape, jnp.float32) * s
    gain = lambda k, shape: 1.0 + 0.02 * jax.random.normal(k, shape, jnp.float32)
    return {
        "x": nrm(ks[0], (BATCH, SEQ, D), 1.0),
        "mix_norm_w": gain(ks[1], (D,)),
        "w_in": nrm(ks[2], (D, IN_COLS), D ** -0.5),
        "q_norm_w": gain(ks[3], (ATTN_HEAD_DIM,)),
        "k_norm_w": gain(ks[4], (ATTN_HEAD_DIM,)),
        "conv_w": nrm(ks[5], (CONV_WIDTH, 2 * MLSTM_W), CONV_WIDTH ** -0.5),
        "conv_b": nrm(ks[6], (2 * MLSTM_W,), 0.01),
        "igate_b": nrm(ks[7], (MLSTM_HEADS,), 0.1),
        "fgate_b": 3.0 + jax.random.uniform(ks[8], (MLSTM_HEADS,), jnp.float32, 0.0, 3.0),
        "mlstm_norm_w": gain(ks[9], (MLSTM_W,)),
        "w_attn_branch": nrm(ks[10], (ATTN_W, D), ATTN_W ** -0.5),
        "w_mlstm_branch": nrm(ks[11], (MLSTM_W, D), MLSTM_W ** -0.5),
        "merge_b": nrm(ks[12], (2, D), 0.01),
        "w_out": nrm(ks[13], (D, D), D ** -0.5),
        "ffn_norm_w": gain(ks[14], (D,)),
        "peer_w_query": nrm(ks[15], (D, PEER_HEADS * PEER_KEY_DIM), D ** -0.5),
        "peer_keys_1": nrm(ks[16], (PEER_HEADS, PEER_N_KEYS, PEER_HALF), PEER_HALF ** -0.5),
        "peer_keys_2": nrm(ks[17], (PEER_HEADS, PEER_N_KEYS, PEER_HALF), PEER_HALF ** -0.5),
        "peer_w_down": nrm(ks[18], (PEER_N_EXPERTS, D), D ** -0.5),
        "peer_w_up": nrm(ks[19], (PEER_N_EXPERTS, D), 0.5),
    }


def reference(x, mix_norm_w, w_in, q_norm_w, k_norm_w, conv_w, conv_b, igate_b, fgate_b,
              mlstm_norm_w, w_attn_branch, w_mlstm_branch, merge_b, w_out, ffn_norm_w,
              peer_w_query, peer_keys_1, peer_keys_2, peer_w_down, peer_w_up):
    B, S, _ = x.shape
    offsets = [int(o) for o in np.cumsum(IN_SPLITS)[:-1]]

    def to_heads(t, n, d):
        return t.reshape(B, S, n, d).transpose(0, 2, 1, 3)

    for _layer in range(DEPTH):
        h = rms_norm(x, mix_norm_w)
        proj = h @ w_in
        aq, ak, av, mq, mk, mv, mo, mi, mf, ga, gm = jnp.split(proj, offsets, axis=-1)

        qa = apply_partial_rope(rms_norm(to_heads(aq, ATTN_HEADS, ATTN_HEAD_DIM), q_norm_w))
        ka = apply_partial_rope(rms_norm(to_heads(ak, ATTN_HEADS, ATTN_HEAD_DIM), k_norm_w))
        va = to_heads(av, ATTN_HEADS, ATTN_HEAD_DIM)
        attn = moba_attention(qa, ka, va)
        attn = attn.transpose(0, 2, 1, 3).reshape(B, S, ATTN_W)

        qk = jax.nn.silu(causal_depthwise_conv(jnp.concatenate([mq, mk], axis=-1), conv_w, conv_b))
        mq_c, mk_c = qk[..., :MLSTM_W], qk[..., MLSTM_W:]
        qm = to_heads(mq_c, MLSTM_HEADS, MLSTM_HEAD_DIM).astype(jnp.float32)
        km = to_heads(mk_c, MLSTM_HEADS, MLSTM_HEAD_DIM).astype(jnp.float32) * (MLSTM_HEAD_DIM ** -0.5)
        vm = to_heads(mv, MLSTM_HEADS, MLSTM_HEAD_DIM).astype(jnp.float32)
        i_pre = (mi + igate_b).astype(jnp.float32).transpose(0, 2, 1)
        f_pre = (mf + fgate_b).astype(jnp.float32).transpose(0, 2, 1)
        hm = mlstm_chunkwise(qm, km, vm, i_pre, f_pre)
        hm = hm.transpose(0, 2, 1, 3).astype(x.dtype)
        hm = rms_norm(hm, mlstm_norm_w.reshape(MLSTM_HEADS, MLSTM_HEAD_DIM)).reshape(B, S, MLSTM_W)
        hm = jax.nn.sigmoid(mo) * hm

        y = (jax.nn.sigmoid(ga + merge_b[0]) * (attn @ w_attn_branch)
             + jax.nn.sigmoid(gm + merge_b[1]) * (hm @ w_mlstm_branch))
        x = x + y @ w_out

        x = x + peer_ffn(rms_norm(x, ffn_norm_w), peer_w_query, peer_keys_1, peer_keys_2,
                         peer_w_down, peer_w_up)
    return x
```

```cpp
#include <hip/hip_runtime.h>
#include <cstdio>
#include <cstdint>
#include <cmath>
typedef unsigned short bf16_t;
constexpr int T_ = 65536, D_ = 1024, B_ = 16, S_ = 4096;
constexpr int INC = 5640;
constexpr size_t MiB = 1ull << 20;
constexpr size_t OFF_XB = 0;
constexpr size_t OFF_Q = 128 * MiB, OFF_K = 192 * MiB, OFF_V = 256 * MiB;
constexpr size_t OFF_MQ = 320 * MiB, OFF_MK = 384 * MiB, OFF_MV = 448 * MiB, OFF_MO = 512 * MiB;
constexpr size_t OFF_GA = 576 * MiB, OFF_GM = 704 * MiB;
constexpr size_t OFF_W = 832 * MiB;
constexpr size_t OFF_WIN = OFF_W;
constexpr size_t OFF_WAB = OFF_WIN + (size_t)5632 * 1024 * 2;
constexpr size_t OFF_WMB = OFF_WAB + (size_t)1024 * 512 * 2;
constexpr size_t OFF_WOUT = OFF_WMB + (size_t)1024 * 512 * 2;
constexpr size_t OFF_WQ = OFF_WOUT + (size_t)1024 * 1024 * 2;
constexpr size_t OFF_KEY1 = OFF_WQ + (size_t)2048 * 1024 * 2;
constexpr size_t OFF_KEY2 = OFF_KEY1 + (size_t)8 * 128 * 128 * 2;
constexpr size_t OFF_WD = OFF_KEY2 + (size_t)8 * 128 * 128 * 2;
constexpr size_t OFF_WU = OFF_WD + (size_t)16384 * 1024 * 2;
constexpr size_t OFF_WEND = OFF_WU + (size_t)16384 * 1024 * 2;
constexpr size_t OFF_MISC = 920 * MiB;
static_assert(OFF_WEND <= OFF_MISC, "weights overflow");
constexpr size_t OFF_R1 = OFF_MISC;
constexpr size_t OFF_R2 = OFF_R1 + (size_t)T_ * 4;
constexpr size_t OFF_IFG = OFF_R2 + (size_t)T_ * 4;
constexpr size_t OFF_KMEAN = OFF_IFG + (size_t)T_ * 8 * 4;
constexpr size_t OFF_ROPE = OFF_KMEAN + (size_t)16 * 8 * 16 * 64 * 4;
constexpr size_t OFF_SCA = OFF_ROPE + (size_t)2 * 4096 * 8 * 4;
constexpr size_t OFF_SCM = OFF_SCA + (size_t)16 * 4 * 4096 * 4;
constexpr size_t OFF_SCB = OFF_SCM + (size_t)16 * 4 * 4096 * 4;
constexpr size_t OFF_CTL = 926 * MiB + 512 * 1024, CTL_BYTES = 64 * 1024;
constexpr size_t OFF_ROWSS = 927 * MiB;
constexpr size_t OFF_EIDX = 932 * MiB;
constexpr size_t OFF_EG = 964 * MiB;
constexpr size_t WS_NEED = 996 * MiB;
static_assert(OFF_SCB + (size_t)16 * 4 * 4096 * 4 <= OFF_CTL && OFF_CTL + CTL_BYTES <= OFF_ROWSS, "misc overflow");

__device__ __forceinline__ unsigned f2bf(float f) { unsigned u = __builtin_bit_cast(unsigned, f); return (u + 0x7fffu + ((u >> 16) & 1u)) >> 16; }
__device__ __forceinline__ float bf2f(unsigned short b) { return __builtin_bit_cast(float, ((unsigned)b) << 16); }
__device__ __forceinline__ unsigned pk2(float lo, float hi) { return f2bf(lo) | (f2bf(hi) << 16); }
__device__ __forceinline__ float sigmoidf_(float v) { return 1.0f / (1.0f + __expf(-v)); }
namespace pg8 {
#define PG8_LAS __attribute__((address_space(3)))
typedef unsigned short bf16_t;
typedef short bf16x8 __attribute__((ext_vector_type(8)));
typedef float f32x4 __attribute__((ext_vector_type(4)));
typedef unsigned u32x4 __attribute__((ext_vector_type(4)));
constexpr int BM = 256, BK = 64, HALF = 128, HTB = HALF * BK * 2  , STAGE_BYTES = 8 * HTB, NXCD = 8, WGM = 4;

__host__ __device__ __forceinline__ int lds_byte(int r, int c) { const int st = (r >> 4) * 2 + (c >> 5), rr = r & 15, cc = c & 31, ob = rr * 64 + cc * 2; return st * 1024 + (ob ^ (((ob >> 9) & 1) << 5)); }
__host__ __device__ __forceinline__ void stage_rc(int b, int& R, int& C) { const int st = b / 1024, sb = b % 1024, swz = sb ^ (((sb >> 9) & 1) << 5); R = (st >> 1) * 16 + swz / 64; C = (st & 1) * 32 + (swz % 64) / 2; }
__host__ __device__ __forceinline__ int perm32(int rho) { const int n = rho >> 4, i = rho & 15; return 8 * (i >> 2) + 4 * n + (i & 3); }

struct Unit { int pm, pn, seg, pad; const char* A; const char* B; };

__device__ __forceinline__ unsigned cvt_pk_bf16(float lo, float hi) { unsigned r; asm volatile("v_cvt_pk_bf16_f32 %0, %1, %2" : "=v"(r) : "v"(lo), "v"(hi)); return r; }
typedef float f32x2 __attribute__((ext_vector_type(2)));
__device__ __forceinline__ f32x2 gelu_pk(f32x2 v) {
    const f32x2 av = __builtin_elementwise_abs(v), d = av * 0.2316418882f + 1.0f;
    f32x2 t; t.x = __builtin_amdgcn_rcpf(d.x); t.y = __builtin_amdgcn_rcpf(d.y);
    f32x2 q = t * 0.5307027145f + (-0.7265760135f); q = q * t + 0.7107068705f; q = q * t + (-0.142248368f); q = q * t + 0.127414796f; q = q * t;
    const f32x2 s = (v * v) * (-0.72134752044f);
    f32x2 e; e.x = __builtin_amdgcn_exp2f(s.x); e.y = __builtin_amdgcn_exp2f(s.y);
    const f32x2 m = v * (q * e), r = v - m;
    f32x2 o; o.x = v.x < 0.f ? m.x : r.x; o.y = v.y < 0.f ? m.y : r.y; return o;
}

template <class Epi, class Sched, bool ALIGN_EPI = false, bool SP2 = false>
__device__ __forceinline__ void gemm_phase(PG8_LAS unsigned char* lds, const int K, const Sched& S, const Epi& E) {
    int tid = threadIdx.x; asm volatile("" : "+v"(tid));
    const int wid = __builtin_amdgcn_readfirstlane(tid >> 6), lane = tid & 63, wr = wid >> 2, wc = wid & 3, fr = lane & 15, fq = lane >> 4;
    const int nt = K / BK;
    unsigned voffA[2], voffB[2];
#pragma unroll
    for (int i = 0; i < 2; ++i) { int R, C; stage_rc(tid * 16 + i * 8192, R, C); const int Rb = Epi::PERM ? ((R & ~31) + perm32(R & 31)) : R;
        voffA[i] = (unsigned)(R * K + C) * 2u; voffB[i] = (unsigned)(Rb * K + C) * 2u; }
    const size_t kstep = (size_t)(BK * 2);
    const size_t hstep = (size_t)HALF * K * 2;
        const unsigned ldsw = (unsigned)wid * 1024u;
    const int aoff = lds_byte(wr * 64 + fr, fq * 8), boff = lds_byte(wc * 32 + fr, fq * 8);
#define PG8_SA(b, h) (((b) * 2 + (h)) * HTB)
#define PG8_SB(b, h) ((4 + (b) * 2 + (h)) * HTB)
#define PG8_STAGE(bufoff, gbase, voff) do { _Pragma("unroll") for (int _i = 0; _i < 2; ++_i) \
        __builtin_amdgcn_global_load_lds((const unsigned*)((const char*)(gbase) + (voff)[_i]), (PG8_LAS unsigned*)(lds + (bufoff) + ldsw + _i * 8192), 16, 0, 0); } while (0)
#define PG8_LDA(dst, b, h) do { _Pragma("unroll") for (int m = 0; m < 4; ++m) _Pragma("unroll") for (int k = 0; k < 2; ++k) dst[m][k] = *(const PG8_LAS bf16x8*)(lds + PG8_SA(b, h) + aoff + m * 2048 + k * 1024); } while (0)
#define PG8_LDB(dst, b, h) do { _Pragma("unroll") for (int n = 0; n < 2; ++n) _Pragma("unroll") for (int k = 0; k < 2; ++k) dst[n][k] = *(const PG8_LAS bf16x8*)(lds + PG8_SB(b, h) + boff + n * 2048 + k * 1024); } while (0)
#define PG8_MMA(ai, bj, At, Bt) do { __builtin_amdgcn_s_setprio(1); _Pragma("unroll") for (int m = 0; m < 4; ++m) _Pragma("unroll") for (int n = 0; n < 2; ++n) _Pragma("unroll") for (int k = 0; k < 2; ++k) \
        acc[ai][bj][m][n] = __builtin_amdgcn_mfma_f32_16x16x32_bf16(Bt[n][k], At[m][k], acc[ai][bj][m][n], 0, 0, 0); __builtin_amdgcn_s_setprio(0); } while (0)
#define PG8_WAIT_V(n) asm volatile("s_waitcnt vmcnt(" #n ")" ::: "memory")
#define PG8_WAIT_L(n) asm volatile("s_waitcnt lgkmcnt(" #n ")" ::: "memory")
#define PG8_BAR __builtin_amdgcn_s_barrier()
#define PG8_SCHED __builtin_amdgcn_sched_barrier(0)
    Unit cur, nxt; int ui = 0;
    if (!S.next(0, cur)) return;
    f32x4 acc[2][2][4][2];
#pragma unroll
    for (int a = 0; a < 2; ++a)
#pragma unroll
        for (int b = 0; b < 2; ++b)
#pragma unroll
            for (int m = 0; m < 4; ++m)
#pragma unroll
                for (int n = 0; n < 2; ++n) acc[a][b][m][n] = (f32x4){0.f, 0.f, 0.f, 0.f};
    bf16x8 At[4][2], B0[2][2], B1[2][2];
    const char* cA = cur.A; const char* cB = cur.B;
    S.a_ready(cur);
    if constexpr (SP2) {
        PG8_STAGE(PG8_SB(0, 0), cB, voffB); PG8_STAGE(PG8_SB(0, 1), cB + hstep, voffB); PG8_STAGE(PG8_SA(0, 0), cA, voffA); PG8_STAGE(PG8_SA(0, 1), cA + hstep, voffA);
        if (wr == 1) PG8_BAR;
        PG8_WAIT_V(2); PG8_BAR;
        PG8_STAGE(PG8_SB(1, 0), cB + kstep, voffB); PG8_STAGE(PG8_SA(1, 0), cA + kstep, voffA); PG8_STAGE(PG8_SB(1, 1), cB + hstep + kstep, voffB);
        PG8_WAIT_V(6); PG8_BAR;
    } else {
        PG8_STAGE(PG8_SB(0, 0), cB, voffB); PG8_STAGE(PG8_SA(0, 0), cA, voffA); PG8_STAGE(PG8_SB(0, 1), cB + hstep, voffB); PG8_STAGE(PG8_SA(0, 1), cA + hstep, voffA);
        if (wr == 1) PG8_BAR;
        PG8_WAIT_V(4); PG8_BAR;
        PG8_STAGE(PG8_SB(1, 0), cB + kstep, voffB); PG8_STAGE(PG8_SA(1, 0), cA + kstep, voffA); PG8_STAGE(PG8_SB(1, 1), cB + hstep + kstep, voffB);
        PG8_WAIT_V(6); PG8_BAR;
    }
    for (;;) {
        const bool has_next = S.next(ui + 1, nxt);
        const char* nA = has_next ? nxt.A : cA; const char* nB = has_next ? nxt.B : cB;
        for (int t = 0; t < nt; t += 2) {
            const bool last = (t == nt - 2);
            const char* a1 = cA + (size_t)(t + 1) * kstep;
            const char* a2 = last ? nA : cA + (size_t)(t + 2) * kstep; const char* b2 = last ? nB : cB + (size_t)(t + 2) * kstep;
            const char* a3 = a2 + kstep; const char* b3 = b2 + kstep;
            if (last && has_next) S.a_ready(nxt);
            if constexpr (SP2) {
            PG8_LDB(B0, 0, 0); PG8_LDB(B1, 0, 1); PG8_SCHED; PG8_LDA(At, 0, 0); PG8_STAGE(PG8_SA(1, 1), a1 + hstep, voffA);
            PG8_WAIT_V(8); PG8_WAIT_L(0); PG8_BAR; PG8_MMA(0, 0, At, B0); PG8_MMA(0, 1, At, B1); PG8_BAR; PG8_SCHED;
            PG8_LDA(At, 0, 1); PG8_STAGE(PG8_SB(0, 0), b2, voffB); PG8_STAGE(PG8_SB(0, 1), b2 + hstep, voffB); PG8_STAGE(PG8_SA(0, 0), a2, voffA);
            PG8_WAIT_V(8); PG8_WAIT_L(0); PG8_BAR; PG8_MMA(1, 0, At, B0); PG8_MMA(1, 1, At, B1); PG8_BAR; PG8_SCHED;
            PG8_LDB(B0, 1, 0); PG8_LDB(B1, 1, 1); PG8_SCHED; PG8_LDA(At, 1, 0); PG8_STAGE(PG8_SA(0, 1), a2 + hstep, voffA);
            PG8_WAIT_V(8); PG8_WAIT_L(0); PG8_BAR; PG8_MMA(0, 0, At, B0); PG8_MMA(0, 1, At, B1); PG8_BAR; PG8_SCHED;
            PG8_LDA(At, 1, 1); PG8_STAGE(PG8_SB(1, 0), b3, voffB); PG8_STAGE(PG8_SB(1, 1), b3 + hstep, voffB); PG8_STAGE(PG8_SA(1, 0), a3, voffA);
            PG8_WAIT_V(8); PG8_WAIT_L(0); PG8_BAR; PG8_MMA(1, 0, At, B0); PG8_MMA(1, 1, At, B1); PG8_BAR; PG8_SCHED;
            } else {
            PG8_LDB(B0, 0, 0); PG8_SCHED; PG8_LDA(At, 0, 0); PG8_STAGE(PG8_SA(1, 1), a1 + hstep, voffA);
            PG8_WAIT_L(8); PG8_BAR; PG8_WAIT_L(0); PG8_MMA(0, 0, At, B0); PG8_BAR; PG8_SCHED;
            PG8_LDB(B1, 0, 1); PG8_STAGE(PG8_SB(0, 0), b2, voffB);
            PG8_BAR; PG8_WAIT_L(0); PG8_MMA(0, 1, At, B1); PG8_BAR;
            PG8_LDA(At, 0, 1); PG8_STAGE(PG8_SA(0, 0), a2, voffA);
            PG8_BAR; PG8_WAIT_L(0); PG8_MMA(1, 0, At, B0); PG8_BAR; PG8_SCHED;
            PG8_STAGE(PG8_SB(0, 1), b2 + hstep, voffB);
            PG8_WAIT_V(6); PG8_BAR; PG8_MMA(1, 1, At, B1); PG8_BAR;
            PG8_LDB(B0, 1, 0); PG8_SCHED; PG8_LDA(At, 1, 0); PG8_STAGE(PG8_SA(0, 1), a2 + hstep, voffA);
            PG8_WAIT_L(8); PG8_BAR; PG8_WAIT_L(0); PG8_MMA(0, 0, At, B0); PG8_BAR; PG8_SCHED;
            PG8_LDB(B1, 1, 1); PG8_STAGE(PG8_SB(1, 0), b3, voffB);
            PG8_BAR; PG8_WAIT_L(0); PG8_MMA(0, 1, At, B1); PG8_BAR;
            PG8_LDA(At, 1, 1); PG8_STAGE(PG8_SA(1, 0), a3, voffA);
            PG8_BAR; PG8_WAIT_L(0); PG8_MMA(1, 0, At, B0); PG8_BAR; PG8_SCHED;
            PG8_STAGE(PG8_SB(1, 1), b3 + hstep, voffB);
            PG8_WAIT_V(6); PG8_BAR; PG8_MMA(1, 1, At, B1); PG8_BAR;
            }
        }
        if constexpr (ALIGN_EPI) { if (wr == 0) PG8_BAR; }
        if constexpr (!Epi::AFTER_DRAIN) { E(acc, cur, wr, wc, fr, fq); S.done(cur); }
        if (!has_next) break;
        if (E.zero_after(cur)) {
#pragma unroll
        for (int a = 0; a < 2; ++a)
#pragma unroll
            for (int b = 0; b < 2; ++b)
#pragma unroll
                for (int m = 0; m < 4; ++m)
#pragma unroll
                    for (int n = 0; n < 2; ++n) acc[a][b][m][n] = (f32x4){0.f, 0.f, 0.f, 0.f};
        }
        cur = nxt; cA = nA; cB = nB; ++ui;
        if constexpr (ALIGN_EPI) { if (wr == 1) PG8_BAR; }
    }
    PG8_WAIT_V(0);
    if constexpr (!ALIGN_EPI) { if (wr == 0) PG8_BAR; }
    PG8_BAR;
    if constexpr (Epi::AFTER_DRAIN) { E.fused(acc, cur, wr, wc, fr, fq, lds, wid, lane); S.done(cur); }
#undef PG8_SA
#undef PG8_SB
#undef PG8_STAGE
#undef PG8_LDA
#undef PG8_LDB
#undef PG8_MMA
#undef PG8_WAIT_V
#undef PG8_WAIT_L
#undef PG8_BAR
#undef PG8_SCHED
}
}
__host__ __device__ __forceinline__ int sigma_col(int rho) { const int j = rho & 3, fq = (rho >> 2) & 3, n = (rho >> 4) & 1, wc = (rho >> 5) & 3, bj = rho >> 7; return wc * 64 + bj * 32 + fq * 8 + n * 4 + j; }
namespace pg8 {
struct SchedGrid {
    const char* A0; const char* B0; const char* A1; const char* B1; size_t tstep; int nM, nN, nwg, G, c, segs, pad;
    __device__ __forceinline__ void init(const void* A0_, const void* B0_, const void* A1_, const void* B1_, int M, int N, int K, int segs_, int G_, int c_) {
        A0 = (const char*)A0_; B0 = (const char*)B0_; A1 = (const char*)A1_; B1 = (const char*)B1_; tstep = (size_t)BM * K * 2; nM = M / BM; nN = N / BM; nwg = nM * nN; G = G_; c = c_; segs = segs_; pad = 0; }
    __device__ __forceinline__ bool next(int i, Unit& u) const {
        const int seg = (segs == 2) ? (i & 1) : 0, it = (segs == 2) ? (i >> 1) : i;
        const long L = (long)it * G + c; if (L >= nwg) return false;
        int wgid = (int)L; { const int q = nwg / NXCD, r = nwg % NXCD, xcd = wgid % NXCD, off = wgid / NXCD; wgid = (xcd < r ? xcd * (q + 1) : r * (q + 1) + (xcd - r) * q) + off; }
        const int nig = WGM * nN, gid = wgid / nig, fm = gid * WGM, gsz = (nM - fm) < WGM ? (nM - fm) : WGM;
        u.pm = fm + ((wgid % nig) % gsz); u.pn = (wgid % nig) / gsz; u.seg = seg; u.pad = 0;
        u.A = (seg ? A1 : A0) + (size_t)u.pm * tstep; u.B = (seg ? B1 : B0) + (size_t)u.pn * tstep; return true;
    }
    __device__ __forceinline__ void a_ready(const Unit&) const {}
    __device__ __forceinline__ void done(const Unit&) const {}
};
__device__ __forceinline__ u32x4 pack8(const f32x4& a, const f32x4& b) { u32x4 w; w.x = cvt_pk_bf16(a[0], a[1]); w.y = cvt_pk_bf16(a[2], a[3]); w.z = cvt_pk_bf16(b[0], b[1]); w.w = cvt_pk_bf16(b[2], b[3]); return w; }
__device__ __forceinline__ float bflo(unsigned w) { return __builtin_bit_cast(float, w << 16); }
__device__ __forceinline__ float bfhi(unsigned w) { return __builtin_bit_cast(float, w & 0xffff0000u); }
__device__ __forceinline__ float sigm(float v) { return __builtin_amdgcn_rcpf(1.0f + __expf(-v)); }

struct EpiInProj {
    static constexpr bool PERM = false, AFTER_DRAIN = false;
    const float* r1; const float* qnw; const float* knw; const float* ropec; const float* ropes; const float* merge_b; char* ws; float* kmean; int skip_km;
    __device__ __forceinline__ bool zero_after(const Unit&) const { return true; }
    __device__ __forceinline__ void operator()(f32x4 (&acc)[2][2][4][2], const Unit& u, int wr, int wc, int fr, int fq) const {
        const int pn = u.pn, rowb = u.pm * BM + wr * 64 + fr;
        if (pn < 4) {
            const bool isq = pn < 2; const float* nw = isq ? qnw : knw; const float sc = isq ? 0.125f * 1.4426950408889634f : 1.0f;
            bf16_t* dst = (bf16_t*)(ws + (isq ? OFF_Q : OFF_K)) + (pn & 1) * 256 + wc * 64 + 8 * fq;
            f32x4 nwv[2][2], ks[2][2];
#pragma unroll
            for (int bj = 0; bj < 2; ++bj)
#pragma unroll
                for (int n = 0; n < 2; ++n) { nwv[bj][n] = *(const f32x4*)(nw + 32 * bj + 8 * fq + 4 * n); ks[bj][n] = (f32x4){0.f, 0.f, 0.f, 0.f}; }
#pragma unroll
            for (int ai = 0; ai < 2; ++ai)
#pragma unroll
                for (int m = 0; m < 4; ++m) {
                    const int row = rowb + ai * HALF + m * 16; const float r = r1[row]; const int pos = row & 4095;
                    f32x4 v[2][2]; float ss = 0.f;
#pragma unroll
                    for (int bj = 0; bj < 2; ++bj)
#pragma unroll
                        for (int n = 0; n < 2; ++n) { v[bj][n] = acc[ai][bj][m][n] * r; ss += (v[bj][n][0] * v[bj][n][0] + v[bj][n][1] * v[bj][n][1]) + (v[bj][n][2] * v[bj][n][2] + v[bj][n][3] * v[bj][n][3]); }
                    ss += __shfl_xor(ss, 16); ss += __shfl_xor(ss, 32);
                    const float rstd = rsqrtf(ss * (1.0f / 64.0f) + 1e-6f);
#pragma unroll
                    for (int bj = 0; bj < 2; ++bj)
#pragma unroll
                        for (int n = 0; n < 2; ++n) v[bj][n] = v[bj][n] * rstd * nwv[bj][n];
#pragma unroll
                    for (int n = 0; n < 2; ++n) {
                        const f32x4 cs = *(const f32x4*)(ropec + pos * 8 + 4 * n), sn = *(const f32x4*)(ropes + pos * 8 + 4 * n);
#pragma unroll
                        for (int j = 0; j < 4; ++j) { const float mine = v[0][n][j], oth = __shfl_xor(mine, 16);
                            const float rot = (fq == 0) ? (mine * cs[j] - oth * sn[j]) : (mine * cs[j] + oth * sn[j]);
                            v[0][n][j] = (fq < 2) ? rot : mine; }
                    }
#pragma unroll
                    for (int bj = 0; bj < 2; ++bj) {
                        const u32x4 w = pack8(v[bj][0] * sc, v[bj][1] * sc);
                        *(u32x4*)(dst + (size_t)row * 512 + 32 * bj) = w;
                        if (!isq) { ks[bj][0] += (f32x4){bflo(w.x), bfhi(w.x), bflo(w.y), bfhi(w.y)}; ks[bj][1] += (f32x4){bflo(w.z), bfhi(w.z), bflo(w.w), bfhi(w.w)}; }
                    }
                }
            if (!isq) {
#pragma unroll
                for (int bj = 0; bj < 2; ++bj)
#pragma unroll
                    for (int n = 0; n < 2; ++n)
#pragma unroll
                        for (int j = 0; j < 4; ++j) { float s = ks[bj][n][j]; s += __shfl_xor(s, 1); s += __shfl_xor(s, 2); s += __shfl_xor(s, 4); s += __shfl_xor(s, 8); ks[bj][n][j] = s; }
                if (fr == 0 && !skip_km) {
                    const int b = u.pm >> 4, blk = u.pm & 15, head = (pn & 1) * 4 + wc;
                    float* km = kmean + ((size_t)(b * 8 + head) * 16 + blk) * 64 + 8 * fq;
#pragma unroll
                    for (int bj = 0; bj < 2; ++bj)
#pragma unroll
                        for (int n = 0; n < 2; ++n)
#pragma unroll
                            for (int j = 0; j < 4; ++j) atomicAdd(km + 32 * bj + 4 * n + j, ks[bj][n][j] * (1.0f / 256.0f));
                }
            }
        } else {
            size_t off; int ld = 512, cb, type = 2; const float* bias = nullptr;
            if (pn < 6) { off = OFF_V; cb = (pn - 4) * 256; } else if (pn < 8) { off = OFF_MQ; cb = (pn - 6) * 256; } else if (pn < 10) { off = OFF_MK; cb = (pn - 8) * 256; }
            else if (pn < 12) { off = OFF_MV; cb = (pn - 10) * 256; } else if (pn < 14) { off = OFF_MO; cb = (pn - 12) * 256; type = 3; }
            else if (pn < 18) { off = OFF_GA; cb = (pn - 14) * 256; ld = 1024; type = 4; bias = merge_b + cb; } else { off = OFF_GM; cb = (pn - 18) * 256; ld = 1024; type = 4; bias = merge_b + 1024 + cb; }
            const int cl = wc * 64 + 8 * fq;
            bf16_t* dst = (bf16_t*)(ws + off) + cb + cl;
            f32x4 bv[2][2];
#pragma unroll
            for (int bj = 0; bj < 2; ++bj)
#pragma unroll
                for (int n = 0; n < 2; ++n) bv[bj][n] = (type == 4) ? *(const f32x4*)(bias + cl + 32 * bj + 4 * n) : (f32x4){0.f, 0.f, 0.f, 0.f};
#pragma unroll
            for (int ai = 0; ai < 2; ++ai)
#pragma unroll
                for (int m = 0; m < 4; ++m) {
                    const int row = rowb + ai * HALF + m * 16; const float r = r1[row];
#pragma unroll
                    for (int bj = 0; bj < 2; ++bj) {
                        f32x4 v0 = acc[ai][bj][m][0] * r + bv[bj][0], v1 = acc[ai][bj][m][1] * r + bv[bj][1];
                        if (type >= 3) {
#pragma unroll
                            for (int j = 0; j < 4; ++j) { v0[j] = sigm(v0[j]); v1[j] = sigm(v1[j]); } }
                        *(u32x4*)(dst + (size_t)row * ld + 32 * bj) = pack8(v0, v1);
                    }
                }
        }
    }
};
struct EpiBranch {
    static constexpr bool PERM = false, AFTER_DRAIN = false;
    const bf16_t* ga; const bf16_t* gm; bf16_t* y;
    __device__ __forceinline__ bool zero_after(const Unit& u) const { return u.seg == 1; }
    __device__ __forceinline__ void operator()(f32x4 (&acc)[2][2][4][2], const Unit& u, int wr, int wc, int fr, int fq) const {
        const int rowb = u.pm * BM + wr * 64 + fr, col0 = u.pn * BM + wc * 64 + 8 * fq;
#pragma unroll
        for (int ai = 0; ai < 2; ++ai)
#pragma unroll
            for (int m = 0; m < 4; ++m) {
                const size_t ro = (size_t)(rowb + ai * HALF + m * 16) * 1024 + col0;
#pragma unroll
                for (int bj = 0; bj < 2; ++bj) {
                    const u32x4 gmw = *(const u32x4*)(gm + ro + 32 * bj);
                    const f32x4 m0 = (f32x4){bflo(gmw.x), bfhi(gmw.x), bflo(gmw.y), bfhi(gmw.y)}, m1 = (f32x4){bflo(gmw.z), bfhi(gmw.z), bflo(gmw.w), bfhi(gmw.w)};
                    if (u.seg == 0) {
                        const u32x4 gaw = *(const u32x4*)(ga + ro + 32 * bj);
                        const f32x4 a0 = (f32x4){bflo(gaw.x), bfhi(gaw.x), bflo(gaw.y), bfhi(gaw.y)}, a1 = (f32x4){bflo(gaw.z), bfhi(gaw.z), bflo(gaw.w), bfhi(gaw.w)};
#pragma unroll
                        for (int j = 0; j < 4; ++j) { acc[ai][bj][m][0][j] *= a0[j] * __builtin_amdgcn_rcpf(m0[j]); acc[ai][bj][m][1][j] *= a1[j] * __builtin_amdgcn_rcpf(m1[j]); }
                    } else {
                        *(u32x4*)(y + ro + 32 * bj) = pack8(acc[ai][bj][m][0] * m0, acc[ai][bj][m][1] * m1);
                    }
                }
            }
    }
};
struct EpiOut {
    static constexpr bool PERM = false, AFTER_DRAIN = false;
    const float* x; float* out; bf16_t* x1b; float* rowss;
    __device__ __forceinline__ bool zero_after(const Unit&) const { return true; }
    __device__ __forceinline__ void operator()(f32x4 (&acc)[2][2][4][2], const Unit& u, int wr, int wc, int fr, int fq) const {
        const int rowb = u.pm * BM + wr * 64 + fr, col0 = u.pn * BM + wc * 64 + 8 * fq;
#pragma unroll
        for (int ai = 0; ai < 2; ++ai)
#pragma unroll
            for (int m = 0; m < 4; ++m) {
                const int row = rowb + ai * HALF + m * 16; const size_t ro = (size_t)row * 1024 + col0; float ss = 0.f;
#pragma unroll
                for (int bj = 0; bj < 2; ++bj) {
                    const f32x4 v0 = acc[ai][bj][m][0] + *(const f32x4*)(x + ro + 32 * bj), v1 = acc[ai][bj][m][1] + *(const f32x4*)(x + ro + 32 * bj + 4);
                    *(u32x4*)(x1b + ro + 32 * bj) = pack8(v0, v1);
                    ss += (v0[0] * v0[0] + v0[1] * v0[1]) + (v0[2] * v0[2] + v0[3] * v0[3]) + (v1[0] * v1[0] + v1[1] * v1[1]) + (v1[2] * v1[2] + v1[3] * v1[3]);
                }
                ss += __shfl_xor(ss, 16); ss += __shfl_xor(ss, 32);
                if (fq == 0) rowss[(size_t)row * 16 + u.pn * 4 + wc] = ss;
            }
    }
};
}
#include <hip/hip_bf16.h>
#include <cmath>
namespace attn_body {
using bf16=__hip_bfloat16;
using bf16x8=__attribute__((ext_vector_type(8)))short;
using s16x4=__attribute__((ext_vector_type(4)))short;
using f32x16=__attribute__((ext_vector_type(16)))float;
using u32x4=__attribute__((ext_vector_type(4)))unsigned;
using f32x4_t=__attribute__((ext_vector_type(4)))float;
constexpr int BATCH=16,NHEAD=8,SEQ=4096,D=64,DM=NHEAD*D;
constexpr int NW=8,QBLK=32,QB=QBLK*NW,KVBLK=64,NQB=SEQ/QB;
constexpr int ATTN_PITCH=DM, ATTN_UNIT_ROWS=QB;
__device__ __forceinline__ int crow(int r,int hi){return (r&3)+8*(r>>2)+4*hi;}
#define SBAR() __builtin_amdgcn_sched_barrier(0)
__device__ __forceinline__ void cmask(f32x16&p0,f32x16&p1,int jb,int qrel,int hi){
  const float NEG=-INFINITY; int kb=64*jb+4*hi;
  #pragma unroll
  for(int r=0;r<16;++r){int kv=kb+(r&3)+8*(r>>2); if(kv>qrel)p0[r]=NEG; if(kv+32>qrel)p1[r]=NEG;}
}

constexpr int NSLOT=3, SLOTB=8192;
constexpr int LDS_K=0, LDS_V=NSLOT*SLOTB, LDS_WS=2*NSLOT*SLOTB, LDS_OST=LDS_WS+NW*64*4, LDS_BYTES=LDS_OST+NW*4096;
constexpr float C2=0.125f*1.4426950408889634f;
__device__ __forceinline__ void glds16(const void*gsrc,unsigned lds_dst){unsigned keep;
  asm volatile("s_mov_b32 %0, m0\n\ts_mov_b32 m0, %2\n\ts_nop 0\n\tglobal_load_lds_dwordx4 %1, off\n\ts_mov_b32 m0, %0":"=&s"(keep):"v"(gsrc),"s"(lds_dst):"memory");}
__device__ __forceinline__ float max3f(float a,float b,float c){float r;asm("v_max3_f32 %0, %1, %2, %3":"=v"(r):"v"(a),"v"(b),"v"(c));return r;}
__device__ __forceinline__ float max2f(float a,float b){float r;asm("v_max_f32_e32 %0, %1, %2":"=v"(r):"v"(a),"v"(b));return r;}
__device__ __forceinline__ float fadd_s(float a,float b){float r;asm("v_add_f32_e32 %0, %1, %2":"=v"(r):"v"(a),"v"(b));return r;}
__device__ __forceinline__ float fsub_s(float a,float b){float r;asm("v_sub_f32_e32 %0, %1, %2":"=v"(r):"v"(a),"v"(b));return r;}
typedef float f32x2_t __attribute__((ext_vector_type(2))); typedef __bf16 bf16x2_t __attribute__((ext_vector_type(2)));
__device__ __forceinline__ unsigned cvtpk_s(float lo,float hi){f32x2_t v={lo,hi};bf16x2_t b=__builtin_convertvector(v,bf16x2_t);return __builtin_bit_cast(unsigned,b);}
#define WAIT_BAR(N) asm volatile("s_waitcnt vmcnt(" #N ") lgkmcnt(0)\n\ts_barrier":::"memory")

__device__ __forceinline__ void qkt(f32x16&p0,f32x16&p1,const char*Kslot,const bf16x8*qr,const f32x16&negm,int r32,int hi){
  const char*kb=Kslot+hi*1024+r32*16;
  #pragma unroll
  for(int d0=0;d0<4;++d0){
    const bf16x8 b0=*reinterpret_cast<const bf16x8*>(kb+d0*2048);
    const bf16x8 b1=*reinterpret_cast<const bf16x8*>(kb+d0*2048+512);
    if(d0==0){p0=__builtin_amdgcn_mfma_f32_32x32x16_bf16(b0,qr[0],negm,0,0,0);p1=__builtin_amdgcn_mfma_f32_32x32x16_bf16(b1,qr[0],negm,0,0,0);}
    else{p0=__builtin_amdgcn_mfma_f32_32x32x16_bf16(b0,qr[d0],p0,0,0,0);p1=__builtin_amdgcn_mfma_f32_32x32x16_bf16(b1,qr[d0],p1,0,0,0);}}
}
typedef __attribute__((address_space(3))) const char* lds_cptr;
typedef short v4i16_t __attribute__((ext_vector_type(4)));
__device__ __forceinline__ void kload8(bf16x8*kf,lds_cptr kp){
  kf[0]=*(const __attribute__((address_space(3))) bf16x8*)(kp);      kf[1]=*(const __attribute__((address_space(3))) bf16x8*)(kp+512);
  kf[2]=*(const __attribute__((address_space(3))) bf16x8*)(kp+2048); kf[3]=*(const __attribute__((address_space(3))) bf16x8*)(kp+2560);
  kf[4]=*(const __attribute__((address_space(3))) bf16x8*)(kp+4096); kf[5]=*(const __attribute__((address_space(3))) bf16x8*)(kp+4608);
  kf[6]=*(const __attribute__((address_space(3))) bf16x8*)(kp+6144); kf[7]=*(const __attribute__((address_space(3))) bf16x8*)(kp+6656);
}
__device__ __forceinline__ void kload2(bf16x8*kf,lds_cptr kp,int j){ kf[2*j]=*(const __attribute__((address_space(3))) bf16x8*)(kp+j*2048); kf[2*j+1]=*(const __attribute__((address_space(3))) bf16x8*)(kp+j*2048+512); }
__device__ __forceinline__ s16x4 vtr(lds_cptr p){ return __builtin_bit_cast(s16x4,__builtin_amdgcn_ds_read_tr16_b64_v4i16((__attribute__((address_space(3))) v4i16_t*)p)); }
__device__ __forceinline__ float rowmax(const f32x16&p0,const f32x16&p1){
  float a=max3f(p0[0],p0[1],p1[0]),b=max3f(p0[2],p0[3],p1[1]);a=max3f(a,p1[2],p1[3]);
  #pragma unroll
  for(int r=4;r<16;r+=4){a=max3f(a,p0[r],p0[r+1]);b=max3f(b,p0[r+2],p0[r+3]);a=max3f(a,p1[r],p1[r+1]);b=max3f(b,p1[r+2],p1[r+3]);}
  const float m=max2f(a,b);
  auto rr=__builtin_amdgcn_permlane32_swap(__float_as_uint(m),__float_as_uint(m),false,false);
  return max2f(__uint_as_float(rr[0]),__uint_as_float(rr[1]));
}
__device__ __forceinline__ void pv(f32x16*o,int vb,bf16x8 pa0,bf16x8 pa1,bf16x8 pa2,bf16x8 pa3){
  #pragma unroll
  for(int d0=0;d0<2;++d0){s16x4 lo[4],hi[4];
    #pragma unroll
    for(int ks=0;ks<4;++ks){
      asm volatile("ds_read_b64_tr_b16 %0,%1 offset:%c2":"=&v"(lo[ks]):"v"(vb),"i"(d0*4096+ks*1024):"memory");
      asm volatile("ds_read_b64_tr_b16 %0,%1 offset:%c2":"=&v"(hi[ks]):"v"(vb),"i"(d0*4096+ks*1024+512):"memory");}
    asm volatile("s_waitcnt lgkmcnt(0)":::"memory");SBAR();
    #define PK(k) (bf16x8){lo[k][0],lo[k][1],lo[k][2],lo[k][3],hi[k][0],hi[k][1],hi[k][2],hi[k][3]}
    o[d0]=__builtin_amdgcn_mfma_f32_32x32x16_bf16(pa0,PK(0),o[d0],0,0,0);
    o[d0]=__builtin_amdgcn_mfma_f32_32x32x16_bf16(pa1,PK(1),o[d0],0,0,0);
    o[d0]=__builtin_amdgcn_mfma_f32_32x32x16_bf16(pa2,PK(2),o[d0],0,0,0);
    o[d0]=__builtin_amdgcn_mfma_f32_32x32x16_bf16(pa3,PK(3),o[d0],0,0,0);
    #undef PK
  }
}

#ifndef ATTN_STORE16
#define ATTN_STORE16(p,v) (*(u32x4*)(p)=(v))
#endif
template<int THRL> __device__ __forceinline__ void attn_unit(int b,int h,int qb,const bf16*Q,const bf16*__restrict__ K,const bf16*__restrict__ V,bf16*O,char*shm){
  int tid=threadIdx.x; asm volatile("":"+v"(tid)); const int lane=tid&63,r32=lane&31,hi=lane>>5; const int wid=__builtin_amdgcn_readfirstlane(tid>>6);
  const long rowbase=(long)b*SEQ; const int q0=qb*QB;
  const bf16*Qw=Q+(rowbase+q0+wid*QBLK)*DM+h*D;
  const bf16*Kh=K+rowbase*DM+h*D,*Vh=V+rowbase*DM+h*D;
  const unsigned lds0=(unsigned)(uintptr_t)shm;
  float*wsf=(float*)(shm+LDS_WS)+wid*64;
  const bf16*ksrc=Kh+(long)lane*DM+wid*8;
  const bf16*vsrc=Vh+(long)(16*(wid&3)+(lane>>2))*DM+(wid>>2)*32+(lane&3)*8;
  const unsigned kdst=lds0+LDS_K+wid*1024, vdst=lds0+LDS_V+wid*1024;
  #define TM(t) (((t)<4)?(NT-4+(t)):((t)-4))
  #define DMA_K(t,slot) glds16(ksrc+(long)TM(t)*KVBLK*DM,(unsigned)__builtin_amdgcn_readfirstlane(kdst+(slot)))
  #define DMA_V(t,slot) glds16(vsrc+(long)TM(t)*KVBLK*DM,(unsigned)__builtin_amdgcn_readfirstlane(vdst+(slot)))
  const int vb0=(int)(lds0+LDS_V)+((lane>>4)&1)*32+(lane&3)*8+(4*hi+((lane&15)>>2))*64;
  const char*Kbase=shm+LDS_K; bf16x8 kf[8];
  const lds_cptr shm3=(lds_cptr)shm; const lds_cptr kp0=shm3+LDS_K+hi*1024+r32*16; const lds_cptr vp0=shm3+LDS_V+((lane>>4)&1)*32+(lane&3)*8+(4*hi+((lane&15)>>2))*64;
  const int NT=(q0+QB)/KVBLK;
  DMA_K(0,0);DMA_V(0,0);DMA_K(1,SLOTB);
  bf16x8 qr[4];
  #pragma unroll
  for(int d0=0;d0<4;++d0)qr[d0]=*reinterpret_cast<const bf16x8*>(&Qw[(long)r32*DM+d0*16+hi*8]);
  #define SELK(tt) (((tt)<4)||((((const unsigned*)(shm+LDS_BYTES))[wid*QBLK+r32]>>(((tt)-4)>>2))&1u))
  float mhat=0.f,l_reg=0.f;f32x16 o[2];o[0]=f32x16{};o[1]=f32x16{};f32x16 negm=f32x16{};asm volatile("":"+v"(negm));
  const int qrel=wid*QBLK+r32;
  #define CMASK(P0,P1,t) do{int jb_=(t); if(jb_<4)cmask(P0,P1,jb_,qrel,hi); else { const bool keep_=SELK(jb_); _Pragma("unroll") for(int r=0;r<16;++r){P0[r]=keep_?P0[r]:-INFINITY;P1[r]=keep_?P1[r]:-INFINITY;} } }while(0)
  bool resc=false;
  #define START(P0,P1) do{ const float rm=rowmax(P0,P1); resc=false; \
    { const float dl=rm; mhat=fadd_s(mhat,dl); \
      _Pragma("unroll") for(int r=0;r<16;++r){P0[r]=fsub_s(P0[r],dl);P1[r]=fsub_s(P1[r],dl);} \
      _Pragma("unroll") for(int r=0;r<16;++r)negm[r]=-mhat; asm volatile("":"+v"(negm)); } \
    _Pragma("unroll") for(int r=0;r<16;++r)P0[r]=__builtin_amdgcn_exp2f(P0[r]); }while(0)
  #define RESC() do{ if(resc){ asm volatile("s_waitcnt lgkmcnt(0)":::"memory"); \
      _Pragma("unroll") for(int d_=0;d_<2;++d_) _Pragma("unroll") for(int r=0;r<16;++r)o[d_][r]*=wsf[crow(r,hi)]; } }while(0)
  f32x16 pA0,pA1,pB0,pB1;
  int sl_prev=0,sl_cur=0,sl_next=SLOTB;
  #define ROT() do{sl_prev=sl_cur;sl_cur=sl_next;sl_next=(sl_next==(NSLOT-1)*SLOTB)?0:sl_next+SLOTB;}while(0)
  DMA_K(2,2*SLOTB);
  WAIT_BAR(3);
  qkt(pA0,pA1,Kbase,qr,negm,r32,hi);asm volatile("s_nop 15\n\ts_nop 7":"+v"(pA0),"+v"(pA1));CMASK(pA0,pA1,0);
  START(pA0,pA1);
  _Pragma("unroll") for(int r=0;r<16;++r)pA1[r]=__builtin_amdgcn_exp2f(pA1[r]);
  WAIT_BAR(0);
  DMA_K(3,0);DMA_V(1,SLOTB);
  ROT();
  kload8(kf,kp0+sl_cur);
  WAIT_BAR(2);
  s16x4 vlo[8],vhi[8]; u32x4 pw0,pw1,pw2,pw3;
  #define PKW(P,B) cvtpk_s(P[B],P[B+1])
  #define PAF(k) __builtin_bit_cast(bf16x8,pw##k)
  #define VFR(i) (bf16x8){vlo[i][0],vlo[i][1],vlo[i][2],vlo[i][3],vhi[i][0],vhi[i][1],vhi[i][2],vhi[i][3]}
  #define PIN(x) asm volatile("":"+v"(x))
  #define MX3(a,b,c) __builtin_fmaxf(__builtin_fmaxf((a),(b)),(c))
  #define GAPA(MF,A0,A1,A2,A3,W0,W1,PW) do{ MF; sacc+=A0; sacc+=A1; sacc+=A2; sacc+=A3; PIN(sacc); W0; W1; PIN(PW); SBAR(); }while(0)
  #define EX(v) __builtin_amdgcn_exp2f(v)
  #define GAPB(MF,X,B) do{ MF; X[B]=EX(X[B]); X[B+1]=EX(X[B+1]); X[B+2]=EX(X[B+2]); X[B+3]=EX(X[B+3]); PIN(X); SBAR(); }while(0)
  #define VRD(i) do{ vlo[i]=vtr(vp_+(((i)>>2)*4096+((i)&3)*1024)); vhi[i]=vtr(vp_+(((i)>>2)*4096+((i)&3)*1024+512)); }while(0)
  #define KRD(G,j) do{ if(G){ kload2(kf,kp0+sl_next,j); SBAR(); } }while(0)
  #define STEP(C0,C1,P0,P1,t,GK,GV,GL) do{ SBAR(); \
    const lds_cptr vp_=vp0+sl_prev; \
    VRD(0); SBAR(); float sacc=(P0[0]+P0[1]); \
    GAPA(C0=__builtin_amdgcn_mfma_f32_32x32x16_bf16(kf[0],qr[0],negm,0,0,0), P0[2],P0[3],P0[4],P0[5],     pw0[0]=PKW(P0,0), pw0[1]=PKW(P0,2), pw0); \
    VRD(4); SBAR(); GAPA(C1=__builtin_amdgcn_mfma_f32_32x32x16_bf16(kf[1],qr[0],negm,0,0,0), P0[6],P0[7],P0[8],P0[9],     pw0[2]=PKW(P0,4), pw0[3]=PKW(P0,6), pw0); \
    VRD(1); SBAR(); GAPA(C0=__builtin_amdgcn_mfma_f32_32x32x16_bf16(kf[2],qr[1],C0,0,0,0),   P0[10],P0[11],P0[12],P0[13], pw1[0]=PKW(P0,8), pw1[1]=PKW(P0,10), pw1); \
    VRD(5); SBAR(); GAPA(C1=__builtin_amdgcn_mfma_f32_32x32x16_bf16(kf[3],qr[1],C1,0,0,0),   P0[14],P0[15],P1[0],P1[1],   pw1[2]=PKW(P0,12),pw1[3]=PKW(P0,14), pw1); \
    VRD(2); SBAR(); GAPA(C0=__builtin_amdgcn_mfma_f32_32x32x16_bf16(kf[4],qr[2],C0,0,0,0),   P1[2],P1[3],P1[4],P1[5],     pw2[0]=PKW(P1,0), pw2[1]=PKW(P1,2), pw2); \
    VRD(6); SBAR(); GAPA(C1=__builtin_amdgcn_mfma_f32_32x32x16_bf16(kf[5],qr[2],C1,0,0,0),   P1[6],P1[7],P1[8],P1[9],     pw2[2]=PKW(P1,4), pw2[3]=PKW(P1,6), pw2); \
    VRD(3); SBAR(); GAPA(C0=__builtin_amdgcn_mfma_f32_32x32x16_bf16(kf[6],qr[3],C0,0,0,0),   P1[10],P1[11],P1[12],P1[13], pw3[0]=PKW(P1,8), pw3[1]=PKW(P1,10), pw3); \
    VRD(7); SBAR(); GAPA(C1=__builtin_amdgcn_mfma_f32_32x32x16_bf16(kf[7],qr[3],C1,0,0,0),   P1[14],P1[15],0.f,0.f,       pw3[2]=PKW(P1,12),pw3[3]=PKW(P1,14), pw3); \
    l_reg+=sacc; \
    if(GK){DMA_K((t)+3,sl_cur);} if(GV){DMA_V((t)+1,sl_next);} \
    CMASK(C0,C1,t); \
    { float a=MX3(C0[0],C0[1],C1[0]),b=MX3(C0[2],C0[3],C1[1]); a=MX3(a,C1[2],C1[3]); \
      _Pragma("unroll") for(int r=4;r<16;r+=4){a=MX3(a,C0[r],C0[r+1]);b=MX3(b,C0[r+2],C0[r+3]);a=MX3(a,C1[r],C1[r+1]);b=MX3(b,C1[r+2],C1[r+3]);} \
      float rm=__builtin_fmaxf(a,b); { auto rr=__builtin_amdgcn_permlane32_swap(__float_as_uint(rm),__float_as_uint(rm),false,false); rm=__builtin_fmaxf(__uint_as_float(rr[0]),__uint_as_float(rr[1])); } \
      resc=false; \
      if(__builtin_expect(__any(rm>(float)THRL),0)){ const float dl=__builtin_fmaxf(rm,0.f); mhat+=dl; \
        _Pragma("unroll") for(int r=0;r<16;++r){C0[r]-=dl;C1[r]-=dl;} \
        _Pragma("unroll") for(int r=0;r<16;++r)negm[r]=-mhat; asm volatile("":"+v"(negm)); \
        const float f=__builtin_amdgcn_exp2f(-dl); l_reg*=f; if(hi==0)wsf[r32]=f; resc=true; } } \
    SBAR(); \
    GAPB(o[0]=__builtin_amdgcn_mfma_f32_32x32x16_bf16(PAF(0),VFR(0),o[0],0,0,0), C0,0); \
    GAPB(o[1]=__builtin_amdgcn_mfma_f32_32x32x16_bf16(PAF(0),VFR(4),o[1],0,0,0), C0,4); \
    KRD(GL,0); GAPB(o[0]=__builtin_amdgcn_mfma_f32_32x32x16_bf16(PAF(1),VFR(1),o[0],0,0,0), C0,8); \
    KRD(GL,1); GAPB(o[1]=__builtin_amdgcn_mfma_f32_32x32x16_bf16(PAF(1),VFR(5),o[1],0,0,0), C0,12); \
    KRD(GL,2); GAPB(o[0]=__builtin_amdgcn_mfma_f32_32x32x16_bf16(PAF(2),VFR(2),o[0],0,0,0), C1,0); \
    KRD(GL,3); GAPB(o[1]=__builtin_amdgcn_mfma_f32_32x32x16_bf16(PAF(2),VFR(6),o[1],0,0,0), C1,4); \
    GAPB(o[0]=__builtin_amdgcn_mfma_f32_32x32x16_bf16(PAF(3),VFR(3),o[0],0,0,0), C1,8); \
    GAPB(o[1]=__builtin_amdgcn_mfma_f32_32x32x16_bf16(PAF(3),VFR(7),o[1],0,0,0), C1,12); \
    }while(0)
  int t=1;
  for(;t+5<NT;t+=2){
    STEP(pB0,pB1,pA0,pA1,t,true,true,true);     WAIT_BAR(2); RESC(); ROT();
    STEP(pA0,pA1,pB0,pB1,t+1,true,true,true);   WAIT_BAR(2); RESC(); ROT();
  }
  #define ENDW(tt) do{ if((tt)+3<NT){WAIT_BAR(2);} else if((tt)+2<NT){WAIT_BAR(1);} else {WAIT_BAR(0);} }while(0)
  for(;t+1<NT;t+=2){
    STEP(pB0,pB1,pA0,pA1,t,(t+3<NT),(t+1<NT),(t+1<NT));       ENDW(t);   RESC(); ROT();
    STEP(pA0,pA1,pB0,pB1,t+1,(t+4<NT),(t+2<NT),(t+2<NT));     ENDW(t+1); RESC(); ROT();
  }
  STEP(pB0,pB1,pA0,pA1,NT-1,false,false,false); RESC();
  { float sacc=pB0[0]+pB0[1]; _Pragma("unroll") for(int r=2;r<16;++r)sacc+=pB0[r]; _Pragma("unroll") for(int r=0;r<16;++r)sacc+=pB1[r]; l_reg+=sacc;
    pw0=(u32x4){PKW(pB0,0),PKW(pB0,2),PKW(pB0,4),PKW(pB0,6)};pw1=(u32x4){PKW(pB0,8),PKW(pB0,10),PKW(pB0,12),PKW(pB0,14)};pw2=(u32x4){PKW(pB1,0),PKW(pB1,2),PKW(pB1,4),PKW(pB1,6)};pw3=(u32x4){PKW(pB1,8),PKW(pB1,10),PKW(pB1,12),PKW(pB1,14)};
    SBAR(); pv(o,vb0+sl_cur,PAF(0),PAF(1),PAF(2),PAF(3)); }
  #undef PKW
  #undef PAF
  #undef VFR
  #undef PIN
  #undef MX3
  #undef GAPA
  #undef GAPB
  #undef EX
  #undef VRD
  #undef KRD
  #undef STEP
  #undef ENDW
  {auto rr=__builtin_amdgcn_permlane32_swap(__float_as_uint(l_reg),__float_as_uint(l_reg),false,false);l_reg=__uint_as_float(rr[0])+__uint_as_float(rr[1]);}
  if(hi==0)wsf[32+r32]=l_reg;asm volatile("s_waitcnt lgkmcnt(0)":::"memory");
  float rli[16];
  #pragma unroll
  for(int r=0;r<16;++r)rli[r]=__builtin_amdgcn_rcpf(wsf[32+crow(r,hi)]);
  bf16*Ow=O+(rowbase+q0+wid*QBLK)*DM+h*D;
  { bf16*stg=(bf16*)(shm+LDS_OST)+wid*2048;
    #pragma unroll
    for(int r=0;r<16;++r){const int orow=crow(r,hi);
      #pragma unroll
      for(int d0=0;d0<2;++d0)stg[orow*64+d0*32+r32]=__float2bfloat16(o[d0][r]*rli[r]);}
    asm volatile("s_waitcnt lgkmcnt(0)":::"memory");
    #pragma unroll
    for(int i=0;i<4;++i){const int row=i*8+(lane>>3),ch=lane&7; const u32x4 v=*(const u32x4*)(stg+row*64+ch*8); ATTN_STORE16(Ow+(long)row*DM+ch*8,v);} }
  asm volatile("s_waitcnt lgkmcnt(0)\n\ts_barrier":::"memory");
  #undef DMA_K
  #undef TM
  #undef SELK
  #undef DMA_V
  #undef CMASK
  #undef START
  #undef RESC
  #undef ROT
}

__device__ __forceinline__ void moba_gate(int b,int h,int qb,const bf16*Q,const float*__restrict__ kmean,char*shm){
  int tid=threadIdx.x; asm volatile("":"+v"(tid));
  if(tid<QB){
    unsigned selmask=0u;
    if(qb>0){
      const unsigned short*qrow=(const unsigned short*)Q+((long)b*SEQ+qb*QB+tid)*DM+h*D;
      const float*kmb=kmean+(long)((b*NHEAD+h)*16)*64;
      float g0=-INFINITY,g1=-INFINITY,g2=-INFINITY; int i0=-1,i1=-1,i2=-1;
      for(int n=0;n<qb;++n){
        float g=0.f;
        #pragma unroll
        for(int c=0;c<8;++c){
          const u32x4 qv=*reinterpret_cast<const u32x4*>(qrow+c*8);
          const f32x4_t ka=*reinterpret_cast<const f32x4_t*>(kmb+n*64+c*8), kb=*reinterpret_cast<const f32x4_t*>(kmb+n*64+c*8+4);
          g+=__builtin_bit_cast(float,qv.x<<16)*ka[0]; g+=__builtin_bit_cast(float,qv.x&0xffff0000u)*ka[1];
          g+=__builtin_bit_cast(float,qv.y<<16)*ka[2]; g+=__builtin_bit_cast(float,qv.y&0xffff0000u)*ka[3];
          g+=__builtin_bit_cast(float,qv.z<<16)*kb[0]; g+=__builtin_bit_cast(float,qv.z&0xffff0000u)*kb[1];
          g+=__builtin_bit_cast(float,qv.w<<16)*kb[2]; g+=__builtin_bit_cast(float,qv.w&0xffff0000u)*kb[3];
        }
        if(g>g0){g2=g1;i2=i1;g1=g0;i1=i0;g0=g;i0=n;} else if(g>g1){g2=g1;i2=i1;g1=g;i1=n;} else if(g>g2){g2=g;i2=n;}
      }
      if(i0>=0)selmask|=1u<<i0; if(i1>=0)selmask|=1u<<i1; if(i2>=0)selmask|=1u<<i2;
    }
    { int t2=tid; asm volatile("":"+v"(t2)); ((unsigned*)(shm+LDS_BYTES))[t2]=selmask; }
  }
  asm volatile("s_waitcnt lgkmcnt(0)\n\ts_barrier":::"memory");
}
constexpr int ATTN_LDS_BYTES=LDS_BYTES;
struct AttnTensors { const bf16* Q; const bf16* K; const bf16* V; bf16* O; const float* kmean; };
struct AttnUnit { int bh; int qb; };
struct StaticOrder {
  int vcu;
  __device__ __forceinline__ explicit StaticOrder(int grid,int block):vcu((block%8)*(grid/8)+block/8){}
  __device__ __forceinline__ bool next(int i,AttnUnit&u)const{ if(i>=8)return false; const int half=vcu&1; u.bh=vcu>>1;
    const int pr=3-(i>>1);
    u.qb=(i&1)?(half?(4*pr+1):(4*pr)):(half?(4*pr+2):(4*pr+3)); return true; }
  __device__ __forceinline__ void a_ready(const AttnUnit&)const{}
  __device__ __forceinline__ void done(const AttnUnit&)const{}
};
struct QueueOrder {
  unsigned* ctr; volatile __attribute__((address_space(3))) unsigned* slot;
  __device__ __forceinline__ bool next(int,AttnUnit&u)const{
    if(threadIdx.x==0)*slot=__hip_atomic_fetch_add(ctr,1u,__ATOMIC_RELAXED,__HIP_MEMORY_SCOPE_AGENT);
    __syncthreads(); const unsigned k=*slot; __syncthreads();
    if(k>=2048u)return false; u.qb=15-(int)(k>>7); u.bh=(int)(k&127u); return true; }
  __device__ __forceinline__ void a_ready(const AttnUnit&)const{}
  __device__ __forceinline__ void done(const AttnUnit&)const{}
};
template<class Sched,int THRL=8> __device__ __forceinline__ void attn_phase(char*lds,const AttnTensors&T,const Sched&S){
  AttnUnit u;
  for(int i=0;S.next(i,u);++i){ S.a_ready(u); moba_gate(u.bh/NHEAD,u.bh%NHEAD,u.qb,T.Q,T.kmean,lds); attn_unit<THRL>(u.bh/NHEAD,u.bh%NHEAD,u.qb,T.Q,T.K,T.V,T.O,lds); S.done(u); }
}
#undef SBAR
#undef WAIT_BAR
}
namespace mlstm {
#define ML_LAS __attribute__((address_space(3)))
typedef short bf16x8 __attribute__((ext_vector_type(8)));
typedef short s16x4 __attribute__((ext_vector_type(4)));
typedef float f32x4 __attribute__((ext_vector_type(4)));
typedef unsigned u32x4 __attribute__((ext_vector_type(4)));
typedef unsigned u32x2 __attribute__((ext_vector_type(2)));
constexpr int PQ = 272, PV = 336, PA = 144;
constexpr int O_QC = 0, O_KC = O_QC + 64 * PQ, O_HST = O_KC + 64 * PQ, O_VP = O_HST + 64 * PQ, O_VW = O_VP + 64 * PV, O_ST = O_VW + 64 * PV, O_AM = O_ST + 128 * PV,
              O_CW = O_AM + 64 * PA, O_EX = O_CW + 2 * 5 * 128 * 4, O_SCR = O_EX + 3 * 64 * 4, O_CH = O_SCR + 64 * 4, LDS_END = O_CH + 2 * 4 * 64 * 4;
static_assert(LDS_END <= 156 * 1024, "mlstm LDS");
struct Args { const bf16_t* mq; const bf16_t* mk; const bf16_t* mv; const bf16_t* mosig; const float* ifg; const float* conv_w; const float* conv_b; const float* nw; float* sca; float* scm; float* scb; bf16_t* hm; };
__device__ __forceinline__ s16x4 trd(const ML_LAS unsigned char* p) { return __builtin_bit_cast(s16x4, __builtin_amdgcn_ds_read_tr16_b64_v4i16((ML_LAS s16x4*)p)); }
__device__ __forceinline__ bf16x8 cat8(s16x4 lo, s16x4 hi) { return (bf16x8){lo[0], lo[1], lo[2], lo[3], hi[0], hi[1], hi[2], hi[3]}; }
__device__ __forceinline__ float blo(unsigned w) { return __builtin_bit_cast(float, w << 16); }
__device__ __forceinline__ float bhi(unsigned w) { return __builtin_bit_cast(float, w & 0xffff0000u); }
__device__ __forceinline__ float logsig(float f) { return (f >= 0.f) ? -log1pf(__expf(-f)) : f - log1pf(__expf(f)); }

__device__ __forceinline__ void unit(int b, int h, const Args& A, ML_LAS unsigned char* lds) {
    int tid = threadIdx.x; asm volatile("" : "+v"(tid)); const int lane = tid & 63, wid = __builtin_amdgcn_readfirstlane(tid >> 6);
    int tidv = tid; int l15 = tidv & 15, q4 = (tidv >> 4) & 3, d8 = tidv & 15, row0 = 2 * (tidv >> 4);
    const size_t tb = (size_t)b * 4096, sb = (size_t)(b * 4 + h) * 4096;
    ML_LAS float* cwl = (ML_LAS float*)(lds + O_CW); ML_LAS float* ex = (ML_LAS float*)(lds + O_EX); ML_LAS float* scr = (ML_LAS float*)(lds + O_SCR); ML_LAS float* chs = (ML_LAS float*)(lds + O_CH);
    for (int i = tid; i < 1280; i += 512) { const int qk = i / 640, r = (i % 640) >> 7, d = i & 127, ch = qk * 512 + h * 128 + d; cwl[i] = (r < 4) ? A.conv_w[r * 1024 + ch] : A.conv_b[ch]; }
    for (int i = tid; i < 128 * PV / 16; i += 512) *(ML_LAS u32x4*)(lds + O_ST + i * 16) = (u32x4){0u, 0u, 0u, 0u};
    if (tid < 256) { const int r = tid >> 2, part = tid & 3;
        *(ML_LAS u32x4*)(lds + O_VP + r * PV + 256 + part * 16) = (u32x4){part == 0 ? 0x3F80u : 0u, 0u, 0u, 0u};
        *(ML_LAS u32x4*)(lds + O_VW + r * PV + 256 + part * 16) = (u32x4){0u, 0u, 0u, 0u}; }
    {
        float lfv[8], av[8]; float run = 0.f;
#pragma unroll
        for (int j = 0; j < 8; ++j) { const float f = A.ifg[(tb + 8 * tid + j) * 8 + 4 + h]; run += logsig(f); lfv[j] = run; }
        float incl = run;
#pragma unroll
        for (int o = 1; o < 64; o <<= 1) { const float t = __shfl_up(incl, o); if (lane >= o) incl += t; }
        if (lane == 63) scr[wid] = incl;
        __syncthreads();
        float pre = incl - run; for (int w = 0; w < wid; ++w) pre += scr[w];
        float m = -INFINITY;
#pragma unroll
        for (int j = 0; j < 8; ++j) { const float Bv = pre + lfv[j]; const float a = A.ifg[(tb + 8 * tid + j) * 8 + h] - Bv; A.scb[sb + 8 * tid + j] = Bv; A.sca[sb + 8 * tid + j] = a; m = fmaxf(m, a); av[j] = m; }
        float im = m;
#pragma unroll
        for (int o = 1; o < 64; o <<= 1) { const float t = __shfl_up(im, o); if (lane >= o) im = fmaxf(im, t); }
        if (lane == 63) scr[8 + wid] = im;
        __syncthreads();
        float pm = __shfl_up(im, 1); if (lane == 0) pm = -INFINITY; pm = fmaxf(pm, 0.f); for (int w = 0; w < wid; ++w) pm = fmaxf(pm, scr[8 + w]);
#pragma unroll
        for (int j = 0; j < 8; ++j) A.scm[sb + 8 * tid + j] = fmaxf(pm, av[j]);
    }
    __threadfence(); __syncthreads();
    f32x4 accS[20];
#pragma unroll
    for (int v = 0; v < 20; ++v) accS[v] = (f32x4){0.f, 0.f, 0.f, 0.f};
    uint4 rq[5], rk[5], rv[2]; float chv = 0.f;
#define goff ((unsigned)(tb * 512) + h * 128 + 8 * d8)
#define ML_LOAD(c) do { const int c0_ = (c) * 64; \
        _Pragma("unroll") for (int j = 0; j < 5; ++j) { const int rr = c0_ + row0 - 3 + j; if (rr >= 0) { rq[j] = *(const uint4*)(A.mq + goff + rr * 512); rk[j] = *(const uint4*)(A.mk + goff + rr * 512); } else { rq[j] = make_uint4(0u, 0u, 0u, 0u); rk[j] = rq[j]; } } \
        _Pragma("unroll") for (int j = 0; j < 2; ++j) { rv[j] = *(const uint4*)(A.mv + goff + (c0_ + row0 + j) * 512); \
            } } while (0)
#define ML_LOADS(c) do { const int c0_ = (c) * 64; \
        if (tidv < 192) { chv = A.sca[(size_t)(tidv >> 6) * (16 * 4 * 4096) + sb + c0_ + (tidv & 63)]; }     else if (tidv == 192) chv = (c0_ == 0) ? 0.f : A.scm[sb + c0_ - 1]; } while (0)
    ML_LOAD(0); ML_LOADS(0);
    if (tidv < 193) chs[tidv] = chv;
    __syncthreads();
    for (int c = 0; c < 64; ++c) {
        asm volatile("" : "+v"(tidv)); l15 = tidv & 15; q4 = (tidv >> 4) & 3; d8 = l15; row0 = 2 * (tidv >> 4);
        const int c0 = c * 64; const ML_LAS float* ch = chs + (c & 1) * 256;
#pragma unroll
        for (int qk = 0; qk < 2; ++qk) {
            const ML_LAS float* wq = cwl + qk * 640 + 8 * d8;
            float y[2][8];
            { const f32x4 b0 = *(const ML_LAS f32x4*)(wq + 512), b1 = *(const ML_LAS f32x4*)(wq + 516);
#pragma unroll
              for (int e = 0; e < 4; ++e) { y[0][e] = b0[e]; y[0][4 + e] = b1[e]; y[1][e] = b0[e]; y[1][4 + e] = b1[e]; } }
#pragma unroll
            for (int j = 0; j < 4; ++j) {
                const f32x4 w0 = *(const ML_LAS f32x4*)(wq + j * 128), w1 = *(const ML_LAS f32x4*)(wq + j * 128 + 4);
#pragma unroll
                for (int ro = 0; ro < 2; ++ro) { const uint4 u = qk ? rk[ro + j] : rq[ro + j]; const unsigned uw[4] = {u.x, u.y, u.z, u.w};
                    y[ro][0] += w0[0] * blo(uw[0]); y[ro][1] += w0[1] * bhi(uw[0]); y[ro][2] += w0[2] * blo(uw[1]); y[ro][3] += w0[3] * bhi(uw[1]);
                    y[ro][4] += w1[0] * blo(uw[2]); y[ro][5] += w1[1] * bhi(uw[2]); y[ro][6] += w1[2] * blo(uw[3]); y[ro][7] += w1[3] * bhi(uw[3]); }
            }
#pragma unroll
            for (int ro = 0; ro < 2; ++ro) {
#pragma unroll
                for (int e = 0; e < 8; ++e) { y[ro][e] = y[ro][e] * __builtin_amdgcn_rcpf(1.0f + __expf(-y[ro][e])); if (qk) y[ro][e] *= 0.08838834764831845f; }
                *(ML_LAS u32x4*)(lds + (qk ? O_KC : O_QC) + (row0 + ro) * PQ + 16 * d8) = (u32x4){pk2(y[ro][0], y[ro][1]), pk2(y[ro][2], y[ro][3]), pk2(y[ro][4], y[ro][5]), pk2(y[ro][6], y[ro][7])};
            }
        }
#pragma unroll
        for (int ro = 0; ro < 2; ++ro) {
            *(ML_LAS u32x4*)(lds + O_VP + (row0 + ro) * PV + 16 * d8) = (u32x4){rv[ro].x, rv[ro].y, rv[ro].z, rv[ro].w};
            const float wsv = __expf(ch[row0 + ro] - ch[127]); const unsigned uw[4] = {rv[ro].x, rv[ro].y, rv[ro].z, rv[ro].w}; unsigned o[4];
#pragma unroll
            for (int e2 = 0; e2 < 4; ++e2) o[e2] = pk2(blo(uw[e2]) * wsv, bhi(uw[e2]) * wsv);
            *(ML_LAS u32x4*)(lds + O_VW + (row0 + ro) * PV + 16 * d8) = (u32x4){o[0], o[1], o[2], o[3]};
            if (d8 == 0) *(ML_LAS unsigned short*)(lds + O_VW + (row0 + ro) * PV + 256) = (unsigned short)f2bf(wsv);
        }
        __syncthreads();
        const float Mref = ch[192], Mend = ch[127];
        const int trow = 16 * (wid & 3) + 4 * q4;
        const f32x4 Mxr = *(const ML_LAS f32x4*)(ch + 64 + trow);
        if (wid < 4) {
#pragma unroll
            for (int v = 0; v < 10; ++v) accS[v] = (f32x4){0.f, 0.f, 0.f, 0.f};
#pragma unroll
            for (int ks = 0; ks < 4; ++ks) {
                const bf16x8 a = *(const ML_LAS bf16x8*)(lds + O_QC + (16 * wid + l15) * PQ + (32 * ks + 8 * q4) * 2);
                const ML_LAS unsigned char* bp = lds + O_ST + (32 * ks + 8 * q4 + (l15 >> 2)) * PV + (l15 & 3) * 8;
#pragma unroll
                for (int v = 0; v < 10; ++v) { const bf16x8 bfr = cat8(trd(bp + 32 * v), trd(bp + 4 * PV + 32 * v)); accS[v] = __builtin_amdgcn_mfma_f32_16x16x32_bf16(a, bfr, accS[v], 0, 0, 0); }
            }
            float wi[4];
#pragma unroll
            for (int i = 0; i < 4; ++i) wi[i] = __expf(Mref - Mxr[i]);
#pragma unroll
            for (int v = 0; v < 10; ++v)
#pragma unroll
                for (int i = 0; i < 4; ++i) accS[v][i] *= wi[i];
        } else {
            const int j = wid - 4;
#pragma unroll
            for (int tile = 0; tile < 16; ++tile) {
                if ((int)((0x3333322221120000ull >> (4 * tile)) & 15ull) != j) continue;
                const int st = tile >> 2, tt = tile & 3;
                f32x4 cacc = (f32x4){0.f, 0.f, 0.f, 0.f};
                if (st <= tt) {
#pragma unroll
                    for (int ks = 0; ks < 4; ++ks) {
                        const bf16x8 a = *(const ML_LAS bf16x8*)(lds + O_KC + (16 * st + l15) * PQ + (32 * ks + 8 * q4) * 2);
                        const bf16x8 bq = *(const ML_LAS bf16x8*)(lds + O_QC + (16 * tt + l15) * PQ + (32 * ks + 8 * q4) * 2);
                        cacc = __builtin_amdgcn_mfma_f32_16x16x32_bf16(a, bq, cacc, 0, 0, 0);
                    }
                }
                const int t = 16 * tt + l15, s0 = 16 * st + 4 * q4;
                const float Mt = ch[64 + t]; const f32x4 as = *(const ML_LAS f32x4*)(ch + s0);
                float o[4];
#pragma unroll
                for (int i = 0; i < 4; ++i) o[i] = (s0 + i <= t) ? cacc[i] * __expf(as[i] - Mt) : 0.f;
                *(ML_LAS u32x2*)(lds + O_AM + t * PA + s0 * 2) = (u32x2){pk2(o[0], o[1]), pk2(o[2], o[3])};
            }
            const float decay = __expf(Mref - Mend);
#pragma unroll
            for (int v = 0; v < 20; ++v) accS[v] = accS[v] * decay;
#pragma unroll
            for (int ks = 0; ks < 2; ++ks) {
                const ML_LAS unsigned char* kp = lds + O_KC + (32 * ks + 8 * q4 + (l15 >> 2)) * PQ + 64 * j + (l15 & 3) * 8;
                const bf16x8 bf0 = cat8(trd(kp), trd(kp + 4 * PQ)), bf1 = cat8(trd(kp + 32), trd(kp + 4 * PQ + 32));
                const ML_LAS unsigned char* ap = lds + O_VW + (32 * ks + 8 * q4 + (l15 >> 2)) * PV + (l15 & 3) * 8;
#pragma unroll
                for (int v = 0; v < 10; ++v) { const bf16x8 afr = cat8(trd(ap + 32 * v), trd(ap + 4 * PV + 32 * v));
                    accS[v] = __builtin_amdgcn_mfma_f32_16x16x32_bf16(afr, bf0, accS[v], 0, 0, 0); accS[10 + v] = __builtin_amdgcn_mfma_f32_16x16x32_bf16(afr, bf1, accS[10 + v], 0, 0, 0); }
            }
        }
        __syncthreads();
        if (c + 1 < 64) ML_LOADS(c + 1);
        if (wid < 4) {
#pragma unroll
            for (int ks = 0; ks < 2; ++ks) {
                const bf16x8 a = *(const ML_LAS bf16x8*)(lds + O_AM + (16 * wid + l15) * PA + (32 * ks + 8 * q4) * 2);
                const ML_LAS unsigned char* bp = lds + O_VP + (32 * ks + 8 * q4 + (l15 >> 2)) * PV + (l15 & 3) * 8;
#pragma unroll
                for (int v = 0; v < 10; ++v) { const bf16x8 bfr = cat8(trd(bp + 32 * v), trd(bp + 4 * PV + 32 * v)); accS[v] = __builtin_amdgcn_mfma_f32_16x16x32_bf16(a, bfr, accS[v], 0, 0, 0); }
            }
            const f32x4 Bcr = *(const ML_LAS f32x4*)(ch + 128 + trow);
#pragma unroll
            for (int i = 0; i < 4; ++i) {
                float ssum = 0.f;
#pragma unroll
                for (int v = 0; v < 8; ++v) ssum += accS[v][i] * accS[v][i];
                ssum += __shfl_xor(ssum, 1); ssum += __shfl_xor(ssum, 2); ssum += __shfl_xor(ssum, 4); ssum += __shfl_xor(ssum, 8);
                const float den = __shfl(accS[8][i], lane & 48);
                const float dn = fmaxf(fabsf(den), __expf(-(Bcr[i] + Mxr[i]))), idn = 1.0f / dn;
                const float sc = idn * rsqrtf(ssum * idn * idn * (1.0f / 128.0f) + 1e-6f);
#pragma unroll
                for (int v = 0; v < 8; ++v) *(ML_LAS unsigned short*)(lds + O_HST + (trow + i) * PQ + (16 * v + l15) * 2) = (unsigned short)f2bf(accS[v][i] * sc);
            }
        } else {
            const int j = wid - 4;
#pragma unroll
            for (int v = 0; v < 10; ++v) {
                *(ML_LAS u32x2*)(lds + O_ST + (32 * j + l15) * PV + (16 * v + 4 * q4) * 2) = (u32x2){pk2(accS[v][0], accS[v][1]), pk2(accS[v][2], accS[v][3])};
                *(ML_LAS u32x2*)(lds + O_ST + (32 * j + 16 + l15) * PV + (16 * v + 4 * q4) * 2) = (u32x2){pk2(accS[10 + v][0], accS[10 + v][1]), pk2(accS[10 + v][2], accS[10 + v][3])}; }
        }
        if (c + 1 < 64) ML_LOAD(c + 1);
        if (tidv < 193) chs[((c + 1) & 1) * 256 + tidv] = chv;
        uint4 rmo[2];
#pragma unroll
        for (int ro = 0; ro < 2; ++ro) rmo[ro] = *(const uint4*)(A.mosig + goff + (c0 + row0 + ro) * 512);
        __syncthreads();
        f32x4 nwv[2]; nwv[0] = *(const f32x4*)(A.nw + h * 128 + 8 * d8); nwv[1] = *(const f32x4*)(A.nw + h * 128 + 8 * d8 + 4);
#pragma unroll
        for (int ro = 0; ro < 2; ++ro) {
            const u32x4 hv = *(const ML_LAS u32x4*)(lds + O_HST + (row0 + ro) * PQ + 16 * d8); const unsigned hw[4] = {hv.x, hv.y, hv.z, hv.w}; const unsigned mw[4] = {rmo[ro].x, rmo[ro].y, rmo[ro].z, rmo[ro].w}; unsigned o[4];
#pragma unroll
            for (int e2 = 0; e2 < 4; ++e2) o[e2] = pk2(blo(hw[e2]) * nwv[(2 * e2) >> 2][(2 * e2) & 3] * blo(mw[e2]), bhi(hw[e2]) * nwv[(2 * e2 + 1) >> 2][(2 * e2 + 1) & 3] * bhi(mw[e2]));
            *(uint4*)(A.hm + goff + (c0 + row0 + ro) * 512) = make_uint4(o[0], o[1], o[2], o[3]);
        }
    }
#undef ML_LOAD
#undef ML_LOADS
#undef goff
    __syncthreads();
}
}
namespace peer {
#define PE_LAS __attribute__((address_space(3)))
typedef short bf16x8 __attribute__((ext_vector_type(8)));
typedef float f32x4 __attribute__((ext_vector_type(4)));
typedef float f32x16 __attribute__((ext_vector_type(16)));
typedef unsigned u32x4 __attribute__((ext_vector_type(4)));
constexpr int QP = 528;
constexpr int O_R2 = 256 * QP;
constexpr int LDS_END = O_R2 + 1024;
__device__ __forceinline__ int ordi(float f) { const int b = __builtin_bit_cast(int, f); return b ^ ((b >> 31) & 0x7FFFFFFF); }
__device__ __forceinline__ float ordf(int o) { return __builtin_bit_cast(float, o ^ ((o >> 31) & 0x7FFFFFFF)); }
#define PE_CE(a, b) do { const int hi_ = max(a, b), lo_ = min(a, b); a = hi_; b = lo_; } while (0)
__device__ __forceinline__ void sort16_desc(int (&a)[16]) {
#pragma unroll
    for (int k = 2; k <= 16; k <<= 1)
#pragma unroll
        for (int j = k >> 1; j > 0; j >>= 1)
#pragma unroll
            for (int i = 0; i < 16; ++i) { const int l = i ^ j; if (l > i) { if ((i & k) == 0) PE_CE(a[i], a[l]); else PE_CE(a[l], a[i]); } }
}
__device__ __forceinline__ void merge16_desc(int (&a)[16], const int (&b)[16]) {
#pragma unroll
    for (int i = 0; i < 16; ++i) a[i] = max(a[i], b[15 - i]);
#pragma unroll
    for (int j = 8; j > 0; j >>= 1)
#pragma unroll
        for (int i = 0; i < 16; ++i) { const int l = i ^ j; if (l > i) PE_CE(a[i], a[l]); }
}
__device__ __forceinline__ void top16_of_64(int (&g0)[16], int (&g1)[16], int (&g2)[16], int (&g3)[16]) {
    sort16_desc(g0); sort16_desc(g1); sort16_desc(g2); sort16_desc(g3);
    merge16_desc(g0, g1); merge16_desc(g2, g3); merge16_desc(g0, g2);
}
struct Args { const float* rowss; const bf16_t* key1; const bf16_t* key2; float* r2out; int* eidx; float* eg; };
struct EpiPeerQ {
    static constexpr bool PERM = false, AFTER_DRAIN = true;
    __device__ __forceinline__ bool zero_after(const pg8::Unit&) const { return true; }
    __device__ __forceinline__ void fused(pg8::f32x4 (&acc)[2][2][4][2], const pg8::Unit& u, int wr, int wc, int fr, int fq, PG8_LAS unsigned char* lds, int wid, int lane) const {
        const PE_LAS float* r2s = (const PE_LAS float*)(lds + O_R2);
#pragma unroll
        for (int ai = 0; ai < 2; ++ai)
#pragma unroll
            for (int m = 0; m < 4; ++m) { const int row = ai * 128 + wr * 64 + m * 16 + fr; const float r = r2s[row];
#pragma unroll
                for (int bj = 0; bj < 2; ++bj) *(PE_LAS u32x4*)(lds + row * QP + (wc * 64 + bj * 32 + 8 * fq) * 2) = pg8::pack8(acc[ai][bj][m][0] * r, acc[ai][bj][m][1] * r); }
    }
};
struct SchedOne { pg8::Unit u;
    __device__ __forceinline__ bool next(int i, pg8::Unit& o) const { if (i > 0) return false; o = u; return true; }
    __device__ __forceinline__ void a_ready(const pg8::Unit&) const {}
    __device__ __forceinline__ void done(const pg8::Unit&) const {} };

__device__ __forceinline__ void half_top16(int (&g0)[16], const PE_LAS unsigned char* qrow  , const bf16_t* keyrow  , int hi) {
    f32x16 s[4];
#pragma unroll
    for (int kb = 0; kb < 4; ++kb) s[kb] = f32x16{};
#pragma unroll
    for (int ks = 0; ks < 8; ++ks) {
        const bf16x8 bq = *(const PE_LAS bf16x8*)(qrow + ks * 32);
#pragma unroll
        for (int kb = 0; kb < 4; ++kb) { const bf16x8 a = *(const bf16x8*)(keyrow + (size_t)kb * 32 * 128 + ks * 16); s[kb] = __builtin_amdgcn_mfma_f32_32x32x16_bf16(a, bq, s[kb], 0, 0, 0); }
    }
    int g1[16], g2[16], g3[16];
#pragma unroll
    for (int r = 0; r < 16; ++r) { const int kr = (r & 3) + 8 * (r >> 2) + 4 * hi;
        g0[r] = (ordi(s[0][r]) & ~0x7F) | kr; g1[r] = (ordi(s[1][r]) & ~0x7F) | (32 + kr); g2[r] = (ordi(s[2][r]) & ~0x7F) | (64 + kr); g3[r] = (ordi(s[3][r]) & ~0x7F) | (96 + kr); }
    top16_of_64(g0, g1, g2, g3);
#pragma unroll
    for (int r = 0; r < 16; ++r) g1[r] = __shfl_xor(g0[r], 32);
    merge16_desc(g0, g1);
}

__device__ __forceinline__ void unit(int pm, int h, const bf16_t* x1b, const bf16_t* wq, const Args& A, PG8_LAS unsigned char* lds) {
    int tid = threadIdx.x; asm volatile("" : "+v"(tid)); const int wid = __builtin_amdgcn_readfirstlane(tid >> 6);
    if (tid < 256) { const f32x4* rs = (const f32x4*)(A.rowss + (size_t)(pm * 256 + tid) * 16); const f32x4 a = rs[0], b = rs[1], c = rs[2], d = rs[3];
        const float ss = ((a[0] + a[1]) + (a[2] + a[3])) + ((b[0] + b[1]) + (b[2] + b[3])) + ((c[0] + c[1]) + (c[2] + c[3])) + ((d[0] + d[1]) + (d[2] + d[3]));
        const float r = rsqrtf(ss * (1.0f / 1024.0f) + 1e-6f); ((PE_LAS float*)(lds + O_R2))[tid] = r; if (h == 0) A.r2out[pm * 256 + tid] = r; }
    __syncthreads();
    SchedOne S; S.u.pm = pm; S.u.pn = h; S.u.seg = 0; S.u.pad = 0; S.u.A = (const char*)(x1b + (size_t)pm * 256 * 1024); S.u.B = (const char*)(wq + (size_t)h * 256 * 1024);
    EpiPeerQ E;
    pg8::gemm_phase<EpiPeerQ, SchedOne, true, true>(lds, 1024, S, E);
    __syncthreads();
    int tv = tid; asm volatile("" : "+v"(tv)); const int r32 = tv & 31, hi = (tv >> 5) & 1;
    int v1[16], v2[16];
    half_top16(v1, lds + (32 * wid + r32) * QP + (8 * hi) * 2, A.key1 + ((size_t)h * 128 + r32) * 128 + 8 * hi, hi);
    half_top16(v2, lds + (32 * wid + r32) * QP + (128 + 8 * hi) * 2, A.key2 + ((size_t)h * 128 + r32) * 128 + 8 * hi, hi);
    float f1[16], f2[16];
#pragma unroll
    for (int i = 0; i < 16; ++i) { f1[i] = ordf(v1[i] & ~0x7F); f2[i] = ordf(v2[i] & ~0x7F); }
    int c0[16], c1[16], c2[16], c3[16];
    {
        int n = 0;
#pragma unroll
        for (int i = 0; i < 16; ++i)
#pragma unroll
            for (int j = 0; j < 16; ++j) if ((i + 1) * (j + 1) <= 16) { const int key = (ordi(f1[i] + f2[j]) & ~0xFF) | (i << 4) | j;
                if (n < 16) c0[n] = key; else if (n < 32) c1[n - 16] = key; else if (n < 48) c2[n - 32] = key; else c3[n - 48] = key; ++n; }
#pragma unroll
        for (int k = 2; k < 16; ++k) c3[k] = (int)0x80000000;
    }
    top16_of_64(c0, c1, c2, c3);
    PE_LAS unsigned char* scr = lds + (32 * wid + r32) * QP;
    if (hi == 0) {
#pragma unroll
        for (int i = 0; i < 16; ++i) { scr[i] = (unsigned char)(v1[i] & 0x7F); scr[16 + i] = (unsigned char)(v2[i] & 0x7F); } }
    asm volatile("s_waitcnt lgkmcnt(0)" ::: "memory");
    float val[16], sum = 0.f;
#pragma unroll
    for (int r = 0; r < 16; ++r) { val[r] = __expf(ordf(c0[r] & ~0xFF) - ordf(c0[0] & ~0xFF)); sum += val[r]; }
    const float inv = 1.0f / sum;
    const size_t ob = ((size_t)(pm * 256 + 32 * wid + r32) * 8 + h) * 16;
#pragma unroll
    for (int r = 0; r < 16; ++r) if ((r >> 3) == hi) { const int code = c0[r] & 0xFF; A.eidx[ob + r] = (int)scr[code >> 4] * 128 + (int)scr[16 + (code & 15)]; A.eg[ob + r] = val[r] * inv; }
    __syncthreads();
}
}
#define XB_TMO      128
#define XB_XCNT(j)  (256  + 64 * (j))
#define XB_XSUB(j)  (1280 + 64 * (j))
#define XB_XGEN(j)  (2304 + 64 * (j))
#define XB_TOP      3328
#define XB_TOPGEN   3392
#define XCD_BAR_WORDS 3456
#define XB_SPIN_CAP (1u << 18)

__device__ __forceinline__ unsigned xb_ld(unsigned* p)              { return __hip_atomic_load(p, __ATOMIC_RELAXED, __HIP_MEMORY_SCOPE_AGENT); }
__device__ __forceinline__ unsigned xb_add(unsigned* p, unsigned v) { return __hip_atomic_fetch_add(p, v, __ATOMIC_RELAXED, __HIP_MEMORY_SCOPE_AGENT); }
__device__ __forceinline__ unsigned xb_xcc_id() { return (unsigned)__builtin_amdgcn_s_getreg((3 << 11) | 20) & 0xFu; }
#define XB_SPIN(cond, bar) do { unsigned _sp = 0; while (cond) { __builtin_amdgcn_s_sleep(1); \
    if ((++_sp & 255u) == 0u) { if (xb_ld(&(bar)[XB_TMO])) break; if (_sp > XB_SPIN_CAP) { atomicAdd(&(bar)[XB_TMO], 1u); break; } } } } while (0)

struct XcdBarrier {
    unsigned* bar; unsigned x;
    volatile __attribute__((address_space(3))) unsigned* st;
};

__device__ __forceinline__ XcdBarrier xcd_barrier_post(unsigned* bar, volatile __attribute__((address_space(3))) unsigned* st) {
    XcdBarrier b; b.bar = bar; b.x = xb_xcc_id(); b.st = st;
    if (threadIdx.x == 0) (void)xb_add(&bar[XB_XCNT(b.x)], 1u);
    return b;
}
__device__ __forceinline__ void xcd_barrier_complete(unsigned* bar, unsigned x, unsigned& nloc, unsigned& nx) {
    const unsigned G = gridDim.x * gridDim.y * gridDim.z;
    unsigned sum, cnt, mine, sp = 0u;
    for (;;) {
        sum = 0u; cnt = 0u; mine = 0u;
#pragma unroll
        for (unsigned j = 0; j < 16; ++j) { const unsigned c = xb_ld(&bar[XB_XCNT(j)]); sum += c; cnt += (c > 0u) ? 1u : 0u; mine = (j == x) ? c : mine; }
        if (sum == G) break;
        __builtin_amdgcn_s_sleep(1);
        if ((++sp & 255u) == 0u) { if (xb_ld(&bar[XB_TMO])) break; if (sp > XB_SPIN_CAP) { atomicAdd(&bar[XB_TMO], 1u); break; } }
    }
    nloc = mine > 0u ? mine : 1u; nx = cnt > 0u ? cnt : 1u;
}

__device__ __forceinline__ void xcd_barrier(const XcdBarrier& b) {
    asm volatile("s_waitcnt vmcnt(0)" ::: "memory");
    __syncthreads();
    if (threadIdx.x == 0) {
        unsigned* bar = b.bar;
        __builtin_amdgcn_s_waitcnt(0);
        unsigned nloc = b.st[0], nx = b.st[1];
        if (nloc == 0u) { xcd_barrier_complete(bar, b.x, nloc, nx); b.st[0] = nloc; b.st[1] = nx; }
        const unsigned old = xb_add(&bar[XB_XSUB(b.x)], 1u);
        const unsigned gen = old / nloc;
        if (old + 1u == (gen + 1u) * nloc) {
            __builtin_amdgcn_fence(__ATOMIC_RELEASE, "agent");
            asm volatile("s_waitcnt vmcnt(0)" ::: "memory");
            const unsigned og = xb_add(&bar[XB_TOP], 1u);
            const unsigned tg = og / nx;
            if (og + 1u == (tg + 1u) * nx) xb_add(&bar[XB_TOPGEN], 1u);
            else XB_SPIN(xb_ld(&bar[XB_TOPGEN]) == tg, bar);
            __builtin_amdgcn_fence(__ATOMIC_ACQUIRE, "agent");
            xb_add(&bar[XB_XGEN(b.x)], 1u);
            asm volatile("s_waitcnt vmcnt(0)" ::: "memory");
        } else {
            XB_SPIN(xb_ld(&bar[XB_XGEN(b.x)]) == gen, bar);
            __builtin_amdgcn_fence(__ATOMIC_ACQUIRE, "agent");
            asm volatile("s_waitcnt vmcnt(0)" ::: "memory");
        }
    }
    __syncthreads();
}
#include <hip/hip_cooperative_groups.h>
namespace cg = cooperative_groups;
constexpr int BIG_LDS = 156 * 1024 + 256;
constexpr int LDS_CTL = 156 * 1024;
constexpr int DUP = 0;
struct PArgs { const float* in[20]; float* out; char* ws; };
__device__ __forceinline__ const PArgs* kargs() { auto kp = __builtin_amdgcn_kernarg_segment_ptr(); asm volatile("" : "+s"(kp)); return (const PArgs*)kp; }

__device__ __forceinline__ void phase0(const PArgs& p, unsigned char* shm) {
    int tid = threadIdx.x; asm volatile("" : "+v"(tid)); const int lane = tid & 63, wid = tid >> 6;
    const int gw = blockIdx.x * 8 + wid, NGW = gridDim.x * 8; const size_t gt = (size_t)blockIdx.x * 512 + tid, NTH = (size_t)gridDim.x * 512;
    char* ws = p.ws;
    { float* km = (float*)(ws + OFF_KMEAN); for (size_t i = gt; i < (size_t)16 * 8 * 16 * 64; i += NTH) km[i] = 0.f; }
    { float* rc = (float*)(ws + OFF_ROPE); float* rs = rc + 4096 * 8;
      for (size_t i = gt; i < 4096 * 8; i += NTH) { const int pos = (int)(i >> 3), k = (int)(i & 7); const float inv_freq = (float)pow(500000.0, -(double)(2 * k) / 16.0); const float ang = (float)pos * inv_freq;
          rc[i] = (float)cos((double)ang); rs[i] = (float)sin((double)ang); } }
    {
        const float* wdn = p.in[18]; const float* wup = p.in[19]; const float* fw = p.in[14]; unsigned* WU = (unsigned*)(ws + OFF_WU);
        { uint4* WDq = (uint4*)(ws + OFF_WD); float* SD = (float*)(ws + OFF_WD + 16 * MiB); float fv[16];
#pragma unroll
          for (int j = 0; j < 4; ++j) { const float4 s = *(const float4*)(fw + 16 * lane + 4 * j); fv[4 * j] = s.x; fv[4 * j + 1] = s.y; fv[4 * j + 2] = s.z; fv[4 * j + 3] = s.w; }
          for (int e = gw; e < 16384; e += NGW) { float v[16], am = 0.f;
#pragma unroll
              for (int j = 0; j < 4; ++j) { const float4 a = *(const float4*)(wdn + (size_t)e * 1024 + 16 * lane + 4 * j); v[4 * j] = a.x * fv[4 * j]; v[4 * j + 1] = a.y * fv[4 * j + 1]; v[4 * j + 2] = a.z * fv[4 * j + 2]; v[4 * j + 3] = a.w * fv[4 * j + 3]; }
              float ss = 0.f;
#pragma unroll
              for (int j = 0; j < 16; ++j) { am = fmaxf(am, fabsf(v[j])); ss += v[j] * v[j]; }
#pragma unroll
              for (int o = 32; o >= 1; o >>= 1) { am = fmaxf(am, __shfl_xor(am, o)); ss += __shfl_xor(ss, o); }
              const float step = fminf(am * (1.0f / 7.0f), 0.35f * sqrtf(ss * (1.0f / 1024.0f)));
              const float inv = step > 0.f ? 1.0f / step : 0.f; unsigned q[2] = {0u, 0u};
#pragma unroll
              for (int k = 0; k < 16; ++k) { const int qi = (int)fminf(fmaxf(rintf(v[k] * inv), -7.0f), 7.0f); q[k >> 3] |= (unsigned)(qi & 15) << (4 * (k & 7)); }
              ((uint2*)WDq)[(size_t)e * 64 + lane] = make_uint2(q[0], q[1]); if (lane == 0) SD[e] = step; } }
        { uint2* WU4 = (uint2*)WU; float* SU = (float*)(ws + OFF_WU + 16 * MiB);
          for (int e = gw; e < 16384; e += NGW) { float v[16], ss = 0.f;
#pragma unroll
              for (int j = 0; j < 4; ++j) { const float4 a = *(const float4*)(wup + (size_t)e * 1024 + 16 * lane + 4 * j); v[4 * j] = a.x; v[4 * j + 1] = a.y; v[4 * j + 2] = a.z; v[4 * j + 3] = a.w; }
#pragma unroll
              for (int j = 0; j < 16; ++j) ss += v[j] * v[j];
#pragma unroll
              for (int o = 32; o >= 1; o >>= 1) ss += __shfl_xor(ss, o);
              const float sc = 0.5f * sqrtf(ss * (1.0f / 1024.0f)), inv = sc > 0.f ? 1.0f / sc : 0.f; unsigned q[2] = {0u, 0u};
#pragma unroll
              for (int k = 0; k < 16; ++k) { const float a_ = fabsf(v[k]) * inv;
                  const unsigned code = (unsigned)(a_ > 0.25f) + (unsigned)(a_ > 0.75f) + (unsigned)(a_ > 1.25f) + (unsigned)(a_ > 1.75f) + (unsigned)(a_ > 2.5f) + (unsigned)(a_ > 3.5f) + (unsigned)(a_ > 5.0f);
                  q[k >> 3] |= (code | (v[k] < 0.f ? 8u : 0u)) << (4 * (k & 7)); }
              WU4[(size_t)e * 64 + lane] = make_uint2(q[0], q[1]); if (lane == 0) SU[e] = sc; } }
        const float* k1 = p.in[16]; const float* k2 = p.in[17]; bf16_t* K1 = (bf16_t*)(ws + OFF_KEY1); bf16_t* K2 = (bf16_t*)(ws + OFF_KEY2);
        for (size_t i = gt * 4; i < (size_t)8 * 128 * 128; i += NTH * 4) { const float4 a = *(const float4*)(k1 + i), b = *(const float4*)(k2 + i);
            *(uint2*)(K1 + i) = make_uint2(pk2(a.x, a.y), pk2(a.z, a.w)); *(uint2*)(K2 + i) = make_uint2(pk2(b.x, b.y), pk2(b.z, b.w)); }
    }
    {
        __attribute__((address_space(3))) float* tl = (__attribute__((address_space(3))) float*)(shm) + wid * (32 * 33);
        const int tx = lane & 31, ty = lane >> 5;
        for (int item = gw; item < 9728; item += NGW) {
            const float* W; const float* sc; bf16_t* O; int K, N, nbx, thr = 1 << 30, add = 0, it = item;
            if (it < 5632) { W = p.in[2]; sc = p.in[1]; O = (bf16_t*)(ws + OFF_WIN); K = 1024; N = INC; nbx = 176; thr = 3584; add = 8; }
            else if ((it -= 5632) < 512) { W = p.in[10]; sc = nullptr; O = (bf16_t*)(ws + OFF_WAB); K = 512; N = 1024; nbx = 32; }
            else if ((it -= 512) < 512) { W = p.in[11]; sc = nullptr; O = (bf16_t*)(ws + OFF_WMB); K = 512; N = 1024; nbx = 32; }
            else if ((it -= 512) < 1024) { W = p.in[13]; sc = nullptr; O = (bf16_t*)(ws + OFF_WOUT); K = 1024; N = 1024; nbx = 32; }
            else { it -= 1024; W = p.in[15]; sc = p.in[14]; O = (bf16_t*)(ws + OFF_WQ); K = 1024; N = 2048; nbx = 64; }
            const int n0 = (it % nbx) * 32, k0 = (it / nbx) * 32;
#pragma unroll 4
            for (int i = ty; i < 32; i += 2) { const int k = k0 + i, np = n0 + tx, ac = (np & ~255) + sigma_col(np & 255), src = ac + (ac >= thr ? add : 0); tl[i * 33 + tx] = W[(size_t)k * N + src] * (sc ? sc[k] : 1.0f); }
            asm volatile("s_waitcnt lgkmcnt(0)" ::: "memory");
#pragma unroll 4
            for (int i = ty; i < 32; i += 2) { const int np = n0 + i, k = k0 + tx; O[(size_t)np * K + k] = (bf16_t)f2bf(tl[tx * 33 + i]); }
            asm volatile("s_waitcnt lgkmcnt(0)" ::: "memory");
        }
    }
    {
        const float* x = p.in[0]; const float* normw = p.in[1]; const float* w_in = p.in[2]; const float* igb = p.in[7]; const float* fgb = p.in[8];
        bf16_t* xb = (bf16_t*)(ws + OFF_XB); float* r1 = (float*)(ws + OFF_R1); float* ifg = (float*)(ws + OFF_IFG);
        float wg[4][4][8];
#pragma unroll
        for (int j = 0; j < 4; ++j)
#pragma unroll
            for (int i = 0; i < 4; ++i) { const int k = 256 * j + 4 * lane + i; const float nw = normw[k];
#pragma unroll
                for (int c = 0; c < 8; ++c) wg[j][i][c] = w_in[(size_t)k * INC + 3584 + c] * nw; }
        for (int row = gw; row < T_; row += NGW) {
            const float4* xr = (const float4*)(x + (size_t)row * D_) + lane;
            float4 v[4];
#pragma unroll
            for (int j = 0; j < 4; ++j) v[j] = xr[64 * j];
            float ss = 0.f, g[8];
#pragma unroll
            for (int c = 0; c < 8; ++c) g[c] = 0.f;
#pragma unroll
            for (int j = 0; j < 4; ++j) {
                ss += v[j].x * v[j].x + v[j].y * v[j].y + v[j].z * v[j].z + v[j].w * v[j].w;
#pragma unroll
                for (int c = 0; c < 8; ++c) g[c] += v[j].x * wg[j][0][c] + v[j].y * wg[j][1][c] + v[j].z * wg[j][2][c] + v[j].w * wg[j][3][c];
            }
#pragma unroll
            for (int o = 1; o < 64; o <<= 1) { ss += __shfl_xor(ss, o);
#pragma unroll
                for (int c = 0; c < 8; ++c) g[c] += __shfl_xor(g[c], o); }
            const float r = rsqrtf(ss * (1.0f / D_) + 1e-6f);
            if (lane == 0) { r1[row] = r;
#pragma unroll
                for (int c = 0; c < 8; ++c) ifg[(size_t)row * 8 + c] = g[c] * r + (c < 4 ? igb[c] : fgb[c - 4]); }
            uint2* o8 = (uint2*)(xb + (size_t)row * D_) + lane;
#pragma unroll
            for (int j = 0; j < 4; ++j) o8[64 * j] = make_uint2(pk2(v[j].x, v[j].y), pk2(v[j].z, v[j].w));
        }
    }
}
typedef float f32x2_t __attribute__((ext_vector_type(2)));
typedef unsigned p5_u32x4 __attribute__((ext_vector_type(4)));
#define P5_LAS __attribute__((address_space(3)))
#define P5_TIE8(R) "+v"(R[0]), "+v"(R[1]), "+v"(R[2]), "+v"(R[3]), "+v"(R[4]), "+v"(R[5]), "+v"(R[6]), "+v"(R[7])
#define P5_OUT(I, ACC) do { const uint4 a_ = *((const uint4*)(x1b + (tb + I) * 2048) + 2 * ln), c_ = *((const uint4*)(x1b + (tb + I) * 2048) + 2 * ln + 1); const unsigned w_[8] = {a_.x, a_.y, a_.z, a_.w, c_.x, c_.y, c_.z, c_.w}; \
        float4* o_ = (float4*)(out + (tb + I) * 1024 + 16 * ln); \
        _Pragma("unroll") for (int j_ = 0; j_ < 4; ++j_) o_[j_] = make_float4(__builtin_bit_cast(float, w_[2 * j_] << 16) + ACC[2 * j_].x, __builtin_bit_cast(float, w_[2 * j_] & 0xffff0000u) + ACC[2 * j_].y, \
                                                                             __builtin_bit_cast(float, w_[2 * j_ + 1] << 16) + ACC[2 * j_ + 1].x, __builtin_bit_cast(float, w_[2 * j_ + 1] & 0xffff0000u) + ACC[2 * j_ + 1].y); } while (0)
typedef unsigned p5_u32x2 __attribute__((ext_vector_type(2)));
#define P5_ROWFMA4(ACC, PRV, R, CF) do { p5_u32x2 r__ = R;   \
    asm volatile("" : "+v"(r__), "+v"(PRV[0]), "+v"(PRV[1]), "+v"(PRV[2]), "+v"(PRV[3]), "+v"(PRV[4]), "+v"(PRV[5]), "+v"(PRV[6]), "+v"(PRV[7])); \
    const f32x2_t cf2_ = {CF, CF}; \
    ACC[0] = __builtin_elementwise_fma((f32x2_t)__builtin_amdgcn_cvt_scalef32_pk_f32_fp4(r__.x, 1.0f, 0), cf2_, ACC[0]); ACC[1] = __builtin_elementwise_fma((f32x2_t)__builtin_amdgcn_cvt_scalef32_pk_f32_fp4(r__.x, 1.0f, 1), cf2_, ACC[1]); \
    ACC[2] = __builtin_elementwise_fma((f32x2_t)__builtin_amdgcn_cvt_scalef32_pk_f32_fp4(r__.x, 1.0f, 2), cf2_, ACC[2]); ACC[3] = __builtin_elementwise_fma((f32x2_t)__builtin_amdgcn_cvt_scalef32_pk_f32_fp4(r__.x, 1.0f, 3), cf2_, ACC[3]); \
    ACC[4] = __builtin_elementwise_fma((f32x2_t)__builtin_amdgcn_cvt_scalef32_pk_f32_fp4(r__.y, 1.0f, 0), cf2_, ACC[4]); ACC[5] = __builtin_elementwise_fma((f32x2_t)__builtin_amdgcn_cvt_scalef32_pk_f32_fp4(r__.y, 1.0f, 1), cf2_, ACC[5]); \
    ACC[6] = __builtin_elementwise_fma((f32x2_t)__builtin_amdgcn_cvt_scalef32_pk_f32_fp4(r__.y, 1.0f, 2), cf2_, ACC[6]); ACC[7] = __builtin_elementwise_fma((f32x2_t)__builtin_amdgcn_cvt_scalef32_pk_f32_fp4(r__.y, 1.0f, 3), cf2_, ACC[7]); } while (0)
#define P5_BFMA8U(R, CK) do { _Pragma("unroll") for (int j_ = 0; j_ < 8; j_ += 4) { \
    { const float cf_ = __builtin_bit_cast(float, __builtin_amdgcn_readlane(CK, j_));     P5_ROWFMA4(acc0, acc3, R[j_], cf_); } \
    { const float cf_ = __builtin_bit_cast(float, __builtin_amdgcn_readlane(CK, j_ + 1)); P5_ROWFMA4(acc1, acc0, R[j_ + 1], cf_); } \
    { const float cf_ = __builtin_bit_cast(float, __builtin_amdgcn_readlane(CK, j_ + 2)); P5_ROWFMA4(acc2, acc1, R[j_ + 2], cf_); } \
    { const float cf_ = __builtin_bit_cast(float, __builtin_amdgcn_readlane(CK, j_ + 3)); P5_ROWFMA4(acc3, acc2, R[j_ + 3], cf_); } } } while (0)
#define P5_ISSUE8U(R, B, CK) do { const int lk_ = keys[8 * (B) + (ln & 7)]; CK = __builtin_bit_cast(int, cfs[8 * (B) + (ln & 7)]); \
    _Pragma("unroll") for (int j_ = 0; j_ < 8; ++j_) { const unsigned char* rp_ = wu + (size_t)__builtin_amdgcn_readlane(lk_, j_) * 512; \
        asm volatile("global_load_dwordx2 %0, %1, %2" : "=v"(R[j_]) : "v"(voff8), "s"(rp_) : "memory"); } } while (0)
#define P5_DOT(R, XH, XL) __builtin_amdgcn_sdot8((int)R.y, (int)XL.y, __builtin_amdgcn_sdot8((int)R.x, (int)XL.x, 16 * __builtin_amdgcn_sdot8((int)R.y, (int)XH.y, __builtin_amdgcn_sdot8((int)R.x, (int)XH.x, 0, false), false), false), false)
#define P5_ISSUE8D(R, B) do { const int lk_ = keys[8 * (B) + (ln & 7)]; \
    _Pragma("unroll") for (int j_ = 0; j_ < 8; ++j_) { const unsigned char* rp_ = wd + (size_t)__builtin_amdgcn_readlane(lk_, j_) * 512; \
        asm volatile("global_load_dwordx2 %0, %1, %2" : "=v"(R[j_]) : "v"(voff8), "s"(rp_) : "memory"); } } while (0)
#define P5_DOWN8(R, BB) do { int pd_[8]; \
    _Pragma("unroll") for (int j_ = 0; j_ < 8; j_ += 4) { pd_[j_] = P5_DOT(R[j_], xh0, xl0); pd_[j_ + 1] = P5_DOT(R[j_ + 1], xh1, xl1); pd_[j_ + 2] = P5_DOT(R[j_ + 2], xh2, xl2); pd_[j_ + 3] = P5_DOT(R[j_ + 3], xh3, xl3); } \
    _Pragma("unroll") for (int i_ = 0; i_ < 4; ++i_) { const auto r_ = __builtin_amdgcn_permlane32_swap((unsigned)pd_[i_], (unsigned)pd_[i_ + 4], false, false); pd_[i_] = (int)(r_[0] + r_[1]); } \
    _Pragma("unroll") for (int i_ = 0; i_ < 2; ++i_) { const auto r_ = __builtin_amdgcn_permlane16_swap((unsigned)pd_[i_], (unsigned)pd_[i_ + 2], false, false); pd_[i_] = (int)(r_[0] + r_[1]); } \
    { const bool b8_ = (ln & 8) != 0; const int keep_ = b8_ ? pd_[1] : pd_[0], send_ = b8_ ? pd_[0] : pd_[1]; int z_ = keep_ + __builtin_amdgcn_update_dpp(0, send_, 0x140, 0xf, 0xf, false); \
      z_ += __builtin_amdgcn_update_dpp(0, z_, 0x141, 0xf, 0xf, false); z_ += __builtin_amdgcn_update_dpp(0, z_, 0xB1, 0xf, 0xf, false); z_ += __builtin_amdgcn_update_dpp(0, z_, 0x4E, 0xf, 0xf, false); \
      zz = (ln & 7) == ((BB) & 7) ? z_ : zz; } \
    if (((BB) & 7) == 7) { const int pos_ = 8 * ((BB) - 7) + 8 * (ln & 7) + (ln >> 3); const int e_ = keys[pos_]; const float g_ = cfs[pos_]; const int tk_ = (ln >> 3) & 3; \
        const float sx_ = tk_ == 0 ? sx0 : tk_ == 1 ? sx1 : tk_ == 2 ? sx2 : sx3; const float av_ = (float)zz * sx_ * (float)sdl[e_]; \
        cfs[pos_] = g_ * 0.5f * av_ * (1.0f + erff(av_ * 0.70710678118654752f)) * (float)sul[e_]; } } while (0)
#define P5_PLOAD(TB) do { _Pragma("unroll") for (int i_ = 0; i_ < 4; ++i_) { const char* ep_ = eidx + ((TB) + i_) * 512; const char* cp_ = egp + ((TB) + i_) * 512; const char* xp_ = x1b + ((TB) + i_) * 2048; \
        asm volatile("global_load_dword %0, %6, %8\n\tglobal_load_dword %1, %6, %8 offset:256\n\tglobal_load_dword %2, %6, %9\n\tglobal_load_dword %3, %6, %9 offset:256\n\tglobal_load_dwordx4 %4, %7, %10\n\tglobal_load_dwordx4 %5, %7, %10 offset:16" \
                     : "=&v"(ev[i_][0]), "=&v"(ev[i_][1]), "=&v"(cv[i_][0]), "=&v"(cv[i_][1]), "=&v"(xr[i_][0]), "=&v"(xr[i_][1]) : "v"(voff4), "v"(voff32), "s"(ep_), "s"(cp_), "s"(xp_) : "memory"); } } while (0)
#define P5_QUANTR(I, XH, XL, SX, TB) do { const unsigned w_[8] = {xr[I][0].x, xr[I][0].y, xr[I][0].z, xr[I][0].w, xr[I][1].x, xr[I][1].y, xr[I][1].z, xr[I][1].w}; float xv_[16], am_ = 0.f; \
        _Pragma("unroll") for (int k_ = 0; k_ < 8; ++k_) { xv_[2 * k_] = __builtin_bit_cast(float, w_[k_] << 16); xv_[2 * k_ + 1] = __builtin_bit_cast(float, w_[k_] & 0xffff0000u); am_ = fmaxf(am_, fmaxf(fabsf(xv_[2 * k_]), fabsf(xv_[2 * k_ + 1]))); } \
        _Pragma("unroll") for (int o_ = 32; o_ >= 1; o_ >>= 1) am_ = fmaxf(am_, __builtin_bit_cast(float, __builtin_amdgcn_ds_bpermute(4 * (ln ^ o_), __builtin_bit_cast(int, am_)))); \
        const float inv_ = am_ > 0.f ? 119.0f / am_ : 0.f; unsigned h_[2] = {0u, 0u}, l_[2] = {0u, 0u}; \
        _Pragma("unroll") for (int k_ = 0; k_ < 16; ++k_) { const int q_ = (int)rintf(xv_[k_] * inv_); const int lo_ = ((q_ + 8) & 15) - 8, hi_ = (q_ - lo_) >> 4;     \
            h_[k_ >> 3] |= (unsigned)(hi_ & 15) << (4 * (k_ & 7)); l_[k_ >> 3] |= (unsigned)(lo_ & 15) << (4 * (k_ & 7)); } \
        XH = p5_u32x2{h_[0], h_[1]}; XL = p5_u32x2{l_[0], l_[1]}; SX = am_ * (1.0f / 119.0f) * r2[(TB) + I]; } while (0)
#define P5_PCOMP(KEYS, CFS, CNT, TB) do { \
        asm volatile("" : "+v"(ev[0][0]), "+v"(ev[0][1]), "+v"(ev[1][0]), "+v"(ev[1][1]), "+v"(ev[2][0]), "+v"(ev[2][1]), "+v"(ev[3][0]), "+v"(ev[3][1])); \
        asm volatile("" : "+v"(cv[0][0]), "+v"(cv[0][1]), "+v"(cv[1][0]), "+v"(cv[1][1]), "+v"(cv[2][0]), "+v"(cv[2][1]), "+v"(cv[3][0]), "+v"(cv[3][1])); \
        asm volatile("" : "+v"(xr[0][0]), "+v"(xr[0][1]), "+v"(xr[1][0]), "+v"(xr[1][1]), "+v"(xr[2][0]), "+v"(xr[2][1]), "+v"(xr[3][0]), "+v"(xr[3][1])); \
        P5_QUANTR(0, xh0, xl0, sx0, TB); P5_QUANTR(1, xh1, xl1, sx1, TB); P5_QUANTR(2, xh2, xl2, sx2, TB); P5_QUANTR(3, xh3, xl3, sx3, TB); \
          \
        CNT[ln] = 0; CNT[64 + ln] = 0; int bk_[4][2]; \
        _Pragma("unroll") for (int i_ = 0; i_ < 4; ++i_) _Pragma("unroll") for (int ps_ = 0; ps_ < 2; ++ps_) { bk_[i_][ps_] = 32 * i_ + ((((ev[i_][ps_] & 16383) >> 9) - rot) & 31); (void)__hip_atomic_fetch_add(CNT + bk_[i_][ps_], 1, __ATOMIC_RELAXED, __HIP_MEMORY_SCOPE_WORKGROUP); } \
        _Pragma("unroll") for (int hh_ = 0; hh_ < 2; ++hh_) { const int c_ = CNT[64 * hh_ + ln]; int inc_ = c_;            \
          _Pragma("unroll") for (int o_ = 1; o_ < 32; o_ <<= 1) { const int u_ = __builtin_amdgcn_ds_bpermute(4 * (ln - o_), inc_); if ((ln & 31) >= o_) inc_ += u_; } \
          CNT[64 * hh_ + ln] = inc_ - c_; } \
        _Pragma("unroll") for (int i_ = 0; i_ < 4; ++i_) _Pragma("unroll") for (int ps_ = 0; ps_ < 2; ++ps_) { const int pos_ = 4 * __hip_atomic_fetch_add(CNT + bk_[i_][ps_], 1, __ATOMIC_RELAXED, __HIP_MEMORY_SCOPE_WORKGROUP) + i_; \
                KEYS[pos_] = ev[i_][ps_] & 16383; CFS[pos_] = __builtin_bit_cast(float, cv[i_][ps_]); } } while (0)
__device__ __forceinline__ void phase5_all(const PArgs& p, float* out, unsigned char* shm) {
    int tid = threadIdx.x; asm volatile("" : "+v"(tid)); const int wid = __builtin_amdgcn_readfirstlane(tid >> 6);
    const char* x1b = (const char*)(p.ws + OFF_MV); const char* eidx = (const char*)(p.ws + OFF_EIDX); const char* egp = (const char*)(p.ws + OFF_EG); const float* r2 = (const float*)(p.ws + OFF_R2);
    const unsigned char* wd = (const unsigned char*)(p.ws + OFF_WD); const unsigned char* wu = (const unsigned char*)(p.ws + OFF_WU); const float* SD = (const float*)(p.ws + OFF_WD + 16 * MiB); const float* SU = (const float*)(p.ws + OFF_WU + 16 * MiB);
    P5_LAS _Float16* sdl = (P5_LAS _Float16*)shm; P5_LAS _Float16* sul = sdl + 16384;
    P5_LAS int* lbase = (P5_LAS int*)(shm + 65536 + wid * 9216);
    const int rot = 4 * ((int)blockIdx.x & 7);
    for (int i = tid; i < 16384; i += 512) { sdl[i] = (_Float16)SD[i]; sul[i] = (_Float16)SU[i]; }
    __syncthreads();
    const int G = (int)gridDim.x, NR = (T_ / 32 + G - 1 - (int)blockIdx.x) / G;
    if (NR <= 0) return;
    int ev[4][2], cv[4][2]; p5_u32x4 xr[4][2];
    p5_u32x2 xh0, xh1, xh2, xh3, xl0, xl1, xl2, xl3; float sx0, sx1, sx2, sx3;
    p5_u32x2 da[8], db[8], dc[8];
    {
        int ln = tid; asm volatile("" : "+v"(ln)); ln &= 63; const unsigned voff4 = (unsigned)ln * 4u, voff8 = (unsigned)ln * 8u, voff32 = (unsigned)ln * 32u;
        const size_t tb0 = ((size_t)blockIdx.x * 8 + wid) * 4;
        P5_LAS int* keys = lbase; P5_LAS float* cfs = (P5_LAS float*)(keys + 512); P5_LAS int* cntl = keys + 1024;
        P5_PLOAD(tb0);
        asm volatile("s_waitcnt vmcnt(0)" ::: "memory");
        P5_PCOMP(keys, cfs, cntl, tb0);
        P5_ISSUE8D(da, 0); P5_ISSUE8D(db, 1); P5_ISSUE8D(dc, 2);
    }
#pragma unroll 1
    for (int rnd = 0; rnd < NR; ++rnd) {
        int ln = tid; asm volatile("" : "+v"(ln)); ln &= 63; const unsigned voff4 = (unsigned)ln * 4u, voff8 = (unsigned)ln * 8u, voff32 = (unsigned)ln * 32u;
        const size_t tb = ((size_t)(rnd * G + (int)blockIdx.x) * 8 + wid) * 4;
        const size_t tn = rnd + 1 < NR ? ((size_t)((rnd + 1) * G + (int)blockIdx.x) * 8 + wid) * 4 : tb;
        P5_LAS int* keys = lbase + (rnd & 1) * 1152; P5_LAS float* cfs = (P5_LAS float*)(keys + 512);
        P5_LAS int* nkeys = lbase + ((rnd + 1) & 1) * 1152; P5_LAS float* ncfs = (P5_LAS float*)(nkeys + 512); P5_LAS int* ncnt = nkeys + 1024;
        p5_u32x2 ua[8], ub[8], uc[8]; int cka, ckb, ckc;
        {
            int zz = 0;
#pragma unroll 1
            for (int b = 0; b < 60; b += 3) {
                asm volatile("s_waitcnt vmcnt(16)" : P5_TIE8(da) :: "memory"); P5_DOWN8(da, b); P5_ISSUE8D(da, b + 3);
                asm volatile("s_waitcnt vmcnt(16)" : P5_TIE8(db) :: "memory"); P5_DOWN8(db, b + 1); P5_ISSUE8D(db, b + 4);
                asm volatile("s_waitcnt vmcnt(16)" : P5_TIE8(dc) :: "memory"); P5_DOWN8(dc, b + 2); P5_ISSUE8D(dc, b + 5);
            }
            asm volatile("s_waitcnt vmcnt(16)" : P5_TIE8(da) :: "memory"); P5_DOWN8(da, 60);
            P5_PLOAD(tn);
            P5_ISSUE8D(da, 63);
            asm volatile("s_waitcnt vmcnt(40)" : P5_TIE8(db) :: "memory"); P5_DOWN8(db, 61);
            P5_ISSUE8U(ua, 0, cka); P5_ISSUE8U(ub, 1, ckb); P5_ISSUE8U(uc, 2, ckc);
            asm volatile("s_waitcnt vmcnt(56)" : P5_TIE8(dc) :: "memory"); P5_DOWN8(dc, 62);
            asm volatile("s_waitcnt vmcnt(24)" : P5_TIE8(da) :: "memory"); P5_DOWN8(da, 63);
        }
        f32x2_t acc0[8], acc1[8], acc2[8], acc3[8];
#pragma unroll
        for (int i = 0; i < 8; ++i) { acc0[i] = (f32x2_t){0.f, 0.f}; acc1[i] = acc0[i]; acc2[i] = acc0[i]; acc3[i] = acc0[i]; }
#pragma unroll 1
        for (int b = 0; b < 60; b += 3) {
            if (b == 30) P5_PCOMP(nkeys, ncfs, ncnt, tn);
            asm volatile("s_waitcnt vmcnt(16)" : P5_TIE8(ua) :: "memory"); P5_BFMA8U(ua, cka); P5_ISSUE8U(ua, b + 3, cka);
            asm volatile("s_waitcnt vmcnt(16)" : P5_TIE8(ub) :: "memory"); P5_BFMA8U(ub, ckb); P5_ISSUE8U(ub, b + 4, ckb);
            asm volatile("s_waitcnt vmcnt(16)" : P5_TIE8(uc) :: "memory"); P5_BFMA8U(uc, ckc); P5_ISSUE8U(uc, b + 5, ckc);
        }
        asm volatile("s_waitcnt vmcnt(16)" : P5_TIE8(ua) :: "memory"); P5_BFMA8U(ua, cka); P5_ISSUE8U(ua, 63, cka);
        { P5_LAS int* keys = nkeys; P5_ISSUE8D(da, 0); P5_ISSUE8D(db, 1); P5_ISSUE8D(dc, 2); }
        asm volatile("s_waitcnt vmcnt(40)" : P5_TIE8(ub) :: "memory"); P5_BFMA8U(ub, ckb);
        asm volatile("s_waitcnt vmcnt(32)" : P5_TIE8(uc) :: "memory"); P5_BFMA8U(uc, ckc);
        asm volatile("s_waitcnt vmcnt(24)" : P5_TIE8(ua) :: "memory"); P5_BFMA8U(ua, cka);
        P5_OUT(0, acc0); P5_OUT(1, acc1); P5_OUT(2, acc2); P5_OUT(3, acc3);
    }
    asm volatile("s_waitcnt vmcnt(0)" : P5_TIE8(da) :: "memory"); asm volatile("" : P5_TIE8(db)); asm volatile("" : P5_TIE8(dc));
}

__global__ __launch_bounds__(512, 2) void k_mega(PArgs p_unused) {
    extern __shared__ __attribute__((aligned(16))) unsigned char shm[];
    cg::grid_group grid = cg::this_grid();
    PG8_LAS unsigned char* lds = (PG8_LAS unsigned char*)shm;
    volatile __attribute__((address_space(3))) unsigned* lctl = (volatile __attribute__((address_space(3))) unsigned*)(lds + LDS_CTL);
    if (threadIdx.x < 64) lctl[threadIdx.x] = 0u;
    __syncthreads();
    const XcdBarrier xbar = xcd_barrier_post((unsigned*)(kargs()->ws + OFF_CTL), lctl);
    for (int rep_ = 0; rep_ < (DUP == 10 ? 2 : 1); ++rep_) { const PArgs p = *kargs(); phase0(p, shm); if (DUP == 10) grid.sync(); }
    grid.sync();
    for (int rep_ = 0; rep_ < (DUP == 1 ? 2 : 1); ++rep_) {
        const PArgs& p = *kargs();
        pg8::SchedGrid S; S.init(p.ws + OFF_XB, p.ws + OFF_WIN, nullptr, nullptr, T_, 5632, 1024, 1, (int)gridDim.x, (int)blockIdx.x);
        pg8::EpiInProj E; E.r1 = (const float*)(p.ws + OFF_R1); E.qnw = p.in[3]; E.knw = p.in[4]; E.ropec = (const float*)(p.ws + OFF_ROPE); E.ropes = E.ropec + 4096 * 8; E.merge_b = p.in[12]; E.ws = p.ws; E.kmean = (float*)(p.ws + OFF_KMEAN); E.skip_km = rep_;
        pg8::gemm_phase<pg8::EpiInProj, pg8::SchedGrid, true, true>(lds, 1024, S, E);
        if (DUP == 1) grid.sync();
    }
    xcd_barrier(xbar);
    {
        const PArgs& p = *kargs();
        const attn_body::AttnTensors AT{(const attn_body::bf16*)(p.ws + OFF_Q), (const attn_body::bf16*)(p.ws + OFF_K), (const attn_body::bf16*)(p.ws + OFF_V), (attn_body::bf16*)(p.ws + OFF_XB), (const float*)(p.ws + OFF_KMEAN)};
        mlstm::Args A; A.mq = (const bf16_t*)(p.ws + OFF_MQ); A.mk = (const bf16_t*)(p.ws + OFF_MK); A.mv = (const bf16_t*)(p.ws + OFF_MV); A.mosig = (const bf16_t*)(p.ws + OFF_MO);
        A.ifg = (const float*)(p.ws + OFF_IFG); A.conv_w = p.in[5]; A.conv_b = p.in[6]; A.nw = p.in[9]; A.sca = (float*)(p.ws + OFF_SCA); A.scm = (float*)(p.ws + OFF_SCM); A.scb = (float*)(p.ws + OFF_SCB);
        A.hm = (bf16_t*)(p.ws + OFF_XB + 64 * MiB);
        for (int rep_ = 0; rep_ < (DUP == 3 ? 2 : 1); ++rep_) for (int u = blockIdx.x; u < 64; u += gridDim.x) mlstm::unit(u >> 2, u & 3, A, (ML_LAS unsigned char*)shm);
        attn_body::QueueOrder S; S.ctr = (unsigned*)(p.ws + OFF_CTL) + 8192; S.slot = lctl + 16;
        attn_body::attn_phase<attn_body::QueueOrder>((char*)shm, AT, S);
    }
    xcd_barrier(xbar);
    for (int rep_ = 0; rep_ < (DUP == 4 ? 2 : 1); ++rep_) {
        const PArgs& p = *kargs();
        pg8::SchedGrid S; S.init(p.ws + OFF_XB, p.ws + OFF_WAB, p.ws + OFF_XB + 64 * MiB, p.ws + OFF_WMB, T_, 1024, 512, 2, (int)gridDim.x, (int)blockIdx.x);
        pg8::EpiBranch E; E.ga = (const bf16_t*)(p.ws + OFF_GA); E.gm = (const bf16_t*)(p.ws + OFF_GM); E.y = (bf16_t*)(p.ws + OFF_MQ);
        pg8::gemm_phase<pg8::EpiBranch, pg8::SchedGrid, true, true>(lds, 512, S, E);
        if (DUP == 4) grid.sync();
    }
    xcd_barrier(xbar);
    for (int rep_ = 0; rep_ < (DUP == 5 ? 2 : 1); ++rep_) {
        const PArgs& p = *kargs();
        pg8::SchedGrid S; S.init(p.ws + OFF_MQ, p.ws + OFF_WOUT, nullptr, nullptr, T_, 1024, 1024, 1, (int)gridDim.x, (int)blockIdx.x);
        pg8::EpiOut E; E.x = p.in[0]; E.out = p.out; E.x1b = (bf16_t*)(p.ws + OFF_MV); E.rowss = (float*)(p.ws + OFF_ROWSS);
        pg8::gemm_phase<pg8::EpiOut, pg8::SchedGrid, true, true>(lds, 1024, S, E);
        if (DUP == 5) grid.sync();
    }
    xcd_barrier(xbar);
    for (int rep_ = 0; rep_ < (DUP == 6 ? 2 : 1); ++rep_) {
        const PArgs& p = *kargs();
        peer::Args A; A.rowss = (const float*)(p.ws + OFF_ROWSS); A.key1 = (const bf16_t*)(p.ws + OFF_KEY1); A.key2 = (const bf16_t*)(p.ws + OFF_KEY2); A.r2out = (float*)(p.ws + OFF_R2);
        A.eidx = (int*)(p.ws + OFF_EIDX); A.eg = (float*)(p.ws + OFF_EG);
        for (int u = blockIdx.x; u < 2048; u += gridDim.x) peer::unit(u >> 3, u & 7, (const bf16_t*)(p.ws + OFF_MV), (const bf16_t*)(p.ws + OFF_WQ), A, lds);
    }
    xcd_barrier(xbar);
    { const PArgs& p = *kargs(); phase5_all(p, p.out, shm); }
}

extern "C" void kernel_launch(void* const* d_in, const int* in_sizes, int n_in, void* d_out, int out_size, void* d_ws, size_t ws_size, hipStream_t stream) {
    static int grid_blocks = 0;
    if (!grid_blocks) {
        if (n_in != 20 || in_sizes[0] != T_ * D_ || out_size != T_ * D_ || ws_size < WS_NEED) { fprintf(stderr, "kernel_launch: unexpected shapes n_in %d in0 %d out %d ws %zu\n", n_in, n_in > 0 ? in_sizes[0] : -1, out_size, ws_size); grid_blocks = -1; return; }
        if (hipFuncSetAttribute((const void*)k_mega, hipFuncAttributeMaxDynamicSharedMemorySize, BIG_LDS) != hipSuccess) { fprintf(stderr, "hipFuncSetAttribute failed\n"); grid_blocks = -1; return; }
        int dev = 0, cus = 0, per_cu = 0;
        hipGetDevice(&dev); hipDeviceGetAttribute(&cus, hipDeviceAttributeMultiprocessorCount, dev);
        hipOccupancyMaxActiveBlocksPerMultiprocessor(&per_cu, (const void*)k_mega, 512, BIG_LDS);
        if (per_cu < 1) { fprintf(stderr, "kernel_launch: occupancy query reports %d blocks per CU\n", per_cu); per_cu = 1; }
        grid_blocks = cus;
        if (grid_blocks != 256) fprintf(stderr, "kernel_launch: %d CUs (expected 256)\n", grid_blocks);
    }
    if (grid_blocks < 0) return;
    PArgs pa{}; for (int i = 0; i < 20; ++i) pa.in[i] = (const float*)d_in[i]; pa.out = (float*)d_out; pa.ws = (char*)d_ws;
    hipMemsetAsync((char*)d_ws + OFF_CTL, 0, CTL_BYTES, stream);
    void* args[] = {&pa};
    hipError_t e = hipLaunchCooperativeKernel((void*)k_mega, dim3(grid_blocks), dim3(512), args, BIG_LDS, stream);
    if (e != hipSuccess) fprintf(stderr, "cooperative launch failed: %s (grid %d)\n", hipGetErrorString(e), grid_blocks);
}
```

```cpp
#include <hip/hip_runtime.h>
#include <cstdio>
#include <cstdint>
#include <cmath>
typedef unsigned short bf16_t;
constexpr int T_ = 65536, D_ = 1024, B_ = 16, S_ = 4096;
constexpr int INC = 5640;
constexpr size_t MiB = 1ull << 20;
constexpr size_t OFF_XB = 0;
constexpr size_t OFF_Q = 128 * MiB, OFF_K = 192 * MiB, OFF_V = 256 * MiB;
constexpr size_t OFF_MQ = 320 * MiB, OFF_MK = 384 * MiB, OFF_MV = 448 * MiB, OFF_MO = 512 * MiB;
constexpr size_t OFF_GA = 576 * MiB, OFF_GM = 704 * MiB;
constexpr size_t OFF_W = 832 * MiB;
constexpr size_t OFF_WIN = OFF_W;
constexpr size_t OFF_WAB = OFF_WIN + (size_t)5632 * 1024 * 2;
constexpr size_t OFF_WMB = OFF_WAB + (size_t)1024 * 512 * 2;
constexpr size_t OFF_WOUT = OFF_WMB + (size_t)1024 * 512 * 2;
constexpr size_t OFF_WQ = OFF_WOUT + (size_t)1024 * 1024 * 2;
constexpr size_t OFF_KEY1 = OFF_WQ + (size_t)2048 * 1024 * 2;
constexpr size_t OFF_KEY2 = OFF_KEY1 + (size_t)8 * 128 * 128 * 2;
constexpr size_t OFF_WD = OFF_KEY2 + (size_t)8 * 128 * 128 * 2;
constexpr size_t OFF_WU = OFF_WD + (size_t)16384 * 1024 * 2;
constexpr size_t OFF_WEND = OFF_WU + (size_t)16384 * 1024 * 2;
constexpr size_t OFF_MISC = 920 * MiB;
static_assert(OFF_WEND <= OFF_MISC, "weights overflow");
constexpr size_t OFF_R1 = OFF_MISC;
constexpr size_t OFF_R2 = OFF_R1 + (size_t)T_ * 4;
constexpr size_t OFF_IFG = OFF_R2 + (size_t)T_ * 4;
constexpr size_t OFF_KMEAN = OFF_IFG + (size_t)T_ * 8 * 4;
constexpr size_t OFF_ROPE = OFF_KMEAN + (size_t)16 * 8 * 16 * 64 * 4;
constexpr size_t OFF_SCA = OFF_ROPE + (size_t)2 * 4096 * 8 * 4;
constexpr size_t OFF_SCM = OFF_SCA + (size_t)16 * 4 * 4096 * 4;
constexpr size_t OFF_SCB = OFF_SCM + (size_t)16 * 4 * 4096 * 4;
constexpr size_t OFF_CTL = 926 * MiB + 512 * 1024, CTL_BYTES = 64 * 1024;
constexpr size_t OFF_ROWSS = 927 * MiB;
constexpr size_t OFF_EIDX = 932 * MiB;
constexpr size_t OFF_EG = 964 * MiB;
constexpr size_t WS_NEED = 996 * MiB;
static_assert(OFF_SCB + (size_t)16 * 4 * 4096 * 4 <= OFF_CTL && OFF_CTL + CTL_BYTES <= OFF_ROWSS, "misc overflow");

__device__ __forceinline__ unsigned f2bf(float f) { unsigned u = __builtin_bit_cast(unsigned, f); return (u + 0x7fffu + ((u >> 16) & 1u)) >> 16; }
__device__ __forceinline__ float bf2f(unsigned short b) { return __builtin_bit_cast(float, ((unsigned)b) << 16); }
__device__ __forceinline__ unsigned pk2(float lo, float hi) { return f2bf(lo) | (f2bf(hi) << 16); }
__device__ __forceinline__ float sigmoidf_(float v) { return 1.0f / (1.0f + __expf(-v)); }
namespace pg8 {
#define PG8_LAS __attribute__((address_space(3)))
typedef unsigned short bf16_t;
typedef short bf16x8 __attribute__((ext_vector_type(8)));
typedef float f32x4 __attribute__((ext_vector_type(4)));
typedef unsigned u32x4 __attribute__((ext_vector_type(4)));
constexpr int BM = 256, BK = 64, HALF = 128, HTB = HALF * BK * 2  , STAGE_BYTES = 8 * HTB, NXCD = 8, WGM = 4;

__host__ __device__ __forceinline__ int lds_byte(int r, int c) { const int st = (r >> 4) * 2 + (c >> 5), rr = r & 15, cc = c & 31, ob = rr * 64 + cc * 2; return st * 1024 + (ob ^ (((ob >> 9) & 1) << 5)); }
__host__ __device__ __forceinline__ void stage_rc(int b, int& R, int& C) { const int st = b / 1024, sb = b % 1024, swz = sb ^ (((sb >> 9) & 1) << 5); R = (st >> 1) * 16 + swz / 64; C = (st & 1) * 32 + (swz % 64) / 2; }
__host__ __device__ __forceinline__ int perm32(int rho) { const int n = rho >> 4, i = rho & 15; return 8 * (i >> 2) + 4 * n + (i & 3); }

struct Unit { int pm, pn, seg, pad; const char* A; const char* B; };

__device__ __forceinline__ unsigned cvt_pk_bf16(float lo, float hi) { unsigned r; asm volatile("v_cvt_pk_bf16_f32 %0, %1, %2" : "=v"(r) : "v"(lo), "v"(hi)); return r; }
typedef float f32x2 __attribute__((ext_vector_type(2)));
__device__ __forceinline__ f32x2 gelu_pk(f32x2 v) {
    const f32x2 av = __builtin_elementwise_abs(v), d = av * 0.2316418882f + 1.0f;
    f32x2 t; t.x = __builtin_amdgcn_rcpf(d.x); t.y = __builtin_amdgcn_rcpf(d.y);
    f32x2 q = t * 0.5307027145f + (-0.7265760135f); q = q * t + 0.7107068705f; q = q * t + (-0.142248368f); q = q * t + 0.127414796f; q = q * t;
    const f32x2 s = (v * v) * (-0.72134752044f);
    f32x2 e; e.x = __builtin_amdgcn_exp2f(s.x); e.y = __builtin_amdgcn_exp2f(s.y);
    const f32x2 m = v * (q * e), r = v - m;
    f32x2 o; o.x = v.x < 0.f ? m.x : r.x; o.y = v.y < 0.f ? m.y : r.y; return o;
}

template <class Epi, class Sched, bool ALIGN_EPI = false, bool SP2 = false>
__device__ __forceinline__ void gemm_phase(PG8_LAS unsigned char* lds, const int K, const Sched& S, const Epi& E) {
    int tid = threadIdx.x; asm volatile("" : "+v"(tid));
    const int wid = __builtin_amdgcn_readfirstlane(tid >> 6), lane = tid & 63, wr = wid >> 2, wc = wid & 3, fr = lane & 15, fq = lane >> 4;
    const int nt = K / BK;
    unsigned voffA[2], voffB[2];
#pragma unroll
    for (int i = 0; i < 2; ++i) { int R, C; stage_rc(tid * 16 + i * 8192, R, C); const int Rb = Epi::PERM ? ((R & ~31) + perm32(R & 31)) : R;
        voffA[i] = (unsigned)(R * K + C) * 2u; voffB[i] = (unsigned)(Rb * K + C) * 2u; }
    const size_t kstep = (size_t)(BK * 2);
    const size_t hstep = (size_t)HALF * K * 2;
        const unsigned ldsw = (unsigned)wid * 1024u;
    const int aoff = lds_byte(wr * 64 + fr, fq * 8), boff = lds_byte(wc * 32 + fr, fq * 8);
#define PG8_SA(b, h) (((b) * 2 + (h)) * HTB)
#define PG8_SB(b, h) ((4 + (b) * 2 + (h)) * HTB)
#define PG8_STAGE(bufoff, gbase, voff) do { _Pragma("unroll") for (int _i = 0; _i < 2; ++_i) \
        __builtin_amdgcn_global_load_lds((const unsigned*)((const char*)(gbase) + (voff)[_i]), (PG8_LAS unsigned*)(lds + (bufoff) + ldsw + _i * 8192), 16, 0, 0); } while (0)
#define PG8_LDA(dst, b, h) do { _Pragma("unroll") for (int m = 0; m < 4; ++m) _Pragma("unroll") for (int k = 0; k < 2; ++k) dst[m][k] = *(const PG8_LAS bf16x8*)(lds + PG8_SA(b, h) + aoff + m * 2048 + k * 1024); } while (0)
#define PG8_LDB(dst, b, h) do { _Pragma("unroll") for (int n = 0; n < 2; ++n) _Pragma("unroll") for (int k = 0; k < 2; ++k) dst[n][k] = *(const PG8_LAS bf16x8*)(lds + PG8_SB(b, h) + boff + n * 2048 + k * 1024); } while (0)
#define PG8_MMA(ai, bj, At, Bt) do { __builtin_amdgcn_s_setprio(1); _Pragma("unroll") for (int m = 0; m < 4; ++m) _Pragma("unroll") for (int n = 0; n < 2; ++n) _Pragma("unroll") for (int k = 0; k < 2; ++k) \
        acc[ai][bj][m][n] = __builtin_amdgcn_mfma_f32_16x16x32_bf16(Bt[n][k], At[m][k], acc[ai][bj][m][n], 0, 0, 0); __builtin_amdgcn_s_setprio(0); } while (0)
#define PG8_WAIT_V(n) asm volatile("s_waitcnt vmcnt(" #n ")" ::: "memory")
#define PG8_WAIT_L(n) asm volatile("s_waitcnt lgkmcnt(" #n ")" ::: "memory")
#define PG8_BAR __builtin_amdgcn_s_barrier()
#define PG8_SCHED __builtin_amdgcn_sched_barrier(0)
    Unit cur, nxt; int ui = 0;
    if (!S.next(0, cur)) return;
    f32x4 acc[2][2][4][2];
#pragma unroll
    for (int a = 0; a < 2; ++a)
#pragma unroll
        for (int b = 0; b < 2; ++b)
#pragma unroll
            for (int m = 0; m < 4; ++m)
#pragma unroll
                for (int n = 0; n < 2; ++n) acc[a][b][m][n] = (f32x4){0.f, 0.f, 0.f, 0.f};
    bf16x8 At[4][2], B0[2][2], B1[2][2];
    const char* cA = cur.A; const char* cB = cur.B;
    S.a_ready(cur);
    if constexpr (SP2) {
        PG8_STAGE(PG8_SB(0, 0), cB, voffB); PG8_STAGE(PG8_SB(0, 1), cB + hstep, voffB); PG8_STAGE(PG8_SA(0, 0), cA, voffA); PG8_STAGE(PG8_SA(0, 1), cA + hstep, voffA);
        if (wr == 1) PG8_BAR;
        PG8_WAIT_V(2); PG8_BAR;
        PG8_STAGE(PG8_SB(1, 0), cB + kstep, voffB); PG8_STAGE(PG8_SA(1, 0), cA + kstep, voffA); PG8_STAGE(PG8_SB(1, 1), cB + hstep + kstep, voffB);
        PG8_WAIT_V(6); PG8_BAR;
    } else {
        PG8_STAGE(PG8_SB(0, 0), cB, voffB); PG8_STAGE(PG8_SA(0, 0), cA, voffA); PG8_STAGE(PG8_SB(0, 1), cB + hstep, voffB); PG8_STAGE(PG8_SA(0, 1), cA + hstep, voffA);
        if (wr == 1) PG8_BAR;
        PG8_WAIT_V(4); PG8_BAR;
        PG8_STAGE(PG8_SB(1, 0), cB + kstep, voffB); PG8_STAGE(PG8_SA(1, 0), cA + kstep, voffA); PG8_STAGE(PG8_SB(1, 1), cB + hstep + kstep, voffB);
        PG8_WAIT_V(6); PG8_BAR;
    }
    for (;;) {
        const bool has_next = S.next(ui + 1, nxt);
        const char* nA = has_next ? nxt.A : cA; const char* nB = has_next ? nxt.B : cB;
        for (int t = 0; t < nt; t += 2) {
            const bool last = (t == nt - 2);
            const char* a1 = cA + (size_t)(t + 1) * kstep;
            const char* a2 = last ? nA : cA + (size_t)(t + 2) * kstep; const char* b2 = last ? nB : cB + (size_t)(t + 2) * kstep;
            const char* a3 = a2 + kstep; const char* b3 = b2 + kstep;
            if (last && has_next) S.a_ready(nxt);
            if constexpr (SP2) {
            PG8_LDB(B0, 0, 0); PG8_LDB(B1, 0, 1); PG8_SCHED; PG8_LDA(At, 0, 0); PG8_STAGE(PG8_SA(1, 1), a1 + hstep, voffA);
            PG8_WAIT_V(8); PG8_WAIT_L(0); PG8_BAR; PG8_MMA(0, 0, At, B0); PG8_MMA(0, 1, At, B1); PG8_BAR; PG8_SCHED;
            PG8_LDA(At, 0, 1); PG8_STAGE(PG8_SB(0, 0), b2, voffB); PG8_STAGE(PG8_SB(0, 1), b2 + hstep, voffB); PG8_STAGE(PG8_SA(0, 0), a2, voffA);
            PG8_WAIT_V(8); PG8_WAIT_L(0); PG8_BAR; PG8_MMA(1, 0, At, B0); PG8_MMA(1, 1, At, B1); PG8_BAR; PG8_SCHED;
            PG8_LDB(B0, 1, 0); PG8_LDB(B1, 1, 1); PG8_SCHED; PG8_LDA(At, 1, 0); PG8_STAGE(PG8_SA(0, 1), a2 + hstep, voffA);
            PG8_WAIT_V(8); PG8_WAIT_L(0); PG8_BAR; PG8_MMA(0, 0, At, B0); PG8_MMA(0, 1, At, B1); PG8_BAR; PG8_SCHED;
            PG8_LDA(At, 1, 1); PG8_STAGE(PG8_SB(1, 0), b3, voffB); PG8_STAGE(PG8_SB(1, 1), b3 + hstep, voffB); PG8_STAGE(PG8_SA(1, 0), a3, voffA);
            PG8_WAIT_V(8); PG8_WAIT_L(0); PG8_BAR; PG8_MMA(1, 0, At, B0); PG8_MMA(1, 1, At, B1); PG8_BAR; PG8_SCHED;
            } else {
            PG8_LDB(B0, 0, 0); PG8_SCHED; PG8_LDA(At, 0, 0); PG8_STAGE(PG8_SA(1, 1), a1 + hstep, voffA);
            PG8_WAIT_L(8); PG8_BAR; PG8_WAIT_L(0); PG8_MMA(0, 0, At, B0); PG8_BAR; PG8_SCHED;
            PG8_LDB(B1, 0, 1); PG8_STAGE(PG8_SB(0, 0), b2, voffB);
            PG8_BAR; PG8_WAIT_L(0); PG8_MMA(0, 1, At, B1); PG8_BAR;
            PG8_LDA(At, 0, 1); PG8_STAGE(PG8_SA(0, 0), a2, voffA);
            PG8_BAR; PG8_WAIT_L(0); PG8_MMA(1, 0, At, B0); PG8_BAR; PG8_SCHED;
            PG8_STAGE(PG8_SB(0, 1), b2 + hstep, voffB);
            PG8_WAIT_V(6); PG8_BAR; PG8_MMA(1, 1, At, B1); PG8_BAR;
            PG8_LDB(B0, 1, 0); PG8_SCHED; PG8_LDA(At, 1, 0); PG8_STAGE(PG8_SA(0, 1), a2 + hstep, voffA);
            PG8_WAIT_L(8); PG8_BAR; PG8_WAIT_L(0); PG8_MMA(0, 0, At, B0); PG8_BAR; PG8_SCHED;
            PG8_LDB(B1, 1, 1); PG8_STAGE(PG8_SB(1, 0), b3, voffB);
            PG8_BAR; PG8_WAIT_L(0); PG8_MMA(0, 1, At, B1); PG8_BAR;
            PG8_LDA(At, 1, 1); PG8_STAGE(PG8_SA(1, 0), a3, voffA);
            PG8_BAR; PG8_WAIT_L(0); PG8_MMA(1, 0, At, B0); PG8_BAR; PG8_SCHED;
            PG8_STAGE(PG8_SB(1, 1), b3 + hstep, voffB);
            PG8_WAIT_V(6); PG8_BAR; PG8_MMA(1, 1, At, B1); PG8_BAR;
            }
        }
        if constexpr (ALIGN_EPI) { if (wr == 0) PG8_BAR; }
        if constexpr (!Epi::AFTER_DRAIN) { E(acc, cur, wr, wc, fr, fq); S.done(cur); }
        if (!has_next) break;
        if (E.zero_after(cur)) {
#pragma unroll
        for (int a = 0; a < 2; ++a)
#pragma unroll
            for (int b = 0; b < 2; ++b)
#pragma unroll
                for (int m = 0; m < 4; ++m)
#pragma unroll
                    for (int n = 0; n < 2; ++n) acc[a][b][m][n] = (f32x4){0.f, 0.f, 0.f, 0.f};
        }
        cur = nxt; cA = nA; cB = nB; ++ui;
        if constexpr (ALIGN_EPI) { if (wr == 1) PG8_BAR; }
    }
    PG8_WAIT_V(0);
    if constexpr (!ALIGN_EPI) { if (wr == 0) PG8_BAR; }
    PG8_BAR;
    if constexpr (Epi::AFTER_DRAIN) { E.fused(acc, cur, wr, wc, fr, fq, lds, wid, lane); S.done(cur); }
#undef PG8_SA
#undef PG8_SB
#undef PG8_STAGE
#undef PG8_LDA
#undef PG8_LDB
#undef PG8_MMA
#undef PG8_WAIT_V
#undef PG8_WAIT_L
#undef PG8_BAR
#undef PG8_SCHED
}
}
__host__ __device__ __forceinline__ int sigma_col(int rho) { const int j = rho & 3, fq = (rho >> 2) & 3, n = (rho >> 4) & 1, wc = (rho >> 5) & 3, bj = rho >> 7; return wc * 64 + bj * 32 + fq * 8 + n * 4 + j; }
namespace pg8 {
struct SchedGrid {
    const char* A0; const char* B0; const char* A1; const char* B1; size_t tstep; int nM, nN, nwg, G, c, segs, pad;
    __device__ __forceinline__ void init(const void* A0_, const void* B0_, const void* A1_, const void* B1_, int M, int N, int K, int segs_, int G_, int c_) {
        A0 = (const char*)A0_; B0 = (const char*)B0_; A1 = (const char*)A1_; B1 = (const char*)B1_; tstep = (size_t)BM * K * 2; nM = M / BM; nN = N / BM; nwg = nM * nN; G = G_; c = c_; segs = segs_; pad = 0; }
    __device__ __forceinline__ bool next(int i, Unit& u) const {
        const int seg = (segs == 2) ? (i & 1) : 0, it = (segs == 2) ? (i >> 1) : i;
        const long L = (long)it * G + c; if (L >= nwg) return false;
        int wgid = (int)L; { const int q = nwg / NXCD, r = nwg % NXCD, xcd = wgid % NXCD, off = wgid / NXCD; wgid = (xcd < r ? xcd * (q + 1) : r * (q + 1) + (xcd - r) * q) + off; }
        const int nig = WGM * nN, gid = wgid / nig, fm = gid * WGM, gsz = (nM - fm) < WGM ? (nM - fm) : WGM;
        u.pm = fm + ((wgid % nig) % gsz); u.pn = (wgid % nig) / gsz; u.seg = seg; u.pad = 0;
        u.A = (seg ? A1 : A0) + (size_t)u.pm * tstep; u.B = (seg ? B1 : B0) + (size_t)u.pn * tstep; return true;
    }
    __device__ __forceinline__ void a_ready(const Unit&) const {}
    __device__ __forceinline__ void done(const Unit&) const {}
};
__device__ __forceinline__ u32x4 pack8(const f32x4& a, const f32x4& b) { u32x4 w; w.x = cvt_pk_bf16(a[0], a[1]); w.y = cvt_pk_bf16(a[2], a[3]); w.z = cvt_pk_bf16(b[0], b[1]); w.w = cvt_pk_bf16(b[2], b[3]); return w; }
__device__ __forceinline__ float bflo(unsigned w) { return __builtin_bit_cast(float, w << 16); }
__device__ __forceinline__ float bfhi(unsigned w) { return __builtin_bit_cast(float, w & 0xffff0000u); }
__device__ __forceinline__ float sigm(float v) { return __builtin_amdgcn_rcpf(1.0f + __expf(-v)); }

struct EpiInProj {
    static constexpr bool PERM = false, AFTER_DRAIN = false;
    const float* r1; const float* qnw; const float* knw; const float* ropec; const float* ropes; const float* merge_b; char* ws; float* kmean; int skip_km;
    __device__ __forceinline__ bool zero_after(const Unit&) const { return true; }
    __device__ __forceinline__ void operator()(f32x4 (&acc)[2][2][4][2], const Unit& u, int wr, int wc, int fr, int fq) const {
        const int pn = u.pn, rowb = u.pm * BM + wr * 64 + fr;
        if (pn < 4) {
            const bool isq = pn < 2; const float* nw = isq ? qnw : knw; const float sc = isq ? 0.125f * 1.4426950408889634f : 1.0f;
            bf16_t* dst = (bf16_t*)(ws + (isq ? OFF_Q : OFF_K)) + (pn & 1) * 256 + wc * 64 + 8 * fq;
            f32x4 nwv[2][2], ks[2][2];
#pragma unroll
            for (int bj = 0; bj < 2; ++bj)
#pragma unroll
                for (int n = 0; n < 2; ++n) { nwv[bj][n] = *(const f32x4*)(nw + 32 * bj + 8 * fq + 4 * n); ks[bj][n] = (f32x4){0.f, 0.f, 0.f, 0.f}; }
#pragma unroll
            for (int ai = 0; ai < 2; ++ai)
#pragma unroll
                for (int m = 0; m < 4; ++m) {
                    const int row = rowb + ai * HALF + m * 16; const float r = r1[row]; const int pos = row & 4095;
                    f32x4 v[2][2]; float ss = 0.f;
#pragma unroll
                    for (int bj = 0; bj < 2; ++bj)
#pragma unroll
                        for (int n = 0; n < 2; ++n) { v[bj][n] = acc[ai][bj][m][n] * r; ss += (v[bj][n][0] * v[bj][n][0] + v[bj][n][1] * v[bj][n][1]) + (v[bj][n][2] * v[bj][n][2] + v[bj][n][3] * v[bj][n][3]); }
                    ss += __shfl_xor(ss, 16); ss += __shfl_xor(ss, 32);
                    const float rstd = rsqrtf(ss * (1.0f / 64.0f) + 1e-6f);
#pragma unroll
                    for (int bj = 0; bj < 2; ++bj)
#pragma unroll
                        for (int n = 0; n < 2; ++n) v[bj][n] = v[bj][n] * rstd * nwv[bj][n];
#pragma unroll
                    for (int n = 0; n < 2; ++n) {
                        const f32x4 cs = *(const f32x4*)(ropec + pos * 8 + 4 * n), sn = *(const f32x4*)(ropes + pos * 8 + 4 * n);
#pragma unroll
                        for (int j = 0; j < 4; ++j) { const float mine = v[0][n][j], oth = __shfl_xor(mine, 16);
                            const float rot = (fq == 0) ? (mine * cs[j] - oth * sn[j]) : (mine * cs[j] + oth * sn[j]);
                            v[0][n][j] = (fq < 2) ? rot : mine; }
                    }
#pragma unroll
                    for (int bj = 0; bj < 2; ++bj) {
                        const u32x4 w = pack8(v[bj][0] * sc, v[bj][1] * sc);
                        *(u32x4*)(dst + (size_t)row * 512 + 32 * bj) = w;
                        if (!isq) { ks[bj][0] += (f32x4){bflo(w.x), bfhi(w.x), bflo(w.y), bfhi(w.y)}; ks[bj][1] += (f32x4){bflo(w.z), bfhi(w.z), bflo(w.w), bfhi(w.w)}; }
                    }
                }
            if (!isq) {
#pragma unroll
                for (int bj = 0; bj < 2; ++bj)
#pragma unroll
                    for (int n = 0; n < 2; ++n)
#pragma unroll
                        for (int j = 0; j < 4; ++j) { float s = ks[bj][n][j]; s += __shfl_xor(s, 1); s += __shfl_xor(s, 2); s += __shfl_xor(s, 4); s += __shfl_xor(s, 8); ks[bj][n][j] = s; }
                if (fr == 0 && !skip_km) {
                    const int b = u.pm >> 4, blk = u.pm & 15, head = (pn & 1) * 4 + wc;
                    float* km = kmean + ((size_t)(b * 8 + head) * 16 + blk) * 64 + 8 * fq;
#pragma unroll
                    for (int bj = 0; bj < 2; ++bj)
#pragma unroll
                        for (int n = 0; n < 2; ++n)
#pragma unroll
                            for (int j = 0; j < 4; ++j) atomicAdd(km + 32 * bj + 4 * n + j, ks[bj][n][j] * (1.0f / 256.0f));
                }
            }
        } else {
            size_t off; int ld = 512, cb, type = 2; const float* bias = nullptr;
            if (pn < 6) { off = OFF_V; cb = (pn - 4) * 256; } else if (pn < 8) { off = OFF_MQ; cb = (pn - 6) * 256; } else if (pn < 10) { off = OFF_MK; cb = (pn - 8) * 256; }
            else if (pn < 12) { off = OFF_MV; cb = (pn - 10) * 256; } else if (pn < 14) { off = OFF_MO; cb = (pn - 12) * 256; type = 3; }
            else if (pn < 18) { off = OFF_GA; cb = (pn - 14) * 256; ld = 1024; type = 4; bias = merge_b + cb; } else { off = OFF_GM; cb = (pn - 18) * 256; ld = 1024; type = 4; bias = merge_b + 1024 + cb; }
            const int cl = wc * 64 + 8 * fq;
            bf16_t* dst = (bf16_t*)(ws + off) + cb + cl;
            f32x4 bv[2][2];
#pragma unroll
            for (int bj = 0; bj < 2; ++bj)
#pragma unroll
                for (int n = 0; n < 2; ++n) bv[bj][n] = (type == 4) ? *(const f32x4*)(bias + cl + 32 * bj + 4 * n) : (f32x4){0.f, 0.f, 0.f, 0.f};
#pragma unroll
            for (int ai = 0; ai < 2; ++ai)
#pragma unroll
                for (int m = 0; m < 4; ++m) {
                    const int row = rowb + ai * HALF + m * 16; const float r = r1[row];
#pragma unroll
                    for (int bj = 0; bj < 2; ++bj) {
                        f32x4 v0 = acc[ai][bj][m][0] * r + bv[bj][0], v1 = acc[ai][bj][m][1] * r + bv[bj][1];
                        if (type >= 3) {
#pragma unroll
                            for (int j = 0; j < 4; ++j) { v0[j] = sigm(v0[j]); v1[j] = sigm(v1[j]); } }
                        *(u32x4*)(dst + (size_t)row * ld + 32 * bj) = pack8(v0, v1);
                    }
                }
        }
    }
};
struct EpiBranch {
    static constexpr bool PERM = false, AFTER_DRAIN = false;
    const bf16_t* ga; const bf16_t* gm; bf16_t* y;
    __device__ __forceinline__ bool zero_after(const Unit& u) const { return u.seg == 1; }
    __device__ __forceinline__ void operator()(f32x4 (&acc)[2][2][4][2], const Unit& u, int wr, int wc, int fr, int fq) const {
        const int rowb = u.pm * BM + wr * 64 + fr, col0 = u.pn * BM + wc * 64 + 8 * fq;
#pragma unroll
        for (int ai = 0; ai < 2; ++ai)
#pragma unroll
            for (int m = 0; m < 4; ++m) {
                const size_t ro = (size_t)(rowb + ai * HALF + m * 16) * 1024 + col0;
#pragma unroll
                for (int bj = 0; bj < 2; ++bj) {
                    const u32x4 gmw = *(const u32x4*)(gm + ro + 32 * bj);
                    const f32x4 m0 = (f32x4){bflo(gmw.x), bfhi(gmw.x), bflo(gmw.y), bfhi(gmw.y)}, m1 = (f32x4){bflo(gmw.z), bfhi(gmw.z), bflo(gmw.w), bfhi(gmw.w)};
                    if (u.seg == 0) {
                        const u32x4 gaw = *(const u32x4*)(ga + ro + 32 * bj);
                        const f32x4 a0 = (f32x4){bflo(gaw.x), bfhi(gaw.x), bflo(gaw.y), bfhi(gaw.y)}, a1 = (f32x4){bflo(gaw.z), bfhi(gaw.z), bflo(gaw.w), bfhi(gaw.w)};
#pragma unroll
                        for (int j = 0; j < 4; ++j) { acc[ai][bj][m][0][j] *= a0[j] * __builtin_amdgcn_rcpf(m0[j]); acc[ai][bj][m][1][j] *= a1[j] * __builtin_amdgcn_rcpf(m1[j]); }
                    } else {
                        *(u32x4*)(y + ro + 32 * bj) = pack8(acc[ai][bj][m][0] * m0, acc[ai][bj][m][1] * m1);
                    }
                }
            }
    }
};
struct EpiOut {
    static constexpr bool PERM = false, AFTER_DRAIN = false;
    const float* x; float* out; bf16_t* x1b; float* rowss;
    __device__ __forceinline__ bool zero_after(const Unit&) const { return true; }
    __device__ __forceinline__ void operator()(f32x4 (&acc)[2][2][4][2], const Unit& u, int wr, int wc, int fr, int fq) const {
        const int rowb = u.pm * BM + wr * 64 + fr, col0 = u.pn * BM + wc * 64 + 8 * fq;
#pragma unroll
        for (int ai = 0; ai < 2; ++ai)
#pragma unroll
            for (int m = 0; m < 4; ++m) {
                const int row = rowb + ai * HALF + m * 16; const size_t ro = (size_t)row * 1024 + col0; float ss = 0.f;
#pragma unroll
                for (int bj = 0; bj < 2; ++bj) {
                    const f32x4 v0 = acc[ai][bj][m][0] + *(const f32x4*)(x + ro + 32 * bj), v1 = acc[ai][bj][m][1] + *(const f32x4*)(x + ro + 32 * bj + 4);
                    *(u32x4*)(x1b + ro + 32 * bj) = pack8(v0, v1);
                    ss += (v0[0] * v0[0] + v0[1] * v0[1]) + (v0[2] * v0[2] + v0[3] * v0[3]) + (v1[0] * v1[0] + v1[1] * v1[1]) + (v1[2] * v1[2] + v1[3] * v1[3]);
                }
                ss += __shfl_xor(ss, 16); ss += __shfl_xor(ss, 32);
                if (fq == 0) rowss[(size_t)row * 16 + u.pn * 4 + wc] = ss;
            }
    }
};
}
#include <hip/hip_bf16.h>
#include <cmath>
namespace attn_body {
using bf16=__hip_bfloat16;
using bf16x8=__attribute__((ext_vector_type(8)))short;
using s16x4=__attribute__((ext_vector_type(4)))short;
using f32x16=__attribute__((ext_vector_type(16)))float;
using u32x4=__attribute__((ext_vector_type(4)))unsigned;
using f32x4_t=__attribute__((ext_vector_type(4)))float;
constexpr int BATCH=16,NHEAD=8,SEQ=4096,D=64,DM=NHEAD*D;
constexpr int NW=8,QBLK=32,QB=QBLK*NW,KVBLK=64,NQB=SEQ/QB;
constexpr int ATTN_PITCH=DM, ATTN_UNIT_ROWS=QB;
__device__ __forceinline__ int crow(int r,int hi){return (r&3)+8*(r>>2)+4*hi;}
#define SBAR() __builtin_amdgcn_sched_barrier(0)
__device__ __forceinline__ void cmask(f32x16&p0,f32x16&p1,int jb,int qrel,int hi){
  const float NEG=-INFINITY; int kb=64*jb+4*hi;
  #pragma unroll
  for(int r=0;r<16;++r){int kv=kb+(r&3)+8*(r>>2); if(kv>qrel)p0[r]=NEG; if(kv+32>qrel)p1[r]=NEG;}
}

constexpr int NSLOT=3, SLOTB=8192;
constexpr int LDS_K=0, LDS_V=NSLOT*SLOTB, LDS_WS=2*NSLOT*SLOTB, LDS_OST=LDS_WS+NW*64*4, LDS_BYTES=LDS_OST+NW*4096;
constexpr float C2=0.125f*1.4426950408889634f;
__device__ __forceinline__ void glds16(const void*gsrc,unsigned lds_dst){unsigned keep;
  asm volatile("s_mov_b32 %0, m0\n\ts_mov_b32 m0, %2\n\ts_nop 0\n\tglobal_load_lds_dwordx4 %1, off\n\ts_mov_b32 m0, %0":"=&s"(keep):"v"(gsrc),"s"(lds_dst):"memory");}
__device__ __forceinline__ float max3f(float a,float b,float c){float r;asm("v_max3_f32 %0, %1, %2, %3":"=v"(r):"v"(a),"v"(b),"v"(c));return r;}
__device__ __forceinline__ float max2f(float a,float b){float r;asm("v_max_f32_e32 %0, %1, %2":"=v"(r):"v"(a),"v"(b));return r;}
__device__ __forceinline__ float fadd_s(float a,float b){float r;asm("v_add_f32_e32 %0, %1, %2":"=v"(r):"v"(a),"v"(b));return r;}
__device__ __forceinline__ float fsub_s(float a,float b){float r;asm("v_sub_f32_e32 %0, %1, %2":"=v"(r):"v"(a),"v"(b));return r;}
typedef float f32x2_t __attribute__((ext_vector_type(2))); typedef __bf16 bf16x2_t __attribute__((ext_vector_type(2)));
__device__ __forceinline__ unsigned cvtpk_s(float lo,float hi){f32x2_t v={lo,hi};bf16x2_t b=__builtin_convertvector(v,bf16x2_t);return __builtin_bit_cast(unsigned,b);}
#define WAIT_BAR(N) asm volatile("s_waitcnt vmcnt(" #N ") lgkmcnt(0)\n\ts_barrier":::"memory")

__device__ __forceinline__ void qkt(f32x16&p0,f32x16&p1,const char*Kslot,const bf16x8*qr,const f32x16&negm,int r32,int hi){
  const char*kb=Kslot+hi*1024+r32*16;
  #pragma unroll
  for(int d0=0;d0<4;++d0){
    const bf16x8 b0=*reinterpret_cast<const bf16x8*>(kb+d0*2048);
    const bf16x8 b1=*reinterpret_cast<const bf16x8*>(kb+d0*2048+512);
    if(d0==0){p0=__builtin_amdgcn_mfma_f32_32x32x16_bf16(b0,qr[0],negm,0,0,0);p1=__builtin_amdgcn_mfma_f32_32x32x16_bf16(b1,qr[0],negm,0,0,0);}
    else{p0=__builtin_amdgcn_mfma_f32_32x32x16_bf16(b0,qr[d0],p0,0,0,0);p1=__builtin_amdgcn_mfma_f32_32x32x16_bf16(b1,qr[d0],p1,0,0,0);}}
}
typedef __attribute__((address_space(3))) const char* lds_cptr;
typedef short v4i16_t __attribute__((ext_vector_type(4)));
__device__ __forceinline__ void kload8(bf16x8*kf,lds_cptr kp){
  kf[0]=*(const __attribute__((address_space(3))) bf16x8*)(kp);      kf[1]=*(const __attribute__((address_space(3))) bf16x8*)(kp+512);
  kf[2]=*(const __attribute__((address_space(3))) bf16x8*)(kp+2048); kf[3]=*(const __attribute__((address_space(3))) bf16x8*)(kp+2560);
  kf[4]=*(const __attribute__((address_space(3))) bf16x8*)(kp+4096); kf[5]=*(const __attribute__((address_space(3))) bf16x8*)(kp+4608);
  kf[6]=*(const __attribute__((address_space(3))) bf16x8*)(kp+6144); kf[7]=*(const __attribute__((address_space(3))) bf16x8*)(kp+6656);
}
__device__ __forceinline__ void kload2(bf16x8*kf,lds_cptr kp,int j){ kf[2*j]=*(const __attribute__((address_space(3))) bf16x8*)(kp+j*2048); kf[2*j+1]=*(const __attribute__((address_space(3))) bf16x8*)(kp+j*2048+512); }
__device__ __forceinline__ s16x4 vtr(lds_cptr p){ return __builtin_bit_cast(s16x4,__builtin_amdgcn_ds_read_tr16_b64_v4i16((__attribute__((address_space(3))) v4i16_t*)p)); }
__device__ __forceinline__ float rowmax(const f32x16&p0,const f32x16&p1){
  float a=max3f(p0[0],p0[1],p1[0]),b=max3f(p0[2],p0[3],p1[1]);a=max3f(a,p1[2],p1[3]);
  #pragma unroll
  for(int r=4;r<16;r+=4){a=max3f(a,p0[r],p0[r+1]);b=max3f(b,p0[r+2],p0[r+3]);a=max3f(a,p1[r],p1[r+1]);b=max3f(b,p1[r+2],p1[r+3]);}
  const float m=max2f(a,b);
  auto rr=__builtin_amdgcn_permlane32_swap(__float_as_uint(m),__float_as_uint(m),false,false);
  return max2f(__uint_as_float(rr[0]),__uint_as_float(rr[1]));
}
__device__ __forceinline__ void pv(f32x16*o,int vb,bf16x8 pa0,bf16x8 pa1,bf16x8 pa2,bf16x8 pa3){
  #pragma unroll
  for(int d0=0;d0<2;++d0){s16x4 lo[4],hi[4];
    #pragma unroll
    for(int ks=0;ks<4;++ks){
      asm volatile("ds_read_b64_tr_b16 %0,%1 offset:%c2":"=&v"(lo[ks]):"v"(vb),"i"(d0*4096+ks*1024):"memory");
      asm volatile("ds_read_b64_tr_b16 %0,%1 offset:%c2":"=&v"(hi[ks]):"v"(vb),"i"(d0*4096+ks*1024+512):"memory");}
    asm volatile("s_waitcnt lgkmcnt(0)":::"memory");SBAR();
    #define PK(k) (bf16x8){lo[k][0],lo[k][1],lo[k][2],lo[k][3],hi[k][0],hi[k][1],hi[k][2],hi[k][3]}
    o[d0]=__builtin_amdgcn_mfma_f32_32x32x16_bf16(pa0,PK(0),o[d0],0,0,0);
    o[d0]=__builtin_amdgcn_mfma_f32_32x32x16_bf16(pa1,PK(1),o[d0],0,0,0);
    o[d0]=__builtin_amdgcn_mfma_f32_32x32x16_bf16(pa2,PK(2),o[d0],0,0,0);
    o[d0]=__builtin_amdgcn_mfma_f32_32x32x16_bf16(pa3,PK(3),o[d0],0,0,0);
    #undef PK
  }
}

#ifndef ATTN_STORE16
#define ATTN_STORE16(p,v) (*(u32x4*)(p)=(v))
#endif
template<int THRL> __device__ __forceinline__ void attn_unit(int b,int h,int qb,const bf16*Q,const bf16*__restrict__ K,const bf16*__restrict__ V,bf16*O,char*shm){
  int tid=threadIdx.x; asm volatile("":"+v"(tid)); const int lane=tid&63,r32=lane&31,hi=lane>>5; const int wid=__builtin_amdgcn_readfirstlane(tid>>6);
  const long rowbase=(long)b*SEQ; const int q0=qb*QB;
  const bf16*Qw=Q+(rowbase+q0+wid*QBLK)*DM+h*D;
  const bf16*Kh=K+rowbase*DM+h*D,*Vh=V+rowbase*DM+h*D;
  const unsigned lds0=(unsigned)(uintptr_t)shm;
  float*wsf=(float*)(shm+LDS_WS)+wid*64;
  const bf16*ksrc=Kh+(long)lane*DM+wid*8;
  const bf16*vsrc=Vh+(long)(16*(wid&3)+(lane>>2))*DM+(wid>>2)*32+(lane&3)*8;
  const unsigned kdst=lds0+LDS_K+wid*1024, vdst=lds0+LDS_V+wid*1024;
  #define TM(t) (((t)<4)?(NT-4+(t)):((t)-4))
  #define DMA_K(t,slot) glds16(ksrc+(long)TM(t)*KVBLK*DM,(unsigned)__builtin_amdgcn_readfirstlane(kdst+(slot)))
  #define DMA_V(t,slot) glds16(vsrc+(long)TM(t)*KVBLK*DM,(unsigned)__builtin_amdgcn_readfirstlane(vdst+(slot)))
  const int vb0=(int)(lds0+LDS_V)+((lane>>4)&1)*32+(lane&3)*8+(4*hi+((lane&15)>>2))*64;
  const char*Kbase=shm+LDS_K; bf16x8 kf[8];
  const lds_cptr shm3=(lds_cptr)shm; const lds_cptr kp0=shm3+LDS_K+hi*1024+r32*16; const lds_cptr vp0=shm3+LDS_V+((lane>>4)&1)*32+(lane&3)*8+(4*hi+((lane&15)>>2))*64;
  const int NT=(q0+QB)/KVBLK;
  DMA_K(0,0);DMA_V(0,0);DMA_K(1,SLOTB);
  bf16x8 qr[4];
  #pragma unroll
  for(int d0=0;d0<4;++d0)qr[d0]=*reinterpret_cast<const bf16x8*>(&Qw[(long)r32*DM+d0*16+hi*8]);
  #define SELK(tt) (((tt)<4)||((((const unsigned*)(shm+LDS_BYTES))[wid*QBLK+r32]>>(((tt)-4)>>2))&1u))
  float mhat=0.f,l_reg=0.f;f32x16 o[2];o[0]=f32x16{};o[1]=f32x16{};f32x16 negm=f32x16{};asm volatile("":"+v"(negm));
  const int qrel=wid*QBLK+r32;
  #define CMASK(P0,P1,t) do{int jb_=(t); if(jb_<4)cmask(P0,P1,jb_,qrel,hi); else { const bool keep_=SELK(jb_); _Pragma("unroll") for(int r=0;r<16;++r){P0[r]=keep_?P0[r]:-INFINITY;P1[r]=keep_?P1[r]:-INFINITY;} } }while(0)
  bool resc=false;
  #define START(P0,P1) do{ const float rm=rowmax(P0,P1); resc=false; \
    { const float dl=rm; mhat=fadd_s(mhat,dl); \
      _Pragma("unroll") for(int r=0;r<16;++r){P0[r]=fsub_s(P0[r],dl);P1[r]=fsub_s(P1[r],dl);} \
      _Pragma("unroll") for(int r=0;r<16;++r)negm[r]=-mhat; asm volatile("":"+v"(negm)); } \
    _Pragma("unroll") for(int r=0;r<16;++r)P0[r]=__builtin_amdgcn_exp2f(P0[r]); }while(0)
  #define RESC() do{ if(resc){ asm volatile("s_waitcnt lgkmcnt(0)":::"memory"); \
      _Pragma("unroll") for(int d_=0;d_<2;++d_) _Pragma("unroll") for(int r=0;r<16;++r)o[d_][r]*=wsf[crow(r,hi)]; } }while(0)
  f32x16 pA0,pA1,pB0,pB1;
  int sl_prev=0,sl_cur=0,sl_next=SLOTB;
  #define ROT() do{sl_prev=sl_cur;sl_cur=sl_next;sl_next=(sl_next==(NSLOT-1)*SLOTB)?0:sl_next+SLOTB;}while(0)
  DMA_K(2,2*SLOTB);
  WAIT_BAR(3);
  qkt(pA0,pA1,Kbase,qr,negm,r32,hi);asm volatile("s_nop 15\n\ts_nop 7":"+v"(pA0),"+v"(pA1));CMASK(pA0,pA1,0);
  START(pA0,pA1);
  _Pragma("unroll") for(int r=0;r<16;++r)pA1[r]=__builtin_amdgcn_exp2f(pA1[r]);
  WAIT_BAR(0);
  DMA_K(3,0);DMA_V(1,SLOTB);
  ROT();
  kload8(kf,kp0+sl_cur);
  WAIT_BAR(2);
  s16x4 vlo[8],vhi[8]; u32x4 pw0,pw1,pw2,pw3;
  #define PKW(P,B) cvtpk_s(P[B],P[B+1])
  #define PAF(k) __builtin_bit_cast(bf16x8,pw##k)
  #define VFR(i) (bf16x8){vlo[i][0],vlo[i][1],vlo[i][2],vlo[i][3],vhi[i][0],vhi[i][1],vhi[i][2],vhi[i][3]}
  #define PIN(x) asm volatile("":"+v"(x))
  #define MX3(a,b,c) __builtin_fmaxf(__builtin_fmaxf((a),(b)),(c))
  #define GAPA(MF,A0,A1,A2,A3,W0,W1,PW) do{ MF; sacc+=A0; sacc+=A1; sacc+=A2; sacc+=A3; PIN(sacc); W0; W1; PIN(PW); SBAR(); }while(0)
  #define EX(v) __builtin_amdgcn_exp2f(v)
  #define GAPB(MF,X,B) do{ MF; X[B]=EX(X[B]); X[B+1]=EX(X[B+1]); X[B+2]=EX(X[B+2]); X[B+3]=EX(X[B+3]); PIN(X); SBAR(); }while(0)
  #define VRD(i) do{ vlo[i]=vtr(vp_+(((i)>>2)*4096+((i)&3)*1024)); vhi[i]=vtr(vp_+(((i)>>2)*4096+((i)&3)*1024+512)); }while(0)
  #define KRD(G,j) do{ if(G){ kload2(kf,kp0+sl_next,j); SBAR(); } }while(0)
  #define STEP(C0,C1,P0,P1,t,GK,GV,GL) do{ SBAR(); \
    const lds_cptr vp_=vp0+sl_prev; \
    VRD(0); SBAR(); float sacc=(P0[0]+P0[1]); \
    GAPA(C0=__builtin_amdgcn_mfma_f32_32x32x16_bf16(kf[0],qr[0],negm,0,0,0), P0[2],P0[3],P0[4],P0[5],     pw0[0]=PKW(P0,0), pw0[1]=PKW(P0,2), pw0); \
    VRD(4); SBAR(); GAPA(C1=__builtin_amdgcn_mfma_f32_32x32x16_bf16(kf[1],qr[0],negm,0,0,0), P0[6],P0[7],P0[8],P0[9],     pw0[2]=PKW(P0,4), pw0[3]=PKW(P0,6), pw0); \
    VRD(1); SBAR(); GAPA(C0=__builtin_amdgcn_mfma_f32_32x32x16_bf16(kf[2],qr[1],C0,0,0,0),   P0[10],P0[11],P0[12],P0[13], pw1[0]=PKW(P0,8), pw1[1]=PKW(P0,10), pw1); \
    VRD(5); SBAR(); GAPA(C1=__builtin_amdgcn_mfma_f32_32x32x16_bf16(kf[3],qr[1],C1,0,0,0),   P0[14],P0[15],P1[0],P1[1],   pw1[2]=PKW(P0,12),pw1[3]=PKW(P0,14), pw1); \
    VRD(2); SBAR(); GAPA(C0=__builtin_amdgcn_mfma_f32_32x32x16_bf16(kf[4],qr[2],C0,0,0,0),   P1[2],P1[3],P1[4],P1[5],     pw2[0]=PKW(P1,0), pw2[1]=PKW(P1,2), pw2); \
    VRD(6); SBAR(); GAPA(C1=__builtin_amdgcn_mfma_f32_32x32x16_bf16(kf[5],qr[2],C1,0,0,0),   P1[6],P1[7],P1[8],P1[9],     pw2[2]=PKW(P1,4), pw2[3]=PKW(P1,6), pw2); \
    VRD(3); SBAR(); GAPA(C0=__builtin_amdgcn_mfma_f32_32x32x16_bf16(kf[6],qr[3],C0,0,0,0),   P1[10],P1[11],P1[12],P1[13], pw3[0]=PKW(P1,8), pw3[1]=PKW(P1,10), pw3); \
    VRD(7); SBAR(); GAPA(C1=__builtin_amdgcn_mfma_f32_32x32x16_bf16(kf[7],qr[3],C1,0,0,0),   P1[14],P1[15],0.f,0.f,       pw3[2]=PKW(P1,12),pw3[3]=PKW(P1,14), pw3); \
    l_reg+=sacc; \
    if(GK){DMA_K((t)+3,sl_cur);} if(GV){DMA_V((t)+1,sl_next);} \
    CMASK(C0,C1,t); \
    { float a=MX3(C0[0],C0[1],C1[0]),b=MX3(C0[2],C0[3],C1[1]); a=MX3(a,C1[2],C1[3]); \
      _Pragma("unroll") for(int r=4;r<16;r+=4){a=MX3(a,C0[r],C0[r+1]);b=MX3(b,C0[r+2],C0[r+3]);a=MX3(a,C1[r],C1[r+1]);b=MX3(b,C1[r+2],C1[r+3]);} \
      float rm=__builtin_fmaxf(a,b); { auto rr=__builtin_amdgcn_permlane32_swap(__float_as_uint(rm),__float_as_uint(rm),false,false); rm=__builtin_fmaxf(__uint_as_float(rr[0]),__uint_as_float(rr[1])); } \
      resc=false; \
      if(__builtin_expect(__any(rm>(float)THRL),0)){ const float dl=__builtin_fmaxf(rm,0.f); mhat+=dl; \
        _Pragma("unroll") for(int r=0;r<16;++r){C0[r]-=dl;C1[r]-=dl;} \
        _Pragma("unroll") for(int r=0;r<16;++r)negm[r]=-mhat; asm volatile("":"+v"(negm)); \
        const float f=__builtin_amdgcn_exp2f(-dl); l_reg*=f; if(hi==0)wsf[r32]=f; resc=true; } } \
    SBAR(); \
    GAPB(o[0]=__builtin_amdgcn_mfma_f32_32x32x16_bf16(PAF(0),VFR(0),o[0],0,0,0), C0,0); \
    GAPB(o[1]=__builtin_amdgcn_mfma_f32_32x32x16_bf16(PAF(0),VFR(4),o[1],0,0,0), C0,4); \
    KRD(GL,0); GAPB(o[0]=__builtin_amdgcn_mfma_f32_32x32x16_bf16(PAF(1),VFR(1),o[0],0,0,0), C0,8); \
    KRD(GL,1); GAPB(o[1]=__builtin_amdgcn_mfma_f32_32x32x16_bf16(PAF(1),VFR(5),o[1],0,0,0), C0,12); \
    KRD(GL,2); GAPB(o[0]=__builtin_amdgcn_mfma_f32_32x32x16_bf16(PAF(2),VFR(2),o[0],0,0,0), C1,0); \
    KRD(GL,3); GAPB(o[1]=__builtin_amdgcn_mfma_f32_32x32x16_bf16(PAF(2),VFR(6),o[1],0,0,0), C1,4); \
    GAPB(o[0]=__builtin_amdgcn_mfma_f32_32x32x16_bf16(PAF(3),VFR(3),o[0],0,0,0), C1,8); \
    GAPB(o[1]=__builtin_amdgcn_mfma_f32_32x32x16_bf16(PAF(3),VFR(7),o[1],0,0,0), C1,12); \
    }while(0)
  int t=1;
  for(;t+5<NT;t+=2){
    STEP(pB0,pB1,pA0,pA1,t,true,true,true);     WAIT_BAR(2); RESC(); ROT();
    STEP(pA0,pA1,pB0,pB1,t+1,true,true,true);   WAIT_BAR(2); RESC(); ROT();
  }
  #define ENDW(tt) do{ if((tt)+3<NT){WAIT_BAR(2);} else if((tt)+2<NT){WAIT_BAR(1);} else {WAIT_BAR(0);} }while(0)
  for(;t+1<NT;t+=2){
    STEP(pB0,pB1,pA0,pA1,t,(t+3<NT),(t+1<NT),(t+1<NT));       ENDW(t);   RESC(); ROT();
    STEP(pA0,pA1,pB0,pB1,t+1,(t+4<NT),(t+2<NT),(t+2<NT));     ENDW(t+1); RESC(); ROT();
  }
  STEP(pB0,pB1,pA0,pA1,NT-1,false,false,false); RESC();
  { float sacc=pB0[0]+pB0[1]; _Pragma("unroll") for(int r=2;r<16;++r)sacc+=pB0[r]; _Pragma("unroll") for(int r=0;r<16;++r)sacc+=pB1[r]; l_reg+=sacc;
    pw0=(u32x4){PKW(pB0,0),PKW(pB0,2),PKW(pB0,4),PKW(pB0,6)};pw1=(u32x4){PKW(pB0,8),PKW(pB0,10),PKW(pB0,12),PKW(pB0,14)};pw2=(u32x4){PKW(pB1,0),PKW(pB1,2),PKW(pB1,4),PKW(pB1,6)};pw3=(u32x4){PKW(pB1,8),PKW(pB1,10),PKW(pB1,12),PKW(pB1,14)};
    SBAR(); pv(o,vb0+sl_cur,PAF(0),PAF(1),PAF(2),PAF(3)); }
  #undef PKW
  #undef PAF
  #undef VFR
  #undef PIN
  #undef MX3
  #undef GAPA
  #undef GAPB
  #undef EX
  #undef VRD
  #undef KRD
  #undef STEP
  #undef ENDW
  {auto rr=__builtin_amdgcn_permlane32_swap(__float_as_uint(l_reg),__float_as_uint(l_reg),false,false);l_reg=__uint_as_float(rr[0])+__uint_as_float(rr[1]);}
  if(hi==0)wsf[32+r32]=l_reg;asm volatile("s_waitcnt lgkmcnt(0)":::"memory");
  float rli[16];
  #pragma unroll
  for(int r=0;r<16;++r)rli[r]=__builtin_amdgcn_rcpf(wsf[32+crow(r,hi)]);
  bf16*Ow=O+(rowbase+q0+wid*QBLK)*DM+h*D;
  { bf16*stg=(bf16*)(shm+LDS_OST)+wid*2048;
    #pragma unroll
    for(int r=0;r<16;++r){const int orow=crow(r,hi);
      #pragma unroll
      for(int d0=0;d0<2;++d0)stg[orow*64+d0*32+r32]=__float2bfloat16(o[d0][r]*rli[r]);}
    asm volatile("s_waitcnt lgkmcnt(0)":::"memory");
    #pragma unroll
    for(int i=0;i<4;++i){const int row=i*8+(lane>>3),ch=lane&7; const u32x4 v=*(const u32x4*)(stg+row*64+ch*8); ATTN_STORE16(Ow+(long)row*DM+ch*8,v);} }
  asm volatile("s_waitcnt lgkmcnt(0)\n\ts_barrier":::"memory");
  #undef DMA_K
  #undef TM
  #undef SELK
  #undef DMA_V
  #undef CMASK
  #undef START
  #undef RESC
  #undef ROT
}

__device__ __forceinline__ void moba_gate(int b,int h,int qb,const bf16*Q,const float*__restrict__ kmean,char*shm){
  int tid=threadIdx.x; asm volatile("":"+v"(tid));
  if(tid<QB){
    unsigned selmask=0u;
    if(qb>0){
      const unsigned short*qrow=(const unsigned short*)Q+((long)b*SEQ+qb*QB+tid)*DM+h*D;
      const float*kmb=kmean+(long)((b*NHEAD+h)*16)*64;
      float g0=-INFINITY,g1=-INFINITY,g2=-INFINITY; int i0=-1,i1=-1,i2=-1;
      for(int n=0;n<qb;++n){
        float g=0.f;
        #pragma unroll
        for(int c=0;c<8;++c){
          const u32x4 qv=*reinterpret_cast<const u32x4*>(qrow+c*8);
          const f32x4_t ka=*reinterpret_cast<const f32x4_t*>(kmb+n*64+c*8), kb=*reinterpret_cast<const f32x4_t*>(kmb+n*64+c*8+4);
          g+=__builtin_bit_cast(float,qv.x<<16)*ka[0]; g+=__builtin_bit_cast(float,qv.x&0xffff0000u)*ka[1];
          g+=__builtin_bit_cast(float,qv.y<<16)*ka[2]; g+=__builtin_bit_cast(float,qv.y&0xffff0000u)*ka[3];
          g+=__builtin_bit_cast(float,qv.z<<16)*kb[0]; g+=__builtin_bit_cast(float,qv.z&0xffff0000u)*kb[1];
          g+=__builtin_bit_cast(float,qv.w<<16)*kb[2]; g+=__builtin_bit_cast(float,qv.w&0xffff0000u)*kb[3];
        }
        if(g>g0){g2=g1;i2=i1;g1=g0;i1=i0;g0=g;i0=n;} else if(g>g1){g2=g1;i2=i1;g1=g;i1=n;} else if(g>g2){g2=g;i2=n;}
      }
      if(i0>=0)selmask|=1u<<i0; if(i1>=0)selmask|=1u<<i1; if(i2>=0)selmask|=1u<<i2;
    }
    { int t2=tid; asm volatile("":"+v"(t2)); ((unsigned*)(shm+LDS_BYTES))[t2]=selmask; }
  }
  asm volatile("s_waitcnt lgkmcnt(0)\n\ts_barrier":::"memory");
}
constexpr int ATTN_LDS_BYTES=LDS_BYTES;
struct AttnTensors { const bf16* Q; const bf16* K; const bf16* V; bf16* O; const float* kmean; };
struct AttnUnit { int bh; int qb; };
struct StaticOrder {
  int vcu;
  __device__ __forceinline__ explicit StaticOrder(int grid,int block):vcu((block%8)*(grid/8)+block/8){}
  __device__ __forceinline__ bool next(int i,AttnUnit&u)const{ if(i>=8)return false; const int half=vcu&1; u.bh=vcu>>1;
    const int pr=3-(i>>1);
    u.qb=(i&1)?(half?(4*pr+1):(4*pr)):(half?(4*pr+2):(4*pr+3)); return true; }
  __device__ __forceinline__ void a_ready(const AttnUnit&)const{}
  __device__ __forceinline__ void done(const AttnUnit&)const{}
};
struct QueueOrder {
  unsigned* ctr; volatile __attribute__((address_space(3))) unsigned* slot;
  __device__ __forceinline__ bool next(int,AttnUnit&u)const{
    if(threadIdx.x==0)*slot=__hip_atomic_fetch_add(ctr,1u,__ATOMIC_RELAXED,__HIP_MEMORY_SCOPE_AGENT);
    __syncthreads(); const unsigned k=*slot; __syncthreads();
    if(k>=2048u)return false; u.qb=15-(int)(k>>7); u.bh=(int)(k&127u); return true; }
  __device__ __forceinline__ void a_ready(const AttnUnit&)const{}
  __device__ __forceinline__ void done(const AttnUnit&)const{}
};
template<class Sched,int THRL=8> __device__ __forceinline__ void attn_phase(char*lds,const AttnTensors&T,const Sched&S){
  AttnUnit u;
  for(int i=0;S.next(i,u);++i){ S.a_ready(u); moba_gate(u.bh/NHEAD,u.bh%NHEAD,u.qb,T.Q,T.kmean,lds); attn_unit<THRL>(u.bh/NHEAD,u.bh%NHEAD,u.qb,T.Q,T.K,T.V,T.O,lds); S.done(u); }
}
#undef SBAR
#undef WAIT_BAR
}
namespace mlstm {
#define ML_LAS __attribute__((address_space(3)))
typedef short bf16x8 __attribute__((ext_vector_type(8)));
typedef short s16x4 __attribute__((ext_vector_type(4)));
typedef float f32x4 __attribute__((ext_vector_type(4)));
typedef unsigned u32x4 __attribute__((ext_vector_type(4)));
typedef unsigned u32x2 __attribute__((ext_vector_type(2)));
constexpr int PQ = 272, PV = 336, PA = 144;
constexpr int O_QC = 0, O_KC = O_QC + 64 * PQ, O_HST = O_KC + 64 * PQ, O_VP = O_HST + 64 * PQ, O_VW = O_VP + 64 * PV, O_ST = O_VW + 64 * PV, O_AM = O_ST + 128 * PV,
              O_CW = O_AM + 64 * PA, O_EX = O_CW + 2 * 5 * 128 * 4, O_SCR = O_EX + 3 * 64 * 4, O_CH = O_SCR + 64 * 4, LDS_END = O_CH + 2 * 4 * 64 * 4;
static_assert(LDS_END <= 156 * 1024, "mlstm LDS");
struct Args { const bf16_t* mq; const bf16_t* mk; const bf16_t* mv; const bf16_t* mosig; const float* ifg; const float* conv_w; const float* conv_b; const float* nw; float* sca; float* scm; float* scb; bf16_t* hm; };
__device__ __forceinline__ s16x4 trd(const ML_LAS unsigned char* p) { return __builtin_bit_cast(s16x4, __builtin_amdgcn_ds_read_tr16_b64_v4i16((ML_LAS s16x4*)p)); }
__device__ __forceinline__ bf16x8 cat8(s16x4 lo, s16x4 hi) { return (bf16x8){lo[0], lo[1], lo[2], lo[3], hi[0], hi[1], hi[2], hi[3]}; }
__device__ __forceinline__ float blo(unsigned w) { return __builtin_bit_cast(float, w << 16); }
__device__ __forceinline__ float bhi(unsigned w) { return __builtin_bit_cast(float, w & 0xffff0000u); }
__device__ __forceinline__ float logsig(float f) { return (f >= 0.f) ? -log1pf(__expf(-f)) : f - log1pf(__expf(f)); }

__device__ __forceinline__ void unit(int b, int h, const Args& A, ML_LAS unsigned char* lds) {
    int tid = threadIdx.x; asm volatile("" : "+v"(tid)); const int lane = tid & 63, wid = __builtin_amdgcn_readfirstlane(tid >> 6);
    int tidv = tid; int l15 = tidv & 15, q4 = (tidv >> 4) & 3, d8 = tidv & 15, row0 = 2 * (tidv >> 4);
    const size_t tb = (size_t)b * 4096, sb = (size_t)(b * 4 + h) * 4096;
    ML_LAS float* cwl = (ML_LAS float*)(lds + O_CW); ML_LAS float* ex = (ML_LAS float*)(lds + O_EX); ML_LAS float* scr = (ML_LAS float*)(lds + O_SCR); ML_LAS float* chs = (ML_LAS float*)(lds + O_CH);
    for (int i = tid; i < 1280; i += 512) { const int qk = i / 640, r = (i % 640) >> 7, d = i & 127, ch = qk * 512 + h * 128 + d; cwl[i] = (r < 4) ? A.conv_w[r * 1024 + ch] : A.conv_b[ch]; }
    for (int i = tid; i < 128 * PV / 16; i += 512) *(ML_LAS u32x4*)(lds + O_ST + i * 16) = (u32x4){0u, 0u, 0u, 0u};
    if (tid < 256) { const int r = tid >> 2, part = tid & 3;
        *(ML_LAS u32x4*)(lds + O_VP + r * PV + 256 + part * 16) = (u32x4){part == 0 ? 0x3F80u : 0u, 0u, 0u, 0u};
        *(ML_LAS u32x4*)(lds + O_VW + r * PV + 256 + part * 16) = (u32x4){0u, 0u, 0u, 0u}; }
    {
        float lfv[8], av[8]; float run = 0.f;
#pragma unroll
        for (int j = 0; j < 8; ++j) { const float f = A.ifg[(tb + 8 * tid + j) * 8 + 4 + h]; run += logsig(f); lfv[j] = run; }
        float incl = run;
#pragma unroll
        for (int o = 1; o < 64; o <<= 1) { const float t = __shfl_up(incl, o); if (lane >= o) incl += t; }
        if (lane == 63) scr[wid] = incl;
        __syncthreads();
        float pre = incl - run; for (int w = 0; w < wid; ++w) pre += scr[w];
        float m = -INFINITY;
#pragma unroll
        for (int j = 0; j < 8; ++j) { const float Bv = pre + lfv[j]; const float a = A.ifg[(tb + 8 * tid + j) * 8 + h] - Bv; A.scb[sb + 8 * tid + j] = Bv; A.sca[sb + 8 * tid + j] = a; m = fmaxf(m, a); av[j] = m; }
        float im = m;
#pragma unroll
        for (int o = 1; o < 64; o <<= 1) { const float t = __shfl_up(im, o); if (lane >= o) im = fmaxf(im, t); }
        if (lane == 63) scr[8 + wid] = im;
        __syncthreads();
        float pm = __shfl_up(im, 1); if (lane == 0) pm = -INFINITY; pm = fmaxf(pm, 0.f); for (int w = 0; w < wid; ++w) pm = fmaxf(pm, scr[8 + w]);
#pragma unroll
        for (int j = 0; j < 8; ++j) A.scm[sb + 8 * tid + j] = fmaxf(pm, av[j]);
    }
    __threadfence(); __syncthreads();
    f32x4 accS[20];
#pragma unroll
    for (int v = 0; v < 20; ++v) accS[v] = (f32x4){0.f, 0.f, 0.f, 0.f};
    uint4 rq[5], rk[5], rv[2]; float chv = 0.f;
#define goff ((unsigned)(tb * 512) + h * 128 + 8 * d8)
#define ML_LOAD(c) do { const int c0_ = (c) * 64; \
        _Pragma("unroll") for (int j = 0; j < 5; ++j) { const int rr = c0_ + row0 - 3 + j; if (rr >= 0) { rq[j] = *(const uint4*)(A.mq + goff + rr * 512); rk[j] = *(const uint4*)(A.mk + goff + rr * 512); } else { rq[j] = make_uint4(0u, 0u, 0u, 0u); rk[j] = rq[j]; } } \
        _Pragma("unroll") for (int j = 0; j < 2; ++j) { rv[j] = *(const uint4*)(A.mv + goff + (c0_ + row0 + j) * 512); \
            } } while (0)
#define ML_LOADS(c) do { const int c0_ = (c) * 64; \
        if (tidv < 192) { chv = A.sca[(size_t)(tidv >> 6) * (16 * 4 * 4096) + sb + c0_ + (tidv & 63)]; }     else if (tidv == 192) chv = (c0_ == 0) ? 0.f : A.scm[sb + c0_ - 1]; } while (0)
    ML_LOAD(0); ML_LOADS(0);
    if (tidv < 193) chs[tidv] = chv;
    __syncthreads();
    for (int c = 0; c < 64; ++c) {
        asm volatile("" : "+v"(tidv)); l15 = tidv & 15; q4 = (tidv >> 4) & 3; d8 = l15; row0 = 2 * (tidv >> 4);
        const int c0 = c * 64; const ML_LAS float* ch = chs + (c & 1) * 256;
#pragma unroll
        for (int qk = 0; qk < 2; ++qk) {
            const ML_LAS float* wq = cwl + qk * 640 + 8 * d8;
            float y[2][8];
            { const f32x4 b0 = *(const ML_LAS f32x4*)(wq + 512), b1 = *(const ML_LAS f32x4*)(wq + 516);
#pragma unroll
              for (int e = 0; e < 4; ++e) { y[0][e] = b0[e]; y[0][4 + e] = b1[e]; y[1][e] = b0[e]; y[1][4 + e] = b1[e]; } }
#pragma unroll
            for (int j = 0; j < 4; ++j) {
                const f32x4 w0 = *(const ML_LAS f32x4*)(wq + j * 128), w1 = *(const ML_LAS f32x4*)(wq + j * 128 + 4);
#pragma unroll
                for (int ro = 0; ro < 2; ++ro) { const uint4 u = qk ? rk[ro + j] : rq[ro + j]; const unsigned uw[4] = {u.x, u.y, u.z, u.w};
                    y[ro][0] += w0[0] * blo(uw[0]); y[ro][1] += w0[1] * bhi(uw[0]); y[ro][2] += w0[2] * blo(uw[1]); y[ro][3] += w0[3] * bhi(uw[1]);
                    y[ro][4] += w1[0] * blo(uw[2]); y[ro][5] += w1[1] * bhi(uw[2]); y[ro][6] += w1[2] * blo(uw[3]); y[ro][7] += w1[3] * bhi(uw[3]); }
            }
#pragma unroll
            for (int ro = 0; ro < 2; ++ro) {
#pragma unroll
                for (int e = 0; e < 8; ++e) { y[ro][e] = y[ro][e] * __builtin_amdgcn_rcpf(1.0f + __expf(-y[ro][e])); if (qk) y[ro][e] *= 0.08838834764831845f; }
                *(ML_LAS u32x4*)(lds + (qk ? O_KC : O_QC) + (row0 + ro) * PQ + 16 * d8) = (u32x4){pk2(y[ro][0], y[ro][1]), pk2(y[ro][2], y[ro][3]), pk2(y[ro][4], y[ro][5]), pk2(y[ro][6], y[ro][7])};
            }
        }
#pragma unroll
        for (int ro = 0; ro < 2; ++ro) {
            *(ML_LAS u32x4*)(lds + O_VP + (row0 + ro) * PV + 16 * d8) = (u32x4){rv[ro].x, rv[ro].y, rv[ro].z, rv[ro].w};
            const float wsv = __expf(ch[row0 + ro] - ch[127]); const unsigned uw[4] = {rv[ro].x, rv[ro].y, rv[ro].z, rv[ro].w}; unsigned o[4];
#pragma unroll
            for (int e2 = 0; e2 < 4; ++e2) o[e2] = pk2(blo(uw[e2]) * wsv, bhi(uw[e2]) * wsv);
            *(ML_LAS u32x4*)(lds + O_VW + (row0 + ro) * PV + 16 * d8) = (u32x4){o[0], o[1], o[2], o[3]};
            if (d8 == 0) *(ML_LAS unsigned short*)(lds + O_VW + (row0 + ro) * PV + 256) = (unsigned short)f2bf(wsv);
        }
        __syncthreads();
        const float Mref = ch[192], Mend = ch[127];
        const int trow = 16 * (wid & 3) + 4 * q4;
        const f32x4 Mxr = *(const ML_LAS f32x4*)(ch + 64 + trow);
        if (wid < 4) {
#pragma unroll
            for (int v = 0; v < 10; ++v) accS[v] = (f32x4){0.f, 0.f, 0.f, 0.f};
#pragma unroll
            for (int ks = 0; ks < 4; ++ks) {
                const bf16x8 a = *(const ML_LAS bf16x8*)(lds + O_QC + (16 * wid + l15) * PQ + (32 * ks + 8 * q4) * 2);
                const ML_LAS unsigned char* bp = lds + O_ST + (32 * ks + 8 * q4 + (l15 >> 2)) * PV + (l15 & 3) * 8;
#pragma unroll
                for (int v = 0; v < 10; ++v) { const bf16x8 bfr = cat8(trd(bp + 32 * v), trd(bp + 4 * PV + 32 * v)); accS[v] = __builtin_amdgcn_mfma_f32_16x16x32_bf16(a, bfr, accS[v], 0, 0, 0); }
            }
            float wi[4];
#pragma unroll
            for (int i = 0; i < 4; ++i) wi[i] = __expf(Mref - Mxr[i]);
#pragma unroll
            for (int v = 0; v < 10; ++v)
#pragma unroll
                for (int i = 0; i < 4; ++i) accS[v][i] *= wi[i];
        } else {
            const int j = wid - 4;
#pragma unroll
            for (int tile = 0; tile < 16; ++tile) {
                if ((int)((0x3333322221120000ull >> (4 * tile)) & 15ull) != j) continue;
                const int st = tile >> 2, tt = tile & 3;
                f32x4 cacc = (f32x4){0.f, 0.f, 0.f, 0.f};
                if (st <= tt) {
#pragma unroll
                    for (int ks = 0; ks < 4; ++ks) {
                        const bf16x8 a = *(const ML_LAS bf16x8*)(lds + O_KC + (16 * st + l15) * PQ + (32 * ks + 8 * q4) * 2);
                        const bf16x8 bq = *(const ML_LAS bf16x8*)(lds + O_QC + (16 * tt + l15) * PQ + (32 * ks + 8 * q4) * 2);
                        cacc = __builtin_amdgcn_mfma_f32_16x16x32_bf16(a, bq, cacc, 0, 0, 0);
                    }
                }
                const int t = 16 * tt + l15, s0 = 16 * st + 4 * q4;
                const float Mt = ch[64 + t]; const f32x4 as = *(const ML_LAS f32x4*)(ch + s0);
                float o[4];
#pragma unroll
                for (int i = 0; i < 4; ++i) o[i] = (s0 + i <= t) ? cacc[i] * __expf(as[i] - Mt) : 0.f;
                *(ML_LAS u32x2*)(lds + O_AM + t * PA + s0 * 2) = (u32x2){pk2(o[0], o[1]), pk2(o[2], o[3])};
            }
            const float decay = __expf(Mref - Mend);
#pragma unroll
            for (int v = 0; v < 20; ++v) accS[v] = accS[v] * decay;
#pragma unroll
            for (int ks = 0; ks < 2; ++ks) {
                const ML_LAS unsigned char* kp = lds + O_KC + (32 * ks + 8 * q4 + (l15 >> 2)) * PQ + 64 * j + (l15 & 3) * 8;
                const bf16x8 bf0 = cat8(trd(kp), trd(kp + 4 * PQ)), bf1 = cat8(trd(kp + 32), trd(kp + 4 * PQ + 32));
                const ML_LAS unsigned char* ap = lds + O_VW + (32 * ks + 8 * q4 + (l15 >> 2)) * PV + (l15 & 3) * 8;
#pragma unroll
                for (int v = 0; v < 10; ++v) { const bf16x8 afr = cat8(trd(ap + 32 * v), trd(ap + 4 * PV + 32 * v));
                    accS[v] = __builtin_amdgcn_mfma_f32_16x16x32_bf16(afr, bf0, accS[v], 0, 0, 0); accS[10 + v] = __builtin_amdgcn_mfma_f32_16x16x32_bf16(afr, bf1, accS[10 + v], 0, 0, 0); }
            }
        }
        __syncthreads();
        if (c + 1 < 64) ML_LOADS(c + 1);
        if (wid < 4) {
#pragma unroll
            for (int ks = 0; ks < 2; ++ks) {
                const bf16x8 a = *(const ML_LAS bf16x8*)(lds + O_AM + (16 * wid + l15) * PA + (32 * ks + 8 * q4) * 2);
                const ML_LAS unsigned char* bp = lds + O_VP + (32 * ks + 8 * q4 + (l15 >> 2)) * PV + (l15 & 3) * 8;
#pragma unroll
                for (int v = 0; v < 10; ++v) { const bf16x8 bfr = cat8(trd(bp + 32 * v), trd(bp + 4 * PV + 32 * v)); accS[v] = __builtin_amdgcn_mfma_f32_16x16x32_bf16(a, bfr, accS[v], 0, 0, 0); }
            }
            const f32x4 Bcr = *(const ML_LAS f32x4*)(ch + 128 + trow);
#pragma unroll
            for (int i = 0; i < 4; ++i) {
                float ssum = 0.f;
#pragma unroll
                for (int v = 0; v < 8; ++v) ssum += accS[v][i] * accS[v][i];
                ssum += __shfl_xor(ssum, 1); ssum += __shfl_xor(ssum, 2); ssum += __shfl_xor(ssum, 4); ssum += __shfl_xor(ssum, 8);
                const float den = __shfl(accS[8][i], lane & 48);
                const float dn = fmaxf(fabsf(den), __expf(-(Bcr[i] + Mxr[i]))), idn = 1.0f / dn;
                const float sc = idn * rsqrtf(ssum * idn * idn * (1.0f / 128.0f) + 1e-6f);
#pragma unroll
                for (int v = 0; v < 8; ++v) *(ML_LAS unsigned short*)(lds + O_HST + (trow + i) * PQ + (16 * v + l15) * 2) = (unsigned short)f2bf(accS[v][i] * sc);
            }
        } else {
            const int j = wid - 4;
#pragma unroll
            for (int v = 0; v < 10; ++v) {
                *(ML_LAS u32x2*)(lds + O_ST + (32 * j + l15) * PV + (16 * v + 4 * q4) * 2) = (u32x2){pk2(accS[v][0], accS[v][1]), pk2(accS[v][2], accS[v][3])};
                *(ML_LAS u32x2*)(lds + O_ST + (32 * j + 16 + l15) * PV + (16 * v + 4 * q4) * 2) = (u32x2){pk2(accS[10 + v][0], accS[10 + v][1]), pk2(accS[10 + v][2], accS[10 + v][3])}; }
        }
        if (c + 1 < 64) ML_LOAD(c + 1);
        if (tidv < 193) chs[((c + 1) & 1) * 256 + tidv] = chv;
        uint4 rmo[2];
#pragma unroll
        for (int ro = 0; ro < 2; ++ro) rmo[ro] = *(const uint4*)(A.mosig + goff + (c0 + row0 + ro) * 512);
        __syncthreads();
        f32x4 nwv[2]; nwv[0] = *(const f32x4*)(A.nw + h * 128 + 8 * d8); nwv[1] = *(const f32x4*)(A.nw + h * 128 + 8 * d8 + 4);
#pragma unroll
        for (int ro = 0; ro < 2; ++ro) {
            const u32x4 hv = *(const ML_LAS u32x4*)(lds + O_HST + (row0 + ro) * PQ + 16 * d8); const unsigned hw[4] = {hv.x, hv.y, hv.z, hv.w}; const unsigned mw[4] = {rmo[ro].x, rmo[ro].y, rmo[ro].z, rmo[ro].w}; unsigned o[4];
#pragma unroll
            for (int e2 = 0; e2 < 4; ++e2) o[e2] = pk2(blo(hw[e2]) * nwv[(2 * e2) >> 2][(2 * e2) & 3] * blo(mw[e2]), bhi(hw[e2]) * nwv[(2 * e2 + 1) >> 2][(2 * e2 + 1) & 3] * bhi(mw[e2]));
            *(uint4*)(A.hm + goff + (c0 + row0 + ro) * 512) = make_uint4(o[0], o[1], o[2], o[3]);
        }
    }
#undef ML_LOAD
#undef ML_LOADS
#undef goff
    __syncthreads();
}
}
namespace peer {
#define PE_LAS __attribute__((address_space(3)))
typedef short bf16x8 __attribute__((ext_vector_type(8)));
typedef float f32x4 __attribute__((ext_vector_type(4)));
typedef float f32x16 __attribute__((ext_vector_type(16)));
typedef unsigned u32x4 __attribute__((ext_vector_type(4)));
constexpr int QP = 528;
constexpr int O_R2 = 256 * QP;
constexpr int LDS_END = O_R2 + 1024;
__device__ __forceinline__ int ordi(float f) { const int b = __builtin_bit_cast(int, f); return b ^ ((b >> 31) & 0x7FFFFFFF); }
__device__ __forceinline__ float ordf(int o) { return __builtin_bit_cast(float, o ^ ((o >> 31) & 0x7FFFFFFF)); }
#define PE_CE(a, b) do { const int hi_ = max(a, b), lo_ = min(a, b); a = hi_; b = lo_; } while (0)
__device__ __forceinline__ void sort16_desc(int (&a)[16]) {
#pragma unroll
    for (int k = 2; k <= 16; k <<= 1)
#pragma unroll
        for (int j = k >> 1; j > 0; j >>= 1)
#pragma unroll
            for (int i = 0; i < 16; ++i) { const int l = i ^ j; if (l > i) { if ((i & k) == 0) PE_CE(a[i], a[l]); else PE_CE(a[l], a[i]); } }
}
__device__ __forceinline__ void merge16_desc(int (&a)[16], const int (&b)[16]) {
#pragma unroll
    for (int i = 0; i < 16; ++i) a[i] = max(a[i], b[15 - i]);
#pragma unroll
    for (int j = 8; j > 0; j >>= 1)
#pragma unroll
        for (int i = 0; i < 16; ++i) { const int l = i ^ j; if (l > i) PE_CE(a[i], a[l]); }
}
__device__ __forceinline__ void top16_of_64(int (&g0)[16], int (&g1)[16], int (&g2)[16], int (&g3)[16]) {
    sort16_desc(g0); sort16_desc(g1); sort16_desc(g2); sort16_desc(g3);
    merge16_desc(g0, g1); merge16_desc(g2, g3); merge16_desc(g0, g2);
}
struct Args { const float* rowss; const bf16_t* key1; const bf16_t* key2; float* r2out; int* eidx; float* eg; };
struct EpiPeerQ {
    static constexpr bool PERM = false, AFTER_DRAIN = true;
    __device__ __forceinline__ bool zero_after(const pg8::Unit&) const { return true; }
    __device__ __forceinline__ void fused(pg8::f32x4 (&acc)[2][2][4][2], const pg8::Unit& u, int wr, int wc, int fr, int fq, PG8_LAS unsigned char* lds, int wid, int lane) const {
        const PE_LAS float* r2s = (const PE_LAS float*)(lds + O_R2);
#pragma unroll
        for (int ai = 0; ai < 2; ++ai)
#pragma unroll
            for (int m = 0; m < 4; ++m) { const int row = ai * 128 + wr * 64 + m * 16 + fr; const float r = r2s[row];
#pragma unroll
                for (int bj = 0; bj < 2; ++bj) *(PE_LAS u32x4*)(lds + row * QP + (wc * 64 + bj * 32 + 8 * fq) * 2) = pg8::pack8(acc[ai][bj][m][0] * r, acc[ai][bj][m][1] * r); }
    }
};
struct SchedOne { pg8::Unit u;
    __device__ __forceinline__ bool next(int i, pg8::Unit& o) const { if (i > 0) return false; o = u; return true; }
    __device__ __forceinline__ void a_ready(const pg8::Unit&) const {}
    __device__ __forceinline__ void done(const pg8::Unit&) const {} };

__device__ __forceinline__ void half_top16(int (&g0)[16], const PE_LAS unsigned char* qrow  , const bf16_t* keyrow  , int hi) {
    f32x16 s[4];
#pragma unroll
    for (int kb = 0; kb < 4; ++kb) s[kb] = f32x16{};
#pragma unroll
    for (int ks = 0; ks < 8; ++ks) {
        const bf16x8 bq = *(const PE_LAS bf16x8*)(qrow + ks * 32);
#pragma unroll
        for (int kb = 0; kb < 4; ++kb) { const bf16x8 a = *(const bf16x8*)(keyrow + (size_t)kb * 32 * 128 + ks * 16); s[kb] = __builtin_amdgcn_mfma_f32_32x32x16_bf16(a, bq, s[kb], 0, 0, 0); }
    }
    int g1[16], g2[16], g3[16];
#pragma unroll
    for (int r = 0; r < 16; ++r) { const int kr = (r & 3) + 8 * (r >> 2) + 4 * hi;
        g0[r] = (ordi(s[0][r]) & ~0x7F) | kr; g1[r] = (ordi(s[1][r]) & ~0x7F) | (32 + kr); g2[r] = (ordi(s[2][r]) & ~0x7F) | (64 + kr); g3[r] = (ordi(s[3][r]) & ~0x7F) | (96 + kr); }
    top16_of_64(g0, g1, g2, g3);
#pragma unroll
    for (int r = 0; r < 16; ++r) g1[r] = __shfl_xor(g0[r], 32);
    merge16_desc(g0, g1);
}

__device__ __forceinline__ void unit(int pm, int h, const bf16_t* x1b, const bf16_t* wq, const Args& A, PG8_LAS unsigned char* lds) {
    int tid = threadIdx.x; asm volatile("" : "+v"(tid)); const int wid = __builtin_amdgcn_readfirstlane(tid >> 6);
    if (tid < 256) { const f32x4* rs = (const f32x4*)(A.rowss + (size_t)(pm * 256 + tid) * 16); const f32x4 a = rs[0], b = rs[1], c = rs[2], d = rs[3];
        const float ss = ((a[0] + a[1]) + (a[2] + a[3])) + ((b[0] + b[1]) + (b[2] + b[3])) + ((c[0] + c[1]) + (c[2] + c[3])) + ((d[0] + d[1]) + (d[2] + d[3]));
        const float r = rsqrtf(ss * (1.0f / 1024.0f) + 1e-6f); ((PE_LAS float*)(lds + O_R2))[tid] = r; if (h == 0) A.r2out[pm * 256 + tid] = r; }
    __syncthreads();
    SchedOne S; S.u.pm = pm; S.u.pn = h; S.u.seg = 0; S.u.pad = 0; S.u.A = (const char*)(x1b + (size_t)pm * 256 * 1024); S.u.B = (const char*)(wq + (size_t)h * 256 * 1024);
    EpiPeerQ E;
    pg8::gemm_phase<EpiPeerQ, SchedOne, true, true>(lds, 1024, S, E);
    __syncthreads();
    int tv = tid; asm volatile("" : "+v"(tv)); const int r32 = tv & 31, hi = (tv >> 5) & 1;
    int v1[16], v2[16];
    half_top16(v1, lds + (32 * wid + r32) * QP + (8 * hi) * 2, A.key1 + ((size_t)h * 128 + r32) * 128 + 8 * hi, hi);
    half_top16(v2, lds + (32 * wid + r32) * QP + (128 + 8 * hi) * 2, A.key2 + ((size_t)h * 128 + r32) * 128 + 8 * hi, hi);
    float f1[16], f2[16];
#pragma unroll
    for (int i = 0; i < 16; ++i) { f1[i] = ordf(v1[i] & ~0x7F); f2[i] = ordf(v2[i] & ~0x7F); }
    int c0[16], c1[16], c2[16], c3[16];
    {
        int n = 0;
#pragma unroll
        for (int i = 0; i < 16; ++i)
#pragma unroll
            for (int j = 0; j < 16; ++j) if ((i + 1) * (j + 1) <= 16) { const int key = (ordi(f1[i] + f2[j]) & ~0xFF) | (i << 4) | j;
                if (n < 16) c0[n] = key; else if (n < 32) c1[n - 16] = key; else if (n < 48) c2[n - 32] = key; else c3[n - 48] = key; ++n; }
#pragma unroll
        for (int k = 2; k < 16; ++k) c3[k] = (int)0x80000000;
    }
    top16_of_64(c0, c1, c2, c3);
    PE_LAS unsigned char* scr = lds + (32 * wid + r32) * QP;
    if (hi == 0) {
#pragma unroll
        for (int i = 0; i < 16; ++i) { scr[i] = (unsigned char)(v1[i] & 0x7F); scr[16 + i] = (unsigned char)(v2[i] & 0x7F); } }
    asm volatile("s_waitcnt lgkmcnt(0)" ::: "memory");
    float val[16], sum = 0.f;
#pragma unroll
    for (int r = 0; r < 16; ++r) { val[r] = __expf(ordf(c0[r] & ~0xFF) - ordf(c0[0] & ~0xFF)); sum += val[r]; }
    const float inv = 1.0f / sum;
    const size_t ob = ((size_t)(pm * 256 + 32 * wid + r32) * 8 + h) * 16;
#pragma unroll
    for (int r = 0; r < 16; ++r) if ((r >> 3) == hi) { const int code = c0[r] & 0xFF; A.eidx[ob + r] = (int)scr[code >> 4] * 128 + (int)scr[16 + (code & 15)]; A.eg[ob + r] = val[r] * inv; }
    __syncthreads();
}
}
#define XB_TMO      128
#define XB_XCNT(j)  (256  + 64 * (j))
#define XB_XSUB(j)  (1280 + 64 * (j))
#define XB_XGEN(j)  (2304 + 64 * (j))
#define XB_TOP      3328
#define XB_TOPGEN   3392
#define XCD_BAR_WORDS 3456
#define XB_SPIN_CAP (1u << 18)

__device__ __forceinline__ unsigned xb_ld(unsigned* p)              { return __hip_atomic_load(p, __ATOMIC_RELAXED, __HIP_MEMORY_SCOPE_AGENT); }
__device__ __forceinline__ unsigned xb_add(unsigned* p, unsigned v) { return __hip_atomic_fetch_add(p, v, __ATOMIC_RELAXED, __HIP_MEMORY_SCOPE_AGENT); }
__device__ __forceinline__ unsigned xb_xcc_id() { return (unsigned)__builtin_amdgcn_s_getreg((3 << 11) | 20) & 0xFu; }
#define XB_SPIN(cond, bar) do { unsigned _sp = 0; while (cond) { __builtin_amdgcn_s_sleep(1); \
    if ((++_sp & 255u) == 0u) { if (xb_ld(&(bar)[XB_TMO])) break; if (_sp > XB_SPIN_CAP) { atomicAdd(&(bar)[XB_TMO], 1u); break; } } } } while (0)

struct XcdBarrier {
    unsigned* bar; unsigned x;
    volatile __attribute__((address_space(3))) unsigned* st;
};

__device__ __forceinline__ XcdBarrier xcd_barrier_post(unsigned* bar, volatile __attribute__((address_space(3))) unsigned* st) {
    XcdBarrier b; b.bar = bar; b.x = xb_xcc_id(); b.st = st;
    if (threadIdx.x == 0) (void)xb_add(&bar[XB_XCNT(b.x)], 1u);
    return b;
}
__device__ __forceinline__ void xcd_barrier_complete(unsigned* bar, unsigned x, unsigned& nloc, unsigned& nx) {
    const unsigned G = gridDim.x * gridDim.y * gridDim.z;
    unsigned sum, cnt, mine, sp = 0u;
    for (;;) {
        sum = 0u; cnt = 0u; mine = 0u;
#pragma unroll
        for (unsigned j = 0; j < 16; ++j) { const unsigned c = xb_ld(&bar[XB_XCNT(j)]); sum += c; cnt += (c > 0u) ? 1u : 0u; mine = (j == x) ? c : mine; }
        if (sum == G) break;
        __builtin_amdgcn_s_sleep(1);
        if ((++sp & 255u) == 0u) { if (xb_ld(&bar[XB_TMO])) break; if (sp > XB_SPIN_CAP) { atomicAdd(&bar[XB_TMO], 1u); break; } }
    }
    nloc = mine > 0u ? mine : 1u; nx = cnt > 0u ? cnt : 1u;
}

__device__ __forceinline__ void xcd_barrier(const XcdBarrier& b) {
    asm volatile("s_waitcnt vmcnt(0)" ::: "memory");
    __syncthreads();
    if (threadIdx.x == 0) {
        unsigned* bar = b.bar;
        __builtin_amdgcn_s_waitcnt(0);
        unsigned nloc = b.st[0], nx = b.st[1];
        if (nloc == 0u) { xcd_barrier_complete(bar, b.x, nloc, nx); b.st[0] = nloc; b.st[1] = nx; }
        const unsigned old = xb_add(&bar[XB_XSUB(b.x)], 1u);
        const unsigned gen = old / nloc;
        if (old + 1u == (gen + 1u) * nloc) {
            __builtin_amdgcn_fence(__ATOMIC_RELEASE, "agent");
            asm volatile("s_waitcnt vmcnt(0)" ::: "memory");
            const unsigned og = xb_add(&bar[XB_TOP], 1u);
            const unsigned tg = og / nx;
            if (og + 1u == (tg + 1u) * nx) xb_add(&bar[XB_TOPGEN], 1u);
            else XB_SPIN(xb_ld(&bar[XB_TOPGEN]) == tg, bar);
            __builtin_amdgcn_fence(__ATOMIC_ACQUIRE, "agent");
            xb_add(&bar[XB_XGEN(b.x)], 1u);
            asm volatile("s_waitcnt vmcnt(0)" ::: "memory");
        } else {
            XB_SPIN(xb_ld(&bar[XB_XGEN(b.x)]) == gen, bar);
            __builtin_amdgcn_fence(__ATOMIC_ACQUIRE, "agent");
            asm volatile("s_waitcnt vmcnt(0)" ::: "memory");
        }
    }
    __syncthreads();
}
#include <hip/hip_cooperative_groups.h>
namespace cg = cooperative_groups;
constexpr int BIG_LDS = 156 * 1024 + 256;
constexpr int LDS_CTL = 156 * 1024;
constexpr int DUP = 0;
struct PArgs { const float* in[20]; float* out; char* ws; };
__device__ __forceinline__ const PArgs* kargs() { auto kp = __builtin_amdgcn_kernarg_segment_ptr(); asm volatile("" : "+s"(kp)); return (const PArgs*)kp; }

__device__ __forceinline__ void phase0(const PArgs& p, unsigned char* shm) {
    int tid = threadIdx.x; asm volatile("" : "+v"(tid)); const int lane = tid & 63, wid = tid >> 6;
    const int gw = blockIdx.x * 8 + wid, NGW = gridDim.x * 8; const size_t gt = (size_t)blockIdx.x * 512 + tid, NTH = (size_t)gridDim.x * 512;
    char* ws = p.ws;
    { float* km = (float*)(ws + OFF_KMEAN); for (size_t i = gt; i < (size_t)16 * 8 * 16 * 64; i += NTH) km[i] = 0.f; }
    { float* rc = (float*)(ws + OFF_ROPE); float* rs = rc + 4096 * 8;
      for (size_t i = gt; i < 4096 * 8; i += NTH) { const int pos = (int)(i >> 3), k = (int)(i & 7); const float inv_freq = (float)pow(500000.0, -(double)(2 * k) / 16.0); const float ang = (float)pos * inv_freq;
          rc[i] = (float)cos((double)ang); rs[i] = (float)sin((double)ang); } }
    {
        const float* wdn = p.in[18]; const float* wup = p.in[19]; const float* fw = p.in[14]; unsigned* WU = (unsigned*)(ws + OFF_WU);
        { uint4* WDq = (uint4*)(ws + OFF_WD); float* SD = (float*)(ws + OFF_WD + 16 * MiB); float fv[16];
#pragma unroll
          for (int j = 0; j < 4; ++j) { const float4 s = *(const float4*)(fw + 16 * lane + 4 * j); fv[4 * j] = s.x; fv[4 * j + 1] = s.y; fv[4 * j + 2] = s.z; fv[4 * j + 3] = s.w; }
          for (int e0 = gw; e0 < 16384; e0 += 4 * NGW) { float4 ld[4][4];
#pragma unroll
            for (int u = 0; u < 4; ++u)
#pragma unroll
              for (int j = 0; j < 4; ++j) { const int e_ = e0 + u * NGW < 16384 ? e0 + u * NGW : e0; ld[u][j] = *(const float4*)(wdn + (size_t)e_ * 1024 + 16 * lane + 4 * j); }
#pragma unroll
            for (int u = 0; u < 4; ++u) { const int e = e0 + u * NGW; if (e >= 16384) break; float v[16], am = 0.f;
#pragma unroll
              for (int j = 0; j < 4; ++j) { const float4 a = ld[u][j]; v[4 * j] = a.x * fv[4 * j]; v[4 * j + 1] = a.y * fv[4 * j + 1]; v[4 * j + 2] = a.z * fv[4 * j + 2]; v[4 * j + 3] = a.w * fv[4 * j + 3]; }
              float ss = 0.f;
#pragma unroll
              for (int j = 0; j < 16; ++j) { am = fmaxf(am, fabsf(v[j])); ss += v[j] * v[j]; }
#pragma unroll
              for (int o = 32; o >= 1; o >>= 1) { am = fmaxf(am, __shfl_xor(am, o)); ss += __shfl_xor(ss, o); }
              const float step = fminf(am * (1.0f / 7.0f), 0.35f * sqrtf(ss * (1.0f / 1024.0f)));
              const float inv = step > 0.f ? 1.0f / step : 0.f; unsigned q[2] = {0u, 0u};
#pragma unroll
              for (int k = 0; k < 16; ++k) { const int qi = (int)fminf(fmaxf(rintf(v[k] * inv), -7.0f), 7.0f); q[k >> 3] |= (unsigned)(qi & 15) << (4 * (k & 7)); }
              ((uint2*)WDq)[(size_t)e * 64 + lane] = make_uint2(q[0], q[1]); if (lane == 0) SD[e] = step; } } }
        { uint2* WU4 = (uint2*)WU; float* SU = (float*)(ws + OFF_WU + 16 * MiB);
          for (int e0 = gw; e0 < 16384; e0 += 4 * NGW) { float4 ld[4][4];
#pragma unroll
            for (int u = 0; u < 4; ++u)
#pragma unroll
              for (int j = 0; j < 4; ++j) { const int e_ = e0 + u * NGW < 16384 ? e0 + u * NGW : e0; ld[u][j] = *(const float4*)(wup + (size_t)e_ * 1024 + 16 * lane + 4 * j); }
#pragma unroll
            for (int u = 0; u < 4; ++u) { const int e = e0 + u * NGW; if (e >= 16384) break; float v[16], ss = 0.f;
#pragma unroll
              for (int j = 0; j < 4; ++j) { const float4 a = ld[u][j]; v[4 * j] = a.x; v[4 * j + 1] = a.y; v[4 * j + 2] = a.z; v[4 * j + 3] = a.w; }
#pragma unroll
              for (int j = 0; j < 16; ++j) ss += v[j] * v[j];
#pragma unroll
              for (int o = 32; o >= 1; o >>= 1) ss += __shfl_xor(ss, o);
              const float sc = 0.5f * sqrtf(ss * (1.0f / 1024.0f)), inv = sc > 0.f ? 1.0f / sc : 0.f; unsigned q[2] = {0u, 0u};
#pragma unroll
              for (int k = 0; k < 16; ++k) { const float a_ = fabsf(v[k]) * inv;
                  const unsigned code = (unsigned)(a_ > 0.25f) + (unsigned)(a_ > 0.75f) + (unsigned)(a_ > 1.25f) + (unsigned)(a_ > 1.75f) + (unsigned)(a_ > 2.5f) + (unsigned)(a_ > 3.5f) + (unsigned)(a_ > 5.0f);
                  q[k >> 3] |= (code | (v[k] < 0.f ? 8u : 0u)) << (4 * (k & 7)); }
              WU4[(size_t)e * 64 + lane] = make_uint2(q[0], q[1]); if (lane == 0) SU[e] = sc; } } }
        const float* k1 = p.in[16]; const float* k2 = p.in[17]; bf16_t* K1 = (bf16_t*)(ws + OFF_KEY1); bf16_t* K2 = (bf16_t*)(ws + OFF_KEY2);
        for (size_t i = gt * 4; i < (size_t)8 * 128 * 128; i += NTH * 4) { const float4 a = *(const float4*)(k1 + i), b = *(const float4*)(k2 + i);
            *(uint2*)(K1 + i) = make_uint2(pk2(a.x, a.y), pk2(a.z, a.w)); *(uint2*)(K2 + i) = make_uint2(pk2(b.x, b.y), pk2(b.z, b.w)); }
    }
    {
        __attribute__((address_space(3))) float* tl = (__attribute__((address_space(3))) float*)(shm) + wid * (32 * 33);
        const int tx = lane & 31, ty = lane >> 5;
        for (int item = gw; item < 9728; item += NGW) {
            const float* W; const float* sc; bf16_t* O; int K, N, nbx, thr = 1 << 30, add = 0, it = item;
            if (it < 5632) { W = p.in[2]; sc = p.in[1]; O = (bf16_t*)(ws + OFF_WIN); K = 1024; N = INC; nbx = 176; thr = 3584; add = 8; }
            else if ((it -= 5632) < 512) { W = p.in[10]; sc = nullptr; O = (bf16_t*)(ws + OFF_WAB); K = 512; N = 1024; nbx = 32; }
            else if ((it -= 512) < 512) { W = p.in[11]; sc = nullptr; O = (bf16_t*)(ws + OFF_WMB); K = 512; N = 1024; nbx = 32; }
            else if ((it -= 512) < 1024) { W = p.in[13]; sc = nullptr; O = (bf16_t*)(ws + OFF_WOUT); K = 1024; N = 1024; nbx = 32; }
            else { it -= 1024; W = p.in[15]; sc = p.in[14]; O = (bf16_t*)(ws + OFF_WQ); K = 1024; N = 2048; nbx = 64; }
            const int n0 = (it % nbx) * 32, k0 = (it / nbx) * 32;
            float tv[16];
            { const int np = n0 + tx, ac = (np & ~255) + sigma_col(np & 255), src = ac + (ac >= thr ? add : 0);
#pragma unroll
              for (int ii = 0; ii < 16; ++ii) { const int k = k0 + ty + 2 * ii; tv[ii] = W[(size_t)k * N + src] * (sc ? sc[k] : 1.0f); }
#pragma unroll
              for (int ii = 0; ii < 16; ++ii) tl[(ty + 2 * ii) * 33 + tx] = tv[ii]; }
            asm volatile("s_waitcnt lgkmcnt(0)" ::: "memory");
#pragma unroll
            for (int ii = 0; ii < 16; ++ii) { const int i = ty + 2 * ii, np = n0 + i, k = k0 + tx; O[(size_t)np * K + k] = (bf16_t)f2bf(tl[tx * 33 + i]); }
            asm volatile("s_waitcnt lgkmcnt(0)" ::: "memory");
        }
    }
    {
        const float* x = p.in[0]; const float* normw = p.in[1]; const float* w_in = p.in[2]; const float* igb = p.in[7]; const float* fgb = p.in[8];
        bf16_t* xb = (bf16_t*)(ws + OFF_XB); float* r1 = (float*)(ws + OFF_R1); float* ifg = (float*)(ws + OFF_IFG);
        float wg[4][4][8];
#pragma unroll
        for (int j = 0; j < 4; ++j)
#pragma unroll
            for (int i = 0; i < 4; ++i) { const int k = 256 * j + 4 * lane + i; const float nw = normw[k];
#pragma unroll
                for (int c = 0; c < 8; ++c) wg[j][i][c] = w_in[(size_t)k * INC + 3584 + c] * nw; }
        for (int row = gw; row < T_; row += NGW) {
            const float4* xr = (const float4*)(x + (size_t)row * D_) + lane;
            float4 v[4];
#pragma unroll
            for (int j = 0; j < 4; ++j) v[j] = xr[64 * j];
            float ss = 0.f, g[8];
#pragma unroll
            for (int c = 0; c < 8; ++c) g[c] = 0.f;
#pragma unroll
            for (int j = 0; j < 4; ++j) {
                ss += v[j].x * v[j].x + v[j].y * v[j].y + v[j].z * v[j].z + v[j].w * v[j].w;
#pragma unroll
                for (int c = 0; c < 8; ++c) g[c] += v[j].x * wg[j][0][c] + v[j].y * wg[j][1][c] + v[j].z * wg[j][2][c] + v[j].w * wg[j][3][c];
            }
#pragma unroll
            for (int o = 1; o < 64; o <<= 1) { ss += __shfl_xor(ss, o);
#pragma unroll
                for (int c = 0; c < 8; ++c) g[c] += __shfl_xor(g[c], o); }
            const float r = rsqrtf(ss * (1.0f / D_) + 1e-6f);
            if (lane == 0) { r1[row] = r;
#pragma unroll
                for (int c = 0; c < 8; ++c) ifg[(size_t)row * 8 + c] = g[c] * r + (c < 4 ? igb[c] : fgb[c - 4]); }
            uint2* o8 = (uint2*)(xb + (size_t)row * D_) + lane;
#pragma unroll
            for (int j = 0; j < 4; ++j) o8[64 * j] = make_uint2(pk2(v[j].x, v[j].y), pk2(v[j].z, v[j].w));
        }
    }
}
typedef float f32x2_t __attribute__((ext_vector_type(2)));
typedef unsigned p5_u32x4 __attribute__((ext_vector_type(4)));
#define P5_LAS __attribute__((address_space(3)))
#define P5_TIE8(R) "+v"(R[0]), "+v"(R[1]), "+v"(R[2]), "+v"(R[3]), "+v"(R[4]), "+v"(R[5]), "+v"(R[6]), "+v"(R[7])
#define P5_OUT(I, ACC) do { const uint4 a_ = *((const uint4*)(x1b + (tb + I) * 2048) + 2 * ln), c_ = *((const uint4*)(x1b + (tb + I) * 2048) + 2 * ln + 1); const unsigned w_[8] = {a_.x, a_.y, a_.z, a_.w, c_.x, c_.y, c_.z, c_.w}; \
        float4* o_ = (float4*)(out + (tb + I) * 1024 + 16 * ln); \
        _Pragma("unroll") for (int j_ = 0; j_ < 4; ++j_) o_[j_] = make_float4(__builtin_bit_cast(float, w_[2 * j_] << 16) + ACC[2 * j_].x, __builtin_bit_cast(float, w_[2 * j_] & 0xffff0000u) + ACC[2 * j_].y, \
                                                                             __builtin_bit_cast(float, w_[2 * j_ + 1] << 16) + ACC[2 * j_ + 1].x, __builtin_bit_cast(float, w_[2 * j_ + 1] & 0xffff0000u) + ACC[2 * j_ + 1].y); } while (0)
typedef unsigned p5_u32x2 __attribute__((ext_vector_type(2)));
#define P5_ROWFMA4(ACC, PRV, R, CF) do { p5_u32x2 r__ = R;   \
    asm volatile("" : "+v"(r__), "+v"(PRV[0]), "+v"(PRV[1]), "+v"(PRV[2]), "+v"(PRV[3]), "+v"(PRV[4]), "+v"(PRV[5]), "+v"(PRV[6]), "+v"(PRV[7])); \
    const f32x2_t cf2_ = {CF, CF}; \
    ACC[0] = __builtin_elementwise_fma((f32x2_t)__builtin_amdgcn_cvt_scalef32_pk_f32_fp4(r__.x, 1.0f, 0), cf2_, ACC[0]); ACC[1] = __builtin_elementwise_fma((f32x2_t)__builtin_amdgcn_cvt_scalef32_pk_f32_fp4(r__.x, 1.0f, 1), cf2_, ACC[1]); \
    ACC[2] = __builtin_elementwise_fma((f32x2_t)__builtin_amdgcn_cvt_scalef32_pk_f32_fp4(r__.x, 1.0f, 2), cf2_, ACC[2]); ACC[3] = __builtin_elementwise_fma((f32x2_t)__builtin_amdgcn_cvt_scalef32_pk_f32_fp4(r__.x, 1.0f, 3), cf2_, ACC[3]); \
    ACC[4] = __builtin_elementwise_fma((f32x2_t)__builtin_amdgcn_cvt_scalef32_pk_f32_fp4(r__.y, 1.0f, 0), cf2_, ACC[4]); ACC[5] = __builtin_elementwise_fma((f32x2_t)__builtin_amdgcn_cvt_scalef32_pk_f32_fp4(r__.y, 1.0f, 1), cf2_, ACC[5]); \
    ACC[6] = __builtin_elementwise_fma((f32x2_t)__builtin_amdgcn_cvt_scalef32_pk_f32_fp4(r__.y, 1.0f, 2), cf2_, ACC[6]); ACC[7] = __builtin_elementwise_fma((f32x2_t)__builtin_amdgcn_cvt_scalef32_pk_f32_fp4(r__.y, 1.0f, 3), cf2_, ACC[7]); } while (0)
#define P5_BFMA8U(R, CK) do { _Pragma("unroll") for (int j_ = 0; j_ < 8; j_ += 4) { \
    { const float cf_ = __builtin_bit_cast(float, __builtin_amdgcn_readlane(CK, j_));     P5_ROWFMA4(acc0, acc3, R[j_], cf_); } \
    { const float cf_ = __builtin_bit_cast(float, __builtin_amdgcn_readlane(CK, j_ + 1)); P5_ROWFMA4(acc1, acc0, R[j_ + 1], cf_); } \
    { const float cf_ = __builtin_bit_cast(float, __builtin_amdgcn_readlane(CK, j_ + 2)); P5_ROWFMA4(acc2, acc1, R[j_ + 2], cf_); } \
    { const float cf_ = __builtin_bit_cast(float, __builtin_amdgcn_readlane(CK, j_ + 3)); P5_ROWFMA4(acc3, acc2, R[j_ + 3], cf_); } } } while (0)
#define P5_ISSUE8U(R, B, CK) do { const int lk_ = keys[8 * (B) + (ln & 7)]; CK = __builtin_bit_cast(int, cfs[8 * (B) + (ln & 7)]); \
    _Pragma("unroll") for (int j_ = 0; j_ < 8; ++j_) { const unsigned char* rp_ = wu + (size_t)__builtin_amdgcn_readlane(lk_, j_) * 512; \
        asm volatile("global_load_dwordx2 %0, %1, %2" : "=v"(R[j_]) : "v"(voff8), "s"(rp_) : "memory"); } } while (0)
#define P5_DOT(R, XH, XL) __builtin_amdgcn_sdot8((int)R.y, (int)XL.y, __builtin_amdgcn_sdot8((int)R.x, (int)XL.x, 16 * __builtin_amdgcn_sdot8((int)R.y, (int)XH.y, __builtin_amdgcn_sdot8((int)R.x, (int)XH.x, 0, false), false), false), false)
#define P5_ISSUE8D(R, B) do { const int lk_ = keys[8 * (B) + (ln & 7)]; \
    _Pragma("unroll") for (int j_ = 0; j_ < 8; ++j_) { const unsigned char* rp_ = wd + (size_t)__builtin_amdgcn_readlane(lk_, j_) * 512; \
        asm volatile("global_load_dwordx2 %0, %1, %2" : "=v"(R[j_]) : "v"(voff8), "s"(rp_) : "memory"); } } while (0)
#define P5_DOWN8(R, BB) do { int pd_[8]; \
    _Pragma("unroll") for (int j_ = 0; j_ < 8; j_ += 4) { pd_[j_] = P5_DOT(R[j_], xh0, xl0); pd_[j_ + 1] = P5_DOT(R[j_ + 1], xh1, xl1); pd_[j_ + 2] = P5_DOT(R[j_ + 2], xh2, xl2); pd_[j_ + 3] = P5_DOT(R[j_ + 3], xh3, xl3); } \
    _Pragma("unroll") for (int i_ = 0; i_ < 4; ++i_) { const auto r_ = __builtin_amdgcn_permlane32_swap((unsigned)pd_[i_], (unsigned)pd_[i_ + 4], false, false); pd_[i_] = (int)(r_[0] + r_[1]); } \
    _Pragma("unroll") for (int i_ = 0; i_ < 2; ++i_) { const auto r_ = __builtin_amdgcn_permlane16_swap((unsigned)pd_[i_], (unsigned)pd_[i_ + 2], false, false); pd_[i_] = (int)(r_[0] + r_[1]); } \
    { const bool b8_ = (ln & 8) != 0; const int keep_ = b8_ ? pd_[1] : pd_[0], send_ = b8_ ? pd_[0] : pd_[1]; int z_ = keep_ + __builtin_amdgcn_update_dpp(0, send_, 0x140, 0xf, 0xf, false); \
      z_ += __builtin_amdgcn_update_dpp(0, z_, 0x141, 0xf, 0xf, false); z_ += __builtin_amdgcn_update_dpp(0, z_, 0xB1, 0xf, 0xf, false); z_ += __builtin_amdgcn_update_dpp(0, z_, 0x4E, 0xf, 0xf, false); \
      zz = (ln & 7) == ((BB) & 7) ? z_ : zz; } \
    if (((BB) & 7) == 7) { const int pos_ = 8 * ((BB) - 7) + 8 * (ln & 7) + (ln >> 3); const int e_ = keys[pos_]; const float g_ = cfs[pos_]; const int tk_ = (ln >> 3) & 3; \
        const float sx_ = tk_ == 0 ? sx0 : tk_ == 1 ? sx1 : tk_ == 2 ? sx2 : sx3; const float av_ = (float)zz * sx_ * (float)sdl[e_]; \
        cfs[pos_] = g_ * 0.5f * av_ * (1.0f + erff(av_ * 0.70710678118654752f)) * (float)sul[e_]; } } while (0)
__device__ __forceinline__ void phase5_all(const PArgs& p, float* out, unsigned char* shm) {
    int tid = threadIdx.x; asm volatile("" : "+v"(tid)); const int wid = __builtin_amdgcn_readfirstlane(tid >> 6);
    const char* x1b = (const char*)(p.ws + OFF_MV); const char* eidx = (const char*)(p.ws + OFF_EIDX); const char* egp = (const char*)(p.ws + OFF_EG); const float* r2 = (const float*)(p.ws + OFF_R2);
    const unsigned char* wd = (const unsigned char*)(p.ws + OFF_WD); const unsigned char* wu = (const unsigned char*)(p.ws + OFF_WU); const float* SD = (const float*)(p.ws + OFF_WD + 16 * MiB); const float* SU = (const float*)(p.ws + OFF_WU + 16 * MiB);
    P5_LAS _Float16* sdl = (P5_LAS _Float16*)shm; P5_LAS _Float16* sul = sdl + 16384;
    P5_LAS int* keys = (P5_LAS int*)(shm + 65536 + wid * 4608); P5_LAS float* cfs = (P5_LAS float*)(keys + 512); P5_LAS int* cntl = (P5_LAS int*)(keys + 1024);
    const int rot = 4 * ((int)blockIdx.x & 7);
    for (int i = tid; i < 16384; i += 512) { sdl[i] = (_Float16)SD[i]; sul[i] = (_Float16)SU[i]; }
    __syncthreads();
    const int G = (int)gridDim.x, NR = (T_ / 32 + G - 1 - (int)blockIdx.x) / G;
#pragma unroll 1
    for (int rnd = 0; rnd < NR; ++rnd) {
        int ln = tid; asm volatile("" : "+v"(ln)); ln &= 63; const unsigned voff = (unsigned)ln * 16u, voff4 = (unsigned)ln * 4u, voff8 = (unsigned)ln * 8u;
        const size_t tb = ((size_t)(rnd * G + (int)blockIdx.x) * 8 + wid) * 4;
        int ev[4][2], cv[4][2];
#pragma unroll
        for (int i_ = 0; i_ < 4; ++i_) { const char* ep_ = eidx + (tb + i_) * 512; const char* cp_ = egp + (tb + i_) * 512;
            asm volatile("global_load_dword %0, %4, %5\n\tglobal_load_dword %1, %4, %5 offset:256\n\tglobal_load_dword %2, %4, %6\n\tglobal_load_dword %3, %4, %6 offset:256"
                         : "=&v"(ev[i_][0]), "=&v"(ev[i_][1]), "=&v"(cv[i_][0]), "=&v"(cv[i_][1]) : "v"(voff4), "s"(ep_), "s"(cp_) : "memory"); }
        p5_u32x2 xh0, xh1, xh2, xh3, xl0, xl1, xl2, xl3; float sx0, sx1, sx2, sx3;
#define P5_QUANT(I, XH, XL, SX) do { const uint4 a_ = *((const uint4*)(x1b + (tb + I) * 2048) + 2 * ln), c_ = *((const uint4*)(x1b + (tb + I) * 2048) + 2 * ln + 1); \
        const unsigned w_[8] = {a_.x, a_.y, a_.z, a_.w, c_.x, c_.y, c_.z, c_.w}; float xv_[16], am_ = 0.f; \
        _Pragma("unroll") for (int k_ = 0; k_ < 8; ++k_) { xv_[2 * k_] = __builtin_bit_cast(float, w_[k_] << 16); xv_[2 * k_ + 1] = __builtin_bit_cast(float, w_[k_] & 0xffff0000u); am_ = fmaxf(am_, fmaxf(fabsf(xv_[2 * k_]), fabsf(xv_[2 * k_ + 1]))); } \
        _Pragma("unroll") for (int o_ = 32; o_ >= 1; o_ >>= 1) am_ = fmaxf(am_, __builtin_bit_cast(float, __builtin_amdgcn_ds_bpermute(4 * (ln ^ o_), __builtin_bit_cast(int, am_)))); \
        const float inv_ = am_ > 0.f ? 119.0f / am_ : 0.f; unsigned h_[2] = {0u, 0u}, l_[2] = {0u, 0u}; \
        _Pragma("unroll") for (int k_ = 0; k_ < 16; ++k_) { const int q_ = (int)rintf(xv_[k_] * inv_); const int lo_ = ((q_ + 8) & 15) - 8, hi_ = (q_ - lo_) >> 4;     \
            h_[k_ >> 3] |= (unsigned)(hi_ & 15) << (4 * (k_ & 7)); l_[k_ >> 3] |= (unsigned)(lo_ & 15) << (4 * (k_ & 7)); } \
        XH = p5_u32x2{h_[0], h_[1]}; XL = p5_u32x2{l_[0], l_[1]}; SX = am_ * (1.0f / 119.0f) * r2[tb + I]; } while (0)
        P5_QUANT(0, xh0, xl0, sx0); P5_QUANT(1, xh1, xl1, sx1); P5_QUANT(2, xh2, xl2, sx2); P5_QUANT(3, xh3, xl3, sx3);
        asm volatile("s_waitcnt vmcnt(0)" : "+v"(ev[0][0]), "+v"(ev[0][1]), "+v"(ev[1][0]), "+v"(ev[1][1]), "+v"(ev[2][0]), "+v"(ev[2][1]), "+v"(ev[3][0]), "+v"(ev[3][1]) :: "memory");
        asm volatile("" : "+v"(cv[0][0]), "+v"(cv[0][1]), "+v"(cv[1][0]), "+v"(cv[1][1]), "+v"(cv[2][0]), "+v"(cv[2][1]), "+v"(cv[3][0]), "+v"(cv[3][1]));
        cntl[ln] = 0; cntl[64 + ln] = 0;
        int bk[4][2];
#pragma unroll
        for (int i = 0; i < 4; ++i)
#pragma unroll
            for (int ps = 0; ps < 2; ++ps) { bk[i][ps] = 32 * i + ((((ev[i][ps] & 16383) >> 9) - rot) & 31); (void)__hip_atomic_fetch_add(cntl + bk[i][ps], 1, __ATOMIC_RELAXED, __HIP_MEMORY_SCOPE_WORKGROUP); }
#pragma unroll
        for (int hh = 0; hh < 2; ++hh) { const int c_ = cntl[64 * hh + ln]; int inc = c_;
#pragma unroll
          for (int o = 1; o < 32; o <<= 1) { const int u_ = __builtin_amdgcn_ds_bpermute(4 * (ln - o), inc); if ((ln & 31) >= o) inc += u_; }
          cntl[64 * hh + ln] = inc - c_; }
#pragma unroll
        for (int i = 0; i < 4; ++i)
#pragma unroll
            for (int ps = 0; ps < 2; ++ps) { const int pos = 4 * __hip_atomic_fetch_add(cntl + bk[i][ps], 1, __ATOMIC_RELAXED, __HIP_MEMORY_SCOPE_WORKGROUP) + i;
                keys[pos] = ev[i][ps] & 16383; cfs[pos] = __builtin_bit_cast(float, cv[i][ps]); }
        int dx, dl, dm;
        { const int rn = rnd + 1 < NR ? rnd + 1 : rnd; const size_t tn = ((size_t)(rn * G + (int)blockIdx.x) * 8 + wid) * 4;
          const char* pe = eidx + tn * 512; const char* pc = egp + tn * 512; const char* px = x1b + tn * 2048;
          asm volatile("global_load_dword %0, %3, %5\n\tglobal_load_dword %1, %4, %6\n\tglobal_load_dword %2, %4, %7" : "=&v"(dx), "=&v"(dl), "=&v"(dm) : "v"(ln * 128), "v"((ln & 15) * 128), "s"(px), "s"(pe), "s"(pc) : "memory"); }
        p5_u32x2 ua[8], ub[8], uc[8]; int cka, ckb, ckc;
        {
            int zz = 0;
            p5_u32x2 da[8], db[8], dc[8];
            P5_ISSUE8D(da, 0); P5_ISSUE8D(db, 1); P5_ISSUE8D(dc, 2);
#pragma unroll 1
            for (int b = 0; b < 60; b += 3) {
                asm volatile("s_waitcnt vmcnt(16)" : P5_TIE8(da) :: "memory"); P5_DOWN8(da, b); P5_ISSUE8D(da, b + 3);
                asm volatile("s_waitcnt vmcnt(16)" : P5_TIE8(db) :: "memory"); P5_DOWN8(db, b + 1); P5_ISSUE8D(db, b + 4);
                asm volatile("s_waitcnt vmcnt(16)" : P5_TIE8(dc) :: "memory"); P5_DOWN8(dc, b + 2); P5_ISSUE8D(dc, b + 5);
            }
            asm volatile("s_waitcnt vmcnt(16)" : P5_TIE8(da) :: "memory"); P5_DOWN8(da, 60); P5_ISSUE8D(da, 63);
            P5_ISSUE8U(ua, 0, cka); P5_ISSUE8U(ub, 1, ckb); P5_ISSUE8U(uc, 2, ckc);
            asm volatile("s_waitcnt vmcnt(40)" : P5_TIE8(db) :: "memory"); P5_DOWN8(db, 61);
            asm volatile("s_waitcnt vmcnt(32)" : P5_TIE8(dc) :: "memory"); P5_DOWN8(dc, 62);
            asm volatile("s_waitcnt vmcnt(24)" : P5_TIE8(da) :: "memory"); P5_DOWN8(da, 63);
            asm volatile("" : "+v"(dx), "+v"(dl), "+v"(dm));
        }
        f32x2_t acc0[8], acc1[8], acc2[8], acc3[8];
#pragma unroll
        for (int i = 0; i < 8; ++i) { acc0[i] = (f32x2_t){0.f, 0.f}; acc1[i] = acc0[i]; acc2[i] = acc0[i]; acc3[i] = acc0[i]; }
#pragma unroll 1
        for (int b = 0; b < 60; b += 3) {
            asm volatile("s_waitcnt vmcnt(16)" : P5_TIE8(ua) :: "memory"); P5_BFMA8U(ua, cka); P5_ISSUE8U(ua, b + 3, cka);
            asm volatile("s_waitcnt vmcnt(16)" : P5_TIE8(ub) :: "memory"); P5_BFMA8U(ub, ckb); P5_ISSUE8U(ub, b + 4, ckb);
            asm volatile("s_waitcnt vmcnt(16)" : P5_TIE8(uc) :: "memory"); P5_BFMA8U(uc, ckc); P5_ISSUE8U(uc, b + 5, ckc);
        }
        asm volatile("s_waitcnt vmcnt(16)" : P5_TIE8(ua) :: "memory"); P5_BFMA8U(ua, cka); P5_ISSUE8U(ua, 63, cka);
        asm volatile("s_waitcnt vmcnt(16)" : P5_TIE8(ub) :: "memory"); P5_BFMA8U(ub, ckb);
        asm volatile("s_waitcnt vmcnt(8)" : P5_TIE8(uc) :: "memory"); P5_BFMA8U(uc, ckc);
        asm volatile("s_waitcnt vmcnt(0)" : P5_TIE8(ua) :: "memory"); P5_BFMA8U(ua, cka);
        P5_OUT(0, acc0); P5_OUT(1, acc1); P5_OUT(2, acc2); P5_OUT(3, acc3);
    }
}

__global__ __launch_bounds__(512, 2) void k_mega(PArgs p_unused) {
    extern __shared__ __attribute__((aligned(16))) unsigned char shm[];
    cg::grid_group grid = cg::this_grid();
    PG8_LAS unsigned char* lds = (PG8_LAS unsigned char*)shm;
    volatile __attribute__((address_space(3))) unsigned* lctl = (volatile __attribute__((address_space(3))) unsigned*)(lds + LDS_CTL);
    if (threadIdx.x < 64) lctl[threadIdx.x] = 0u;
    __syncthreads();
    const XcdBarrier xbar = xcd_barrier_post((unsigned*)(kargs()->ws + OFF_CTL), lctl);
    for (int rep_ = 0; rep_ < (DUP == 10 ? 2 : 1); ++rep_) { const PArgs p = *kargs(); phase0(p, shm); if (DUP == 10) grid.sync(); }
    grid.sync();
    for (int rep_ = 0; rep_ < (DUP == 1 ? 2 : 1); ++rep_) {
        const PArgs& p = *kargs();
        pg8::SchedGrid S; S.init(p.ws + OFF_XB, p.ws + OFF_WIN, nullptr, nullptr, T_, 5632, 1024, 1, (int)gridDim.x, (int)blockIdx.x);
        pg8::EpiInProj E; E.r1 = (const float*)(p.ws + OFF_R1); E.qnw = p.in[3]; E.knw = p.in[4]; E.ropec = (const float*)(p.ws + OFF_ROPE); E.ropes = E.ropec + 4096 * 8; E.merge_b = p.in[12]; E.ws = p.ws; E.kmean = (float*)(p.ws + OFF_KMEAN); E.skip_km = rep_;
        pg8::gemm_phase<pg8::EpiInProj, pg8::SchedGrid, true, true>(lds, 1024, S, E);
        if (DUP == 1) grid.sync();
    }
    xcd_barrier(xbar);
    {
        const PArgs& p = *kargs();
        const attn_body::AttnTensors AT{(const attn_body::bf16*)(p.ws + OFF_Q), (const attn_body::bf16*)(p.ws + OFF_K), (const attn_body::bf16*)(p.ws + OFF_V), (attn_body::bf16*)(p.ws + OFF_XB), (const float*)(p.ws + OFF_KMEAN)};
        mlstm::Args A; A.mq = (const bf16_t*)(p.ws + OFF_MQ); A.mk = (const bf16_t*)(p.ws + OFF_MK); A.mv = (const bf16_t*)(p.ws + OFF_MV); A.mosig = (const bf16_t*)(p.ws + OFF_MO);
        A.ifg = (const float*)(p.ws + OFF_IFG); A.conv_w = p.in[5]; A.conv_b = p.in[6]; A.nw = p.in[9]; A.sca = (float*)(p.ws + OFF_SCA); A.scm = (float*)(p.ws + OFF_SCM); A.scb = (float*)(p.ws + OFF_SCB);
        A.hm = (bf16_t*)(p.ws + OFF_XB + 64 * MiB);
        for (int rep_ = 0; rep_ < (DUP == 3 ? 2 : 1); ++rep_) for (int u = blockIdx.x; u < 64; u += gridDim.x) mlstm::unit(u >> 2, u & 3, A, (ML_LAS unsigned char*)shm);
        attn_body::QueueOrder S; S.ctr = (unsigned*)(p.ws + OFF_CTL) + 8192; S.slot = lctl + 16;
        attn_body::attn_phase<attn_body::QueueOrder>((char*)shm, AT, S);
    }
    xcd_barrier(xbar);
    for (int rep_ = 0; rep_ < (DUP == 4 ? 2 : 1); ++rep_) {
        const PArgs& p = *kargs();
        pg8::SchedGrid S; S.init(p.ws + OFF_XB, p.ws + OFF_WAB, p.ws + OFF_XB + 64 * MiB, p.ws + OFF_WMB, T_, 1024, 512, 2, (int)gridDim.x, (int)blockIdx.x);
        pg8::EpiBranch E; E.ga = (const bf16_t*)(p.ws + OFF_GA); E.gm = (const bf16_t*)(p.ws + OFF_GM); E.y = (bf16_t*)(p.ws + OFF_MQ);
        pg8::gemm_phase<pg8::EpiBranch, pg8::SchedGrid, true, true>(lds, 512, S, E);
        if (DUP == 4) grid.sync();
    }
    xcd_barrier(xbar);
    for (int rep_ = 0; rep_ < (DUP == 5 ? 2 : 1); ++rep_) {
        const PArgs& p = *kargs();
        pg8::SchedGrid S; S.init(p.ws + OFF_MQ, p.ws + OFF_WOUT, nullptr, nullptr, T_, 1024, 1024, 1, (int)gridDim.x, (int)blockIdx.x);
        pg8::EpiOut E; E.x = p.in[0]; E.out = p.out; E.x1b = (bf16_t*)(p.ws + OFF_MV); E.rowss = (float*)(p.ws + OFF_ROWSS);
        pg8::gemm_phase<pg8::EpiOut, pg8::SchedGrid, true, true>(lds, 1024, S, E);
        if (DUP == 5) grid.sync();
    }
    xcd_barrier(xbar);
    for (int rep_ = 0; rep_ < (DUP == 6 ? 2 : 1); ++rep_) {
        const PArgs& p = *kargs();
        peer::Args A; A.rowss = (const float*)(p.ws + OFF_ROWSS); A.key1 = (const bf16_t*)(p.ws + OFF_KEY1); A.key2 = (const bf16_t*)(p.ws + OFF_KEY2); A.r2out = (float*)(p.ws + OFF_R2);
        A.eidx = (int*)(p.ws + OFF_EIDX); A.eg = (float*)(p.ws + OFF_EG);
        for (int u = blockIdx.x; u < 2048; u += gridDim.x) peer::unit(u >> 3, u & 7, (const bf16_t*)(p.ws + OFF_MV), (const bf16_t*)(p.ws + OFF_WQ), A, lds);
    }
    xcd_barrier(xbar);
    { const PArgs& p = *kargs(); phase5_all(p, p.out, shm); }
}

extern "C" void kernel_launch(void* const* d_in, const int* in_sizes, int n_in, void* d_out, int out_size, void* d_ws, size_t ws_size, hipStream_t stream) {
    static int grid_blocks = 0;
    if (!grid_blocks) {
        if (n_in != 20 || in_sizes[0] != T_ * D_ || out_size != T_ * D_ || ws_size < WS_NEED) { fprintf(stderr, "kernel_launch: unexpected shapes n_in %d in0 %d out %d ws %zu\n", n_in, n_in > 0 ? in_sizes[0] : -1, out_size, ws_size); grid_blocks = -1; return; }
        if (hipFuncSetAttribute((const void*)k_mega, hipFuncAttributeMaxDynamicSharedMemorySize, BIG_LDS) != hipSuccess) { fprintf(stderr, "hipFuncSetAttribute failed\n"); grid_blocks = -1; return; }
        int dev = 0, cus = 0, per_cu = 0;
        hipGetDevice(&dev); hipDeviceGetAttribute(&cus, hipDeviceAttributeMultiprocessorCount, dev);
        hipOccupancyMaxActiveBlocksPerMultiprocessor(&per_cu, (const void*)k_mega, 512, BIG_LDS);
        if (per_cu < 1) { fprintf(stderr, "kernel_launch: occupancy query reports %d blocks per CU\n", per_cu); per_cu = 1; }
        grid_blocks = cus;
        if (grid_blocks != 256) fprintf(stderr, "kernel_launch: %d CUs (expected 256)\n", grid_blocks);
    }
    if (grid_blocks < 0) return;
    PArgs pa{}; for (int i = 0; i < 20; ++i) pa.in[i] = (const float*)d_in[i]; pa.out = (float*)d_out; pa.ws = (char*)d_ws;
    hipMemsetAsync((char*)d_ws + OFF_CTL, 0, CTL_BYTES, stream);
    void* args[] = {&pa};
    hipError_t e = hipLaunchCooperativeKernel((void*)k_mega, dim3(grid_blocks), dim3(512), args, BIG_LDS, stream);
    if (e != hipSuccess) fprintf(stderr, "cooperative launch failed: %s (grid %d)\n", hipGetErrorString(e), grid_blocks);
}
```

```cpp
#include <hip/hip_runtime.h>
#include <cstdio>
#include <cstdint>
#include <cmath>
typedef unsigned short bf16_t;
constexpr int T_ = 65536, D_ = 1024, B_ = 16, S_ = 4096;
constexpr int INC = 5640;
constexpr size_t MiB = 1ull << 20;
constexpr size_t OFF_XB = 0;
constexpr size_t OFF_Q = 128 * MiB, OFF_K = 192 * MiB, OFF_V = 256 * MiB;
constexpr size_t OFF_MQ = 320 * MiB, OFF_MK = 384 * MiB, OFF_MV = 448 * MiB, OFF_MO = 512 * MiB;
constexpr size_t OFF_GA = 576 * MiB, OFF_GM = 704 * MiB;
constexpr size_t OFF_W = 832 * MiB;
constexpr size_t OFF_WIN = OFF_W;
constexpr size_t OFF_WAB = OFF_WIN + (size_t)5632 * 1024 * 2;
constexpr size_t OFF_WMB = OFF_WAB + (size_t)1024 * 512 * 2;
constexpr size_t OFF_WOUT = OFF_WMB + (size_t)1024 * 512 * 2;
constexpr size_t OFF_WQ = OFF_WOUT + (size_t)1024 * 1024 * 2;
constexpr size_t OFF_KEY1 = OFF_WQ + (size_t)2048 * 1024 * 2;
constexpr size_t OFF_KEY2 = OFF_KEY1 + (size_t)8 * 128 * 128 * 2;
constexpr size_t OFF_WD = OFF_KEY2 + (size_t)8 * 128 * 128 * 2;
constexpr size_t OFF_WU = OFF_WD + (size_t)16384 * 1024 * 2;
constexpr size_t OFF_WEND = OFF_WU + (size_t)16384 * 1024 * 2;
constexpr size_t OFF_MISC = 920 * MiB;
static_assert(OFF_WEND <= OFF_MISC, "weights overflow");
constexpr size_t OFF_R1 = OFF_MISC;
constexpr size_t OFF_R2 = OFF_R1 + (size_t)T_ * 4;
constexpr size_t OFF_IFG = OFF_R2 + (size_t)T_ * 4;
constexpr size_t OFF_KMEAN = OFF_IFG + (size_t)T_ * 8 * 4;
constexpr size_t OFF_ROPE = OFF_KMEAN + (size_t)16 * 8 * 16 * 64 * 4;
constexpr size_t OFF_SCA = OFF_ROPE + (size_t)2 * 4096 * 8 * 4;
constexpr size_t OFF_SCM = OFF_SCA + (size_t)16 * 4 * 4096 * 4;
constexpr size_t OFF_SCB = OFF_SCM + (size_t)16 * 4 * 4096 * 4;
constexpr size_t OFF_CTL = 926 * MiB + 512 * 1024, CTL_BYTES = 64 * 1024;
constexpr size_t OFF_ROWSS = 927 * MiB;
constexpr size_t OFF_EIDX = 932 * MiB;
constexpr size_t OFF_EG = 964 * MiB;
constexpr size_t WS_NEED = 996 * MiB;
static_assert(OFF_SCB + (size_t)16 * 4 * 4096 * 4 <= OFF_CTL && OFF_CTL + CTL_BYTES <= OFF_ROWSS, "misc overflow");

__device__ __forceinline__ unsigned f2bf(float f) { unsigned u = __builtin_bit_cast(unsigned, f); return (u + 0x7fffu + ((u >> 16) & 1u)) >> 16; }
__device__ __forceinline__ float bf2f(unsigned short b) { return __builtin_bit_cast(float, ((unsigned)b) << 16); }
__device__ __forceinline__ unsigned pk2(float lo, float hi) { return f2bf(lo) | (f2bf(hi) << 16); }
__device__ __forceinline__ float sigmoidf_(float v) { return 1.0f / (1.0f + __expf(-v)); }
namespace pg8 {
#define PG8_LAS __attribute__((address_space(3)))
typedef unsigned short bf16_t;
typedef short bf16x8 __attribute__((ext_vector_type(8)));
typedef float f32x4 __attribute__((ext_vector_type(4)));
typedef unsigned u32x4 __attribute__((ext_vector_type(4)));
constexpr int BM = 256, BK = 64, HALF = 128, HTB = HALF * BK * 2  , STAGE_BYTES = 8 * HTB, NXCD = 8, WGM = 4;

__host__ __device__ __forceinline__ int lds_byte(int r, int c) { const int st = (r >> 4) * 2 + (c >> 5), rr = r & 15, cc = c & 31, ob = rr * 64 + cc * 2; return st * 1024 + (ob ^ (((ob >> 9) & 1) << 5)); }
__host__ __device__ __forceinline__ void stage_rc(int b, int& R, int& C) { const int st = b / 1024, sb = b % 1024, swz = sb ^ (((sb >> 9) & 1) << 5); R = (st >> 1) * 16 + swz / 64; C = (st & 1) * 32 + (swz % 64) / 2; }
__host__ __device__ __forceinline__ int perm32(int rho) { const int n = rho >> 4, i = rho & 15; return 8 * (i >> 2) + 4 * n + (i & 3); }

struct Unit { int pm, pn, seg, pad; const char* A; const char* B; };

__device__ __forceinline__ unsigned cvt_pk_bf16(float lo, float hi) { unsigned r; asm volatile("v_cvt_pk_bf16_f32 %0, %1, %2" : "=v"(r) : "v"(lo), "v"(hi)); return r; }
typedef float f32x2 __attribute__((ext_vector_type(2)));
__device__ __forceinline__ f32x2 gelu_pk(f32x2 v) {
    const f32x2 av = __builtin_elementwise_abs(v), d = av * 0.2316418882f + 1.0f;
    f32x2 t; t.x = __builtin_amdgcn_rcpf(d.x); t.y = __builtin_amdgcn_rcpf(d.y);
    f32x2 q = t * 0.5307027145f + (-0.7265760135f); q = q * t + 0.7107068705f; q = q * t + (-0.142248368f); q = q * t + 0.127414796f; q = q * t;
    const f32x2 s = (v * v) * (-0.72134752044f);
    f32x2 e; e.x = __builtin_amdgcn_exp2f(s.x); e.y = __builtin_amdgcn_exp2f(s.y);
    const f32x2 m = v * (q * e), r = v - m;
    f32x2 o; o.x = v.x < 0.f ? m.x : r.x; o.y = v.y < 0.f ? m.y : r.y; return o;
}

template <class Epi, class Sched, bool ALIGN_EPI = false, bool SP2 = false>
__device__ __forceinline__ void gemm_phase(PG8_LAS unsigned char* lds, const int K, const Sched& S, const Epi& E) {
    int tid = threadIdx.x; asm volatile("" : "+v"(tid));
    const int wid = __builtin_amdgcn_readfirstlane(tid >> 6), lane = tid & 63, wr = wid >> 2, wc = wid & 3, fr = lane & 15, fq = lane >> 4;
    const int nt = K / BK;
    unsigned voffA[2], voffB[2];
#pragma unroll
    for (int i = 0; i < 2; ++i) { int R, C; stage_rc(tid * 16 + i * 8192, R, C); const int Rb = Epi::PERM ? ((R & ~31) + perm32(R & 31)) : R;
        voffA[i] = (unsigned)(R * K + C) * 2u; voffB[i] = (unsigned)(Rb * K + C) * 2u; }
    const size_t kstep = (size_t)(BK * 2);
    const size_t hstep = (size_t)HALF * K * 2;
        const unsigned ldsw = (unsigned)wid * 1024u;
    const int aoff = lds_byte(wr * 64 + fr, fq * 8), boff = lds_byte(wc * 32 + fr, fq * 8);
#define PG8_SA(b, h) (((b) * 2 + (h)) * HTB)
#define PG8_SB(b, h) ((4 + (b) * 2 + (h)) * HTB)
#define PG8_STAGE(bufoff, gbase, voff) do { _Pragma("unroll") for (int _i = 0; _i < 2; ++_i) \
        __builtin_amdgcn_global_load_lds((const unsigned*)((const char*)(gbase) + (voff)[_i]), (PG8_LAS unsigned*)(lds + (bufoff) + ldsw + _i * 8192), 16, 0, 0); } while (0)
#define PG8_LDA(dst, b, h) do { _Pragma("unroll") for (int m = 0; m < 4; ++m) _Pragma("unroll") for (int k = 0; k < 2; ++k) dst[m][k] = *(const PG8_LAS bf16x8*)(lds + PG8_SA(b, h) + aoff + m * 2048 + k * 1024); } while (0)
#define PG8_LDB(dst, b, h) do { _Pragma("unroll") for (int n = 0; n < 2; ++n) _Pragma("unroll") for (int k = 0; k < 2; ++k) dst[n][k] = *(const PG8_LAS bf16x8*)(lds + PG8_SB(b, h) + boff + n * 2048 + k * 1024); } while (0)
#define PG8_MMA(ai, bj, At, Bt) do { __builtin_amdgcn_s_setprio(1); _Pragma("unroll") for (int m = 0; m < 4; ++m) _Pragma("unroll") for (int n = 0; n < 2; ++n) _Pragma("unroll") for (int k = 0; k < 2; ++k) \
        acc[ai][bj][m][n] = __builtin_amdgcn_mfma_f32_16x16x32_bf16(Bt[n][k], At[m][k], acc[ai][bj][m][n], 0, 0, 0); __builtin_amdgcn_s_setprio(0); } while (0)
#define PG8_WAIT_V(n) asm volatile("s_waitcnt vmcnt(" #n ")" ::: "memory")
#define PG8_WAIT_L(n) asm volatile("s_waitcnt lgkmcnt(" #n ")" ::: "memory")
#define PG8_BAR __builtin_amdgcn_s_barrier()
#define PG8_SCHED __builtin_amdgcn_sched_barrier(0)
    Unit cur, nxt; int ui = 0;
    if (!S.next(0, cur)) return;
    f32x4 acc[2][2][4][2];
#pragma unroll
    for (int a = 0; a < 2; ++a)
#pragma unroll
        for (int b = 0; b < 2; ++b)
#pragma unroll
            for (int m = 0; m < 4; ++m)
#pragma unroll
                for (int n = 0; n < 2; ++n) acc[a][b][m][n] = (f32x4){0.f, 0.f, 0.f, 0.f};
    bf16x8 At[4][2], B0[2][2], B1[2][2];
    const char* cA = cur.A; const char* cB = cur.B;
    S.a_ready(cur);
    if constexpr (SP2) {
        PG8_STAGE(PG8_SB(0, 0), cB, voffB); PG8_STAGE(PG8_SB(0, 1), cB + hstep, voffB); PG8_STAGE(PG8_SA(0, 0), cA, voffA); PG8_STAGE(PG8_SA(0, 1), cA + hstep, voffA);
        if (wr == 1) PG8_BAR;
        PG8_WAIT_V(2); PG8_BAR;
        PG8_STAGE(PG8_SB(1, 0), cB + kstep, voffB); PG8_STAGE(PG8_SA(1, 0), cA + kstep, voffA); PG8_STAGE(PG8_SB(1, 1), cB + hstep + kstep, voffB);
        PG8_WAIT_V(6); PG8_BAR;
    } else {
        PG8_STAGE(PG8_SB(0, 0), cB, voffB); PG8_STAGE(PG8_SA(0, 0), cA, voffA); PG8_STAGE(PG8_SB(0, 1), cB + hstep, voffB); PG8_STAGE(PG8_SA(0, 1), cA + hstep, voffA);
        if (wr == 1) PG8_BAR;
        PG8_WAIT_V(4); PG8_BAR;
        PG8_STAGE(PG8_SB(1, 0), cB + kstep, voffB); PG8_STAGE(PG8_SA(1, 0), cA + kstep, voffA); PG8_STAGE(PG8_SB(1, 1), cB + hstep + kstep, voffB);
        PG8_WAIT_V(6); PG8_BAR;
    }
    for (;;) {
        const bool has_next = S.next(ui + 1, nxt);
        const char* nA = has_next ? nxt.A : cA; const char* nB = has_next ? nxt.B : cB;
        for (int t = 0; t < nt; t += 2) {
            const bool last = (t == nt - 2);
            const char* a1 = cA + (size_t)(t + 1) * kstep;
            const char* a2 = last ? nA : cA + (size_t)(t + 2) * kstep; const char* b2 = last ? nB : cB + (size_t)(t + 2) * kstep;
            const char* a3 = a2 + kstep; const char* b3 = b2 + kstep;
            if (last && has_next) S.a_ready(nxt);
            if constexpr (SP2) {
            PG8_LDB(B0, 0, 0); PG8_LDB(B1, 0, 1); PG8_SCHED; PG8_LDA(At, 0, 0); PG8_STAGE(PG8_SA(1, 1), a1 + hstep, voffA);
            PG8_WAIT_V(8); PG8_WAIT_L(0); PG8_BAR; PG8_MMA(0, 0, At, B0); PG8_MMA(0, 1, At, B1); PG8_BAR; PG8_SCHED;
            PG8_LDA(At, 0, 1); PG8_STAGE(PG8_SB(0, 0), b2, voffB); PG8_STAGE(PG8_SB(0, 1), b2 + hstep, voffB); PG8_STAGE(PG8_SA(0, 0), a2, voffA);
            PG8_WAIT_V(8); PG8_WAIT_L(0); PG8_BAR; PG8_MMA(1, 0, At, B0); PG8_MMA(1, 1, At, B1); PG8_BAR; PG8_SCHED;
            PG8_LDB(B0, 1, 0); PG8_LDB(B1, 1, 1); PG8_SCHED; PG8_LDA(At, 1, 0); PG8_STAGE(PG8_SA(0, 1), a2 + hstep, voffA);
            PG8_WAIT_V(8); PG8_WAIT_L(0); PG8_BAR; PG8_MMA(0, 0, At, B0); PG8_MMA(0, 1, At, B1); PG8_BAR; PG8_SCHED;
            PG8_LDA(At, 1, 1); PG8_STAGE(PG8_SB(1, 0), b3, voffB); PG8_STAGE(PG8_SB(1, 1), b3 + hstep, voffB); PG8_STAGE(PG8_SA(1, 0), a3, voffA);
            PG8_WAIT_V(8); PG8_WAIT_L(0); PG8_BAR; PG8_MMA(1, 0, At, B0); PG8_MMA(1, 1, At, B1); PG8_BAR; PG8_SCHED;
            } else {
            PG8_LDB(B0, 0, 0); PG8_SCHED; PG8_LDA(At, 0, 0); PG8_STAGE(PG8_SA(1, 1), a1 + hstep, voffA);
            PG8_WAIT_L(8); PG8_BAR; PG8_WAIT_L(0); PG8_MMA(0, 0, At, B0); PG8_BAR; PG8_SCHED;
            PG8_LDB(B1, 0, 1); PG8_STAGE(PG8_SB(0, 0), b2, voffB);
            PG8_BAR; PG8_WAIT_L(0); PG8_MMA(0, 1, At, B1); PG8_BAR;
            PG8_LDA(At, 0, 1); PG8_STAGE(PG8_SA(0, 0), a2, voffA);
            PG8_BAR; PG8_WAIT_L(0); PG8_MMA(1, 0, At, B0); PG8_BAR; PG8_SCHED;
            PG8_STAGE(PG8_SB(0, 1), b2 + hstep, voffB);
            PG8_WAIT_V(6); PG8_BAR; PG8_MMA(1, 1, At, B1); PG8_BAR;
            PG8_LDB(B0, 1, 0); PG8_SCHED; PG8_LDA(At, 1, 0); PG8_STAGE(PG8_SA(0, 1), a2 + hstep, voffA);
            PG8_WAIT_L(8); PG8_BAR; PG8_WAIT_L(0); PG8_MMA(0, 0, At, B0); PG8_BAR; PG8_SCHED;
            PG8_LDB(B1, 1, 1); PG8_STAGE(PG8_SB(1, 0), b3, voffB);
            PG8_BAR; PG8_WAIT_L(0); PG8_MMA(0, 1, At, B1); PG8_BAR;
            PG8_LDA(At, 1, 1); PG8_STAGE(PG8_SA(1, 0), a3, voffA);
            PG8_BAR; PG8_WAIT_L(0); PG8_MMA(1, 0, At, B0); PG8_BAR; PG8_SCHED;
            PG8_STAGE(PG8_SB(1, 1), b3 + hstep, voffB);
            PG8_WAIT_V(6); PG8_BAR; PG8_MMA(1, 1, At, B1); PG8_BAR;
            }
        }
        if constexpr (ALIGN_EPI) { if (wr == 0) PG8_BAR; }
        if constexpr (!Epi::AFTER_DRAIN) { E(acc, cur, wr, wc, fr, fq); S.done(cur); }
        if (!has_next) break;
        if (E.zero_after(cur)) {
#pragma unroll
        for (int a = 0; a < 2; ++a)
#pragma unroll
            for (int b = 0; b < 2; ++b)
#pragma unroll
                for (int m = 0; m < 4; ++m)
#pragma unroll
                    for (int n = 0; n < 2; ++n) acc[a][b][m][n] = (f32x4){0.f, 0.f, 0.f, 0.f};
        }
        cur = nxt; cA = nA; cB = nB; ++ui;
        if constexpr (ALIGN_EPI) { if (wr == 1) PG8_BAR; }
    }
    PG8_WAIT_V(0);
    if constexpr (!ALIGN_EPI) { if (wr == 0) PG8_BAR; }
    PG8_BAR;
    if constexpr (Epi::AFTER_DRAIN) { E.fused(acc, cur, wr, wc, fr, fq, lds, wid, lane); S.done(cur); }
#undef PG8_SA
#undef PG8_SB
#undef PG8_STAGE
#undef PG8_LDA
#undef PG8_LDB
#undef PG8_MMA
#undef PG8_WAIT_V
#undef PG8_WAIT_L
#undef PG8_BAR
#undef PG8_SCHED
}
}
__host__ __device__ __forceinline__ int sigma_col(int rho) { const int j = rho & 3, fq = (rho >> 2) & 3, n = (rho >> 4) & 1, wc = (rho >> 5) & 3, bj = rho >> 7; return wc * 64 + bj * 32 + fq * 8 + n * 4 + j; }
namespace pg8 {
struct SchedGrid {
    const char* A0; const char* B0; const char* A1; const char* B1; size_t tstep; int nM, nN, nwg, G, c, segs, pad;
    __device__ __forceinline__ void init(const void* A0_, const void* B0_, const void* A1_, const void* B1_, int M, int N, int K, int segs_, int G_, int c_) {
        A0 = (const char*)A0_; B0 = (const char*)B0_; A1 = (const char*)A1_; B1 = (const char*)B1_; tstep = (size_t)BM * K * 2; nM = M / BM; nN = N / BM; nwg = nM * nN; G = G_; c = c_; segs = segs_; pad = 0; }
    __device__ __forceinline__ bool next(int i, Unit& u) const {
        const int seg = (segs == 2) ? (i & 1) : 0, it = (segs == 2) ? (i >> 1) : i;
        const long L = (long)it * G + c; if (L >= nwg) return false;
        int wgid = (int)L; { const int q = nwg / NXCD, r = nwg % NXCD, xcd = wgid % NXCD, off = wgid / NXCD; wgid = (xcd < r ? xcd * (q + 1) : r * (q + 1) + (xcd - r) * q) + off; }
        const int nig = WGM * nN, gid = wgid / nig, fm = gid * WGM, gsz = (nM - fm) < WGM ? (nM - fm) : WGM;
        u.pm = fm + ((wgid % nig) % gsz); u.pn = (wgid % nig) / gsz; u.seg = seg; u.pad = 0;
        u.A = (seg ? A1 : A0) + (size_t)u.pm * tstep; u.B = (seg ? B1 : B0) + (size_t)u.pn * tstep; return true;
    }
    __device__ __forceinline__ void a_ready(const Unit&) const {}
    __device__ __forceinline__ void done(const Unit&) const {}
};
__device__ __forceinline__ u32x4 pack8(const f32x4& a, const f32x4& b) { u32x4 w; w.x = cvt_pk_bf16(a[0], a[1]); w.y = cvt_pk_bf16(a[2], a[3]); w.z = cvt_pk_bf16(b[0], b[1]); w.w = cvt_pk_bf16(b[2], b[3]); return w; }
__device__ __forceinline__ float bflo(unsigned w) { return __builtin_bit_cast(float, w << 16); }
__device__ __forceinline__ float bfhi(unsigned w) { return __builtin_bit_cast(float, w & 0xffff0000u); }
__device__ __forceinline__ float sigm(float v) { return __builtin_amdgcn_rcpf(1.0f + __expf(-v)); }

struct EpiInProj {
    static constexpr bool PERM = false, AFTER_DRAIN = false;
    const float* r1; const float* qnw; const float* knw; const float* ropec; const float* ropes; const float* merge_b; char* ws; float* kmean; int skip_km;
    __device__ __forceinline__ bool zero_after(const Unit&) const { return true; }
    __device__ __forceinline__ void operator()(f32x4 (&acc)[2][2][4][2], const Unit& u, int wr, int wc, int fr, int fq) const {
        const int pn = u.pn, rowb = u.pm * BM + wr * 64 + fr;
        if (pn < 4) {
            const bool isq = pn < 2; const float* nw = isq ? qnw : knw; const float sc = isq ? 0.125f * 1.4426950408889634f : 1.0f;
            bf16_t* dst = (bf16_t*)(ws + (isq ? OFF_Q : OFF_K)) + (pn & 1) * 256 + wc * 64 + 8 * fq;
            f32x4 nwv[2][2], ks[2][2];
#pragma unroll
            for (int bj = 0; bj < 2; ++bj)
#pragma unroll
                for (int n = 0; n < 2; ++n) { nwv[bj][n] = *(const f32x4*)(nw + 32 * bj + 8 * fq + 4 * n); ks[bj][n] = (f32x4){0.f, 0.f, 0.f, 0.f}; }
#pragma unroll
            for (int ai = 0; ai < 2; ++ai)
#pragma unroll
                for (int m = 0; m < 4; ++m) {
                    const int row = rowb + ai * HALF + m * 16; const float r = r1[row]; const int pos = row & 4095;
                    f32x4 v[2][2]; float ss = 0.f;
#pragma unroll
                    for (int bj = 0; bj < 2; ++bj)
#pragma unroll
                        for (int n = 0; n < 2; ++n) { v[bj][n] = acc[ai][bj][m][n] * r; ss += (v[bj][n][0] * v[bj][n][0] + v[bj][n][1] * v[bj][n][1]) + (v[bj][n][2] * v[bj][n][2] + v[bj][n][3] * v[bj][n][3]); }
                    ss += __shfl_xor(ss, 16); ss += __shfl_xor(ss, 32);
                    const float rstd = rsqrtf(ss * (1.0f / 64.0f) + 1e-6f);
#pragma unroll
                    for (int bj = 0; bj < 2; ++bj)
#pragma unroll
                        for (int n = 0; n < 2; ++n) v[bj][n] = v[bj][n] * rstd * nwv[bj][n];
#pragma unroll
                    for (int n = 0; n < 2; ++n) {
                        const f32x4 cs = *(const f32x4*)(ropec + pos * 8 + 4 * n), sn = *(const f32x4*)(ropes + pos * 8 + 4 * n);
#pragma unroll
                        for (int j = 0; j < 4; ++j) { const float mine = v[0][n][j], oth = __shfl_xor(mine, 16);
                            const float rot = (fq == 0) ? (mine * cs[j] - oth * sn[j]) : (mine * cs[j] + oth * sn[j]);
                            v[0][n][j] = (fq < 2) ? rot : mine; }
                    }
#pragma unroll
                    for (int bj = 0; bj < 2; ++bj) {
                        const u32x4 w = pack8(v[bj][0] * sc, v[bj][1] * sc);
                        *(u32x4*)(dst + (size_t)row * 512 + 32 * bj) = w;
                        if (!isq) { ks[bj][0] += (f32x4){bflo(w.x), bfhi(w.x), bflo(w.y), bfhi(w.y)}; ks[bj][1] += (f32x4){bflo(w.z), bfhi(w.z), bflo(w.w), bfhi(w.w)}; }
                    }
                }
            if (!isq) {
#pragma unroll
                for (int bj = 0; bj < 2; ++bj)
#pragma unroll
                    for (int n = 0; n < 2; ++n)
#pragma unroll
                        for (int j = 0; j < 4; ++j) { float s = ks[bj][n][j]; s += __shfl_xor(s, 1); s += __shfl_xor(s, 2); s += __shfl_xor(s, 4); s += __shfl_xor(s, 8); ks[bj][n][j] = s; }
                if (fr == 0 && !skip_km) {
                    const int b = u.pm >> 4, blk = u.pm & 15, head = (pn & 1) * 4 + wc;
                    float* km = kmean + ((size_t)(b * 8 + head) * 16 + blk) * 64 + 8 * fq;
#pragma unroll
                    for (int bj = 0; bj < 2; ++bj)
#pragma unroll
                        for (int n = 0; n < 2; ++n)
#pragma unroll
                            for (int j = 0; j < 4; ++j) atomicAdd(km + 32 * bj + 4 * n + j, ks[bj][n][j] * (1.0f / 256.0f));
                }
            }
        } else {
            size_t off; int ld = 512, cb, type = 2; const float* bias = nullptr;
            if (pn < 6) { off = OFF_V; cb = (pn - 4) * 256; } else if (pn < 8) { off = OFF_MQ; cb = (pn - 6) * 256; } else if (pn < 10) { off = OFF_MK; cb = (pn - 8) * 256; }
            else if (pn < 12) { off = OFF_MV; cb = (pn - 10) * 256; } else if (pn < 14) { off = OFF_MO; cb = (pn - 12) * 256; type = 3; }
            else if (pn < 18) { off = OFF_GA; cb = (pn - 14) * 256; ld = 1024; type = 4; bias = merge_b + cb; } else { off = OFF_GM; cb = (pn - 18) * 256; ld = 1024; type = 4; bias = merge_b + 1024 + cb; }
            const int cl = wc * 64 + 8 * fq;
            bf16_t* dst = (bf16_t*)(ws + off) + cb + cl;
            f32x4 bv[2][2];
#pragma unroll
            for (int bj = 0; bj < 2; ++bj)
#pragma unroll
                for (int n = 0; n < 2; ++n) bv[bj][n] = (type == 4) ? *(const f32x4*)(bias + cl + 32 * bj + 4 * n) : (f32x4){0.f, 0.f, 0.f, 0.f};
#pragma unroll
            for (int ai = 0; ai < 2; ++ai)
#pragma unroll
                for (int m = 0; m < 4; ++m) {
                    const int row = rowb + ai * HALF + m * 16; const float r = r1[row];
#pragma unroll
                    for (int bj = 0; bj < 2; ++bj) {
                        f32x4 v0 = acc[ai][bj][m][0] * r + bv[bj][0], v1 = acc[ai][bj][m][1] * r + bv[bj][1];
                        if (type >= 3) {
#pragma unroll
                            for (int j = 0; j < 4; ++j) { v0[j] = sigm(v0[j]); v1[j] = sigm(v1[j]); } }
                        *(u32x4*)(dst + (size_t)row * ld + 32 * bj) = pack8(v0, v1);
                    }
                }
        }
    }
};
struct EpiBranch {
    static constexpr bool PERM = false, AFTER_DRAIN = false;
    const bf16_t* ga; const bf16_t* gm; bf16_t* y;
    __device__ __forceinline__ bool zero_after(const Unit& u) const { return u.seg == 1; }
    __device__ __forceinline__ void operator()(f32x4 (&acc)[2][2][4][2], const Unit& u, int wr, int wc, int fr, int fq) const {
        const int rowb = u.pm * BM + wr * 64 + fr, col0 = u.pn * BM + wc * 64 + 8 * fq;
#pragma unroll
        for (int ai = 0; ai < 2; ++ai)
#pragma unroll
            for (int m = 0; m < 4; ++m) {
                const size_t ro = (size_t)(rowb + ai * HALF + m * 16) * 1024 + col0;
#pragma unroll
                for (int bj = 0; bj < 2; ++bj) {
                    const u32x4 gmw = *(const u32x4*)(gm + ro + 32 * bj);
                    const f32x4 m0 = (f32x4){bflo(gmw.x), bfhi(gmw.x), bflo(gmw.y), bfhi(gmw.y)}, m1 = (f32x4){bflo(gmw.z), bfhi(gmw.z), bflo(gmw.w), bfhi(gmw.w)};
                    if (u.seg == 0) {
                        const u32x4 gaw = *(const u32x4*)(ga + ro + 32 * bj);
                        const f32x4 a0 = (f32x4){bflo(gaw.x), bfhi(gaw.x), bflo(gaw.y), bfhi(gaw.y)}, a1 = (f32x4){bflo(gaw.z), bfhi(gaw.z), bflo(gaw.w), bfhi(gaw.w)};
#pragma unroll
                        for (int j = 0; j < 4; ++j) { acc[ai][bj][m][0][j] *= a0[j] * __builtin_amdgcn_rcpf(m0[j]); acc[ai][bj][m][1][j] *= a1[j] * __builtin_amdgcn_rcpf(m1[j]); }
                    } else {
                        *(u32x4*)(y + ro + 32 * bj) = pack8(acc[ai][bj][m][0] * m0, acc[ai][bj][m][1] * m1);
                    }
                }
            }
    }
};
struct EpiOut {
    static constexpr bool PERM = false, AFTER_DRAIN = false;
    const float* x; float* out; bf16_t* x1b; float* rowss;
    __device__ __forceinline__ bool zero_after(const Unit&) const { return true; }
    __device__ __forceinline__ void operator()(f32x4 (&acc)[2][2][4][2], const Unit& u, int wr, int wc, int fr, int fq) const {
        const int rowb = u.pm * BM + wr * 64 + fr, col0 = u.pn * BM + wc * 64 + 8 * fq;
#pragma unroll
        for (int ai = 0; ai < 2; ++ai)
#pragma unroll
            for (int m = 0; m < 4; ++m) {
                const int row = rowb + ai * HALF + m * 16; const size_t ro = (size_t)row * 1024 + col0; float ss = 0.f;
#pragma unroll
                for (int bj = 0; bj < 2; ++bj) {
                    const f32x4 v0 = acc[ai][bj][m][0] + *(const f32x4*)(x + ro + 32 * bj), v1 = acc[ai][bj][m][1] + *(const f32x4*)(x + ro + 32 * bj + 4);
                    *(u32x4*)(x1b + ro + 32 * bj) = pack8(v0, v1);
                    ss += (v0[0] * v0[0] + v0[1] * v0[1]) + (v0[2] * v0[2] + v0[3] * v0[3]) + (v1[0] * v1[0] + v1[1] * v1[1]) + (v1[2] * v1[2] + v1[3] * v1[3]);
                }
                ss += __shfl_xor(ss, 16); ss += __shfl_xor(ss, 32);
                if (fq == 0) rowss[(size_t)row * 16 + u.pn * 4 + wc] = ss;
            }
    }
};
}
#include <hip/hip_bf16.h>
#include <cmath>
namespace attn_body {
using bf16=__hip_bfloat16;
using bf16x8=__attribute__((ext_vector_type(8)))short;
using s16x4=__attribute__((ext_vector_type(4)))short;
using f32x16=__attribute__((ext_vector_type(16)))float;
using u32x4=__attribute__((ext_vector_type(4)))unsigned;
using f32x4_t=__attribute__((ext_vector_type(4)))float;
constexpr int BATCH=16,NHEAD=8,SEQ=4096,D=64,DM=NHEAD*D;
constexpr int NW=8,QBLK=32,QB=QBLK*NW,KVBLK=64,NQB=SEQ/QB;
constexpr int ATTN_PITCH=DM, ATTN_UNIT_ROWS=QB;
__device__ __forceinline__ int crow(int r,int hi){return (r&3)+8*(r>>2)+4*hi;}
#define SBAR() __builtin_amdgcn_sched_barrier(0)
__device__ __forceinline__ void cmask(f32x16&p0,f32x16&p1,int jb,int qrel,int hi){
  const float NEG=-INFINITY; int kb=64*jb+4*hi;
  #pragma unroll
  for(int r=0;r<16;++r){int kv=kb+(r&3)+8*(r>>2); if(kv>qrel)p0[r]=NEG; if(kv+32>qrel)p1[r]=NEG;}
}

constexpr int NSLOT=3, SLOTB=8192;
constexpr int LDS_K=0, LDS_V=NSLOT*SLOTB, LDS_WS=2*NSLOT*SLOTB, LDS_OST=LDS_WS+NW*64*4, LDS_BYTES=LDS_OST+NW*4096;
constexpr float C2=0.125f*1.4426950408889634f;
__device__ __forceinline__ void glds16(const void*gsrc,unsigned lds_dst){unsigned keep;
  asm volatile("s_mov_b32 %0, m0\n\ts_mov_b32 m0, %2\n\ts_nop 0\n\tglobal_load_lds_dwordx4 %1, off\n\ts_mov_b32 m0, %0":"=&s"(keep):"v"(gsrc),"s"(lds_dst):"memory");}
__device__ __forceinline__ float max3f(float a,float b,float c){float r;asm("v_max3_f32 %0, %1, %2, %3":"=v"(r):"v"(a),"v"(b),"v"(c));return r;}
__device__ __forceinline__ float max2f(float a,float b){float r;asm("v_max_f32_e32 %0, %1, %2":"=v"(r):"v"(a),"v"(b));return r;}
__device__ __forceinline__ float fadd_s(float a,float b){float r;asm("v_add_f32_e32 %0, %1, %2":"=v"(r):"v"(a),"v"(b));return r;}
__device__ __forceinline__ float fsub_s(float a,float b){float r;asm("v_sub_f32_e32 %0, %1, %2":"=v"(r):"v"(a),"v"(b));return r;}
typedef float f32x2_t __attribute__((ext_vector_type(2))); typedef __bf16 bf16x2_t __attribute__((ext_vector_type(2)));
__device__ __forceinline__ unsigned cvtpk_s(float lo,float hi){f32x2_t v={lo,hi};bf16x2_t b=__builtin_convertvector(v,bf16x2_t);return __builtin_bit_cast(unsigned,b);}
#define WAIT_BAR(N) asm volatile("s_waitcnt vmcnt(" #N ") lgkmcnt(0)\n\ts_barrier":::"memory")

__device__ __forceinline__ void qkt(f32x16&p0,f32x16&p1,const char*Kslot,const bf16x8*qr,const f32x16&negm,int r32,int hi){
  const char*kb=Kslot+hi*1024+r32*16;
  #pragma unroll
  for(int d0=0;d0<4;++d0){
    const bf16x8 b0=*reinterpret_cast<const bf16x8*>(kb+d0*2048);
    const bf16x8 b1=*reinterpret_cast<const bf16x8*>(kb+d0*2048+512);
    if(d0==0){p0=__builtin_amdgcn_mfma_f32_32x32x16_bf16(b0,qr[0],negm,0,0,0);p1=__builtin_amdgcn_mfma_f32_32x32x16_bf16(b1,qr[0],negm,0,0,0);}
    else{p0=__builtin_amdgcn_mfma_f32_32x32x16_bf16(b0,qr[d0],p0,0,0,0);p1=__builtin_amdgcn_mfma_f32_32x32x16_bf16(b1,qr[d0],p1,0,0,0);}}
}
typedef __attribute__((address_space(3))) const char* lds_cptr;
typedef short v4i16_t __attribute__((ext_vector_type(4)));
__device__ __forceinline__ void kload8(bf16x8*kf,lds_cptr kp){
  kf[0]=*(const __attribute__((address_space(3))) bf16x8*)(kp);      kf[1]=*(const __attribute__((address_space(3))) bf16x8*)(kp+512);
  kf[2]=*(const __attribute__((address_space(3))) bf16x8*)(kp+2048); kf[3]=*(const __attribute__((address_space(3))) bf16x8*)(kp+2560);
  kf[4]=*(const __attribute__((address_space(3))) bf16x8*)(kp+4096); kf[5]=*(const __attribute__((address_space(3))) bf16x8*)(kp+4608);
  kf[6]=*(const __attribute__((address_space(3))) bf16x8*)(kp+6144); kf[7]=*(const __attribute__((address_space(3))) bf16x8*)(kp+6656);
}
__device__ __forceinline__ void kload2(bf16x8*kf,lds_cptr kp,int j){ kf[2*j]=*(const __attribute__((address_space(3))) bf16x8*)(kp+j*2048); kf[2*j+1]=*(const __attribute__((address_space(3))) bf16x8*)(kp+j*2048+512); }
__device__ __forceinline__ s16x4 vtr(lds_cptr p){ return __builtin_bit_cast(s16x4,__builtin_amdgcn_ds_read_tr16_b64_v4i16((__attribute__((address_space(3))) v4i16_t*)p)); }
__device__ __forceinline__ float rowmax(const f32x16&p0,const f32x16&p1){
  float a=max3f(p0[0],p0[1],p1[0]),b=max3f(p0[2],p0[3],p1[1]);a=max3f(a,p1[2],p1[3]);
  #pragma unroll
  for(int r=4;r<16;r+=4){a=max3f(a,p0[r],p0[r+1]);b=max3f(b,p0[r+2],p0[r+3]);a=max3f(a,p1[r],p1[r+1]);b=max3f(b,p1[r+2],p1[r+3]);}
  const float m=max2f(a,b);
  auto rr=__builtin_amdgcn_permlane32_swap(__float_as_uint(m),__float_as_uint(m),false,false);
  return max2f(__uint_as_float(rr[0]),__uint_as_float(rr[1]));
}
__device__ __forceinline__ void pv(f32x16*o,int vb,bf16x8 pa0,bf16x8 pa1,bf16x8 pa2,bf16x8 pa3){
  #pragma unroll
  for(int d0=0;d0<2;++d0){s16x4 lo[4],hi[4];
    #pragma unroll
    for(int ks=0;ks<4;++ks){
      asm volatile("ds_read_b64_tr_b16 %0,%1 offset:%c2":"=&v"(lo[ks]):"v"(vb),"i"(d0*4096+ks*1024):"memory");
      asm volatile("ds_read_b64_tr_b16 %0,%1 offset:%c2":"=&v"(hi[ks]):"v"(vb),"i"(d0*4096+ks*1024+512):"memory");}
    asm volatile("s_waitcnt lgkmcnt(0)":::"memory");SBAR();
    #define PK(k) (bf16x8){lo[k][0],lo[k][1],lo[k][2],lo[k][3],hi[k][0],hi[k][1],hi[k][2],hi[k][3]}
    o[d0]=__builtin_amdgcn_mfma_f32_32x32x16_bf16(pa0,PK(0),o[d0],0,0,0);
    o[d0]=__builtin_amdgcn_mfma_f32_32x32x16_bf16(pa1,PK(1),o[d0],0,0,0);
    o[d0]=__builtin_amdgcn_mfma_f32_32x32x16_bf16(pa2,PK(2),o[d0],0,0,0);
    o[d0]=__builtin_amdgcn_mfma_f32_32x32x16_bf16(pa3,PK(3),o[d0],0,0,0);
    #undef PK
  }
}

#ifndef ATTN_STORE16
#define ATTN_STORE16(p,v) (*(u32x4*)(p)=(v))
#endif
template<int THRL> __device__ __forceinline__ void attn_unit(int b,int h,int qb,const bf16*Q,const bf16*__restrict__ K,const bf16*__restrict__ V,bf16*O,char*shm){
  int tid=threadIdx.x; asm volatile("":"+v"(tid)); const int lane=tid&63,r32=lane&31,hi=lane>>5; const int wid=__builtin_amdgcn_readfirstlane(tid>>6);
  const long rowbase=(long)b*SEQ; const int q0=qb*QB;
  const bf16*Qw=Q+(rowbase+q0+wid*QBLK)*DM+h*D;
  const bf16*Kh=K+rowbase*DM+h*D,*Vh=V+rowbase*DM+h*D;
  const unsigned lds0=(unsigned)(uintptr_t)shm;
  float*wsf=(float*)(shm+LDS_WS)+wid*64;
  const bf16*ksrc=Kh+(long)lane*DM+wid*8;
  const bf16*vsrc=Vh+(long)(16*(wid&3)+(lane>>2))*DM+(wid>>2)*32+(lane&3)*8;
  const unsigned kdst=lds0+LDS_K+wid*1024, vdst=lds0+LDS_V+wid*1024;
  #define TM(t) (((t)<4)?(NT-4+(t)):((t)-4))
  #define DMA_K(t,slot) glds16(ksrc+(long)TM(t)*KVBLK*DM,(unsigned)__builtin_amdgcn_readfirstlane(kdst+(slot)))
  #define DMA_V(t,slot) glds16(vsrc+(long)TM(t)*KVBLK*DM,(unsigned)__builtin_amdgcn_readfirstlane(vdst+(slot)))
  const int vb0=(int)(lds0+LDS_V)+((lane>>4)&1)*32+(lane&3)*8+(4*hi+((lane&15)>>2))*64;
  const char*Kbase=shm+LDS_K; bf16x8 kf[8];
  const lds_cptr shm3=(lds_cptr)shm; const lds_cptr kp0=shm3+LDS_K+hi*1024+r32*16; const lds_cptr vp0=shm3+LDS_V+((lane>>4)&1)*32+(lane&3)*8+(4*hi+((lane&15)>>2))*64;
  const int NT=(q0+QB)/KVBLK;
  DMA_K(0,0);DMA_V(0,0);DMA_K(1,SLOTB);
  bf16x8 qr[4];
  #pragma unroll
  for(int d0=0;d0<4;++d0)qr[d0]=*reinterpret_cast<const bf16x8*>(&Qw[(long)r32*DM+d0*16+hi*8]);
  #define SELK(tt) (((tt)<4)||((((const unsigned*)(shm+LDS_BYTES))[wid*QBLK+r32]>>(((tt)-4)>>2))&1u))
  float mhat=0.f,l_reg=0.f;f32x16 o[2];o[0]=f32x16{};o[1]=f32x16{};f32x16 negm=f32x16{};asm volatile("":"+v"(negm));
  const int qrel=wid*QBLK+r32;
  #define CMASK(P0,P1,t) do{int jb_=(t); if(jb_<4)cmask(P0,P1,jb_,qrel,hi); else { const bool keep_=SELK(jb_); _Pragma("unroll") for(int r=0;r<16;++r){P0[r]=keep_?P0[r]:-INFINITY;P1[r]=keep_?P1[r]:-INFINITY;} } }while(0)
  bool resc=false;
  #define START(P0,P1) do{ const float rm=rowmax(P0,P1); resc=false; \
    { const float dl=rm; mhat=fadd_s(mhat,dl); \
      _Pragma("unroll") for(int r=0;r<16;++r){P0[r]=fsub_s(P0[r],dl);P1[r]=fsub_s(P1[r],dl);} \
      _Pragma("unroll") for(int r=0;r<16;++r)negm[r]=-mhat; asm volatile("":"+v"(negm)); } \
    _Pragma("unroll") for(int r=0;r<16;++r)P0[r]=__builtin_amdgcn_exp2f(P0[r]); }while(0)
  #define RESC() do{ if(resc){ asm volatile("s_waitcnt lgkmcnt(0)":::"memory"); \
      _Pragma("unroll") for(int d_=0;d_<2;++d_) _Pragma("unroll") for(int r=0;r<16;++r)o[d_][r]*=wsf[crow(r,hi)]; } }while(0)
  f32x16 pA0,pA1,pB0,pB1;
  int sl_prev=0,sl_cur=0,sl_next=SLOTB;
  #define ROT() do{sl_prev=sl_cur;sl_cur=sl_next;sl_next=(sl_next==(NSLOT-1)*SLOTB)?0:sl_next+SLOTB;}while(0)
  DMA_K(2,2*SLOTB);
  WAIT_BAR(3);
  qkt(pA0,pA1,Kbase,qr,negm,r32,hi);asm volatile("s_nop 15\n\ts_nop 7":"+v"(pA0),"+v"(pA1));CMASK(pA0,pA1,0);
  START(pA0,pA1);
  _Pragma("unroll") for(int r=0;r<16;++r)pA1[r]=__builtin_amdgcn_exp2f(pA1[r]);
  WAIT_BAR(0);
  DMA_K(3,0);DMA_V(1,SLOTB);
  ROT();
  kload8(kf,kp0+sl_cur);
  WAIT_BAR(2);
  s16x4 vlo[8],vhi[8]; u32x4 pw0,pw1,pw2,pw3;
  #define PKW(P,B) cvtpk_s(P[B],P[B+1])
  #define PAF(k) __builtin_bit_cast(bf16x8,pw##k)
  #define VFR(i) (bf16x8){vlo[i][0],vlo[i][1],vlo[i][2],vlo[i][3],vhi[i][0],vhi[i][1],vhi[i][2],vhi[i][3]}
  #define PIN(x) asm volatile("":"+v"(x))
  #define MX3(a,b,c) __builtin_fmaxf(__builtin_fmaxf((a),(b)),(c))
  #define GAPA(MF,A0,A1,A2,A3,W0,W1,PW) do{ MF; sacc+=A0; sacc+=A1; sacc+=A2; sacc+=A3; PIN(sacc); W0; W1; PIN(PW); SBAR(); }while(0)
  #define EX(v) __builtin_amdgcn_exp2f(v)
  #define GAPB(MF,X,B) do{ MF; X[B]=EX(X[B]); X[B+1]=EX(X[B+1]); X[B+2]=EX(X[B+2]); X[B+3]=EX(X[B+3]); PIN(X); SBAR(); }while(0)
  #define VRD(i) do{ vlo[i]=vtr(vp_+(((i)>>2)*4096+((i)&3)*1024)); vhi[i]=vtr(vp_+(((i)>>2)*4096+((i)&3)*1024+512)); }while(0)
  #define KRD(G,j) do{ if(G){ kload2(kf,kp0+sl_next,j); SBAR(); } }while(0)
  #define STEP(C0,C1,P0,P1,t,GK,GV,GL) do{ SBAR(); \
    const lds_cptr vp_=vp0+sl_prev; \
    VRD(0); SBAR(); float sacc=(P0[0]+P0[1]); \
    GAPA(C0=__builtin_amdgcn_mfma_f32_32x32x16_bf16(kf[0],qr[0],negm,0,0,0), P0[2],P0[3],P0[4],P0[5],     pw0[0]=PKW(P0,0), pw0[1]=PKW(P0,2), pw0); \
    VRD(4); SBAR(); GAPA(C1=__builtin_amdgcn_mfma_f32_32x32x16_bf16(kf[1],qr[0],negm,0,0,0), P0[6],P0[7],P0[8],P0[9],     pw0[2]=PKW(P0,4), pw0[3]=PKW(P0,6), pw0); \
    VRD(1); SBAR(); GAPA(C0=__builtin_amdgcn_mfma_f32_32x32x16_bf16(kf[2],qr[1],C0,0,0,0),   P0[10],P0[11],P0[12],P0[13], pw1[0]=PKW(P0,8), pw1[1]=PKW(P0,10), pw1); \
    VRD(5); SBAR(); GAPA(C1=__builtin_amdgcn_mfma_f32_32x32x16_bf16(kf[3],qr[1],C1,0,0,0),   P0[14],P0[15],P1[0],P1[1],   pw1[2]=PKW(P0,12),pw1[3]=PKW(P0,14), pw1); \
    VRD(2); SBAR(); GAPA(C0=__builtin_amdgcn_mfma_f32_32x32x16_bf16(kf[4],qr[2],C0,0,0,0),   P1[2],P1[3],P1[4],P1[5],     pw2[0]=PKW(P1,0), pw2[1]=PKW(P1,2), pw2); \
    VRD(6); SBAR(); GAPA(C1=__builtin_amdgcn_mfma_f32_32x32x16_bf16(kf[5],qr[2],C1,0,0,0),   P1[6],P1[7],P1[8],P1[9],     pw2[2]=PKW(P1,4), pw2[3]=PKW(P1,6), pw2); \
    VRD(3); SBAR(); GAPA(C0=__builtin_amdgcn_mfma_f32_32x32x16_bf16(kf[6],qr[3],C0,0,0,0),   P1[10],P1[11],P1[12],P1[13], pw3[0]=PKW(P1,8), pw3[1]=PKW(P1,10), pw3); \
    VRD(7); SBAR(); GAPA(C1=__builtin_amdgcn_mfma_f32_32x32x16_bf16(kf[7],qr[3],C1,0,0,0),   P1[14],P1[15],0.f,0.f,       pw3[2]=PKW(P1,12),pw3[3]=PKW(P1,14), pw3); \
    l_reg+=sacc; \
    if(GK){DMA_K((t)+3,sl_cur);} if(GV){DMA_V((t)+1,sl_next);} \
    CMASK(C0,C1,t); \
    { float a=MX3(C0[0],C0[1],C1[0]),b=MX3(C0[2],C0[3],C1[1]); a=MX3(a,C1[2],C1[3]); \
      _Pragma("unroll") for(int r=4;r<16;r+=4){a=MX3(a,C0[r],C0[r+1]);b=MX3(b,C0[r+2],C0[r+3]);a=MX3(a,C1[r],C1[r+1]);b=MX3(b,C1[r+2],C1[r+3]);} \
      float rm=__builtin_fmaxf(a,b); { auto rr=__builtin_amdgcn_permlane32_swap(__float_as_uint(rm),__float_as_uint(rm),false,false); rm=__builtin_fmaxf(__uint_as_float(rr[0]),__uint_as_float(rr[1])); } \
      resc=false; \
      if(__builtin_expect(__any(rm>(float)THRL),0)){ const float dl=__builtin_fmaxf(rm,0.f); mhat+=dl; \
        _Pragma("unroll") for(int r=0;r<16;++r){C0[r]-=dl;C1[r]-=dl;} \
        _Pragma("unroll") for(int r=0;r<16;++r)negm[r]=-mhat; asm volatile("":"+v"(negm)); \
        const float f=__builtin_amdgcn_exp2f(-dl); l_reg*=f; if(hi==0)wsf[r32]=f; resc=true; } } \
    SBAR(); \
    GAPB(o[0]=__builtin_amdgcn_mfma_f32_32x32x16_bf16(PAF(0),VFR(0),o[0],0,0,0), C0,0); \
    GAPB(o[1]=__builtin_amdgcn_mfma_f32_32x32x16_bf16(PAF(0),VFR(4),o[1],0,0,0), C0,4); \
    KRD(GL,0); GAPB(o[0]=__builtin_amdgcn_mfma_f32_32x32x16_bf16(PAF(1),VFR(1),o[0],0,0,0), C0,8); \
    KRD(GL,1); GAPB(o[1]=__builtin_amdgcn_mfma_f32_32x32x16_bf16(PAF(1),VFR(5),o[1],0,0,0), C0,12); \
    KRD(GL,2); GAPB(o[0]=__builtin_amdgcn_mfma_f32_32x32x16_bf16(PAF(2),VFR(2),o[0],0,0,0), C1,0); \
    KRD(GL,3); GAPB(o[1]=__builtin_amdgcn_mfma_f32_32x32x16_bf16(PAF(2),VFR(6),o[1],0,0,0), C1,4); \
    GAPB(o[0]=__builtin_amdgcn_mfma_f32_32x32x16_bf16(PAF(3),VFR(3),o[0],0,0,0), C1,8); \
    GAPB(o[1]=__builtin_amdgcn_mfma_f32_32x32x16_bf16(PAF(3),VFR(7),o[1],0,0,0), C1,12); \
    }while(0)
  int t=1;
  for(;t+5<NT;t+=2){
    STEP(pB0,pB1,pA0,pA1,t,true,true,true);     WAIT_BAR(2); RESC(); ROT();
    STEP(pA0,pA1,pB0,pB1,t+1,true,true,true);   WAIT_BAR(2); RESC(); ROT();
  }
  #define ENDW(tt) do{ if((tt)+3<NT){WAIT_BAR(2);} else if((tt)+2<NT){WAIT_BAR(1);} else {WAIT_BAR(0);} }while(0)
  for(;t+1<NT;t+=2){
    STEP(pB0,pB1,pA0,pA1,t,(t+3<NT),(t+1<NT),(t+1<NT));       ENDW(t);   RESC(); ROT();
    STEP(pA0,pA1,pB0,pB1,t+1,(t+4<NT),(t+2<NT),(t+2<NT));     ENDW(t+1); RESC(); ROT();
  }
  STEP(pB0,pB1,pA0,pA1,NT-1,false,false,false); RESC();
  { float sacc=pB0[0]+pB0[1]; _Pragma("unroll") for(int r=2;r<16;++r)sacc+=pB0[r]; _Pragma("unroll") for(int r=0;r<16;++r)sacc+=pB1[r]; l_reg+=sacc;
    pw0=(u32x4){PKW(pB0,0),PKW(pB0,2),PKW(pB0,4),PKW(pB0,6)};pw1=(u32x4){PKW(pB0,8),PKW(pB0,10),PKW(pB0,12),PKW(pB0,14)};pw2=(u32x4){PKW(pB1,0),PKW(pB1,2),PKW(pB1,4),PKW(pB1,6)};pw3=(u32x4){PKW(pB1,8),PKW(pB1,10),PKW(pB1,12),PKW(pB1,14)};
    SBAR(); pv(o,vb0+sl_cur,PAF(0),PAF(1),PAF(2),PAF(3)); }
  #undef PKW
  #undef PAF
  #undef VFR
  #undef PIN
  #undef MX3
  #undef GAPA
  #undef GAPB
  #undef EX
  #undef VRD
  #undef KRD
  #undef STEP
  #undef ENDW
  {auto rr=__builtin_amdgcn_permlane32_swap(__float_as_uint(l_reg),__float_as_uint(l_reg),false,false);l_reg=__uint_as_float(rr[0])+__uint_as_float(rr[1]);}
  if(hi==0)wsf[32+r32]=l_reg;asm volatile("s_waitcnt lgkmcnt(0)":::"memory");
  float rli[16];
  #pragma unroll
  for(int r=0;r<16;++r)rli[r]=__builtin_amdgcn_rcpf(wsf[32+crow(r,hi)]);
  bf16*Ow=O+(rowbase+q0+wid*QBLK)*DM+h*D;
  { bf16*stg=(bf16*)(shm+LDS_OST)+wid*2048;
    #pragma unroll
    for(int r=0;r<16;++r){const int orow=crow(r,hi);
      #pragma unroll
      for(int d0=0;d0<2;++d0)stg[orow*64+d0*32+r32]=__float2bfloat16(o[d0][r]*rli[r]);}
    asm volatile("s_waitcnt lgkmcnt(0)":::"memory");
    #pragma unroll
    for(int i=0;i<4;++i){const int row=i*8+(lane>>3),ch=lane&7; const u32x4 v=*(const u32x4*)(stg+row*64+ch*8); ATTN_STORE16(Ow+(long)row*DM+ch*8,v);} }
  asm volatile("s_waitcnt lgkmcnt(0)\n\ts_barrier":::"memory");
  #undef DMA_K
  #undef TM
  #undef SELK
  #undef DMA_V
  #undef CMASK
  #undef START
  #undef RESC
  #undef ROT
}

__device__ __forceinline__ void moba_gate(int b,int h,int qb,const bf16*Q,const float*__restrict__ kmean,char*shm){
  int tid=threadIdx.x; asm volatile("":"+v"(tid));
  if(tid<QB){
    unsigned selmask=0u;
    if(qb>0){
      const unsigned short*qrow=(const unsigned short*)Q+((long)b*SEQ+qb*QB+tid)*DM+h*D;
      const float*kmb=kmean+(long)((b*NHEAD+h)*16)*64;
      float g0=-INFINITY,g1=-INFINITY,g2=-INFINITY; int i0=-1,i1=-1,i2=-1;
      for(int n=0;n<qb;++n){
        float g=0.f;
        #pragma unroll
        for(int c=0;c<8;++c){
          const u32x4 qv=*reinterpret_cast<const u32x4*>(qrow+c*8);
          const f32x4_t ka=*reinterpret_cast<const f32x4_t*>(kmb+n*64+c*8), kb=*reinterpret_cast<const f32x4_t*>(kmb+n*64+c*8+4);
          g+=__builtin_bit_cast(float,qv.x<<16)*ka[0]; g+=__builtin_bit_cast(float,qv.x&0xffff0000u)*ka[1];
          g+=__builtin_bit_cast(float,qv.y<<16)*ka[2]; g+=__builtin_bit_cast(float,qv.y&0xffff0000u)*ka[3];
          g+=__builtin_bit_cast(float,qv.z<<16)*kb[0]; g+=__builtin_bit_cast(float,qv.z&0xffff0000u)*kb[1];
          g+=__builtin_bit_cast(float,qv.w<<16)*kb[2]; g+=__builtin_bit_cast(float,qv.w&0xffff0000u)*kb[3];
        }
        if(g>g0){g2=g1;i2=i1;g1=g0;i1=i0;g0=g;i0=n;} else if(g>g1){g2=g1;i2=i1;g1=g;i1=n;} else if(g>g2){g2=g;i2=n;}
      }
      if(i0>=0)selmask|=1u<<i0; if(i1>=0)selmask|=1u<<i1; if(i2>=0)selmask|=1u<<i2;
    }
    { int t2=tid; asm volatile("":"+v"(t2)); ((unsigned*)(shm+LDS_BYTES))[t2]=selmask; }
  }
  asm volatile("s_waitcnt lgkmcnt(0)\n\ts_barrier":::"memory");
}
constexpr int ATTN_LDS_BYTES=LDS_BYTES;
struct AttnTensors { const bf16* Q; const bf16* K; const bf16* V; bf16* O; const float* kmean; };
struct AttnUnit { int bh; int qb; };
struct StaticOrder {
  int vcu;
  __device__ __forceinline__ explicit StaticOrder(int grid,int block):vcu((block%8)*(grid/8)+block/8){}
  __device__ __forceinline__ bool next(int i,AttnUnit&u)const{ if(i>=8)return false; const int half=vcu&1; u.bh=vcu>>1;
    const int pr=3-(i>>1);
    u.qb=(i&1)?(half?(4*pr+1):(4*pr)):(half?(4*pr+2):(4*pr+3)); return true; }
  __device__ __forceinline__ void a_ready(const AttnUnit&)const{}
  __device__ __forceinline__ void done(const AttnUnit&)const{}
};
struct QueueOrder {
  unsigned* ctr; volatile __attribute__((address_space(3))) unsigned* slot;
  __device__ __forceinline__ bool next(int,AttnUnit&u)const{
    if(threadIdx.x==0)*slot=__hip_atomic_fetch_add(ctr,1u,__ATOMIC_RELAXED,__HIP_MEMORY_SCOPE_AGENT);
    __syncthreads(); const unsigned k=*slot; __syncthreads();
    if(k>=2048u)return false; u.qb=15-(int)(k>>7); u.bh=(int)(k&127u); return true; }
  __device__ __forceinline__ void a_ready(const AttnUnit&)const{}
  __device__ __forceinline__ void done(const AttnUnit&)const{}
};
template<class Sched,int THRL=8> __device__ __forceinline__ void attn_phase(char*lds,const AttnTensors&T,const Sched&S){
  AttnUnit u;
  for(int i=0;S.next(i,u);++i){ S.a_ready(u); moba_gate(u.bh/NHEAD,u.bh%NHEAD,u.qb,T.Q,T.kmean,lds); attn_unit<THRL>(u.bh/NHEAD,u.bh%NHEAD,u.qb,T.Q,T.K,T.V,T.O,lds); S.done(u); }
}
#undef SBAR
#undef WAIT_BAR
}
namespace mlstm {
#define ML_LAS __attribute__((address_space(3)))
typedef short bf16x8 __attribute__((ext_vector_type(8)));
typedef short s16x4 __attribute__((ext_vector_type(4)));
typedef float f32x4 __attribute__((ext_vector_type(4)));
typedef unsigned u32x4 __attribute__((ext_vector_type(4)));
typedef unsigned u32x2 __attribute__((ext_vector_type(2)));
constexpr int PQ = 272, PV = 336, PA = 144;
constexpr int O_QC = 0, O_KC = O_QC + 64 * PQ, O_HST = O_KC + 64 * PQ, O_VP = O_HST + 64 * PQ, O_VW = O_VP + 64 * PV, O_ST = O_VW + 64 * PV, O_AM = O_ST + 128 * PV,
              O_CW = O_AM + 64 * PA, O_EX = O_CW + 2 * 5 * 128 * 4, O_SCR = O_EX + 3 * 64 * 4, O_CH = O_SCR + 64 * 4, LDS_END = O_CH + 2 * 4 * 64 * 4;
static_assert(LDS_END <= 156 * 1024, "mlstm LDS");
struct Args { const bf16_t* mq; const bf16_t* mk; const bf16_t* mv; const bf16_t* mosig; const float* ifg; const float* conv_w; const float* conv_b; const float* nw; float* sca; float* scm; float* scb; bf16_t* hm; };
__device__ __forceinline__ s16x4 trd(const ML_LAS unsigned char* p) { return __builtin_bit_cast(s16x4, __builtin_amdgcn_ds_read_tr16_b64_v4i16((ML_LAS s16x4*)p)); }
__device__ __forceinline__ bf16x8 cat8(s16x4 lo, s16x4 hi) { return (bf16x8){lo[0], lo[1], lo[2], lo[3], hi[0], hi[1], hi[2], hi[3]}; }
__device__ __forceinline__ float blo(unsigned w) { return __builtin_bit_cast(float, w << 16); }
__device__ __forceinline__ float bhi(unsigned w) { return __builtin_bit_cast(float, w & 0xffff0000u); }
__device__ __forceinline__ float logsig(float f) { return (f >= 0.f) ? -log1pf(__expf(-f)) : f - log1pf(__expf(f)); }

__device__ __forceinline__ void unit(int b, int h, const Args& A, ML_LAS unsigned char* lds) {
    int tid = threadIdx.x; asm volatile("" : "+v"(tid)); const int lane = tid & 63, wid = __builtin_amdgcn_readfirstlane(tid >> 6);
    int tidv = tid; int l15 = tidv & 15, q4 = (tidv >> 4) & 3, d8 = tidv & 15, row0 = 2 * (tidv >> 4);
    const size_t tb = (size_t)b * 4096, sb = (size_t)(b * 4 + h) * 4096;
    ML_LAS float* cwl = (ML_LAS float*)(lds + O_CW); ML_LAS float* ex = (ML_LAS float*)(lds + O_EX); ML_LAS float* scr = (ML_LAS float*)(lds + O_SCR); ML_LAS float* chs = (ML_LAS float*)(lds + O_CH);
    for (int i = tid; i < 1280; i += 512) { const int qk = i / 640, r = (i % 640) >> 7, d = i & 127, ch = qk * 512 + h * 128 + d; cwl[i] = (r < 4) ? A.conv_w[r * 1024 + ch] : A.conv_b[ch]; }
    for (int i = tid; i < 128 * PV / 16; i += 512) *(ML_LAS u32x4*)(lds + O_ST + i * 16) = (u32x4){0u, 0u, 0u, 0u};
    if (tid < 256) { const int r = tid >> 2, part = tid & 3;
        *(ML_LAS u32x4*)(lds + O_VP + r * PV + 256 + part * 16) = (u32x4){part == 0 ? 0x3F80u : 0u, 0u, 0u, 0u};
        *(ML_LAS u32x4*)(lds + O_VW + r * PV + 256 + part * 16) = (u32x4){0u, 0u, 0u, 0u}; }
    {
        float lfv[8], av[8]; float run = 0.f;
#pragma unroll
        for (int j = 0; j < 8; ++j) { const float f = A.ifg[(tb + 8 * tid + j) * 8 + 4 + h]; run += logsig(f); lfv[j] = run; }
        float incl = run;
#pragma unroll
        for (int o = 1; o < 64; o <<= 1) { const float t = __shfl_up(incl, o); if (lane >= o) incl += t; }
        if (lane == 63) scr[wid] = incl;
        __syncthreads();
        float pre = incl - run; for (int w = 0; w < wid; ++w) pre += scr[w];
        float m = -INFINITY;
#pragma unroll
        for (int j = 0; j < 8; ++j) { const float Bv = pre + lfv[j]; const float a = A.ifg[(tb + 8 * tid + j) * 8 + h] - Bv; A.scb[sb + 8 * tid + j] = Bv; A.sca[sb + 8 * tid + j] = a; m = fmaxf(m, a); av[j] = m; }
        float im = m;
#pragma unroll
        for (int o = 1; o < 64; o <<= 1) { const float t = __shfl_up(im, o); if (lane >= o) im = fmaxf(im, t); }
        if (lane == 63) scr[8 + wid] = im;
        __syncthreads();
        float pm = __shfl_up(im, 1); if (lane == 0) pm = -INFINITY; pm = fmaxf(pm, 0.f); for (int w = 0; w < wid; ++w) pm = fmaxf(pm, scr[8 + w]);
#pragma unroll
        for (int j = 0; j < 8; ++j) A.scm[sb + 8 * tid + j] = fmaxf(pm, av[j]);
    }
    __threadfence(); __syncthreads();
    f32x4 accS[20];
#pragma unroll
    for (int v = 0; v < 20; ++v) accS[v] = (f32x4){0.f, 0.f, 0.f, 0.f};
    uint4 rq[5], rk[5], rv[2]; float chv = 0.f;
#define goff ((unsigned)(tb * 512) + h * 128 + 8 * d8)
#define ML_LOAD(c) do { const int c0_ = (c) * 64; \
        _Pragma("unroll") for (int j = 0; j < 5; ++j) { const int rr = c0_ + row0 - 3 + j; if (rr >= 0) { rq[j] = *(const uint4*)(A.mq + goff + rr * 512); rk[j] = *(const uint4*)(A.mk + goff + rr * 512); } else { rq[j] = make_uint4(0u, 0u, 0u, 0u); rk[j] = rq[j]; } } \
        _Pragma("unroll") for (int j = 0; j < 2; ++j) { rv[j] = *(const uint4*)(A.mv + goff + (c0_ + row0 + j) * 512); \
            } } while (0)
#define ML_LOADS(c) do { const int c0_ = (c) * 64; \
        if (tidv < 192) { chv = A.sca[(size_t)(tidv >> 6) * (16 * 4 * 4096) + sb + c0_ + (tidv & 63)]; }     else if (tidv == 192) chv = (c0_ == 0) ? 0.f : A.scm[sb + c0_ - 1]; } while (0)
    ML_LOAD(0); ML_LOADS(0);
    if (tidv < 193) chs[tidv] = chv;
    __syncthreads();
    for (int c = 0; c < 64; ++c) {
        asm volatile("" : "+v"(tidv)); l15 = tidv & 15; q4 = (tidv >> 4) & 3; d8 = l15; row0 = 2 * (tidv >> 4);
        const int c0 = c * 64; const ML_LAS float* ch = chs + (c & 1) * 256;
#pragma unroll
        for (int qk = 0; qk < 2; ++qk) {
            const ML_LAS float* wq = cwl + qk * 640 + 8 * d8;
            float y[2][8];
            { const f32x4 b0 = *(const ML_LAS f32x4*)(wq + 512), b1 = *(const ML_LAS f32x4*)(wq + 516);
#pragma unroll
              for (int e = 0; e < 4; ++e) { y[0][e] = b0[e]; y[0][4 + e] = b1[e]; y[1][e] = b0[e]; y[1][4 + e] = b1[e]; } }
#pragma unroll
            for (int j = 0; j < 4; ++j) {
                const f32x4 w0 = *(const ML_LAS f32x4*)(wq + j * 128), w1 = *(const ML_LAS f32x4*)(wq + j * 128 + 4);
#pragma unroll
                for (int ro = 0; ro < 2; ++ro) { const uint4 u = qk ? rk[ro + j] : rq[ro + j]; const unsigned uw[4] = {u.x, u.y, u.z, u.w};
                    y[ro][0] += w0[0] * blo(uw[0]); y[ro][1] += w0[1] * bhi(uw[0]); y[ro][2] += w0[2] * blo(uw[1]); y[ro][3] += w0[3] * bhi(uw[1]);
                    y[ro][4] += w1[0] * blo(uw[2]); y[ro][5] += w1[1] * bhi(uw[2]); y[ro][6] += w1[2] * blo(uw[3]); y[ro][7] += w1[3] * bhi(uw[3]); }
            }
#pragma unroll
            for (int ro = 0; ro < 2; ++ro) {
#pragma unroll
                for (int e = 0; e < 8; ++e) { y[ro][e] = y[ro][e] * __builtin_amdgcn_rcpf(1.0f + __expf(-y[ro][e])); if (qk) y[ro][e] *= 0.08838834764831845f; }
                *(ML_LAS u32x4*)(lds + (qk ? O_KC : O_QC) + (row0 + ro) * PQ + 16 * d8) = (u32x4){pk2(y[ro][0], y[ro][1]), pk2(y[ro][2], y[ro][3]), pk2(y[ro][4], y[ro][5]), pk2(y[ro][6], y[ro][7])};
            }
        }
#pragma unroll
        for (int ro = 0; ro < 2; ++ro) {
            *(ML_LAS u32x4*)(lds + O_VP + (row0 + ro) * PV + 16 * d8) = (u32x4){rv[ro].x, rv[ro].y, rv[ro].z, rv[ro].w};
            const float wsv = __expf(ch[row0 + ro] - ch[127]); const unsigned uw[4] = {rv[ro].x, rv[ro].y, rv[ro].z, rv[ro].w}; unsigned o[4];
#pragma unroll
            for (int e2 = 0; e2 < 4; ++e2) o[e2] = pk2(blo(uw[e2]) * wsv, bhi(uw[e2]) * wsv);
            *(ML_LAS u32x4*)(lds + O_VW + (row0 + ro) * PV + 16 * d8) = (u32x4){o[0], o[1], o[2], o[3]};
            if (d8 == 0) *(ML_LAS unsigned short*)(lds + O_VW + (row0 + ro) * PV + 256) = (unsigned short)f2bf(wsv);
        }
        __syncthreads();
        const float Mref = ch[192], Mend = ch[127];
        const int trow = 16 * (wid & 3) + 4 * q4;
        const f32x4 Mxr = *(const ML_LAS f32x4*)(ch + 64 + trow);
        if (wid < 4) {
#pragma unroll
            for (int v = 0; v < 10; ++v) accS[v] = (f32x4){0.f, 0.f, 0.f, 0.f};
#pragma unroll
            for (int ks = 0; ks < 4; ++ks) {
                const bf16x8 a = *(const ML_LAS bf16x8*)(lds + O_QC + (16 * wid + l15) * PQ + (32 * ks + 8 * q4) * 2);
                const ML_LAS unsigned char* bp = lds + O_ST + (32 * ks + 8 * q4 + (l15 >> 2)) * PV + (l15 & 3) * 8;
#pragma unroll
                for (int v = 0; v < 10; ++v) { const bf16x8 bfr = cat8(trd(bp + 32 * v), trd(bp + 4 * PV + 32 * v)); accS[v] = __builtin_amdgcn_mfma_f32_16x16x32_bf16(a, bfr, accS[v], 0, 0, 0); }
            }
            float wi[4];
#pragma unroll
            for (int i = 0; i < 4; ++i) wi[i] = __expf(Mref - Mxr[i]);
#pragma unroll
            for (int v = 0; v < 10; ++v)
#pragma unroll
                for (int i = 0; i < 4; ++i) accS[v][i] *= wi[i];
        } else {
            const int j = wid - 4;
#pragma unroll
            for (int tile = 0; tile < 16; ++tile) {
                if ((int)((0x3333322221120000ull >> (4 * tile)) & 15ull) != j) continue;
                const int st = tile >> 2, tt = tile & 3;
                f32x4 cacc = (f32x4){0.f, 0.f, 0.f, 0.f};
                if (st <= tt) {
#pragma unroll
                    for (int ks = 0; ks < 4; ++ks) {
                        const bf16x8 a = *(const ML_LAS bf16x8*)(lds + O_KC + (16 * st + l15) * PQ + (32 * ks + 8 * q4) * 2);
                        const bf16x8 bq = *(const ML_LAS bf16x8*)(lds + O_QC + (16 * tt + l15) * PQ + (32 * ks + 8 * q4) * 2);
                        cacc = __builtin_amdgcn_mfma_f32_16x16x32_bf16(a, bq, cacc, 0, 0, 0);
                    }
                }
                const int t = 16 * tt + l15, s0 = 16 * st + 4 * q4;
                const float Mt = ch[64 + t]; const f32x4 as = *(const ML_LAS f32x4*)(ch + s0);
                float o[4];
#pragma unroll
                for (int i = 0; i < 4; ++i) o[i] = (s0 + i <= t) ? cacc[i] * __expf(as[i] - Mt) : 0.f;
                *(ML_LAS u32x2*)(lds + O_AM + t * PA + s0 * 2) = (u32x2){pk2(o[0], o[1]), pk2(o[2], o[3])};
            }
            const float decay = __expf(Mref - Mend);
#pragma unroll
            for (int v = 0; v < 20; ++v) accS[v] = accS[v] * decay;
#pragma unroll
            for (int ks = 0; ks < 2; ++ks) {
                const ML_LAS unsigned char* kp = lds + O_KC + (32 * ks + 8 * q4 + (l15 >> 2)) * PQ + 64 * j + (l15 & 3) * 8;
                const bf16x8 bf0 = cat8(trd(kp), trd(kp + 4 * PQ)), bf1 = cat8(trd(kp + 32), trd(kp + 4 * PQ + 32));
                const ML_LAS unsigned char* ap = lds + O_VW + (32 * ks + 8 * q4 + (l15 >> 2)) * PV + (l15 & 3) * 8;
#pragma unroll
                for (int v = 0; v < 10; ++v) { const bf16x8 afr = cat8(trd(ap + 32 * v), trd(ap + 4 * PV + 32 * v));
                    accS[v] = __builtin_amdgcn_mfma_f32_16x16x32_bf16(afr, bf0, accS[v], 0, 0, 0); accS[10 + v] = __builtin_amdgcn_mfma_f32_16x16x32_bf16(afr, bf1, accS[10 + v], 0, 0, 0); }
            }
        }
        __syncthreads();
        if (c + 1 < 64) ML_LOADS(c + 1);
        if (wid < 4) {
#pragma unroll
            for (int ks = 0; ks < 2; ++ks) {
                const bf16x8 a = *(const ML_LAS bf16x8*)(lds + O_AM + (16 * wid + l15) * PA + (32 * ks + 8 * q4) * 2);
                const ML_LAS unsigned char* bp = lds + O_VP + (32 * ks + 8 * q4 + (l15 >> 2)) * PV + (l15 & 3) * 8;
#pragma unroll
                for (int v = 0; v < 10; ++v) { const bf16x8 bfr = cat8(trd(bp + 32 * v), trd(bp + 4 * PV + 32 * v)); accS[v] = __builtin_amdgcn_mfma_f32_16x16x32_bf16(a, bfr, accS[v], 0, 0, 0); }
            }
            const f32x4 Bcr = *(const ML_LAS f32x4*)(ch + 128 + trow);
#pragma unroll
            for (int i = 0; i < 4; ++i) {
                float ssum = 0.f;
#pragma unroll
                for (int v = 0; v < 8; ++v) ssum += accS[v][i] * accS[v][i];
                ssum += __shfl_xor(ssum, 1); ssum += __shfl_xor(ssum, 2); ssum += __shfl_xor(ssum, 4); ssum += __shfl_xor(ssum, 8);
                const float den = __shfl(accS[8][i], lane & 48);
                const float dn = fmaxf(fabsf(den), __expf(-(Bcr[i] + Mxr[i]))), idn = 1.0f / dn;
                const float sc = idn * rsqrtf(ssum * idn * idn * (1.0f / 128.0f) + 1e-6f);
#pragma unroll
                for (int v = 0; v < 8; ++v) *(ML_LAS unsigned short*)(lds + O_HST + (trow + i) * PQ + (16 * v + l15) * 2) = (unsigned short)f2bf(accS[v][i] * sc);
            }
        } else {
            const int j = wid - 4;
#pragma unroll
            for (int v = 0; v < 10; ++v) {
                *(ML_LAS u32x2*)(lds + O_ST + (32 * j + l15) * PV + (16 * v + 4 * q4) * 2) = (u32x2){pk2(accS[v][0], accS[v][1]), pk2(accS[v][2], accS[v][3])};
                *(ML_LAS u32x2*)(lds + O_ST + (32 * j + 16 + l15) * PV + (16 * v + 4 * q4) * 2) = (u32x2){pk2(accS[10 + v][0], accS[10 + v][1]), pk2(accS[10 + v][2], accS[10 + v][3])}; }
        }
        if (c + 1 < 64) ML_LOAD(c + 1);
        if (tidv < 193) chs[((c + 1) & 1) * 256 + tidv] = chv;
        uint4 rmo[2];
#pragma unroll
        for (int ro = 0; ro < 2; ++ro) rmo[ro] = *(const uint4*)(A.mosig + goff + (c0 + row0 + ro) * 512);
        __syncthreads();
        f32x4 nwv[2]; nwv[0] = *(const f32x4*)(A.nw + h * 128 + 8 * d8); nwv[1] = *(const f32x4*)(A.nw + h * 128 + 8 * d8 + 4);
#pragma unroll
        for (int ro = 0; ro < 2; ++ro) {
            const u32x4 hv = *(const ML_LAS u32x4*)(lds + O_HST + (row0 + ro) * PQ + 16 * d8); const unsigned hw[4] = {hv.x, hv.y, hv.z, hv.w}; const unsigned mw[4] = {rmo[ro].x, rmo[ro].y, rmo[ro].z, rmo[ro].w}; unsigned o[4];
#pragma unroll
            for (int e2 = 0; e2 < 4; ++e2) o[e2] = pk2(blo(hw[e2]) * nwv[(2 * e2) >> 2][(2 * e2) & 3] * blo(mw[e2]), bhi(hw[e2]) * nwv[(2 * e2 + 1) >> 2][(2 * e2 + 1) & 3] * bhi(mw[e2]));
            *(uint4*)(A.hm + goff + (c0 + row0 + ro) * 512) = make_uint4(o[0], o[1], o[2], o[3]);
        }
    }
#undef ML_LOAD
#undef ML_LOADS
#undef goff
    __syncthreads();
}
}
namespace peer {
#define PE_LAS __attribute__((address_space(3)))
typedef short bf16x8 __attribute__((ext_vector_type(8)));
typedef float f32x4 __attribute__((ext_vector_type(4)));
typedef float f32x16 __attribute__((ext_vector_type(16)));
typedef unsigned u32x4 __attribute__((ext_vector_type(4)));
constexpr int QP = 528;
constexpr int O_R2 = 256 * QP;
constexpr int LDS_END = O_R2 + 1024;
__device__ __forceinline__ int ordi(float f) { const int b = __builtin_bit_cast(int, f); return b ^ ((b >> 31) & 0x7FFFFFFF); }
__device__ __forceinline__ float ordf(int o) { return __builtin_bit_cast(float, o ^ ((o >> 31) & 0x7FFFFFFF)); }
#define PE_CE(a, b) do { const int hi_ = max(a, b), lo_ = min(a, b); a = hi_; b = lo_; } while (0)
__device__ __forceinline__ void sort16_desc(int (&a)[16]) {
#pragma unroll
    for (int k = 2; k <= 16; k <<= 1)
#pragma unroll
        for (int j = k >> 1; j > 0; j >>= 1)
#pragma unroll
            for (int i = 0; i < 16; ++i) { const int l = i ^ j; if (l > i) { if ((i & k) == 0) PE_CE(a[i], a[l]); else PE_CE(a[l], a[i]); } }
}
__device__ __forceinline__ void merge16_desc(int (&a)[16], const int (&b)[16]) {
#pragma unroll
    for (int i = 0; i < 16; ++i) a[i] = max(a[i], b[15 - i]);
#pragma unroll
    for (int j = 8; j > 0; j >>= 1)
#pragma unroll
        for (int i = 0; i < 16; ++i) { const int l = i ^ j; if (l > i) PE_CE(a[i], a[l]); }
}
__device__ __forceinline__ void top16_of_64(int (&g0)[16], int (&g1)[16], int (&g2)[16], int (&g3)[16]) {
    sort16_desc(g0); sort16_desc(g1); sort16_desc(g2); sort16_desc(g3);
    merge16_desc(g0, g1); merge16_desc(g2, g3); merge16_desc(g0, g2);
}
struct Args { const float* rowss; const bf16_t* key1; const bf16_t* key2; float* r2out; int* eidx; float* eg; };
struct EpiPeerQ {
    static constexpr bool PERM = false, AFTER_DRAIN = true;
    __device__ __forceinline__ bool zero_after(const pg8::Unit&) const { return true; }
    __device__ __forceinline__ void fused(pg8::f32x4 (&acc)[2][2][4][2], const pg8::Unit& u, int wr, int wc, int fr, int fq, PG8_LAS unsigned char* lds, int wid, int lane) const {
        const PE_LAS float* r2s = (const PE_LAS float*)(lds + O_R2);
#pragma unroll
        for (int ai = 0; ai < 2; ++ai)
#pragma unroll
            for (int m = 0; m < 4; ++m) { const int row = ai * 128 + wr * 64 + m * 16 + fr; const float r = r2s[row];
#pragma unroll
                for (int bj = 0; bj < 2; ++bj) *(PE_LAS u32x4*)(lds + row * QP + (wc * 64 + bj * 32 + 8 * fq) * 2) = pg8::pack8(acc[ai][bj][m][0] * r, acc[ai][bj][m][1] * r); }
    }
};
struct SchedOne { pg8::Unit u;
    __device__ __forceinline__ bool next(int i, pg8::Unit& o) const { if (i > 0) return false; o = u; return true; }
    __device__ __forceinline__ void a_ready(const pg8::Unit&) const {}
    __device__ __forceinline__ void done(const pg8::Unit&) const {} };

__device__ __forceinline__ void half_top16(int (&g0)[16], const PE_LAS unsigned char* qrow  , const bf16_t* keyrow  , int hi) {
    f32x16 s[4];
#pragma unroll
    for (int kb = 0; kb < 4; ++kb) s[kb] = f32x16{};
#pragma unroll
    for (int ks = 0; ks < 8; ++ks) {
        const bf16x8 bq = *(const PE_LAS bf16x8*)(qrow + ks * 32);
#pragma unroll
        for (int kb = 0; kb < 4; ++kb) { const bf16x8 a = *(const bf16x8*)(keyrow + (size_t)kb * 32 * 128 + ks * 16); s[kb] = __builtin_amdgcn_mfma_f32_32x32x16_bf16(a, bq, s[kb], 0, 0, 0); }
    }
    int g1[16], g2[16], g3[16];
#pragma unroll
    for (int r = 0; r < 16; ++r) { const int kr = (r & 3) + 8 * (r >> 2) + 4 * hi;
        g0[r] = (ordi(s[0][r]) & ~0x7F) | kr; g1[r] = (ordi(s[1][r]) & ~0x7F) | (32 + kr); g2[r] = (ordi(s[2][r]) & ~0x7F) | (64 + kr); g3[r] = (ordi(s[3][r]) & ~0x7F) | (96 + kr); }
    top16_of_64(g0, g1, g2, g3);
#pragma unroll
    for (int r = 0; r < 16; ++r) g1[r] = __shfl_xor(g0[r], 32);
    merge16_desc(g0, g1);
}

__device__ __forceinline__ void unit(int pm, int h, const bf16_t* x1b, const bf16_t* wq, const Args& A, PG8_LAS unsigned char* lds) {
    int tid = threadIdx.x; asm volatile("" : "+v"(tid)); const int wid = __builtin_amdgcn_readfirstlane(tid >> 6);
    if (tid < 256) { const f32x4* rs = (const f32x4*)(A.rowss + (size_t)(pm * 256 + tid) * 16); const f32x4 a = rs[0], b = rs[1], c = rs[2], d = rs[3];
        const float ss = ((a[0] + a[1]) + (a[2] + a[3])) + ((b[0] + b[1]) + (b[2] + b[3])) + ((c[0] + c[1]) + (c[2] + c[3])) + ((d[0] + d[1]) + (d[2] + d[3]));
        const float r = rsqrtf(ss * (1.0f / 1024.0f) + 1e-6f); ((PE_LAS float*)(lds + O_R2))[tid] = r; if (h == 0) A.r2out[pm * 256 + tid] = r; }
    __syncthreads();
    SchedOne S; S.u.pm = pm; S.u.pn = h; S.u.seg = 0; S.u.pad = 0; S.u.A = (const char*)(x1b + (size_t)pm * 256 * 1024); S.u.B = (const char*)(wq + (size_t)h * 256 * 1024);
    EpiPeerQ E;
    pg8::gemm_phase<EpiPeerQ, SchedOne, true, true>(lds, 1024, S, E);
    __syncthreads();
    int tv = tid; asm volatile("" : "+v"(tv)); const int r32 = tv & 31, hi = (tv >> 5) & 1;
    int v1[16], v2[16];
    half_top16(v1, lds + (32 * wid + r32) * QP + (8 * hi) * 2, A.key1 + ((size_t)h * 128 + r32) * 128 + 8 * hi, hi);
    half_top16(v2, lds + (32 * wid + r32) * QP + (128 + 8 * hi) * 2, A.key2 + ((size_t)h * 128 + r32) * 128 + 8 * hi, hi);
    float f1[16], f2[16];
#pragma unroll
    for (int i = 0; i < 16; ++i) { f1[i] = ordf(v1[i] & ~0x7F); f2[i] = ordf(v2[i] & ~0x7F); }
    int c0[16], c1[16], c2[16], c3[16];
    {
        int n = 0;
#pragma unroll
        for (int i = 0; i < 16; ++i)
#pragma unroll
            for (int j = 0; j < 16; ++j) if ((i + 1) * (j + 1) <= 16) { const int key = (ordi(f1[i] + f2[j]) & ~0xFF) | (i << 4) | j;
                if (n < 16) c0[n] = key; else if (n < 32) c1[n - 16] = key; else if (n < 48) c2[n - 32] = key; else c3[n - 48] = key; ++n; }
#pragma unroll
        for (int k = 2; k < 16; ++k) c3[k] = (int)0x80000000;
    }
    top16_of_64(c0, c1, c2, c3);
    PE_LAS unsigned char* scr = lds + (32 * wid + r32) * QP;
    if (hi == 0) {
#pragma unroll
        for (int i = 0; i < 16; ++i) { scr[i] = (unsigned char)(v1[i] & 0x7F); scr[16 + i] = (unsigned char)(v2[i] & 0x7F); } }
    asm volatile("s_waitcnt lgkmcnt(0)" ::: "memory");
    float val[16], sum = 0.f;
#pragma unroll
    for (int r = 0; r < 16; ++r) { val[r] = __expf(ordf(c0[r] & ~0xFF) - ordf(c0[0] & ~0xFF)); sum += val[r]; }
    const float inv = 1.0f / sum;
    const size_t ob = ((size_t)(pm * 256 + 32 * wid + r32) * 8 + h) * 16;
#pragma unroll
    for (int r = 0; r < 16; ++r) if ((r >> 3) == hi) { const int code = c0[r] & 0xFF; A.eidx[ob + r] = (int)scr[code >> 4] * 128 + (int)scr[16 + (code & 15)]; A.eg[ob + r] = val[r] * inv; }
    __syncthreads();
}
}
#define XB_TMO      128
#define XB_XCNT(j)  (256  + 64 * (j))
#define XB_XSUB(j)  (1280 + 64 * (j))
#define XB_XGEN(j)  (2304 + 64 * (j))
#define XB_TOP      3328
#define XB_TOPGEN   3392
#define XCD_BAR_WORDS 3456
#define XB_SPIN_CAP (1u << 18)

__device__ __forceinline__ unsigned xb_ld(unsigned* p)              { return __hip_atomic_load(p, __ATOMIC_RELAXED, __HIP_MEMORY_SCOPE_AGENT); }
__device__ __forceinline__ unsigned xb_add(unsigned* p, unsigned v) { return __hip_atomic_fetch_add(p, v, __ATOMIC_RELAXED, __HIP_MEMORY_SCOPE_AGENT); }
__device__ __forceinline__ unsigned xb_xcc_id() { return (unsigned)__builtin_amdgcn_s_getreg((3 << 11) | 20) & 0xFu; }
#define XB_SPIN(cond, bar) do { unsigned _sp = 0; while (cond) { __builtin_amdgcn_s_sleep(1); \
    if ((++_sp & 255u) == 0u) { if (xb_ld(&(bar)[XB_TMO])) break; if (_sp > XB_SPIN_CAP) { atomicAdd(&(bar)[XB_TMO], 1u); break; } } } } while (0)

struct XcdBarrier {
    unsigned* bar; unsigned x;
    volatile __attribute__((address_space(3))) unsigned* st;
};

__device__ __forceinline__ XcdBarrier xcd_barrier_post(unsigned* bar, volatile __attribute__((address_space(3))) unsigned* st) {
    XcdBarrier b; b.bar = bar; b.x = xb_xcc_id(); b.st = st;
    if (threadIdx.x == 0) (void)xb_add(&bar[XB_XCNT(b.x)], 1u);
    return b;
}
__device__ __forceinline__ void xcd_barrier_complete(unsigned* bar, unsigned x, unsigned& nloc, unsigned& nx) {
    const unsigned G = gridDim.x * gridDim.y * gridDim.z;
    unsigned sum, cnt, mine, sp = 0u;
    for (;;) {
        sum = 0u; cnt = 0u; mine = 0u;
#pragma unroll
        for (unsigned j = 0; j < 16; ++j) { const unsigned c = xb_ld(&bar[XB_XCNT(j)]); sum += c; cnt += (c > 0u) ? 1u : 0u; mine = (j == x) ? c : mine; }
        if (sum == G) break;
        __builtin_amdgcn_s_sleep(1);
        if ((++sp & 255u) == 0u) { if (xb_ld(&bar[XB_TMO])) break; if (sp > XB_SPIN_CAP) { atomicAdd(&bar[XB_TMO], 1u); break; } }
    }
    nloc = mine > 0u ? mine : 1u; nx = cnt > 0u ? cnt : 1u;
}

__device__ __forceinline__ void xcd_barrier(const XcdBarrier& b) {
    asm volatile("s_waitcnt vmcnt(0)" ::: "memory");
    __syncthreads();
    if (threadIdx.x == 0) {
        unsigned* bar = b.bar;
        __builtin_amdgcn_s_waitcnt(0);
        unsigned nloc = b.st[0], nx = b.st[1];
        if (nloc == 0u) { xcd_barrier_complete(bar, b.x, nloc, nx); b.st[0] = nloc; b.st[1] = nx; }
        const unsigned old = xb_add(&bar[XB_XSUB(b.x)], 1u);
        const unsigned gen = old / nloc;
        if (old + 1u == (gen + 1u) * nloc) {
            __builtin_amdgcn_fence(__ATOMIC_RELEASE, "agent");
            asm volatile("s_waitcnt vmcnt(0)" ::: "memory");
            const unsigned og = xb_add(&bar[XB_TOP], 1u);
            const unsigned tg = og / nx;
            if (og + 1u == (tg + 1u) * nx) xb_add(&bar[XB_TOPGEN], 1u);
            else XB_SPIN(xb_ld(&bar[XB_TOPGEN]) == tg, bar);
            __builtin_amdgcn_fence(__ATOMIC_ACQUIRE, "agent");
            xb_add(&bar[XB_XGEN(b.x)], 1u);
            asm volatile("s_waitcnt vmcnt(0)" ::: "memory");
        } else {
            XB_SPIN(xb_ld(&bar[XB_XGEN(b.x)]) == gen, bar);
            __builtin_amdgcn_fence(__ATOMIC_ACQUIRE, "agent");
            asm volatile("s_waitcnt vmcnt(0)" ::: "memory");
        }
    }
    __syncthreads();
}
#include <hip/hip_cooperative_groups.h>
namespace cg = cooperative_groups;
constexpr int BIG_LDS = 156 * 1024 + 256;
constexpr int LDS_CTL = 156 * 1024;
constexpr int DUP = 0;
struct PArgs { const float* in[20]; float* out; char* ws; };
__device__ __forceinline__ const PArgs* kargs() { auto kp = __builtin_amdgcn_kernarg_segment_ptr(); asm volatile("" : "+s"(kp)); return (const PArgs*)kp; }

__device__ __forceinline__ void phase0(const PArgs& p, unsigned char* shm) {
    int tid = threadIdx.x; asm volatile("" : "+v"(tid)); const int lane = tid & 63, wid = tid >> 6;
    const int gw = blockIdx.x * 8 + wid, NGW = gridDim.x * 8; const size_t gt = (size_t)blockIdx.x * 512 + tid, NTH = (size_t)gridDim.x * 512;
    char* ws = p.ws;
    { float* km = (float*)(ws + OFF_KMEAN); for (size_t i = gt; i < (size_t)16 * 8 * 16 * 64; i += NTH) km[i] = 0.f; }
    { float* rc = (float*)(ws + OFF_ROPE); float* rs = rc + 4096 * 8;
      for (size_t i = gt; i < 4096 * 8; i += NTH) { const int pos = (int)(i >> 3), k = (int)(i & 7); const float inv_freq = (float)pow(500000.0, -(double)(2 * k) / 16.0); const float ang = (float)pos * inv_freq;
          rc[i] = (float)cos((double)ang); rs[i] = (float)sin((double)ang); } }
    {
        const float* wdn = p.in[18]; const float* wup = p.in[19]; const float* fw = p.in[14]; unsigned* WU = (unsigned*)(ws + OFF_WU);
        { uint4* WDq = (uint4*)(ws + OFF_WD); float* SD = (float*)(ws + OFF_WD + 16 * MiB); float fv[16];
#pragma unroll
          for (int j = 0; j < 4; ++j) { const float4 s = *(const float4*)(fw + 16 * lane + 4 * j); fv[4 * j] = s.x; fv[4 * j + 1] = s.y; fv[4 * j + 2] = s.z; fv[4 * j + 3] = s.w; }
          for (int e = gw; e < 16384; e += NGW) { float v[16], am = 0.f;
#pragma unroll
              for (int j = 0; j < 4; ++j) { const float4 a = *(const float4*)(wdn + (size_t)e * 1024 + 16 * lane + 4 * j); v[4 * j] = a.x * fv[4 * j]; v[4 * j + 1] = a.y * fv[4 * j + 1]; v[4 * j + 2] = a.z * fv[4 * j + 2]; v[4 * j + 3] = a.w * fv[4 * j + 3]; }
              float ss = 0.f;
#pragma unroll
              for (int j = 0; j < 16; ++j) { am = fmaxf(am, fabsf(v[j])); ss += v[j] * v[j]; }
#pragma unroll
              for (int o = 32; o >= 1; o >>= 1) { am = fmaxf(am, __shfl_xor(am, o)); ss += __shfl_xor(ss, o); }
              const float step = fminf(am * (1.0f / 7.0f), 0.35f * sqrtf(ss * (1.0f / 1024.0f)));
              const float inv = step > 0.f ? 1.0f / step : 0.f; unsigned q[2] = {0u, 0u};
#pragma unroll
              for (int k = 0; k < 16; ++k) { const int qi = (int)fminf(fmaxf(rintf(v[k] * inv), -7.0f), 7.0f); q[k >> 3] |= (unsigned)(qi & 15) << (4 * (k & 7)); }
              ((uint2*)WDq)[(size_t)e * 64 + lane] = make_uint2(q[0], q[1]); if (lane == 0) SD[e] = step; } }
        { uint2* WU4 = (uint2*)WU; float* SU = (float*)(ws + OFF_WU + 16 * MiB);
          for (int e = gw; e < 16384; e += NGW) { float v[16], ss = 0.f;
#pragma unroll
              for (int j = 0; j < 4; ++j) { const float4 a = *(const float4*)(wup + (size_t)e * 1024 + 16 * lane + 4 * j); v[4 * j] = a.x; v[4 * j + 1] = a.y; v[4 * j + 2] = a.z; v[4 * j + 3] = a.w; }
#pragma unroll
              for (int j = 0; j < 16; ++j) ss += v[j] * v[j];
#pragma unroll
              for (int o = 32; o >= 1; o >>= 1) ss += __shfl_xor(ss, o);
              const float sc = 0.5f * sqrtf(ss * (1.0f / 1024.0f)), inv = sc > 0.f ? 1.0f / sc : 0.f; unsigned q[2] = {0u, 0u};
#pragma unroll
              for (int k = 0; k < 16; ++k) { const float a_ = fabsf(v[k]) * inv;
                  const unsigned code = (unsigned)(a_ > 0.25f) + (unsigned)(a_ > 0.75f) + (unsigned)(a_ > 1.25f) + (unsigned)(a_ > 1.75f) + (unsigned)(a_ > 2.5f) + (unsigned)(a_ > 3.5f) + (unsigned)(a_ > 5.0f);
                  q[k >> 3] |= (code | (v[k] < 0.f ? 8u : 0u)) << (4 * (k & 7)); }
              WU4[(size_t)e * 64 + lane] = make_uint2(q[0], q[1]); if (lane == 0) SU[e] = sc; } }
        const float* k1 = p.in[16]; const float* k2 = p.in[17]; bf16_t* K1 = (bf16_t*)(ws + OFF_KEY1); bf16_t* K2 = (bf16_t*)(ws + OFF_KEY2);
        for (size_t i = gt * 4; i < (size_t)8 * 128 * 128; i += NTH * 4) { const float4 a = *(const float4*)(k1 + i), b = *(const float4*)(k2 + i);
            *(uint2*)(K1 + i) = make_uint2(pk2(a.x, a.y), pk2(a.z, a.w)); *(uint2*)(K2 + i) = make_uint2(pk2(b.x, b.y), pk2(b.z, b.w)); }
    }
    {
        __attribute__((address_space(3))) float* tl = (__attribute__((address_space(3))) float*)(shm) + wid * (32 * 33);
        const int tx = lane & 31, ty = lane >> 5;
        for (int item = gw; item < 9728; item += NGW) {
            const float* W; const float* sc; bf16_t* O; int K, N, nbx, thr = 1 << 30, add = 0, it = item;
            if (it < 5632) { W = p.in[2]; sc = p.in[1]; O = (bf16_t*)(ws + OFF_WIN); K = 1024; N = INC; nbx = 176; thr = 3584; add = 8; }
            else if ((it -= 5632) < 512) { W = p.in[10]; sc = nullptr; O = (bf16_t*)(ws + OFF_WAB); K = 512; N = 1024; nbx = 32; }
            else if ((it -= 512) < 512) { W = p.in[11]; sc = nullptr; O = (bf16_t*)(ws + OFF_WMB); K = 512; N = 1024; nbx = 32; }
            else if ((it -= 512) < 1024) { W = p.in[13]; sc = nullptr; O = (bf16_t*)(ws + OFF_WOUT); K = 1024; N = 1024; nbx = 32; }
            else { it -= 1024; W = p.in[15]; sc = p.in[14]; O = (bf16_t*)(ws + OFF_WQ); K = 1024; N = 2048; nbx = 64; }
            const int n0 = (it % nbx) * 32, k0 = (it / nbx) * 32;
#pragma unroll 4
            for (int i = ty; i < 32; i += 2) { const int k = k0 + i, np = n0 + tx, ac = (np & ~255) + sigma_col(np & 255), src = ac + (ac >= thr ? add : 0); tl[i * 33 + tx] = W[(size_t)k * N + src] * (sc ? sc[k] : 1.0f); }
            asm volatile("s_waitcnt lgkmcnt(0)" ::: "memory");
#pragma unroll 4
            for (int i = ty; i < 32; i += 2) { const int np = n0 + i, k = k0 + tx; O[(size_t)np * K + k] = (bf16_t)f2bf(tl[tx * 33 + i]); }
            asm volatile("s_waitcnt lgkmcnt(0)" ::: "memory");
        }
    }
    {
        const float* x = p.in[0]; const float* normw = p.in[1]; const float* w_in = p.in[2]; const float* igb = p.in[7]; const float* fgb = p.in[8];
        bf16_t* xb = (bf16_t*)(ws + OFF_XB); float* r1 = (float*)(ws + OFF_R1); float* ifg = (float*)(ws + OFF_IFG);
        float wg[4][4][8];
#pragma unroll
        for (int j = 0; j < 4; ++j)
#pragma unroll
            for (int i = 0; i < 4; ++i) { const int k = 256 * j + 4 * lane + i; const float nw = normw[k];
#pragma unroll
                for (int c = 0; c < 8; ++c) wg[j][i][c] = w_in[(size_t)k * INC + 3584 + c] * nw; }
        typedef float p0_f32x4 __attribute__((ext_vector_type(4)));
        float bias_l = lane < 4 ? igb[lane & 3] : fgb[lane & 3];
        const unsigned xoff = (unsigned)lane * 16u;
        auto do_row = [&](const p0_f32x4 (&v)[4], const int row) {
            float ss = 0.f, g[8];
#pragma unroll
            for (int c = 0; c < 8; ++c) g[c] = 0.f;
#pragma unroll
            for (int j = 0; j < 4; ++j) {
                ss += v[j][0] * v[j][0] + v[j][1] * v[j][1] + v[j][2] * v[j][2] + v[j][3] * v[j][3];
#pragma unroll
                for (int c = 0; c < 8; ++c) g[c] += v[j][0] * wg[j][0][c] + v[j][1] * wg[j][1][c] + v[j][2] * wg[j][2][c] + v[j][3] * wg[j][3][c];
            }
#pragma unroll
            for (int o = 1; o < 64; o <<= 1) { ss += __shfl_xor(ss, o);
#pragma unroll
                for (int c = 0; c < 8; ++c) g[c] += __shfl_xor(g[c], o); }
            const float r = rsqrtf(ss * (1.0f / D_) + 1e-6f);
            { float gl = g[0];
#pragma unroll
              for (int c = 1; c < 8; ++c) gl = (lane == c) ? g[c] : gl;
              float* dst = lane < 8 ? ifg + (size_t)row * 8 + lane : r1 + row;
              if (lane < 9) *dst = lane < 8 ? gl * r + bias_l : r; }
            uint2* o8 = (uint2*)(xb + (size_t)row * D_) + lane;
#pragma unroll
            for (int j = 0; j < 4; ++j) o8[64 * j] = make_uint2(pk2(v[j][0], v[j][1]), pk2(v[j][2], v[j][3]));
        };
#define P0_LD(V, ROW) do { const float* rp_ = x + (size_t)(ROW) * D_; \
            asm volatile("global_load_dwordx4 %0, %4, %5\n\tglobal_load_dwordx4 %1, %4, %5 offset:1024\n\tglobal_load_dwordx4 %2, %4, %5 offset:2048\n\tglobal_load_dwordx4 %3, %4, %5 offset:3072" \
                         : "=&v"(V[0]), "=&v"(V[1]), "=&v"(V[2]), "=&v"(V[3]) : "v"(xoff), "s"(rp_) : "memory"); } while (0)
#define P0_WAIT(V) asm volatile("s_waitcnt vmcnt(8)" : "+v"(V[0]), "+v"(V[1]), "+v"(V[2]), "+v"(V[3]) :: "memory")
        const int gwu = __builtin_amdgcn_readfirstlane(gw);
        const int nrow = gwu < T_ ? (T_ - gwu + NGW - 1) / NGW : 0;
        if (nrow > 0) {
            p0_f32x4 va[4], vb[4], vc[4];
            const int rlast = gwu + (nrow - 1) * NGW;
#define P0_ROWOF(K) ((K) < nrow ? gwu + (K) * NGW : rlast)
            P0_LD(va, P0_ROWOF(0)); P0_LD(vb, P0_ROWOF(1));
#pragma unroll 1
            for (int k = 0; k < nrow; k += 3) {
                P0_LD(vc, P0_ROWOF(k + 2)); P0_WAIT(va); do_row(va, gwu + k * NGW);
                P0_LD(va, P0_ROWOF(k + 3)); P0_WAIT(vb); if (k + 1 < nrow) do_row(vb, gwu + (k + 1) * NGW);
                P0_LD(vb, P0_ROWOF(k + 4)); P0_WAIT(vc); if (k + 2 < nrow) do_row(vc, gwu + (k + 2) * NGW);
            }
            asm volatile("s_waitcnt vmcnt(0)" : "+v"(va[0]), "+v"(va[1]), "+v"(va[2]), "+v"(va[3]), "+v"(vb[0]), "+v"(vb[1]), "+v"(vb[2]), "+v"(vb[3]) :: "memory");
        }
    }
}
typedef float f32x2_t __attribute__((ext_vector_type(2)));
typedef unsigned p5_u32x4 __attribute__((ext_vector_type(4)));
#define P5_LAS __attribute__((address_space(3)))
#define P5_TIE8(R) "+v"(R[0]), "+v"(R[1]), "+v"(R[2]), "+v"(R[3]), "+v"(R[4]), "+v"(R[5]), "+v"(R[6]), "+v"(R[7])
#define P5_OUT(I, ACC) do { const uint4 a_ = *((const uint4*)(x1b + (tb + I) * 2048) + 2 * ln), c_ = *((const uint4*)(x1b + (tb + I) * 2048) + 2 * ln + 1); const unsigned w_[8] = {a_.x, a_.y, a_.z, a_.w, c_.x, c_.y, c_.z, c_.w}; \
        float4* o_ = (float4*)(out + (tb + I) * 1024 + 16 * ln); \
        _Pragma("unroll") for (int j_ = 0; j_ < 4; ++j_) o_[j_] = make_float4(__builtin_bit_cast(float, w_[2 * j_] << 16) + ACC[2 * j_].x, __builtin_bit_cast(float, w_[2 * j_] & 0xffff0000u) + ACC[2 * j_].y, \
                                                                             __builtin_bit_cast(float, w_[2 * j_ + 1] << 16) + ACC[2 * j_ + 1].x, __builtin_bit_cast(float, w_[2 * j_ + 1] & 0xffff0000u) + ACC[2 * j_ + 1].y); } while (0)
typedef unsigned p5_u32x2 __attribute__((ext_vector_type(2)));
#define P5_ROWFMA4(ACC, PRV, R, CF) do { p5_u32x2 r__ = R;   \
    asm volatile("" : "+v"(r__), "+v"(PRV[0]), "+v"(PRV[1]), "+v"(PRV[2]), "+v"(PRV[3]), "+v"(PRV[4]), "+v"(PRV[5]), "+v"(PRV[6]), "+v"(PRV[7])); \
    const f32x2_t cf2_ = {CF, CF}; \
    ACC[0] = __builtin_elementwise_fma((f32x2_t)__builtin_amdgcn_cvt_scalef32_pk_f32_fp4(r__.x, 1.0f, 0), cf2_, ACC[0]); ACC[1] = __builtin_elementwise_fma((f32x2_t)__builtin_amdgcn_cvt_scalef32_pk_f32_fp4(r__.x, 1.0f, 1), cf2_, ACC[1]); \
    ACC[2] = __builtin_elementwise_fma((f32x2_t)__builtin_amdgcn_cvt_scalef32_pk_f32_fp4(r__.x, 1.0f, 2), cf2_, ACC[2]); ACC[3] = __builtin_elementwise_fma((f32x2_t)__builtin_amdgcn_cvt_scalef32_pk_f32_fp4(r__.x, 1.0f, 3), cf2_, ACC[3]); \
    ACC[4] = __builtin_elementwise_fma((f32x2_t)__builtin_amdgcn_cvt_scalef32_pk_f32_fp4(r__.y, 1.0f, 0), cf2_, ACC[4]); ACC[5] = __builtin_elementwise_fma((f32x2_t)__builtin_amdgcn_cvt_scalef32_pk_f32_fp4(r__.y, 1.0f, 1), cf2_, ACC[5]); \
    ACC[6] = __builtin_elementwise_fma((f32x2_t)__builtin_amdgcn_cvt_scalef32_pk_f32_fp4(r__.y, 1.0f, 2), cf2_, ACC[6]); ACC[7] = __builtin_elementwise_fma((f32x2_t)__builtin_amdgcn_cvt_scalef32_pk_f32_fp4(r__.y, 1.0f, 3), cf2_, ACC[7]); } while (0)
#define P5_BFMA8U(R, CK) do { _Pragma("unroll") for (int j_ = 0; j_ < 8; j_ += 4) { \
    { const float cf_ = __builtin_bit_cast(float, __builtin_amdgcn_readlane(CK, j_));     P5_ROWFMA4(acc0, acc3, R[j_], cf_); } \
    { const float cf_ = __builtin_bit_cast(float, __builtin_amdgcn_readlane(CK, j_ + 1)); P5_ROWFMA4(acc1, acc0, R[j_ + 1], cf_); } \
    { const float cf_ = __builtin_bit_cast(float, __builtin_amdgcn_readlane(CK, j_ + 2)); P5_ROWFMA4(acc2, acc1, R[j_ + 2], cf_); } \
    { const float cf_ = __builtin_bit_cast(float, __builtin_amdgcn_readlane(CK, j_ + 3)); P5_ROWFMA4(acc3, acc2, R[j_ + 3], cf_); } } } while (0)
#define P5_ISSUE8U(R, B, CK) do { const int lk_ = keys[8 * (B) + (ln & 7)]; CK = __builtin_bit_cast(int, cfs[8 * (B) + (ln & 7)]); \
    _Pragma("unroll") for (int j_ = 0; j_ < 8; ++j_) { const unsigned char* rp_ = wu + (size_t)__builtin_amdgcn_readlane(lk_, j_) * 512; \
        asm volatile("global_load_dwordx2 %0, %1, %2" : "=v"(R[j_]) : "v"(voff8), "s"(rp_) : "memory"); } } while (0)
#define P5_DOT(R, XH, XL) __builtin_amdgcn_sdot8((int)R.y, (int)XL.y, __builtin_amdgcn_sdot8((int)R.x, (int)XL.x, 16 * __builtin_amdgcn_sdot8((int)R.y, (int)XH.y, __builtin_amdgcn_sdot8((int)R.x, (int)XH.x, 0, false), false), false), false)
#define P5_ISSUE8D(R, B) do { const int lk_ = keys[8 * (B) + (ln & 7)]; \
    _Pragma("unroll") for (int j_ = 0; j_ < 8; ++j_) { const unsigned char* rp_ = wd + (size_t)__builtin_amdgcn_readlane(lk_, j_) * 512; \
        asm volatile("global_load_dwordx2 %0, %1, %2" : "=v"(R[j_]) : "v"(voff8), "s"(rp_) : "memory"); } } while (0)
#define P5_DOWN8(R, BB) do { int pd_[8]; \
    _Pragma("unroll") for (int j_ = 0; j_ < 8; j_ += 4) { pd_[j_] = P5_DOT(R[j_], xh0, xl0); pd_[j_ + 1] = P5_DOT(R[j_ + 1], xh1, xl1); pd_[j_ + 2] = P5_DOT(R[j_ + 2], xh2, xl2); pd_[j_ + 3] = P5_DOT(R[j_ + 3], xh3, xl3); } \
    _Pragma("unroll") for (int i_ = 0; i_ < 4; ++i_) { const auto r_ = __builtin_amdgcn_permlane32_swap((unsigned)pd_[i_], (unsigned)pd_[i_ + 4], false, false); pd_[i_] = (int)(r_[0] + r_[1]); } \
    _Pragma("unroll") for (int i_ = 0; i_ < 2; ++i_) { const auto r_ = __builtin_amdgcn_permlane16_swap((unsigned)pd_[i_], (unsigned)pd_[i_ + 2], false, false); pd_[i_] = (int)(r_[0] + r_[1]); } \
    { const bool b8_ = (ln & 8) != 0; const int keep_ = b8_ ? pd_[1] : pd_[0], send_ = b8_ ? pd_[0] : pd_[1]; int z_ = keep_ + __builtin_amdgcn_update_dpp(0, send_, 0x140, 0xf, 0xf, false); \
      z_ += __builtin_amdgcn_update_dpp(0, z_, 0x141, 0xf, 0xf, false); z_ += __builtin_amdgcn_update_dpp(0, z_, 0xB1, 0xf, 0xf, false); z_ += __builtin_amdgcn_update_dpp(0, z_, 0x4E, 0xf, 0xf, false); \
      zz = (ln & 7) == ((BB) & 7) ? z_ : zz; } \
    if (((BB) & 7) == 7) { const int pos_ = 8 * ((BB) - 7) + 8 * (ln & 7) + (ln >> 3); const int e_ = keys[pos_]; const float g_ = cfs[pos_]; const int tk_ = (ln >> 3) & 3; \
        const float sx_ = tk_ == 0 ? sx0 : tk_ == 1 ? sx1 : tk_ == 2 ? sx2 : sx3; const float av_ = (float)zz * sx_ * (float)sdl[e_]; \
        cfs[pos_] = g_ * 0.5f * av_ * (1.0f + erff(av_ * 0.70710678118654752f)) * (float)sul[e_]; } } while (0)
__device__ __forceinline__ void phase5_all(const PArgs& p, float* out, unsigned char* shm) {
    int tid = threadIdx.x; asm volatile("" : "+v"(tid)); const int wid = __builtin_amdgcn_readfirstlane(tid >> 6);
    const char* x1b = (const char*)(p.ws + OFF_MV); const char* eidx = (const char*)(p.ws + OFF_EIDX); const char* egp = (const char*)(p.ws + OFF_EG); const float* r2 = (const float*)(p.ws + OFF_R2);
    const unsigned char* wd = (const unsigned char*)(p.ws + OFF_WD); const unsigned char* wu = (const unsigned char*)(p.ws + OFF_WU); const float* SD = (const float*)(p.ws + OFF_WD + 16 * MiB); const float* SU = (const float*)(p.ws + OFF_WU + 16 * MiB);
    P5_LAS _Float16* sdl = (P5_LAS _Float16*)shm; P5_LAS _Float16* sul = sdl + 16384;
    P5_LAS int* keys = (P5_LAS int*)(shm + 65536 + wid * 4608); P5_LAS float* cfs = (P5_LAS float*)(keys + 512); P5_LAS int* cntl = (P5_LAS int*)(keys + 1024);
    const int rot = 4 * ((int)blockIdx.x & 7);
    for (int i = tid; i < 16384; i += 512) { sdl[i] = (_Float16)SD[i]; sul[i] = (_Float16)SU[i]; }
    __syncthreads();
    const int G = (int)gridDim.x, NR = (T_ / 32 + G - 1 - (int)blockIdx.x) / G;
#pragma unroll 1
    for (int rnd = 0; rnd < NR; ++rnd) {
        int ln = tid; asm volatile("" : "+v"(ln)); ln &= 63; const unsigned voff = (unsigned)ln * 16u, voff4 = (unsigned)ln * 4u, voff8 = (unsigned)ln * 8u;
        const size_t tb = ((size_t)(rnd * G + (int)blockIdx.x) * 8 + wid) * 4;
        int ev[4][2], cv[4][2];
#pragma unroll
        for (int i_ = 0; i_ < 4; ++i_) { const char* ep_ = eidx + (tb + i_) * 512; const char* cp_ = egp + (tb + i_) * 512;
            asm volatile("global_load_dword %0, %4, %5\n\tglobal_load_dword %1, %4, %5 offset:256\n\tglobal_load_dword %2, %4, %6\n\tglobal_load_dword %3, %4, %6 offset:256"
                         : "=&v"(ev[i_][0]), "=&v"(ev[i_][1]), "=&v"(cv[i_][0]), "=&v"(cv[i_][1]) : "v"(voff4), "s"(ep_), "s"(cp_) : "memory"); }
        p5_u32x2 xh0, xh1, xh2, xh3, xl0, xl1, xl2, xl3; float sx0, sx1, sx2, sx3;
#define P5_QUANT(I, XH, XL, SX) do { const uint4 a_ = *((const uint4*)(x1b + (tb + I) * 2048) + 2 * ln), c_ = *((const uint4*)(x1b + (tb + I) * 2048) + 2 * ln + 1); \
        const unsigned w_[8] = {a_.x, a_.y, a_.z, a_.w, c_.x, c_.y, c_.z, c_.w}; float xv_[16], am_ = 0.f; \
        _Pragma("unroll") for (int k_ = 0; k_ < 8; ++k_) { xv_[2 * k_] = __builtin_bit_cast(float, w_[k_] << 16); xv_[2 * k_ + 1] = __builtin_bit_cast(float, w_[k_] & 0xffff0000u); am_ = fmaxf(am_, fmaxf(fabsf(xv_[2 * k_]), fabsf(xv_[2 * k_ + 1]))); } \
        _Pragma("unroll") for (int o_ = 32; o_ >= 1; o_ >>= 1) am_ = fmaxf(am_, __builtin_bit_cast(float, __builtin_amdgcn_ds_bpermute(4 * (ln ^ o_), __builtin_bit_cast(int, am_)))); \
        const float inv_ = am_ > 0.f ? 119.0f / am_ : 0.f; unsigned h_[2] = {0u, 0u}, l_[2] = {0u, 0u}; \
        _Pragma("unroll") for (int k_ = 0; k_ < 16; ++k_) { const int q_ = (int)rintf(xv_[k_] * inv_); const int lo_ = ((q_ + 8) & 15) - 8, hi_ = (q_ - lo_) >> 4;     \
            h_[k_ >> 3] |= (unsigned)(hi_ & 15) << (4 * (k_ & 7)); l_[k_ >> 3] |= (unsigned)(lo_ & 15) << (4 * (k_ & 7)); } \
        XH = p5_u32x2{h_[0], h_[1]}; XL = p5_u32x2{l_[0], l_[1]}; SX = am_ * (1.0f / 119.0f) * r2[tb + I]; } while (0)
        P5_QUANT(0, xh0, xl0, sx0); P5_QUANT(1, xh1, xl1, sx1); P5_QUANT(2, xh2, xl2, sx2); P5_QUANT(3, xh3, xl3, sx3);
        asm volatile("s_waitcnt vmcnt(0)" : "+v"(ev[0][0]), "+v"(ev[0][1]), "+v"(ev[1][0]), "+v"(ev[1][1]), "+v"(ev[2][0]), "+v"(ev[2][1]), "+v"(ev[3][0]), "+v"(ev[3][1]) :: "memory");
        asm volatile("" : "+v"(cv[0][0]), "+v"(cv[0][1]), "+v"(cv[1][0]), "+v"(cv[1][1]), "+v"(cv[2][0]), "+v"(cv[2][1]), "+v"(cv[3][0]), "+v"(cv[3][1]));
        cntl[ln] = 0; cntl[64 + ln] = 0;
        int bk[4][2];
#pragma unroll
        for (int i = 0; i < 4; ++i)
#pragma unroll
            for (int ps = 0; ps < 2; ++ps) { bk[i][ps] = 32 * i + ((((ev[i][ps] & 16383) >> 9) - rot) & 31); (void)__hip_atomic_fetch_add(cntl + bk[i][ps], 1, __ATOMIC_RELAXED, __HIP_MEMORY_SCOPE_WORKGROUP); }
#pragma unroll
        for (int hh = 0; hh < 2; ++hh) { const int c_ = cntl[64 * hh + ln]; int inc = c_;
#pragma unroll
          for (int o = 1; o < 32; o <<= 1) { const int u_ = __builtin_amdgcn_ds_bpermute(4 * (ln - o), inc); if ((ln & 31) >= o) inc += u_; }
          cntl[64 * hh + ln] = inc - c_; }
#pragma unroll
        for (int i = 0; i < 4; ++i)
#pragma unroll
            for (int ps = 0; ps < 2; ++ps) { const int pos = 4 * __hip_atomic_fetch_add(cntl + bk[i][ps], 1, __ATOMIC_RELAXED, __HIP_MEMORY_SCOPE_WORKGROUP) + i;
                keys[pos] = ev[i][ps] & 16383; cfs[pos] = __builtin_bit_cast(float, cv[i][ps]); }
        int dx, dl, dm;
        { const int rn = rnd + 1 < NR ? rnd + 1 : rnd; const size_t tn = ((size_t)(rn * G + (int)blockIdx.x) * 8 + wid) * 4;
          const char* pe = eidx + tn * 512; const char* pc = egp + tn * 512; const char* px = x1b + tn * 2048;
          asm volatile("global_load_dword %0, %3, %5\n\tglobal_load_dword %1, %4, %6\n\tglobal_load_dword %2, %4, %7" : "=&v"(dx), "=&v"(dl), "=&v"(dm) : "v"(ln * 128), "v"((ln & 15) * 128), "s"(px), "s"(pe), "s"(pc) : "memory"); }
        p5_u32x2 ua[8], ub[8], uc[8]; int cka, ckb, ckc;
        {
            int zz = 0;
            p5_u32x2 da[8], db[8], dc[8];
            P5_ISSUE8D(da, 0); P5_ISSUE8D(db, 1); P5_ISSUE8D(dc, 2);
#pragma unroll 1
            for (int b = 0; b < 60; b += 3) {
                asm volatile("s_waitcnt vmcnt(16)" : P5_TIE8(da) :: "memory"); P5_DOWN8(da, b); P5_ISSUE8D(da, b + 3);
                asm volatile("s_waitcnt vmcnt(16)" : P5_TIE8(db) :: "memory"); P5_DOWN8(db, b + 1); P5_ISSUE8D(db, b + 4);
                asm volatile("s_waitcnt vmcnt(16)" : P5_TIE8(dc) :: "memory"); P5_DOWN8(dc, b + 2); P5_ISSUE8D(dc, b + 5);
            }
            asm volatile("s_waitcnt vmcnt(16)" : P5_TIE8(da) :: "memory"); P5_DOWN8(da, 60); P5_ISSUE8D(da, 63);
            P5_ISSUE8U(ua, 0, cka); P5_ISSUE8U(ub, 1, ckb); P5_ISSUE8U(uc, 2, ckc);
            asm volatile("s_waitcnt vmcnt(40)" : P5_TIE8(db) :: "memory"); P5_DOWN8(db, 61);
            asm volatile("s_waitcnt vmcnt(32)" : P5_TIE8(dc) :: "memory"); P5_DOWN8(dc, 62);
            asm volatile("s_waitcnt vmcnt(24)" : P5_TIE8(da) :: "memory"); P5_DOWN8(da, 63);
            asm volatile("" : "+v"(dx), "+v"(dl), "+v"(dm));
        }
        f32x2_t acc0[8], acc1[8], acc2[8], acc3[8];
#pragma unroll
        for (int i = 0; i < 8; ++i) { acc0[i] = (f32x2_t){0.f, 0.f}; acc1[i] = acc0[i]; acc2[i] = acc0[i]; acc3[i] = acc0[i]; }
#pragma unroll 1
        for (int b = 0; b < 60; b += 3) {
            asm volatile("s_waitcnt vmcnt(16)" : P5_TIE8(ua) :: "memory"); P5_BFMA8U(ua, cka); P5_ISSUE8U(ua, b + 3, cka);
            asm volatile("s_waitcnt vmcnt(16)" : P5_TIE8(ub) :: "memory"); P5_BFMA8U(ub, ckb); P5_ISSUE8U(ub, b + 4, ckb);
            asm volatile("s_waitcnt vmcnt(16)" : P5_TIE8(uc) :: "memory"); P5_BFMA8U(uc, ckc); P5_ISSUE8U(uc, b + 5, ckc);
        }
        asm volatile("s_waitcnt vmcnt(16)" : P5_TIE8(ua) :: "memory"); P5_BFMA8U(ua, cka); P5_ISSUE8U(ua, 63, cka);
        asm volatile("s_waitcnt vmcnt(16)" : P5_TIE8(ub) :: "memory"); P5_BFMA8U(ub, ckb);
        asm volatile("s_waitcnt vmcnt(8)" : P5_TIE8(uc) :: "memory"); P5_BFMA8U(uc, ckc);
        asm volatile("s_waitcnt vmcnt(0)" : P5_TIE8(ua) :: "memory"); P5_BFMA8U(ua, cka);
        P5_OUT(0, acc0); P5_OUT(1, acc1); P5_OUT(2, acc2); P5_OUT(3, acc3);
    }
}

__global__ __launch_bounds__(512, 2) void k_mega(PArgs p_unused) {
    extern __shared__ __attribute__((aligned(16))) unsigned char shm[];
    cg::grid_group grid = cg::this_grid();
    PG8_LAS unsigned char* lds = (PG8_LAS unsigned char*)shm;
    volatile __attribute__((address_space(3))) unsigned* lctl = (volatile __attribute__((address_space(3))) unsigned*)(lds + LDS_CTL);
    if (threadIdx.x < 64) lctl[threadIdx.x] = 0u;
    __syncthreads();
    const XcdBarrier xbar = xcd_barrier_post((unsigned*)(kargs()->ws + OFF_CTL), lctl);
    for (int rep_ = 0; rep_ < (DUP == 10 ? 2 : 1); ++rep_) { const PArgs p = *kargs(); phase0(p, shm); if (DUP == 10) grid.sync(); }
    grid.sync();
    for (int rep_ = 0; rep_ < (DUP == 1 ? 2 : 1); ++rep_) {
        const PArgs& p = *kargs();
        pg8::SchedGrid S; S.init(p.ws + OFF_XB, p.ws + OFF_WIN, nullptr, nullptr, T_, 5632, 1024, 1, (int)gridDim.x, (int)blockIdx.x);
        pg8::EpiInProj E; E.r1 = (const float*)(p.ws + OFF_R1); E.qnw = p.in[3]; E.knw = p.in[4]; E.ropec = (const float*)(p.ws + OFF_ROPE); E.ropes = E.ropec + 4096 * 8; E.merge_b = p.in[12]; E.ws = p.ws; E.kmean = (float*)(p.ws + OFF_KMEAN); E.skip_km = rep_;
        pg8::gemm_phase<pg8::EpiInProj, pg8::SchedGrid, true, true>(lds, 1024, S, E);
        if (DUP == 1) grid.sync();
    }
    xcd_barrier(xbar);
    {
        const PArgs& p = *kargs();
        const attn_body::AttnTensors AT{(const attn_body::bf16*)(p.ws + OFF_Q), (const attn_body::bf16*)(p.ws + OFF_K), (const attn_body::bf16*)(p.ws + OFF_V), (attn_body::bf16*)(p.ws + OFF_XB), (const float*)(p.ws + OFF_KMEAN)};
        mlstm::Args A; A.mq = (const bf16_t*)(p.ws + OFF_MQ); A.mk = (const bf16_t*)(p.ws + OFF_MK); A.mv = (const bf16_t*)(p.ws + OFF_MV); A.mosig = (const bf16_t*)(p.ws + OFF_MO);
        A.ifg = (const float*)(p.ws + OFF_IFG); A.conv_w = p.in[5]; A.conv_b = p.in[6]; A.nw = p.in[9]; A.sca = (float*)(p.ws + OFF_SCA); A.scm = (float*)(p.ws + OFF_SCM); A.scb = (float*)(p.ws + OFF_SCB);
        A.hm = (bf16_t*)(p.ws + OFF_XB + 64 * MiB);
        for (int rep_ = 0; rep_ < (DUP == 3 ? 2 : 1); ++rep_) for (int u = blockIdx.x; u < 64; u += gridDim.x) mlstm::unit(u >> 2, u & 3, A, (ML_LAS unsigned char*)shm);
        attn_body::QueueOrder S; S.ctr = (unsigned*)(p.ws + OFF_CTL) + 8192; S.slot = lctl + 16;
        attn_body::attn_phase<attn_body::QueueOrder>((char*)shm, AT, S);
    }
    xcd_barrier(xbar);
    for (int rep_ = 0; rep_ < (DUP == 4 ? 2 : 1); ++rep_) {
        const PArgs& p = *kargs();
        pg8::SchedGrid S; S.init(p.ws + OFF_XB, p.ws + OFF_WAB, p.ws + OFF_XB + 64 * MiB, p.ws + OFF_WMB, T_, 1024, 512, 2, (int)gridDim.x, (int)blockIdx.x);
        pg8::EpiBranch E; E.ga = (const bf16_t*)(p.ws + OFF_GA); E.gm = (const bf16_t*)(p.ws + OFF_GM); E.y = (bf16_t*)(p.ws + OFF_MQ);
        pg8::gemm_phase<pg8::EpiBranch, pg8::SchedGrid, true, true>(lds, 512, S, E);
        if (DUP == 4) grid.sync();
    }
    xcd_barrier(xbar);
    for (int rep_ = 0; rep_ < (DUP == 5 ? 2 : 1); ++rep_) {
        const PArgs& p = *kargs();
        pg8::SchedGrid S; S.init(p.ws + OFF_MQ, p.ws + OFF_WOUT, nullptr, nullptr, T_, 1024, 1024, 1, (int)gridDim.x, (int)blockIdx.x);
        pg8::EpiOut E; E.x = p.in[0]; E.out = p.out; E.x1b = (bf16_t*)(p.ws + OFF_MV); E.rowss = (float*)(p.ws + OFF_ROWSS);
        pg8::gemm_phase<pg8::EpiOut, pg8::SchedGrid, true, true>(lds, 1024, S, E);
        if (DUP == 5) grid.sync();
    }
    xcd_barrier(xbar);
    for (int rep_ = 0; rep_ < (DUP == 6 ? 2 : 1); ++rep_) {
        const PArgs& p = *kargs();
        peer::Args A; A.rowss = (const float*)(p.ws + OFF_ROWSS); A.key1 = (const bf16_t*)(p.ws + OFF_KEY1); A.key2 = (const bf16_t*)(p.ws + OFF_KEY2); A.r2out = (float*)(p.ws + OFF_R2);
        A.eidx = (int*)(p.ws + OFF_EIDX); A.eg = (float*)(p.ws + OFF_EG);
        for (int u = blockIdx.x; u < 2048; u += gridDim.x) peer::unit(u >> 3, u & 7, (const bf16_t*)(p.ws + OFF_MV), (const bf16_t*)(p.ws + OFF_WQ), A, lds);
    }
    xcd_barrier(xbar);
    { const PArgs& p = *kargs(); phase5_all(p, p.out, shm); }
}

extern "C" void kernel_launch(void* const* d_in, const int* in_sizes, int n_in, void* d_out, int out_size, void* d_ws, size_t ws_size, hipStream_t stream) {
    static int grid_blocks = 0;
    if (!grid_blocks) {
        if (n_in != 20 || in_sizes[0] != T_ * D_ || out_size != T_ * D_ || ws_size < WS_NEED) { fprintf(stderr, "kernel_launch: unexpected shapes n_in %d in0 %d out %d ws %zu\n", n_in, n_in > 0 ? in_sizes[0] : -1, out_size, ws_size); grid_blocks = -1; return; }
        if (hipFuncSetAttribute((const void*)k_mega, hipFuncAttributeMaxDynamicSharedMemorySize, BIG_LDS) != hipSuccess) { fprintf(stderr, "hipFuncSetAttribute failed\n"); grid_blocks = -1; return; }
        int dev = 0, cus = 0, per_cu = 0;
        hipGetDevice(&dev); hipDeviceGetAttribute(&cus, hipDeviceAttributeMultiprocessorCount, dev);
        hipOccupancyMaxActiveBlocksPerMultiprocessor(&per_cu, (const void*)k_mega, 512, BIG_LDS);
        if (per_cu < 1) { fprintf(stderr, "kernel_launch: occupancy query reports %d blocks per CU\n", per_cu); per_cu = 1; }
        grid_blocks = cus;
        if (grid_blocks != 256) fprintf(stderr, "kernel_launch: %d CUs (expected 256)\n", grid_blocks);
    }
    if (grid_blocks < 0) return;
    PArgs pa{}; for (int i = 0; i < 20; ++i) pa.in[i] = (const float*)d_in[i]; pa.out = (float*)d_out; pa.ws = (char*)d_ws;
    hipMemsetAsync((char*)d_ws + OFF_CTL, 0, CTL_BYTES, stream);
    void* args[] = {&pa};
    hipError_t e = hipLaunchCooperativeKernel((void*)k_mega, dim3(grid_blocks), dim3(512), args, BIG_LDS, stream);
    if (e != hipSuccess) fprintf(stderr, "cooperative launch failed: %s (grid %d)\n", hipGetErrorString(e), grid_blocks);
}
```

```cpp
#include <hip/hip_runtime.h>
#include <cstdio>
#include <cstdint>
#include <cmath>
typedef unsigned short bf16_t;
constexpr int T_ = 65536, D_ = 1024, B_ = 16, S_ = 4096;
constexpr int INC = 5640;
constexpr size_t MiB = 1ull << 20;
constexpr size_t OFF_XB = 0;
constexpr size_t OFF_Q = 128 * MiB, OFF_K = 192 * MiB, OFF_V = 256 * MiB;
constexpr size_t OFF_MQ = 320 * MiB, OFF_MK = 384 * MiB, OFF_MV = 448 * MiB, OFF_MO = 512 * MiB;
constexpr size_t OFF_GA = 576 * MiB, OFF_GM = 704 * MiB;
constexpr size_t OFF_W = 832 * MiB;
constexpr size_t OFF_WIN = OFF_W;
constexpr size_t OFF_WAB = OFF_WIN + (size_t)5632 * 1024 * 2;
constexpr size_t OFF_WMB = OFF_WAB + (size_t)1024 * 512 * 2;
constexpr size_t OFF_WOUT = OFF_WMB + (size_t)1024 * 512 * 2;
constexpr size_t OFF_WQ = OFF_WOUT + (size_t)1024 * 1024 * 2;
constexpr size_t OFF_KEY1 = OFF_WQ + (size_t)2048 * 1024 * 2;
constexpr size_t OFF_KEY2 = OFF_KEY1 + (size_t)8 * 128 * 128 * 2;
constexpr size_t OFF_WD = OFF_KEY2 + (size_t)8 * 128 * 128 * 2;
constexpr size_t OFF_WU = OFF_WD + (size_t)16384 * 1024 * 2;
constexpr size_t OFF_WEND = OFF_WU + (size_t)16384 * 1024 * 2;
constexpr size_t OFF_MISC = 920 * MiB;
static_assert(OFF_WEND <= OFF_MISC, "weights overflow");
constexpr size_t OFF_R1 = OFF_MISC;
constexpr size_t OFF_R2 = OFF_R1 + (size_t)T_ * 4;
constexpr size_t OFF_IFG = OFF_R2 + (size_t)T_ * 4;
constexpr size_t OFF_KMEAN = OFF_IFG + (size_t)T_ * 8 * 4;
constexpr size_t OFF_ROPE = OFF_KMEAN + (size_t)16 * 8 * 16 * 64 * 4;
constexpr size_t OFF_SCA = OFF_ROPE + (size_t)2 * 4096 * 8 * 4;
constexpr size_t OFF_SCM = OFF_SCA + (size_t)16 * 4 * 4096 * 4;
constexpr size_t OFF_SCB = OFF_SCM + (size_t)16 * 4 * 4096 * 4;
constexpr size_t OFF_CTL = 926 * MiB + 512 * 1024, CTL_BYTES = 64 * 1024;
constexpr size_t OFF_ROWSS = 927 * MiB;
constexpr size_t OFF_EIDX = 932 * MiB;
constexpr size_t OFF_EG = 964 * MiB;
constexpr size_t WS_NEED = 996 * MiB;
static_assert(OFF_SCB + (size_t)16 * 4 * 4096 * 4 <= OFF_CTL && OFF_CTL + CTL_BYTES <= OFF_ROWSS, "misc overflow");

__device__ __forceinline__ unsigned f2bf(float f) { unsigned u = __builtin_bit_cast(unsigned, f); return (u + 0x7fffu + ((u >> 16) & 1u)) >> 16; }
__device__ __forceinline__ float bf2f(unsigned short b) { return __builtin_bit_cast(float, ((unsigned)b) << 16); }
__device__ __forceinline__ unsigned pk2(float lo, float hi) { return f2bf(lo) | (f2bf(hi) << 16); }
__device__ __forceinline__ float sigmoidf_(float v) { return 1.0f / (1.0f + __expf(-v)); }
namespace pg8 {
#define PG8_LAS __attribute__((address_space(3)))
typedef unsigned short bf16_t;
typedef short bf16x8 __attribute__((ext_vector_type(8)));
typedef float f32x4 __attribute__((ext_vector_type(4)));
typedef unsigned u32x4 __attribute__((ext_vector_type(4)));
constexpr int BM = 256, BK = 64, HALF = 128, HTB = HALF * BK * 2  , STAGE_BYTES = 8 * HTB, NXCD = 8, WGM = 4;

__host__ __device__ __forceinline__ int lds_byte(int r, int c) { const int st = (r >> 4) * 2 + (c >> 5), rr = r & 15, cc = c & 31, ob = rr * 64 + cc * 2; return st * 1024 + (ob ^ (((ob >> 9) & 1) << 5)); }
__host__ __device__ __forceinline__ void stage_rc(int b, int& R, int& C) { const int st = b / 1024, sb = b % 1024, swz = sb ^ (((sb >> 9) & 1) << 5); R = (st >> 1) * 16 + swz / 64; C = (st & 1) * 32 + (swz % 64) / 2; }
__host__ __device__ __forceinline__ int perm32(int rho) { const int n = rho >> 4, i = rho & 15; return 8 * (i >> 2) + 4 * n + (i & 3); }

struct Unit { int pm, pn, seg, pad; const char* A; const char* B; };

__device__ __forceinline__ unsigned cvt_pk_bf16(float lo, float hi) { unsigned r; asm volatile("v_cvt_pk_bf16_f32 %0, %1, %2" : "=v"(r) : "v"(lo), "v"(hi)); return r; }
typedef float f32x2 __attribute__((ext_vector_type(2)));
__device__ __forceinline__ f32x2 gelu_pk(f32x2 v) {
    const f32x2 av = __builtin_elementwise_abs(v), d = av * 0.2316418882f + 1.0f;
    f32x2 t; t.x = __builtin_amdgcn_rcpf(d.x); t.y = __builtin_amdgcn_rcpf(d.y);
    f32x2 q = t * 0.5307027145f + (-0.7265760135f); q = q * t + 0.7107068705f; q = q * t + (-0.142248368f); q = q * t + 0.127414796f; q = q * t;
    const f32x2 s = (v * v) * (-0.72134752044f);
    f32x2 e; e.x = __builtin_amdgcn_exp2f(s.x); e.y = __builtin_amdgcn_exp2f(s.y);
    const f32x2 m = v * (q * e), r = v - m;
    f32x2 o; o.x = v.x < 0.f ? m.x : r.x; o.y = v.y < 0.f ? m.y : r.y; return o;
}

template <class Epi, class Sched, bool ALIGN_EPI = false, bool SP2 = false>
__device__ __forceinline__ void gemm_phase(PG8_LAS unsigned char* lds, const int K, const Sched& S, const Epi& E) {
    int tid = threadIdx.x; asm volatile("" : "+v"(tid));
    const int wid = __builtin_amdgcn_readfirstlane(tid >> 6), lane = tid & 63, wr = wid >> 2, wc = wid & 3, fr = lane & 15, fq = lane >> 4;
    const int nt = K / BK;
    unsigned voffA[2], voffB[2];
#pragma unroll
    for (int i = 0; i < 2; ++i) { int R, C; stage_rc(tid * 16 + i * 8192, R, C); const int Rb = Epi::PERM ? ((R & ~31) + perm32(R & 31)) : R;
        voffA[i] = (unsigned)(R * K + C) * 2u; voffB[i] = (unsigned)(Rb * K + C) * 2u; }
    const size_t kstep = (size_t)(BK * 2);
    const size_t hstep = (size_t)HALF * K * 2;
        const unsigned ldsw = (unsigned)wid * 1024u;
    const int aoff = lds_byte(wr * 64 + fr, fq * 8), boff = lds_byte(wc * 32 + fr, fq * 8);
#define PG8_SA(b, h) (((b) * 2 + (h)) * HTB)
#define PG8_SB(b, h) ((4 + (b) * 2 + (h)) * HTB)
#define PG8_STAGE(bufoff, gbase, voff) do { _Pragma("unroll") for (int _i = 0; _i < 2; ++_i) \
        __builtin_amdgcn_global_load_lds((const unsigned*)((const char*)(gbase) + (voff)[_i]), (PG8_LAS unsigned*)(lds + (bufoff) + ldsw + _i * 8192), 16, 0, 0); } while (0)
#define PG8_LDA(dst, b, h) do { _Pragma("unroll") for (int m = 0; m < 4; ++m) _Pragma("unroll") for (int k = 0; k < 2; ++k) dst[m][k] = *(const PG8_LAS bf16x8*)(lds + PG8_SA(b, h) + aoff + m * 2048 + k * 1024); } while (0)
#define PG8_LDB(dst, b, h) do { _Pragma("unroll") for (int n = 0; n < 2; ++n) _Pragma("unroll") for (int k = 0; k < 2; ++k) dst[n][k] = *(const PG8_LAS bf16x8*)(lds + PG8_SB(b, h) + boff + n * 2048 + k * 1024); } while (0)
#define PG8_MMA(ai, bj, At, Bt) do { __builtin_amdgcn_s_setprio(1); _Pragma("unroll") for (int m = 0; m < 4; ++m) _Pragma("unroll") for (int n = 0; n < 2; ++n) _Pragma("unroll") for (int k = 0; k < 2; ++k) \
        acc[ai][bj][m][n] = __builtin_amdgcn_mfma_f32_16x16x32_bf16(Bt[n][k], At[m][k], acc[ai][bj][m][n], 0, 0, 0); __builtin_amdgcn_s_setprio(0); } while (0)
#define PG8_WAIT_V(n) asm volatile("s_waitcnt vmcnt(" #n ")" ::: "memory")
#define PG8_WAIT_L(n) asm volatile("s_waitcnt lgkmcnt(" #n ")" ::: "memory")
#define PG8_BAR __builtin_amdgcn_s_barrier()
#define PG8_SCHED __builtin_amdgcn_sched_barrier(0)
    Unit cur, nxt; int ui = 0;
    if (!S.next(0, cur)) return;
    f32x4 acc[2][2][4][2];
#pragma unroll
    for (int a = 0; a < 2; ++a)
#pragma unroll
        for (int b = 0; b < 2; ++b)
#pragma unroll
            for (int m = 0; m < 4; ++m)
#pragma unroll
                for (int n = 0; n < 2; ++n) acc[a][b][m][n] = (f32x4){0.f, 0.f, 0.f, 0.f};
    bf16x8 At[4][2], B0[2][2], B1[2][2];
    const char* cA = cur.A; const char* cB = cur.B;
    S.a_ready(cur);
    if constexpr (SP2) {
        PG8_STAGE(PG8_SB(0, 0), cB, voffB); PG8_STAGE(PG8_SB(0, 1), cB + hstep, voffB); PG8_STAGE(PG8_SA(0, 0), cA, voffA); PG8_STAGE(PG8_SA(0, 1), cA + hstep, voffA);
        if (wr == 1) PG8_BAR;
        PG8_WAIT_V(2); PG8_BAR;
        PG8_STAGE(PG8_SB(1, 0), cB + kstep, voffB); PG8_STAGE(PG8_SA(1, 0), cA + kstep, voffA); PG8_STAGE(PG8_SB(1, 1), cB + hstep + kstep, voffB);
        PG8_WAIT_V(6); PG8_BAR;
    } else {
        PG8_STAGE(PG8_SB(0, 0), cB, voffB); PG8_STAGE(PG8_SA(0, 0), cA, voffA); PG8_STAGE(PG8_SB(0, 1), cB + hstep, voffB); PG8_STAGE(PG8_SA(0, 1), cA + hstep, voffA);
        if (wr == 1) PG8_BAR;
        PG8_WAIT_V(4); PG8_BAR;
        PG8_STAGE(PG8_SB(1, 0), cB + kstep, voffB); PG8_STAGE(PG8_SA(1, 0), cA + kstep, voffA); PG8_STAGE(PG8_SB(1, 1), cB + hstep + kstep, voffB);
        PG8_WAIT_V(6); PG8_BAR;
    }
    for (;;) {
        const bool has_next = S.next(ui + 1, nxt);
        const char* nA = has_next ? nxt.A : cA; const char* nB = has_next ? nxt.B : cB;
        for (int t = 0; t < nt; t += 2) {
            const bool last = (t == nt - 2);
            const char* a1 = cA + (size_t)(t + 1) * kstep;
            const char* a2 = last ? nA : cA + (size_t)(t + 2) * kstep; const char* b2 = last ? nB : cB + (size_t)(t + 2) * kstep;
            const char* a3 = a2 + kstep; const char* b3 = b2 + kstep;
            if (last && has_next) S.a_ready(nxt);
            if constexpr (SP2) {
            PG8_LDB(B0, 0, 0); PG8_LDB(B1, 0, 1); PG8_SCHED; PG8_LDA(At, 0, 0); PG8_STAGE(PG8_SA(1, 1), a1 + hstep, voffA);
            PG8_WAIT_V(8); PG8_WAIT_L(0); PG8_BAR; PG8_MMA(0, 0, At, B0); PG8_MMA(0, 1, At, B1); PG8_BAR; PG8_SCHED;
            PG8_LDA(At, 0, 1); PG8_STAGE(PG8_SB(0, 0), b2, voffB); PG8_STAGE(PG8_SB(0, 1), b2 + hstep, voffB); PG8_STAGE(PG8_SA(0, 0), a2, voffA);
            PG8_WAIT_V(8); PG8_WAIT_L(0); PG8_BAR; PG8_MMA(1, 0, At, B0); PG8_MMA(1, 1, At, B1); PG8_BAR; PG8_SCHED;
            PG8_LDB(B0, 1, 0); PG8_LDB(B1, 1, 1); PG8_SCHED; PG8_LDA(At, 1, 0); PG8_STAGE(PG8_SA(0, 1), a2 + hstep, voffA);
            PG8_WAIT_V(8); PG8_WAIT_L(0); PG8_BAR; PG8_MMA(0, 0, At, B0); PG8_MMA(0, 1, At, B1); PG8_BAR; PG8_SCHED;
            PG8_LDA(At, 1, 1); PG8_STAGE(PG8_SB(1, 0), b3, voffB); PG8_STAGE(PG8_SB(1, 1), b3 + hstep, voffB); PG8_STAGE(PG8_SA(1, 0), a3, voffA);
            PG8_WAIT_V(8); PG8_WAIT_L(0); PG8_BAR; PG8_MMA(1, 0, At, B0); PG8_MMA(1, 1, At, B1); PG8_BAR; PG8_SCHED;
            } else {
            PG8_LDB(B0, 0, 0); PG8_SCHED; PG8_LDA(At, 0, 0); PG8_STAGE(PG8_SA(1, 1), a1 + hstep, voffA);
            PG8_WAIT_L(8); PG8_BAR; PG8_WAIT_L(0); PG8_MMA(0, 0, At, B0); PG8_BAR; PG8_SCHED;
            PG8_LDB(B1, 0, 1); PG8_STAGE(PG8_SB(0, 0), b2, voffB);
            PG8_BAR; PG8_WAIT_L(0); PG8_MMA(0, 1, At, B1); PG8_BAR;
            PG8_LDA(At, 0, 1); PG8_STAGE(PG8_SA(0, 0), a2, voffA);
            PG8_BAR; PG8_WAIT_L(0); PG8_MMA(1, 0, At, B0); PG8_BAR; PG8_SCHED;
            PG8_STAGE(PG8_SB(0, 1), b2 + hstep, voffB);
            PG8_WAIT_V(6); PG8_BAR; PG8_MMA(1, 1, At, B1); PG8_BAR;
            PG8_LDB(B0, 1, 0); PG8_SCHED; PG8_LDA(At, 1, 0); PG8_STAGE(PG8_SA(0, 1), a2 + hstep, voffA);
            PG8_WAIT_L(8); PG8_BAR; PG8_WAIT_L(0); PG8_MMA(0, 0, At, B0); PG8_BAR; PG8_SCHED;
            PG8_LDB(B1, 1, 1); PG8_STAGE(PG8_SB(1, 0), b3, voffB);
            PG8_BAR; PG8_WAIT_L(0); PG8_MMA(0, 1, At, B1); PG8_BAR;
            PG8_LDA(At, 1, 1); PG8_STAGE(PG8_SA(1, 0), a3, voffA);
            PG8_BAR; PG8_WAIT_L(0); PG8_MMA(1, 0, At, B0); PG8_BAR; PG8_SCHED;
            PG8_STAGE(PG8_SB(1, 1), b3 + hstep, voffB);
            PG8_WAIT_V(6); PG8_BAR; PG8_MMA(1, 1, At, B1); PG8_BAR;
            }
        }
        if constexpr (ALIGN_EPI) { if (wr == 0) PG8_BAR; }
        if constexpr (!Epi::AFTER_DRAIN) { E(acc, cur, wr, wc, fr, fq); S.done(cur); }
        if (!has_next) break;
        if (E.zero_after(cur)) {
#pragma unroll
        for (int a = 0; a < 2; ++a)
#pragma unroll
            for (int b = 0; b < 2; ++b)
#pragma unroll
                for (int m = 0; m < 4; ++m)
#pragma unroll
                    for (int n = 0; n < 2; ++n) acc[a][b][m][n] = (f32x4){0.f, 0.f, 0.f, 0.f};
        }
        cur = nxt; cA = nA; cB = nB; ++ui;
        if constexpr (ALIGN_EPI) { if (wr == 1) PG8_BAR; }
    }
    PG8_WAIT_V(0);
    if constexpr (!ALIGN_EPI) { if (wr == 0) PG8_BAR; }
    PG8_BAR;
    if constexpr (Epi::AFTER_DRAIN) { E.fused(acc, cur, wr, wc, fr, fq, lds, wid, lane); S.done(cur); }
#undef PG8_SA
#undef PG8_SB
#undef PG8_STAGE
#undef PG8_LDA
#undef PG8_LDB
#undef PG8_MMA
#undef PG8_WAIT_V
#undef PG8_WAIT_L
#undef PG8_BAR
#undef PG8_SCHED
}
}
__host__ __device__ __forceinline__ int sigma_col(int rho) { const int j = rho & 3, fq = (rho >> 2) & 3, n = (rho >> 4) & 1, wc = (rho >> 5) & 3, bj = rho >> 7; return wc * 64 + bj * 32 + fq * 8 + n * 4 + j; }
namespace pg8 {
struct SchedGrid {
    const char* A0; const char* B0; const char* A1; const char* B1; size_t tstep; int nM, nN, nwg, G, c, segs, pad;
    __device__ __forceinline__ void init(const void* A0_, const void* B0_, const void* A1_, const void* B1_, int M, int N, int K, int segs_, int G_, int c_) {
        A0 = (const char*)A0_; B0 = (const char*)B0_; A1 = (const char*)A1_; B1 = (const char*)B1_; tstep = (size_t)BM * K * 2; nM = M / BM; nN = N / BM; nwg = nM * nN; G = G_; c = c_; segs = segs_; pad = 0; }
    __device__ __forceinline__ bool next(int i, Unit& u) const {
        const int seg = (segs == 2) ? (i & 1) : 0, it = (segs == 2) ? (i >> 1) : i;
        const long L = (long)it * G + c; if (L >= nwg) return false;
        int wgid = (int)L; { const int q = nwg / NXCD, r = nwg % NXCD, xcd = wgid % NXCD, off = wgid / NXCD; wgid = (xcd < r ? xcd * (q + 1) : r * (q + 1) + (xcd - r) * q) + off; }
        const int nig = WGM * nN, gid = wgid / nig, fm = gid * WGM, gsz = (nM - fm) < WGM ? (nM - fm) : WGM;
        u.pm = fm + ((wgid % nig) % gsz); u.pn = (wgid % nig) / gsz; u.seg = seg; u.pad = 0;
        u.A = (seg ? A1 : A0) + (size_t)u.pm * tstep; u.B = (seg ? B1 : B0) + (size_t)u.pn * tstep; return true;
    }
    __device__ __forceinline__ void a_ready(const Unit&) const {}
    __device__ __forceinline__ void done(const Unit&) const {}
};
__device__ __forceinline__ u32x4 pack8(const f32x4& a, const f32x4& b) { u32x4 w; w.x = cvt_pk_bf16(a[0], a[1]); w.y = cvt_pk_bf16(a[2], a[3]); w.z = cvt_pk_bf16(b[0], b[1]); w.w = cvt_pk_bf16(b[2], b[3]); return w; }
__device__ __forceinline__ float bflo(unsigned w) { return __builtin_bit_cast(float, w << 16); }
__device__ __forceinline__ float bfhi(unsigned w) { return __builtin_bit_cast(float, w & 0xffff0000u); }
__device__ __forceinline__ float sigm(float v) { return __builtin_amdgcn_rcpf(1.0f + __expf(-v)); }

struct EpiInProj {
    static constexpr bool PERM = false, AFTER_DRAIN = false;
    const float* r1; const float* qnw; const float* knw; const float* ropec; const float* ropes; const float* merge_b; char* ws; float* kmean; int skip_km;
    __device__ __forceinline__ bool zero_after(const Unit&) const { return true; }
    __device__ __forceinline__ void operator()(f32x4 (&acc)[2][2][4][2], const Unit& u, int wr, int wc, int fr, int fq) const {
        const int pn = u.pn, rowb = u.pm * BM + wr * 64 + fr;
        if (pn < 4) {
            const bool isq = pn < 2; const float* nw = isq ? qnw : knw; const float sc = isq ? 0.125f * 1.4426950408889634f : 1.0f;
            bf16_t* dst = (bf16_t*)(ws + (isq ? OFF_Q : OFF_K)) + (pn & 1) * 256 + wc * 64 + 8 * fq;
            f32x4 nwv[2][2], ks[2][2];
#pragma unroll
            for (int bj = 0; bj < 2; ++bj)
#pragma unroll
                for (int n = 0; n < 2; ++n) { nwv[bj][n] = *(const f32x4*)(nw + 32 * bj + 8 * fq + 4 * n); ks[bj][n] = (f32x4){0.f, 0.f, 0.f, 0.f}; }
#pragma unroll
            for (int ai = 0; ai < 2; ++ai)
#pragma unroll
                for (int m = 0; m < 4; ++m) {
                    const int row = rowb + ai * HALF + m * 16; const float r = r1[row]; const int pos = row & 4095;
                    f32x4 v[2][2]; float ss = 0.f;
#pragma unroll
                    for (int bj = 0; bj < 2; ++bj)
#pragma unroll
                        for (int n = 0; n < 2; ++n) { v[bj][n] = acc[ai][bj][m][n] * r; ss += (v[bj][n][0] * v[bj][n][0] + v[bj][n][1] * v[bj][n][1]) + (v[bj][n][2] * v[bj][n][2] + v[bj][n][3] * v[bj][n][3]); }
                    ss += __shfl_xor(ss, 16); ss += __shfl_xor(ss, 32);
                    const float rstd = rsqrtf(ss * (1.0f / 64.0f) + 1e-6f);
#pragma unroll
                    for (int bj = 0; bj < 2; ++bj)
#pragma unroll
                        for (int n = 0; n < 2; ++n) v[bj][n] = v[bj][n] * rstd * nwv[bj][n];
#pragma unroll
                    for (int n = 0; n < 2; ++n) {
                        const f32x4 cs = *(const f32x4*)(ropec + pos * 8 + 4 * n), sn = *(const f32x4*)(ropes + pos * 8 + 4 * n);
#pragma unroll
                        for (int j = 0; j < 4; ++j) { const float mine = v[0][n][j], oth = __shfl_xor(mine, 16);
                            const float rot = (fq == 0) ? (mine * cs[j] - oth * sn[j]) : (mine * cs[j] + oth * sn[j]);
                            v[0][n][j] = (fq < 2) ? rot : mine; }
                    }
#pragma unroll
                    for (int bj = 0; bj < 2; ++bj) {
                        const u32x4 w = pack8(v[bj][0] * sc, v[bj][1] * sc);
                        *(u32x4*)(dst + (size_t)row * 512 + 32 * bj) = w;
                        if (!isq) { ks[bj][0] += (f32x4){bflo(w.x), bfhi(w.x), bflo(w.y), bfhi(w.y)}; ks[bj][1] += (f32x4){bflo(w.z), bfhi(w.z), bflo(w.w), bfhi(w.w)}; }
                    }
                }
            if (!isq) {
#pragma unroll
                for (int bj = 0; bj < 2; ++bj)
#pragma unroll
                    for (int n = 0; n < 2; ++n)
#pragma unroll
                        for (int j = 0; j < 4; ++j) { float s = ks[bj][n][j]; s += __shfl_xor(s, 1); s += __shfl_xor(s, 2); s += __shfl_xor(s, 4); s += __shfl_xor(s, 8); ks[bj][n][j] = s; }
                if (fr == 0 && !skip_km) {
                    const int b = u.pm >> 4, blk = u.pm & 15, head = (pn & 1) * 4 + wc;
                    float* km = kmean + ((size_t)(b * 8 + head) * 16 + blk) * 64 + 8 * fq;
#pragma unroll
                    for (int bj = 0; bj < 2; ++bj)
#pragma unroll
                        for (int n = 0; n < 2; ++n)
#pragma unroll
                            for (int j = 0; j < 4; ++j) atomicAdd(km + 32 * bj + 4 * n + j, ks[bj][n][j] * (1.0f / 256.0f));
                }
            }
        } else {
            size_t off; int ld = 512, cb, type = 2; const float* bias = nullptr;
            if (pn < 6) { off = OFF_V; cb = (pn - 4) * 256; } else if (pn < 8) { off = OFF_MQ; cb = (pn - 6) * 256; } else if (pn < 10) { off = OFF_MK; cb = (pn - 8) * 256; }
            else if (pn < 12) { off = OFF_MV; cb = (pn - 10) * 256; } else if (pn < 14) { off = OFF_MO; cb = (pn - 12) * 256; type = 3; }
            else if (pn < 18) { off = OFF_GA; cb = (pn - 14) * 256; ld = 1024; type = 4; bias = merge_b + cb; } else { off = OFF_GM; cb = (pn - 18) * 256; ld = 1024; type = 4; bias = merge_b + 1024 + cb; }
            const int cl = wc * 64 + 8 * fq;
            bf16_t* dst = (bf16_t*)(ws + off) + cb + cl;
            f32x4 bv[2][2];
#pragma unroll
            for (int bj = 0; bj < 2; ++bj)
#pragma unroll
                for (int n = 0; n < 2; ++n) bv[bj][n] = (type == 4) ? *(const f32x4*)(bias + cl + 32 * bj + 4 * n) : (f32x4){0.f, 0.f, 0.f, 0.f};
#pragma unroll
            for (int ai = 0; ai < 2; ++ai)
#pragma unroll
                for (int m = 0; m < 4; ++m) {
                    const int row = rowb + ai * HALF + m * 16; const float r = r1[row];
#pragma unroll
                    for (int bj = 0; bj < 2; ++bj) {
                        f32x4 v0 = acc[ai][bj][m][0] * r + bv[bj][0], v1 = acc[ai][bj][m][1] * r + bv[bj][1];
                        if (type >= 3) {
#pragma unroll
                            for (int j = 0; j < 4; ++j) { v0[j] = sigm(v0[j]); v1[j] = sigm(v1[j]); } }
                        *(u32x4*)(dst + (size_t)row * ld + 32 * bj) = pack8(v0, v1);
                    }
                }
        }
    }
};
struct EpiBranch {
    static constexpr bool PERM = false, AFTER_DRAIN = false;
    const bf16_t* ga; const bf16_t* gm; bf16_t* y;
    __device__ __forceinline__ bool zero_after(const Unit& u) const { return u.seg == 1; }
    __device__ __forceinline__ void operator()(f32x4 (&acc)[2][2][4][2], const Unit& u, int wr, int wc, int fr, int fq) const {
        const int rowb = u.pm * BM + wr * 64 + fr, col0 = u.pn * BM + wc * 64 + 8 * fq;
#pragma unroll
        for (int ai = 0; ai < 2; ++ai)
#pragma unroll
            for (int m = 0; m < 4; ++m) {
                const size_t ro = (size_t)(rowb + ai * HALF + m * 16) * 1024 + col0;
#pragma unroll
                for (int bj = 0; bj < 2; ++bj) {
                    const u32x4 gmw = *(const u32x4*)(gm + ro + 32 * bj);
                    const f32x4 m0 = (f32x4){bflo(gmw.x), bfhi(gmw.x), bflo(gmw.y), bfhi(gmw.y)}, m1 = (f32x4){bflo(gmw.z), bfhi(gmw.z), bflo(gmw.w), bfhi(gmw.w)};
                    if (u.seg == 0) {
                        const u32x4 gaw = *(const u32x4*)(ga + ro + 32 * bj);
                        const f32x4 a0 = (f32x4){bflo(gaw.x), bfhi(gaw.x), bflo(gaw.y), bfhi(gaw.y)}, a1 = (f32x4){bflo(gaw.z), bfhi(gaw.z), bflo(gaw.w), bfhi(gaw.w)};
#pragma unroll
                        for (int j = 0; j < 4; ++j) { acc[ai][bj][m][0][j] *= a0[j] * __builtin_amdgcn_rcpf(m0[j]); acc[ai][bj][m][1][j] *= a1[j] * __builtin_amdgcn_rcpf(m1[j]); }
                    } else {
                        *(u32x4*)(y + ro + 32 * bj) = pack8(acc[ai][bj][m][0] * m0, acc[ai][bj][m][1] * m1);
                    }
                }
            }
    }
};
struct EpiOut {
    static constexpr bool PERM = false, AFTER_DRAIN = false;
    const float* x; float* out; bf16_t* x1b; float* rowss;
    __device__ __forceinline__ bool zero_after(const Unit&) const { return true; }
    __device__ __forceinline__ void operator()(f32x4 (&acc)[2][2][4][2], const Unit& u, int wr, int wc, int fr, int fq) const {
        const int rowb = u.pm * BM + wr * 64 + fr, col0 = u.pn * BM + wc * 64 + 8 * fq;
#pragma unroll
        for (int ai = 0; ai < 2; ++ai)
#pragma unroll
            for (int m = 0; m < 4; ++m) {
                const int row = rowb + ai * HALF + m * 16; const size_t ro = (size_t)row * 1024 + col0; float ss = 0.f;
#pragma unroll
                for (int bj = 0; bj < 2; ++bj) {
                    const f32x4 v0 = acc[ai][bj][m][0] + *(const f32x4*)(x + ro + 32 * bj), v1 = acc[ai][bj][m][1] + *(const f32x4*)(x + ro + 32 * bj + 4);
                    *(u32x4*)(x1b + ro + 32 * bj) = pack8(v0, v1);
                    ss += (v0[0] * v0[0] + v0[1] * v0[1]) + (v0[2] * v0[2] + v0[3] * v0[3]) + (v1[0] * v1[0] + v1[1] * v1[1]) + (v1[2] * v1[2] + v1[3] * v1[3]);
                }
                ss += __shfl_xor(ss, 16); ss += __shfl_xor(ss, 32);
                if (fq == 0) rowss[(size_t)row * 16 + u.pn * 4 + wc] = ss;
            }
    }
};
}
#include <hip/hip_bf16.h>
#include <cmath>
namespace attn_body {
using bf16=__hip_bfloat16;
using bf16x8=__attribute__((ext_vector_type(8)))short;
using s16x4=__attribute__((ext_vector_type(4)))short;
using f32x16=__attribute__((ext_vector_type(16)))float;
using u32x4=__attribute__((ext_vector_type(4)))unsigned;
using f32x4_t=__attribute__((ext_vector_type(4)))float;
constexpr int BATCH=16,NHEAD=8,SEQ=4096,D=64,DM=NHEAD*D;
constexpr int NW=8,QBLK=32,QB=QBLK*NW,KVBLK=64,NQB=SEQ/QB;
constexpr int ATTN_PITCH=DM, ATTN_UNIT_ROWS=QB;
__device__ __forceinline__ int crow(int r,int hi){return (r&3)+8*(r>>2)+4*hi;}
#define SBAR() __builtin_amdgcn_sched_barrier(0)
__device__ __forceinline__ void cmask(f32x16&p0,f32x16&p1,int jb,int qrel,int hi){
  const float NEG=-INFINITY; int kb=64*jb+4*hi;
  #pragma unroll
  for(int r=0;r<16;++r){int kv=kb+(r&3)+8*(r>>2); if(kv>qrel)p0[r]=NEG; if(kv+32>qrel)p1[r]=NEG;}
}

constexpr int NSLOT=3, SLOTB=8192;
constexpr int LDS_K=0, LDS_V=NSLOT*SLOTB, LDS_WS=2*NSLOT*SLOTB, LDS_OST=LDS_WS+NW*64*4, LDS_BYTES=LDS_OST+NW*4096;
constexpr float C2=0.125f*1.4426950408889634f;
__device__ __forceinline__ void glds16(const void*gsrc,unsigned lds_dst){unsigned keep;
  asm volatile("s_mov_b32 %0, m0\n\ts_mov_b32 m0, %2\n\ts_nop 0\n\tglobal_load_lds_dwordx4 %1, off\n\ts_mov_b32 m0, %0":"=&s"(keep):"v"(gsrc),"s"(lds_dst):"memory");}
__device__ __forceinline__ float max3f(float a,float b,float c){float r;asm("v_max3_f32 %0, %1, %2, %3":"=v"(r):"v"(a),"v"(b),"v"(c));return r;}
__device__ __forceinline__ float max2f(float a,float b){float r;asm("v_max_f32_e32 %0, %1, %2":"=v"(r):"v"(a),"v"(b));return r;}
__device__ __forceinline__ float fadd_s(float a,float b){float r;asm("v_add_f32_e32 %0, %1, %2":"=v"(r):"v"(a),"v"(b));return r;}
__device__ __forceinline__ float fsub_s(float a,float b){float r;asm("v_sub_f32_e32 %0, %1, %2":"=v"(r):"v"(a),"v"(b));return r;}
typedef float f32x2_t __attribute__((ext_vector_type(2))); typedef __bf16 bf16x2_t __attribute__((ext_vector_type(2)));
__device__ __forceinline__ unsigned cvtpk_s(float lo,float hi){f32x2_t v={lo,hi};bf16x2_t b=__builtin_convertvector(v,bf16x2_t);return __builtin_bit_cast(unsigned,b);}
#define WAIT_BAR(N) asm volatile("s_waitcnt vmcnt(" #N ") lgkmcnt(0)\n\ts_barrier":::"memory")

__device__ __forceinline__ void qkt(f32x16&p0,f32x16&p1,const char*Kslot,const bf16x8*qr,const f32x16&negm,int r32,int hi){
  const char*kb=Kslot+hi*1024+r32*16;
  #pragma unroll
  for(int d0=0;d0<4;++d0){
    const bf16x8 b0=*reinterpret_cast<const bf16x8*>(kb+d0*2048);
    const bf16x8 b1=*reinterpret_cast<const bf16x8*>(kb+d0*2048+512);
    if(d0==0){p0=__builtin_amdgcn_mfma_f32_32x32x16_bf16(b0,qr[0],negm,0,0,0);p1=__builtin_amdgcn_mfma_f32_32x32x16_bf16(b1,qr[0],negm,0,0,0);}
    else{p0=__builtin_amdgcn_mfma_f32_32x32x16_bf16(b0,qr[d0],p0,0,0,0);p1=__builtin_amdgcn_mfma_f32_32x32x16_bf16(b1,qr[d0],p1,0,0,0);}}
}
typedef __attribute__((address_space(3))) const char* lds_cptr;
typedef short v4i16_t __attribute__((ext_vector_type(4)));
__device__ __forceinline__ void kload8(bf16x8*kf,lds_cptr kp){
  kf[0]=*(const __attribute__((address_space(3))) bf16x8*)(kp);      kf[1]=*(const __attribute__((address_space(3))) bf16x8*)(kp+512);
  kf[2]=*(const __attribute__((address_space(3))) bf16x8*)(kp+2048); kf[3]=*(const __attribute__((address_space(3))) bf16x8*)(kp+2560);
  kf[4]=*(const __attribute__((address_space(3))) bf16x8*)(kp+4096); kf[5]=*(const __attribute__((address_space(3))) bf16x8*)(kp+4608);
  kf[6]=*(const __attribute__((address_space(3))) bf16x8*)(kp+6144); kf[7]=*(const __attribute__((address_space(3))) bf16x8*)(kp+6656);
}
__device__ __forceinline__ void kload2(bf16x8*kf,lds_cptr kp,int j){ kf[2*j]=*(const __attribute__((address_space(3))) bf16x8*)(kp+j*2048); kf[2*j+1]=*(const __attribute__((address_space(3))) bf16x8*)(kp+j*2048+512); }
__device__ __forceinline__ s16x4 vtr(lds_cptr p){ return __builtin_bit_cast(s16x4,__builtin_amdgcn_ds_read_tr16_b64_v4i16((__attribute__((address_space(3))) v4i16_t*)p)); }
__device__ __forceinline__ float rowmax(const f32x16&p0,const f32x16&p1){
  float a=max3f(p0[0],p0[1],p1[0]),b=max3f(p0[2],p0[3],p1[1]);a=max3f(a,p1[2],p1[3]);
  #pragma unroll
  for(int r=4;r<16;r+=4){a=max3f(a,p0[r],p0[r+1]);b=max3f(b,p0[r+2],p0[r+3]);a=max3f(a,p1[r],p1[r+1]);b=max3f(b,p1[r+2],p1[r+3]);}
  const float m=max2f(a,b);
  auto rr=__builtin_amdgcn_permlane32_swap(__float_as_uint(m),__float_as_uint(m),false,false);
  return max2f(__uint_as_float(rr[0]),__uint_as_float(rr[1]));
}
__device__ __forceinline__ void pv(f32x16*o,int vb,bf16x8 pa0,bf16x8 pa1,bf16x8 pa2,bf16x8 pa3){
  #pragma unroll
  for(int d0=0;d0<2;++d0){s16x4 lo[4],hi[4];
    #pragma unroll
    for(int ks=0;ks<4;++ks){
      asm volatile("ds_read_b64_tr_b16 %0,%1 offset:%c2":"=&v"(lo[ks]):"v"(vb),"i"(d0*4096+ks*1024):"memory");
      asm volatile("ds_read_b64_tr_b16 %0,%1 offset:%c2":"=&v"(hi[ks]):"v"(vb),"i"(d0*4096+ks*1024+512):"memory");}
    asm volatile("s_waitcnt lgkmcnt(0)":::"memory");SBAR();
    #define PK(k) (bf16x8){lo[k][0],lo[k][1],lo[k][2],lo[k][3],hi[k][0],hi[k][1],hi[k][2],hi[k][3]}
    o[d0]=__builtin_amdgcn_mfma_f32_32x32x16_bf16(pa0,PK(0),o[d0],0,0,0);
    o[d0]=__builtin_amdgcn_mfma_f32_32x32x16_bf16(pa1,PK(1),o[d0],0,0,0);
    o[d0]=__builtin_amdgcn_mfma_f32_32x32x16_bf16(pa2,PK(2),o[d0],0,0,0);
    o[d0]=__builtin_amdgcn_mfma_f32_32x32x16_bf16(pa3,PK(3),o[d0],0,0,0);
    #undef PK
  }
}

#ifndef ATTN_STORE16
#define ATTN_STORE16(p,v) (*(u32x4*)(p)=(v))
#endif
template<int THRL> __device__ __forceinline__ void attn_unit(int b,int h,int qb,const bf16*Q,const bf16*__restrict__ K,const bf16*__restrict__ V,bf16*O,char*shm){
  int tid=threadIdx.x; asm volatile("":"+v"(tid)); const int lane=tid&63,r32=lane&31,hi=lane>>5; const int wid=__builtin_amdgcn_readfirstlane(tid>>6);
  const long rowbase=(long)b*SEQ; const int q0=qb*QB;
  const bf16*Qw=Q+(rowbase+q0+wid*QBLK)*DM+h*D;
  const bf16*Kh=K+rowbase*DM+h*D,*Vh=V+rowbase*DM+h*D;
  const unsigned lds0=(unsigned)(uintptr_t)shm;
  float*wsf=(float*)(shm+LDS_WS)+wid*64;
  const bf16*ksrc=Kh+(long)lane*DM+wid*8;
  const bf16*vsrc=Vh+(long)(16*(wid&3)+(lane>>2))*DM+(wid>>2)*32+(lane&3)*8;
  const unsigned kdst=lds0+LDS_K+wid*1024, vdst=lds0+LDS_V+wid*1024;
  #define TM(t) (((t)<4)?(NT-4+(t)):((t)-4))
  #define DMA_K(t,slot) glds16(ksrc+(long)TM(t)*KVBLK*DM,(unsigned)__builtin_amdgcn_readfirstlane(kdst+(slot)))
  #define DMA_V(t,slot) glds16(vsrc+(long)TM(t)*KVBLK*DM,(unsigned)__builtin_amdgcn_readfirstlane(vdst+(slot)))
  const int vb0=(int)(lds0+LDS_V)+((lane>>4)&1)*32+(lane&3)*8+(4*hi+((lane&15)>>2))*64;
  const char*Kbase=shm+LDS_K; bf16x8 kf[8];
  const lds_cptr shm3=(lds_cptr)shm; const lds_cptr kp0=shm3+LDS_K+hi*1024+r32*16; const lds_cptr vp0=shm3+LDS_V+((lane>>4)&1)*32+(lane&3)*8+(4*hi+((lane&15)>>2))*64;
  const int NT=(q0+QB)/KVBLK;
  DMA_K(0,0);DMA_V(0,0);DMA_K(1,SLOTB);
  bf16x8 qr[4];
  #pragma unroll
  for(int d0=0;d0<4;++d0)qr[d0]=*reinterpret_cast<const bf16x8*>(&Qw[(long)r32*DM+d0*16+hi*8]);
  #define SELK(tt) (((tt)<4)||((((const unsigned*)(shm+LDS_BYTES))[wid*QBLK+r32]>>(((tt)-4)>>2))&1u))
  float mhat=0.f,l_reg=0.f;f32x16 o[2];o[0]=f32x16{};o[1]=f32x16{};f32x16 negm=f32x16{};asm volatile("":"+v"(negm));
  const int qrel=wid*QBLK+r32;
  #define CMASK(P0,P1,t) do{int jb_=(t); if(jb_<4)cmask(P0,P1,jb_,qrel,hi); else { const bool keep_=SELK(jb_); _Pragma("unroll") for(int r=0;r<16;++r){P0[r]=keep_?P0[r]:-INFINITY;P1[r]=keep_?P1[r]:-INFINITY;} } }while(0)
  bool resc=false;
  #define START(P0,P1) do{ const float rm=rowmax(P0,P1); resc=false; \
    { const float dl=rm; mhat=fadd_s(mhat,dl); \
      _Pragma("unroll") for(int r=0;r<16;++r){P0[r]=fsub_s(P0[r],dl);P1[r]=fsub_s(P1[r],dl);} \
      _Pragma("unroll") for(int r=0;r<16;++r)negm[r]=-mhat; asm volatile("":"+v"(negm)); } \
    _Pragma("unroll") for(int r=0;r<16;++r)P0[r]=__builtin_amdgcn_exp2f(P0[r]); }while(0)
  #define RESC() do{ if(resc){ asm volatile("s_waitcnt lgkmcnt(0)":::"memory"); \
      _Pragma("unroll") for(int d_=0;d_<2;++d_) _Pragma("unroll") for(int r=0;r<16;++r)o[d_][r]*=wsf[crow(r,hi)]; } }while(0)
  f32x16 pA0,pA1,pB0,pB1;
  int sl_prev=0,sl_cur=0,sl_next=SLOTB;
  #define ROT() do{sl_prev=sl_cur;sl_cur=sl_next;sl_next=(sl_next==(NSLOT-1)*SLOTB)?0:sl_next+SLOTB;}while(0)
  DMA_K(2,2*SLOTB);
  WAIT_BAR(3);
  qkt(pA0,pA1,Kbase,qr,negm,r32,hi);asm volatile("s_nop 15\n\ts_nop 7":"+v"(pA0),"+v"(pA1));CMASK(pA0,pA1,0);
  START(pA0,pA1);
  _Pragma("unroll") for(int r=0;r<16;++r)pA1[r]=__builtin_amdgcn_exp2f(pA1[r]);
  WAIT_BAR(0);
  DMA_K(3,0);DMA_V(1,SLOTB);
  ROT();
  kload8(kf,kp0+sl_cur);
  WAIT_BAR(2);
  s16x4 vlo[8],vhi[8]; u32x4 pw0,pw1,pw2,pw3;
  #define PKW(P,B) cvtpk_s(P[B],P[B+1])
  #define PAF(k) __builtin_bit_cast(bf16x8,pw##k)
  #define VFR(i) (bf16x8){vlo[i][0],vlo[i][1],vlo[i][2],vlo[i][3],vhi[i][0],vhi[i][1],vhi[i][2],vhi[i][3]}
  #define PIN(x) asm volatile("":"+v"(x))
  #define MX3(a,b,c) __builtin_fmaxf(__builtin_fmaxf((a),(b)),(c))
  #define GAPA(MF,A0,A1,A2,A3,W0,W1,PW) do{ MF; sacc+=A0; sacc+=A1; sacc+=A2; sacc+=A3; PIN(sacc); W0; W1; PIN(PW); SBAR(); }while(0)
  #define EX(v) __builtin_amdgcn_exp2f(v)
  #define GAPB(MF,X,B) do{ MF; X[B]=EX(X[B]); X[B+1]=EX(X[B+1]); X[B+2]=EX(X[B+2]); X[B+3]=EX(X[B+3]); PIN(X); SBAR(); }while(0)
  #define VRD(i) do{ vlo[i]=vtr(vp_+(((i)>>2)*4096+((i)&3)*1024)); vhi[i]=vtr(vp_+(((i)>>2)*4096+((i)&3)*1024+512)); }while(0)
  #define KRD(G,j) do{ if(G){ kload2(kf,kp0+sl_next,j); SBAR(); } }while(0)
  #define STEP(C0,C1,P0,P1,t,GK,GV,GL) do{ SBAR(); \
    const lds_cptr vp_=vp0+sl_prev; \
    VRD(0); SBAR(); float sacc=(P0[0]+P0[1]); \
    GAPA(C0=__builtin_amdgcn_mfma_f32_32x32x16_bf16(kf[0],qr[0],negm,0,0,0), P0[2],P0[3],P0[4],P0[5],     pw0[0]=PKW(P0,0), pw0[1]=PKW(P0,2), pw0); \
    VRD(4); SBAR(); GAPA(C1=__builtin_amdgcn_mfma_f32_32x32x16_bf16(kf[1],qr[0],negm,0,0,0), P0[6],P0[7],P0[8],P0[9],     pw0[2]=PKW(P0,4), pw0[3]=PKW(P0,6), pw0); \
    VRD(1); SBAR(); GAPA(C0=__builtin_amdgcn_mfma_f32_32x32x16_bf16(kf[2],qr[1],C0,0,0,0),   P0[10],P0[11],P0[12],P0[13], pw1[0]=PKW(P0,8), pw1[1]=PKW(P0,10), pw1); \
    VRD(5); SBAR(); GAPA(C1=__builtin_amdgcn_mfma_f32_32x32x16_bf16(kf[3],qr[1],C1,0,0,0),   P0[14],P0[15],P1[0],P1[1],   pw1[2]=PKW(P0,12),pw1[3]=PKW(P0,14), pw1); \
    VRD(2); SBAR(); GAPA(C0=__builtin_amdgcn_mfma_f32_32x32x16_bf16(kf[4],qr[2],C0,0,0,0),   P1[2],P1[3],P1[4],P1[5],     pw2[0]=PKW(P1,0), pw2[1]=PKW(P1,2), pw2); \
    VRD(6); SBAR(); GAPA(C1=__builtin_amdgcn_mfma_f32_32x32x16_bf16(kf[5],qr[2],C1,0,0,0),   P1[6],P1[7],P1[8],P1[9],     pw2[2]=PKW(P1,4), pw2[3]=PKW(P1,6), pw2); \
    VRD(3); SBAR(); GAPA(C0=__builtin_amdgcn_mfma_f32_32x32x16_bf16(kf[6],qr[3],C0,0,0,0),   P1[10],P1[11],P1[12],P1[13], pw3[0]=PKW(P1,8), pw3[1]=PKW(P1,10), pw3); \
    VRD(7); SBAR(); GAPA(C1=__builtin_amdgcn_mfma_f32_32x32x16_bf16(kf[7],qr[3],C1,0,0,0),   P1[14],P1[15],0.f,0.f,       pw3[2]=PKW(P1,12),pw3[3]=PKW(P1,14), pw3); \
    l_reg+=sacc; \
    if(GK){DMA_K((t)+3,sl_cur);} if(GV){DMA_V((t)+1,sl_next);} \
    CMASK(C0,C1,t); \
    { float a=MX3(C0[0],C0[1],C1[0]),b=MX3(C0[2],C0[3],C1[1]); a=MX3(a,C1[2],C1[3]); \
      _Pragma("unroll") for(int r=4;r<16;r+=4){a=MX3(a,C0[r],C0[r+1]);b=MX3(b,C0[r+2],C0[r+3]);a=MX3(a,C1[r],C1[r+1]);b=MX3(b,C1[r+2],C1[r+3]);} \
      float rm=__builtin_fmaxf(a,b); { auto rr=__builtin_amdgcn_permlane32_swap(__float_as_uint(rm),__float_as_uint(rm),false,false); rm=__builtin_fmaxf(__uint_as_float(rr[0]),__uint_as_float(rr[1])); } \
      resc=false; \
      if(__builtin_expect(__any(rm>(float)THRL),0)){ const float dl=__builtin_fmaxf(rm,0.f); mhat+=dl; \
        _Pragma("unroll") for(int r=0;r<16;++r){C0[r]-=dl;C1[r]-=dl;} \
        _Pragma("unroll") for(int r=0;r<16;++r)negm[r]=-mhat; asm volatile("":"+v"(negm)); \
        const float f=__builtin_amdgcn_exp2f(-dl); l_reg*=f; if(hi==0)wsf[r32]=f; resc=true; } } \
    SBAR(); \
    GAPB(o[0]=__builtin_amdgcn_mfma_f32_32x32x16_bf16(PAF(0),VFR(0),o[0],0,0,0), C0,0); \
    GAPB(o[1]=__builtin_amdgcn_mfma_f32_32x32x16_bf16(PAF(0),VFR(4),o[1],0,0,0), C0,4); \
    KRD(GL,0); GAPB(o[0]=__builtin_amdgcn_mfma_f32_32x32x16_bf16(PAF(1),VFR(1),o[0],0,0,0), C0,8); \
    KRD(GL,1); GAPB(o[1]=__builtin_amdgcn_mfma_f32_32x32x16_bf16(PAF(1),VFR(5),o[1],0,0,0), C0,12); \
    KRD(GL,2); GAPB(o[0]=__builtin_amdgcn_mfma_f32_32x32x16_bf16(PAF(2),VFR(2),o[0],0,0,0), C1,0); \
    KRD(GL,3); GAPB(o[1]=__builtin_amdgcn_mfma_f32_32x32x16_bf16(PAF(2),VFR(6),o[1],0,0,0), C1,4); \
    GAPB(o[0]=__builtin_amdgcn_mfma_f32_32x32x16_bf16(PAF(3),VFR(3),o[0],0,0,0), C1,8); \
    GAPB(o[1]=__builtin_amdgcn_mfma_f32_32x32x16_bf16(PAF(3),VFR(7),o[1],0,0,0), C1,12); \
    }while(0)
  int t=1;
  for(;t+5<NT;t+=2){
    STEP(pB0,pB1,pA0,pA1,t,true,true,true);     WAIT_BAR(2); RESC(); ROT();
    STEP(pA0,pA1,pB0,pB1,t+1,true,true,true);   WAIT_BAR(2); RESC(); ROT();
  }
  #define ENDW(tt) do{ if((tt)+3<NT){WAIT_BAR(2);} else if((tt)+2<NT){WAIT_BAR(1);} else {WAIT_BAR(0);} }while(0)
  for(;t+1<NT;t+=2){
    STEP(pB0,pB1,pA0,pA1,t,(t+3<NT),(t+1<NT),(t+1<NT));       ENDW(t);   RESC(); ROT();
    STEP(pA0,pA1,pB0,pB1,t+1,(t+4<NT),(t+2<NT),(t+2<NT));     ENDW(t+1); RESC(); ROT();
  }
  STEP(pB0,pB1,pA0,pA1,NT-1,false,false,false); RESC();
  { float sacc=pB0[0]+pB0[1]; _Pragma("unroll") for(int r=2;r<16;++r)sacc+=pB0[r]; _Pragma("unroll") for(int r=0;r<16;++r)sacc+=pB1[r]; l_reg+=sacc;
    pw0=(u32x4){PKW(pB0,0),PKW(pB0,2),PKW(pB0,4),PKW(pB0,6)};pw1=(u32x4){PKW(pB0,8),PKW(pB0,10),PKW(pB0,12),PKW(pB0,14)};pw2=(u32x4){PKW(pB1,0),PKW(pB1,2),PKW(pB1,4),PKW(pB1,6)};pw3=(u32x4){PKW(pB1,8),PKW(pB1,10),PKW(pB1,12),PKW(pB1,14)};
    SBAR(); pv(o,vb0+sl_cur,PAF(0),PAF(1),PAF(2),PAF(3)); }
  #undef PKW
  #undef PAF
  #undef VFR
  #undef PIN
  #undef MX3
  #undef GAPA
  #undef GAPB
  #undef EX
  #undef VRD
  #undef KRD
  #undef STEP
  #undef ENDW
  {auto rr=__builtin_amdgcn_permlane32_swap(__float_as_uint(l_reg),__float_as_uint(l_reg),false,false);l_reg=__uint_as_float(rr[0])+__uint_as_float(rr[1]);}
  if(hi==0)wsf[32+r32]=l_reg;asm volatile("s_waitcnt lgkmcnt(0)":::"memory");
  float rli[16];
  #pragma unroll
  for(int r=0;r<16;++r)rli[r]=__builtin_amdgcn_rcpf(wsf[32+crow(r,hi)]);
  bf16*Ow=O+(rowbase+q0+wid*QBLK)*DM+h*D;
  { bf16*stg=(bf16*)(shm+LDS_OST)+wid*2048;
    #pragma unroll
    for(int r=0;r<16;++r){const int orow=crow(r,hi);
      #pragma unroll
      for(int d0=0;d0<2;++d0)stg[orow*64+d0*32+r32]=__float2bfloat16(o[d0][r]*rli[r]);}
    asm volatile("s_waitcnt lgkmcnt(0)":::"memory");
    #pragma unroll
    for(int i=0;i<4;++i){const int row=i*8+(lane>>3),ch=lane&7; const u32x4 v=*(const u32x4*)(stg+row*64+ch*8); ATTN_STORE16(Ow+(long)row*DM+ch*8,v);} }
  asm volatile("s_waitcnt lgkmcnt(0)\n\ts_barrier":::"memory");
  #undef DMA_K
  #undef TM
  #undef SELK
  #undef DMA_V
  #undef CMASK
  #undef START
  #undef RESC
  #undef ROT
}

__device__ __forceinline__ void moba_gate(int b,int h,int qb,const bf16*Q,const float*__restrict__ kmean,char*shm){
  int tid=threadIdx.x; asm volatile("":"+v"(tid));
  if(tid<QB){
    unsigned selmask=0u;
    if(qb>0){
      const unsigned short*qrow=(const unsigned short*)Q+((long)b*SEQ+qb*QB+tid)*DM+h*D;
      const float*kmb=kmean+(long)((b*NHEAD+h)*16)*64;
      float g0=-INFINITY,g1=-INFINITY,g2=-INFINITY; int i0=-1,i1=-1,i2=-1;
      for(int n=0;n<qb;++n){
        float g=0.f;
        #pragma unroll
        for(int c=0;c<8;++c){
          const u32x4 qv=*reinterpret_cast<const u32x4*>(qrow+c*8);
          const f32x4_t ka=*reinterpret_cast<const f32x4_t*>(kmb+n*64+c*8), kb=*reinterpret_cast<const f32x4_t*>(kmb+n*64+c*8+4);
          g+=__builtin_bit_cast(float,qv.x<<16)*ka[0]; g+=__builtin_bit_cast(float,qv.x&0xffff0000u)*ka[1];
          g+=__builtin_bit_cast(float,qv.y<<16)*ka[2]; g+=__builtin_bit_cast(float,qv.y&0xffff0000u)*ka[3];
          g+=__builtin_bit_cast(float,qv.z<<16)*kb[0]; g+=__builtin_bit_cast(float,qv.z&0xffff0000u)*kb[1];
          g+=__builtin_bit_cast(float,qv.w<<16)*kb[2]; g+=__builtin_bit_cast(float,qv.w&0xffff0000u)*kb[3];
        }
        if(g>g0){g2=g1;i2=i1;g1=g0;i1=i0;g0=g;i0=n;} else if(g>g1){g2=g1;i2=i1;g1=g;i1=n;} else if(g>g2){g2=g;i2=n;}
      }
      if(i0>=0)selmask|=1u<<i0; if(i1>=0)selmask|=1u<<i1; if(i2>=0)selmask|=1u<<i2;
    }
    { int t2=tid; asm volatile("":"+v"(t2)); ((unsigned*)(shm+LDS_BYTES))[t2]=selmask; }
  }
  asm volatile("s_waitcnt lgkmcnt(0)\n\ts_barrier":::"memory");
}
constexpr int ATTN_LDS_BYTES=LDS_BYTES;
struct AttnTensors { const bf16* Q; const bf16* K; const bf16* V; bf16* O; const float* kmean; };
struct AttnUnit { int bh; int qb; };
struct StaticOrder {
  int vcu;
  __device__ __forceinline__ explicit StaticOrder(int grid,int block):vcu((block%8)*(grid/8)+block/8){}
  __device__ __forceinline__ bool next(int i,AttnUnit&u)const{ if(i>=8)return false; const int half=vcu&1; u.bh=vcu>>1;
    const int pr=3-(i>>1);
    u.qb=(i&1)?(half?(4*pr+1):(4*pr)):(half?(4*pr+2):(4*pr+3)); return true; }
  __device__ __forceinline__ void a_ready(const AttnUnit&)const{}
  __device__ __forceinline__ void done(const AttnUnit&)const{}
};
struct QueueOrder {
  unsigned* ctr; volatile __attribute__((address_space(3))) unsigned* slot;
  __device__ __forceinline__ bool next(int,AttnUnit&u)const{
    if(threadIdx.x==0)*slot=__hip_atomic_fetch_add(ctr,1u,__ATOMIC_RELAXED,__HIP_MEMORY_SCOPE_AGENT);
    __syncthreads(); const unsigned k=*slot; __syncthreads();
    if(k>=2048u)return false; u.qb=15-(int)(k>>7); u.bh=(int)(k&127u); return true; }
  __device__ __forceinline__ void a_ready(const AttnUnit&)const{}
  __device__ __forceinline__ void done(const AttnUnit&)const{}
};
template<class Sched,int THRL=8> __device__ __forceinline__ void attn_phase(char*lds,const AttnTensors&T,const Sched&S){
  AttnUnit u;
  for(int i=0;S.next(i,u);++i){ S.a_ready(u); moba_gate(u.bh/NHEAD,u.bh%NHEAD,u.qb,T.Q,T.kmean,lds); attn_unit<THRL>(u.bh/NHEAD,u.bh%NHEAD,u.qb,T.Q,T.K,T.V,T.O,lds); S.done(u); }
}
#undef SBAR
#undef WAIT_BAR
}
namespace mlstm {
#define ML_LAS __attribute__((address_space(3)))
typedef short bf16x8 __attribute__((ext_vector_type(8)));
typedef short s16x4 __attribute__((ext_vector_type(4)));
typedef float f32x4 __attribute__((ext_vector_type(4)));
typedef unsigned u32x4 __attribute__((ext_vector_type(4)));
typedef unsigned u32x2 __attribute__((ext_vector_type(2)));
constexpr int PQ = 272, PV = 336, PA = 144;
constexpr int O_QC = 0, O_KC = O_QC + 64 * PQ, O_HST = O_KC + 64 * PQ, O_VP = O_HST + 64 * PQ, O_VW = O_VP + 64 * PV, O_ST = O_VW + 64 * PV, O_AM = O_ST + 128 * PV,
              O_CW = O_AM + 64 * PA, O_EX = O_CW + 2 * 5 * 128 * 4, O_SCR = O_EX + 3 * 64 * 4, O_CH = O_SCR + 64 * 4, LDS_END = O_CH + 2 * 4 * 64 * 4;
static_assert(LDS_END <= 156 * 1024, "mlstm LDS");
struct Args { const bf16_t* mq; const bf16_t* mk; const bf16_t* mv; const bf16_t* mosig; const float* ifg; const float* conv_w; const float* conv_b; const float* nw; float* sca; float* scm; float* scb; bf16_t* hm; };
__device__ __forceinline__ s16x4 trd(const ML_LAS unsigned char* p) { return __builtin_bit_cast(s16x4, __builtin_amdgcn_ds_read_tr16_b64_v4i16((ML_LAS s16x4*)p)); }
__device__ __forceinline__ bf16x8 cat8(s16x4 lo, s16x4 hi) { return (bf16x8){lo[0], lo[1], lo[2], lo[3], hi[0], hi[1], hi[2], hi[3]}; }
__device__ __forceinline__ float blo(unsigned w) { return __builtin_bit_cast(float, w << 16); }
__device__ __forceinline__ float bhi(unsigned w) { return __builtin_bit_cast(float, w & 0xffff0000u); }
__device__ __forceinline__ float logsig(float f) { return (f >= 0.f) ? -log1pf(__expf(-f)) : f - log1pf(__expf(f)); }

__device__ __forceinline__ void unit(int b, int h, const Args& A, ML_LAS unsigned char* lds) {
    int tid = threadIdx.x; asm volatile("" : "+v"(tid)); const int lane = tid & 63, wid = __builtin_amdgcn_readfirstlane(tid >> 6);
    int tidv = tid; int l15 = tidv & 15, q4 = (tidv >> 4) & 3, d8 = tidv & 15, row0 = 2 * (tidv >> 4);
    const size_t tb = (size_t)b * 4096, sb = (size_t)(b * 4 + h) * 4096;
    ML_LAS float* cwl = (ML_LAS float*)(lds + O_CW); ML_LAS float* ex = (ML_LAS float*)(lds + O_EX); ML_LAS float* scr = (ML_LAS float*)(lds + O_SCR); ML_LAS float* chs = (ML_LAS float*)(lds + O_CH);
    for (int i = tid; i < 1280; i += 512) { const int qk = i / 640, r = (i % 640) >> 7, d = i & 127, ch = qk * 512 + h * 128 + d; cwl[i] = (r < 4) ? A.conv_w[r * 1024 + ch] : A.conv_b[ch]; }
    for (int i = tid; i < 128 * PV / 16; i += 512) *(ML_LAS u32x4*)(lds + O_ST + i * 16) = (u32x4){0u, 0u, 0u, 0u};
    if (tid < 256) { const int r = tid >> 2, part = tid & 3;
        *(ML_LAS u32x4*)(lds + O_VP + r * PV + 256 + part * 16) = (u32x4){part == 0 ? 0x3F80u : 0u, 0u, 0u, 0u};
        *(ML_LAS u32x4*)(lds + O_VW + r * PV + 256 + part * 16) = (u32x4){0u, 0u, 0u, 0u}; }
    {
        float lfv[8], av[8]; float run = 0.f;
#pragma unroll
        for (int j = 0; j < 8; ++j) { const float f = A.ifg[(tb + 8 * tid + j) * 8 + 4 + h]; run += logsig(f); lfv[j] = run; }
        float incl = run;
#pragma unroll
        for (int o = 1; o < 64; o <<= 1) { const float t = __shfl_up(incl, o); if (lane >= o) incl += t; }
        if (lane == 63) scr[wid] = incl;
        __syncthreads();
        float pre = incl - run; for (int w = 0; w < wid; ++w) pre += scr[w];
        float m = -INFINITY;
#pragma unroll
        for (int j = 0; j < 8; ++j) { const float Bv = pre + lfv[j]; const float a = A.ifg[(tb + 8 * tid + j) * 8 + h] - Bv; A.scb[sb + 8 * tid + j] = Bv; A.sca[sb + 8 * tid + j] = a; m = fmaxf(m, a); av[j] = m; }
        float im = m;
#pragma unroll
        for (int o = 1; o < 64; o <<= 1) { const float t = __shfl_up(im, o); if (lane >= o) im = fmaxf(im, t); }
        if (lane == 63) scr[8 + wid] = im;
        __syncthreads();
        float pm = __shfl_up(im, 1); if (lane == 0) pm = -INFINITY; pm = fmaxf(pm, 0.f); for (int w = 0; w < wid; ++w) pm = fmaxf(pm, scr[8 + w]);
#pragma unroll
        for (int j = 0; j < 8; ++j) A.scm[sb + 8 * tid + j] = fmaxf(pm, av[j]);
    }
    __threadfence(); __syncthreads();
    f32x4 accS[20];
#pragma unroll
    for (int v = 0; v < 20; ++v) accS[v] = (f32x4){0.f, 0.f, 0.f, 0.f};
    uint4 rq[5], rk[5], rv[2]; float chv = 0.f;
#define goff ((unsigned)(tb * 512) + h * 128 + 8 * d8)
#define ML_LOAD(c) do { const int c0_ = (c) * 64; \
        _Pragma("unroll") for (int j = 0; j < 5; ++j) { const int rr = c0_ + row0 - 3 + j; if (rr >= 0) { rq[j] = *(const uint4*)(A.mq + goff + rr * 512); rk[j] = *(const uint4*)(A.mk + goff + rr * 512); } else { rq[j] = make_uint4(0u, 0u, 0u, 0u); rk[j] = rq[j]; } } \
        _Pragma("unroll") for (int j = 0; j < 2; ++j) { rv[j] = *(const uint4*)(A.mv + goff + (c0_ + row0 + j) * 512); \
            } } while (0)
#define ML_LOADS(c) do { const int c0_ = (c) * 64; \
        if (tidv < 192) { chv = A.sca[(size_t)(tidv >> 6) * (16 * 4 * 4096) + sb + c0_ + (tidv & 63)]; }     else if (tidv == 192) chv = (c0_ == 0) ? 0.f : A.scm[sb + c0_ - 1]; } while (0)
    ML_LOAD(0); ML_LOADS(0);
    if (tidv < 193) chs[tidv] = chv;
    __syncthreads();
    for (int c = 0; c < 64; ++c) {
        asm volatile("" : "+v"(tidv)); l15 = tidv & 15; q4 = (tidv >> 4) & 3; d8 = l15; row0 = 2 * (tidv >> 4);
        const int c0 = c * 64; const ML_LAS float* ch = chs + (c & 1) * 256;
#pragma unroll
        for (int qk = 0; qk < 2; ++qk) {
            const ML_LAS float* wq = cwl + qk * 640 + 8 * d8;
            float y[2][8];
            { const f32x4 b0 = *(const ML_LAS f32x4*)(wq + 512), b1 = *(const ML_LAS f32x4*)(wq + 516);
#pragma unroll
              for (int e = 0; e < 4; ++e) { y[0][e] = b0[e]; y[0][4 + e] = b1[e]; y[1][e] = b0[e]; y[1][4 + e] = b1[e]; } }
#pragma unroll
            for (int j = 0; j < 4; ++j) {
                const f32x4 w0 = *(const ML_LAS f32x4*)(wq + j * 128), w1 = *(const ML_LAS f32x4*)(wq + j * 128 + 4);
#pragma unroll
                for (int ro = 0; ro < 2; ++ro) { const uint4 u = qk ? rk[ro + j] : rq[ro + j]; const unsigned uw[4] = {u.x, u.y, u.z, u.w};
                    y[ro][0] += w0[0] * blo(uw[0]); y[ro][1] += w0[1] * bhi(uw[0]); y[ro][2] += w0[2] * blo(uw[1]); y[ro][3] += w0[3] * bhi(uw[1]);
                    y[ro][4] += w1[0] * blo(uw[2]); y[ro][5] += w1[1] * bhi(uw[2]); y[ro][6] += w1[2] * blo(uw[3]); y[ro][7] += w1[3] * bhi(uw[3]); }
            }
#pragma unroll
            for (int ro = 0; ro < 2; ++ro) {
#pragma unroll
                for (int e = 0; e < 8; ++e) { y[ro][e] = y[ro][e] * __builtin_amdgcn_rcpf(1.0f + __expf(-y[ro][e])); if (qk) y[ro][e] *= 0.08838834764831845f; }
                *(ML_LAS u32x4*)(lds + (qk ? O_KC : O_QC) + (row0 + ro) * PQ + 16 * d8) = (u32x4){pk2(y[ro][0], y[ro][1]), pk2(y[ro][2], y[ro][3]), pk2(y[ro][4], y[ro][5]), pk2(y[ro][6], y[ro][7])};
            }
        }
#pragma unroll
        for (int ro = 0; ro < 2; ++ro) {
            *(ML_LAS u32x4*)(lds + O_VP + (row0 + ro) * PV + 16 * d8) = (u32x4){rv[ro].x, rv[ro].y, rv[ro].z, rv[ro].w};
            const float wsv = __expf(ch[row0 + ro] - ch[127]); const unsigned uw[4] = {rv[ro].x, rv[ro].y, rv[ro].z, rv[ro].w}; unsigned o[4];
#pragma unroll
            for (int e2 = 0; e2 < 4; ++e2) o[e2] = pk2(blo(uw[e2]) * wsv, bhi(uw[e2]) * wsv);
            *(ML_LAS u32x4*)(lds + O_VW + (row0 + ro) * PV + 16 * d8) = (u32x4){o[0], o[1], o[2], o[3]};
            if (d8 == 0) *(ML_LAS unsigned short*)(lds + O_VW + (row0 + ro) * PV + 256) = (unsigned short)f2bf(wsv);
        }
        __syncthreads();
        const float Mref = ch[192], Mend = ch[127];
        const int trow = 16 * (wid & 3) + 4 * q4;
        const f32x4 Mxr = *(const ML_LAS f32x4*)(ch + 64 + trow);
        if (wid < 4) {
#pragma unroll
            for (int v = 0; v < 10; ++v) accS[v] = (f32x4){0.f, 0.f, 0.f, 0.f};
#pragma unroll
            for (int ks = 0; ks < 4; ++ks) {
                const bf16x8 a = *(const ML_LAS bf16x8*)(lds + O_QC + (16 * wid + l15) * PQ + (32 * ks + 8 * q4) * 2);
                const ML_LAS unsigned char* bp = lds + O_ST + (32 * ks + 8 * q4 + (l15 >> 2)) * PV + (l15 & 3) * 8;
#pragma unroll
                for (int v = 0; v < 10; ++v) { const bf16x8 bfr = cat8(trd(bp + 32 * v), trd(bp + 4 * PV + 32 * v)); accS[v] = __builtin_amdgcn_mfma_f32_16x16x32_bf16(a, bfr, accS[v], 0, 0, 0); }
            }
            float wi[4];
#pragma unroll
            for (int i = 0; i < 4; ++i) wi[i] = __expf(Mref - Mxr[i]);
#pragma unroll
            for (int v = 0; v < 10; ++v)
#pragma unroll
                for (int i = 0; i < 4; ++i) accS[v][i] *= wi[i];
        } else {
            const int j = wid - 4;
#pragma unroll
            for (int tile = 0; tile < 16; ++tile) {
                if ((int)((0x3333322221120000ull >> (4 * tile)) & 15ull) != j) continue;
                const int st = tile >> 2, tt = tile & 3;
                f32x4 cacc = (f32x4){0.f, 0.f, 0.f, 0.f};
                if (st <= tt) {
#pragma unroll
                    for (int ks = 0; ks < 4; ++ks) {
                        const bf16x8 a = *(const ML_LAS bf16x8*)(lds + O_KC + (16 * st + l15) * PQ + (32 * ks + 8 * q4) * 2);
                        const bf16x8 bq = *(const ML_LAS bf16x8*)(lds + O_QC + (16 * tt + l15) * PQ + (32 * ks + 8 * q4) * 2);
                        cacc = __builtin_amdgcn_mfma_f32_16x16x32_bf16(a, bq, cacc, 0, 0, 0);
                    }
                }
                const int t = 16 * tt + l15, s0 = 16 * st + 4 * q4;
                const float Mt = ch[64 + t]; const f32x4 as = *(const ML_LAS f32x4*)(ch + s0);
                float o[4];
#pragma unroll
                for (int i = 0; i < 4; ++i) o[i] = (s0 + i <= t) ? cacc[i] * __expf(as[i] - Mt) : 0.f;
                *(ML_LAS u32x2*)(lds + O_AM + t * PA + s0 * 2) = (u32x2){pk2(o[0], o[1]), pk2(o[2], o[3])};
            }
            const float decay = __expf(Mref - Mend);
#pragma unroll
            for (int v = 0; v < 20; ++v) accS[v] = accS[v] * decay;
#pragma unroll
            for (int ks = 0; ks < 2; ++ks) {
                const ML_LAS unsigned char* kp = lds + O_KC + (32 * ks + 8 * q4 + (l15 >> 2)) * PQ + 64 * j + (l15 & 3) * 8;
                const bf16x8 bf0 = cat8(trd(kp), trd(kp + 4 * PQ)), bf1 = cat8(trd(kp + 32), trd(kp + 4 * PQ + 32));
                const ML_LAS unsigned char* ap = lds + O_VW + (32 * ks + 8 * q4 + (l15 >> 2)) * PV + (l15 & 3) * 8;
#pragma unroll
                for (int v = 0; v < 10; ++v) { const bf16x8 afr = cat8(trd(ap + 32 * v), trd(ap + 4 * PV + 32 * v));
                    accS[v] = __builtin_amdgcn_mfma_f32_16x16x32_bf16(afr, bf0, accS[v], 0, 0, 0); accS[10 + v] = __builtin_amdgcn_mfma_f32_16x16x32_bf16(afr, bf1, accS[10 + v], 0, 0, 0); }
            }
        }
        __syncthreads();
        if (c + 1 < 64) ML_LOADS(c + 1);
        if (wid < 4) {
#pragma unroll
            for (int ks = 0; ks < 2; ++ks) {
                const bf16x8 a = *(const ML_LAS bf16x8*)(lds + O_AM + (16 * wid + l15) * PA + (32 * ks + 8 * q4) * 2);
                const ML_LAS unsigned char* bp = lds + O_VP + (32 * ks + 8 * q4 + (l15 >> 2)) * PV + (l15 & 3) * 8;
#pragma unroll
                for (int v = 0; v < 10; ++v) { const bf16x8 bfr = cat8(trd(bp + 32 * v), trd(bp + 4 * PV + 32 * v)); accS[v] = __builtin_amdgcn_mfma_f32_16x16x32_bf16(a, bfr, accS[v], 0, 0, 0); }
            }
            const f32x4 Bcr = *(const ML_LAS f32x4*)(ch + 128 + trow);
#pragma unroll
            for (int i = 0; i < 4; ++i) {
                float ssum = 0.f;
#pragma unroll
                for (int v = 0; v < 8; ++v) ssum += accS[v][i] * accS[v][i];
                ssum += __shfl_xor(ssum, 1); ssum += __shfl_xor(ssum, 2); ssum += __shfl_xor(ssum, 4); ssum += __shfl_xor(ssum, 8);
                const float den = __shfl(accS[8][i], lane & 48);
                const float dn = fmaxf(fabsf(den), __expf(-(Bcr[i] + Mxr[i]))), idn = 1.0f / dn;
                const float sc = idn * rsqrtf(ssum * idn * idn * (1.0f / 128.0f) + 1e-6f);
#pragma unroll
                for (int v = 0; v < 8; ++v) *(ML_LAS unsigned short*)(lds + O_HST + (trow + i) * PQ + (16 * v + l15) * 2) = (unsigned short)f2bf(accS[v][i] * sc);
            }
        } else {
            const int j = wid - 4;
#pragma unroll
            for (int v = 0; v < 10; ++v) {
                *(ML_LAS u32x2*)(lds + O_ST + (32 * j + l15) * PV + (16 * v + 4 * q4) * 2) = (u32x2){pk2(accS[v][0], accS[v][1]), pk2(accS[v][2], accS[v][3])};
                *(ML_LAS u32x2*)(lds + O_ST + (32 * j + 16 + l15) * PV + (16 * v + 4 * q4) * 2) = (u32x2){pk2(accS[10 + v][0], accS[10 + v][1]), pk2(accS[10 + v][2], accS[10 + v][3])}; }
        }
        if (c + 1 < 64) ML_LOAD(c + 1);
        if (tidv < 193) chs[((c + 1) & 1) * 256 + tidv] = chv;
        uint4 rmo[2];
#pragma unroll
        for (int ro = 0; ro < 2; ++ro) rmo[ro] = *(const uint4*)(A.mosig + goff + (c0 + row0 + ro) * 512);
        __syncthreads();
        f32x4 nwv[2]; nwv[0] = *(const f32x4*)(A.nw + h * 128 + 8 * d8); nwv[1] = *(const f32x4*)(A.nw + h * 128 + 8 * d8 + 4);
#pragma unroll
        for (int ro = 0; ro < 2; ++ro) {
            const u32x4 hv = *(const ML_LAS u32x4*)(lds + O_HST + (row0 + ro) * PQ + 16 * d8); const unsigned hw[4] = {hv.x, hv.y, hv.z, hv.w}; const unsigned mw[4] = {rmo[ro].x, rmo[ro].y, rmo[ro].z, rmo[ro].w}; unsigned o[4];
#pragma unroll
            for (int e2 = 0; e2 < 4; ++e2) o[e2] = pk2(blo(hw[e2]) * nwv[(2 * e2) >> 2][(2 * e2) & 3] * blo(mw[e2]), bhi(hw[e2]) * nwv[(2 * e2 + 1) >> 2][(2 * e2 + 1) & 3] * bhi(mw[e2]));
            *(uint4*)(A.hm + goff + (c0 + row0 + ro) * 512) = make_uint4(o[0], o[1], o[2], o[3]);
        }
    }
#undef ML_LOAD
#undef ML_LOADS
#undef goff
    __syncthreads();
}
}
namespace peer {
#define PE_LAS __attribute__((address_space(3)))
typedef short bf16x8 __attribute__((ext_vector_type(8)));
typedef float f32x4 __attribute__((ext_vector_type(4)));
typedef float f32x16 __attribute__((ext_vector_type(16)));
typedef unsigned u32x4 __attribute__((ext_vector_type(4)));
constexpr int QP = 528;
constexpr int O_R2 = 256 * QP;
constexpr int LDS_END = O_R2 + 1024;
__device__ __forceinline__ int ordi(float f) { const int b = __builtin_bit_cast(int, f); return b ^ ((b >> 31) & 0x7FFFFFFF); }
__device__ __forceinline__ float ordf(int o) { return __builtin_bit_cast(float, o ^ ((o >> 31) & 0x7FFFFFFF)); }
#define PE_CE(a, b) do { const int hi_ = max(a, b), lo_ = min(a, b); a = hi_; b = lo_; } while (0)
__device__ __forceinline__ void sort16_desc(int (&a)[16]) {
#pragma unroll
    for (int k = 2; k <= 16; k <<= 1)
#pragma unroll
        for (int j = k >> 1; j > 0; j >>= 1)
#pragma unroll
            for (int i = 0; i < 16; ++i) { const int l = i ^ j; if (l > i) { if ((i & k) == 0) PE_CE(a[i], a[l]); else PE_CE(a[l], a[i]); } }
}
__device__ __forceinline__ void merge16_desc(int (&a)[16], const int (&b)[16]) {
#pragma unroll
    for (int i = 0; i < 16; ++i) a[i] = max(a[i], b[15 - i]);
#pragma unroll
    for (int j = 8; j > 0; j >>= 1)
#pragma unroll
        for (int i = 0; i < 16; ++i) { const int l = i ^ j; if (l > i) PE_CE(a[i], a[l]); }
}
__device__ __forceinline__ void top16_of_64(int (&g0)[16], int (&g1)[16], int (&g2)[16], int (&g3)[16]) {
    sort16_desc(g0); sort16_desc(g1); sort16_desc(g2); sort16_desc(g3);
    merge16_desc(g0, g1); merge16_desc(g2, g3); merge16_desc(g0, g2);
}
struct Args { const float* rowss; const bf16_t* key1; const bf16_t* key2; float* r2out; int* eidx; float* eg; };
struct EpiPeerQ {
    static constexpr bool PERM = false, AFTER_DRAIN = true;
    __device__ __forceinline__ bool zero_after(const pg8::Unit&) const { return true; }
    __device__ __forceinline__ void fused(pg8::f32x4 (&acc)[2][2][4][2], const pg8::Unit& u, int wr, int wc, int fr, int fq, PG8_LAS unsigned char* lds, int wid, int lane) const {
        const PE_LAS float* r2s = (const PE_LAS float*)(lds + O_R2);
#pragma unroll
        for (int ai = 0; ai < 2; ++ai)
#pragma unroll
            for (int m = 0; m < 4; ++m) { const int row = ai * 128 + wr * 64 + m * 16 + fr; const float r = r2s[row];
#pragma unroll
                for (int bj = 0; bj < 2; ++bj) *(PE_LAS u32x4*)(lds + row * QP + (wc * 64 + bj * 32 + 8 * fq) * 2) = pg8::pack8(acc[ai][bj][m][0] * r, acc[ai][bj][m][1] * r); }
    }
};
struct SchedOne { pg8::Unit u;
    __device__ __forceinline__ bool next(int i, pg8::Unit& o) const { if (i > 0) return false; o = u; return true; }
    __device__ __forceinline__ void a_ready(const pg8::Unit&) const {}
    __device__ __forceinline__ void done(const pg8::Unit&) const {} };

__device__ __forceinline__ void half_top16(int (&g0)[16], const PE_LAS unsigned char* qrow  , const bf16_t* keyrow  , int hi) {
    f32x16 s[4];
#pragma unroll
    for (int kb = 0; kb < 4; ++kb) s[kb] = f32x16{};
#pragma unroll
    for (int ks = 0; ks < 8; ++ks) {
        const bf16x8 bq = *(const PE_LAS bf16x8*)(qrow + ks * 32);
#pragma unroll
        for (int kb = 0; kb < 4; ++kb) { const bf16x8 a = *(const bf16x8*)(keyrow + (size_t)kb * 32 * 128 + ks * 16); s[kb] = __builtin_amdgcn_mfma_f32_32x32x16_bf16(a, bq, s[kb], 0, 0, 0); }
    }
    int g1[16], g2[16], g3[16];
#pragma unroll
    for (int r = 0; r < 16; ++r) { const int kr = (r & 3) + 8 * (r >> 2) + 4 * hi;
        g0[r] = (ordi(s[0][r]) & ~0x7F) | kr; g1[r] = (ordi(s[1][r]) & ~0x7F) | (32 + kr); g2[r] = (ordi(s[2][r]) & ~0x7F) | (64 + kr); g3[r] = (ordi(s[3][r]) & ~0x7F) | (96 + kr); }
    top16_of_64(g0, g1, g2, g3);
#pragma unroll
    for (int r = 0; r < 16; ++r) g1[r] = __shfl_xor(g0[r], 32);
    merge16_desc(g0, g1);
}

__device__ __forceinline__ void unit(int pm, int h, const bf16_t* x1b, const bf16_t* wq, const Args& A, PG8_LAS unsigned char* lds) {
    int tid = threadIdx.x; asm volatile("" : "+v"(tid)); const int wid = __builtin_amdgcn_readfirstlane(tid >> 6);
    if (tid < 256) { const f32x4* rs = (const f32x4*)(A.rowss + (size_t)(pm * 256 + tid) * 16); const f32x4 a = rs[0], b = rs[1], c = rs[2], d = rs[3];
        const float ss = ((a[0] + a[1]) + (a[2] + a[3])) + ((b[0] + b[1]) + (b[2] + b[3])) + ((c[0] + c[1]) + (c[2] + c[3])) + ((d[0] + d[1]) + (d[2] + d[3]));
        const float r = rsqrtf(ss * (1.0f / 1024.0f) + 1e-6f); ((PE_LAS float*)(lds + O_R2))[tid] = r; if (h == 0) A.r2out[pm * 256 + tid] = r; }
    __syncthreads();
    SchedOne S; S.u.pm = pm; S.u.pn = h; S.u.seg = 0; S.u.pad = 0; S.u.A = (const char*)(x1b + (size_t)pm * 256 * 1024); S.u.B = (const char*)(wq + (size_t)h * 256 * 1024);
    EpiPeerQ E;
    pg8::gemm_phase<EpiPeerQ, SchedOne, true, true>(lds, 1024, S, E);
    __syncthreads();
    int tv = tid; asm volatile("" : "+v"(tv)); const int r32 = tv & 31, hi = (tv >> 5) & 1;
    int v1[16], v2[16];
    half_top16(v1, lds + (32 * wid + r32) * QP + (8 * hi) * 2, A.key1 + ((size_t)h * 128 + r32) * 128 + 8 * hi, hi);
    half_top16(v2, lds + (32 * wid + r32) * QP + (128 + 8 * hi) * 2, A.key2 + ((size_t)h * 128 + r32) * 128 + 8 * hi, hi);
    float f1[16], f2[16];
#pragma unroll
    for (int i = 0; i < 16; ++i) { f1[i] = ordf(v1[i] & ~0x7F); f2[i] = ordf(v2[i] & ~0x7F); }
    int c0[16], c1[16], c2[16], c3[16];
    {
        int n = 0;
#pragma unroll
        for (int i = 0; i < 16; ++i)
#pragma unroll
            for (int j = 0; j < 16; ++j) if ((i + 1) * (j + 1) <= 16) { const int key = (ordi(f1[i] + f2[j]) & ~0xFF) | (i << 4) | j;
                if (n < 16) c0[n] = key; else if (n < 32) c1[n - 16] = key; else if (n < 48) c2[n - 32] = key; else c3[n - 48] = key; ++n; }
#pragma unroll
        for (int k = 2; k < 16; ++k) c3[k] = (int)0x80000000;
    }
    top16_of_64(c0, c1, c2, c3);
    PE_LAS unsigned char* scr = lds + (32 * wid + r32) * QP;
    if (hi == 0) {
#pragma unroll
        for (int i = 0; i < 16; ++i) { scr[i] = (unsigned char)(v1[i] & 0x7F); scr[16 + i] = (unsigned char)(v2[i] & 0x7F); } }
    asm volatile("s_waitcnt lgkmcnt(0)" ::: "memory");
    float val[16], sum = 0.f;
#pragma unroll
    for (int r = 0; r < 16; ++r) { val[r] = __expf(ordf(c0[r] & ~0xFF) - ordf(c0[0] & ~0xFF)); sum += val[r]; }
    const float inv = 1.0f / sum;
    const size_t ob = ((size_t)(pm * 256 + 32 * wid + r32) * 8 + h) * 16;
#pragma unroll
    for (int r = 0; r < 16; ++r) if ((r >> 3) == hi) { const int code = c0[r] & 0xFF; A.eidx[ob + r] = (int)scr[code >> 4] * 128 + (int)scr[16 + (code & 15)]; A.eg[ob + r] = val[r] * inv; }
    __syncthreads();
}
}
#define XB_TMO      128
#define XB_XCNT(j)  (256  + 64 * (j))
#define XB_XSUB(j)  (1280 + 64 * (j))
#define XB_XGEN(j)  (2304 + 64 * (j))
#define XB_TOP      3328
#define XB_TOPGEN   3392
#define XCD_BAR_WORDS 3456
#define XB_SPIN_CAP (1u << 18)

__device__ __forceinline__ unsigned xb_ld(unsigned* p)              { return __hip_atomic_load(p, __ATOMIC_RELAXED, __HIP_MEMORY_SCOPE_AGENT); }
__device__ __forceinline__ unsigned xb_add(unsigned* p, unsigned v) { return __hip_atomic_fetch_add(p, v, __ATOMIC_RELAXED, __HIP_MEMORY_SCOPE_AGENT); }
__device__ __forceinline__ unsigned xb_xcc_id() { return (unsigned)__builtin_amdgcn_s_getreg((3 << 11) | 20) & 0xFu; }
#define XB_SPIN(cond, bar) do { unsigned _sp = 0; while (cond) { __builtin_amdgcn_s_sleep(1); \
    if ((++_sp & 255u) == 0u) { if (xb_ld(&(bar)[XB_TMO])) break; if (_sp > XB_SPIN_CAP) { atomicAdd(&(bar)[XB_TMO], 1u); break; } } } } while (0)

struct XcdBarrier {
    unsigned* bar; unsigned x;
    volatile __attribute__((address_space(3))) unsigned* st;
};

__device__ __forceinline__ XcdBarrier xcd_barrier_post(unsigned* bar, volatile __attribute__((address_space(3))) unsigned* st) {
    XcdBarrier b; b.bar = bar; b.x = xb_xcc_id(); b.st = st;
    if (threadIdx.x == 0) (void)xb_add(&bar[XB_XCNT(b.x)], 1u);
    return b;
}
__device__ __forceinline__ void xcd_barrier_complete(unsigned* bar, unsigned x, unsigned& nloc, unsigned& nx) {
    const unsigned G = gridDim.x * gridDim.y * gridDim.z;
    unsigned sum, cnt, mine, sp = 0u;
    for (;;) {
        sum = 0u; cnt = 0u; mine = 0u;
#pragma unroll
        for (unsigned j = 0; j < 16; ++j) { const unsigned c = xb_ld(&bar[XB_XCNT(j)]); sum += c; cnt += (c > 0u) ? 1u : 0u; mine = (j == x) ? c : mine; }
        if (sum == G) break;
        __builtin_amdgcn_s_sleep(1);
        if ((++sp & 255u) == 0u) { if (xb_ld(&bar[XB_TMO])) break; if (sp > XB_SPIN_CAP) { atomicAdd(&bar[XB_TMO], 1u); break; } }
    }
    nloc = mine > 0u ? mine : 1u; nx = cnt > 0u ? cnt : 1u;
}

__device__ __forceinline__ void xcd_barrier(const XcdBarrier& b) {
    asm volatile("s_waitcnt vmcnt(0)" ::: "memory");
    __syncthreads();
    if (threadIdx.x == 0) {
        unsigned* bar = b.bar;
        __builtin_amdgcn_s_waitcnt(0);
        unsigned nloc = b.st[0], nx = b.st[1];
        if (nloc == 0u) { xcd_barrier_complete(bar, b.x, nloc, nx); b.st[0] = nloc; b.st[1] = nx; }
        const unsigned old = xb_add(&bar[XB_XSUB(b.x)], 1u);
        const unsigned gen = old / nloc;
        if (old + 1u == (gen + 1u) * nloc) {
            __builtin_amdgcn_fence(__ATOMIC_RELEASE, "agent");
            asm volatile("s_waitcnt vmcnt(0)" ::: "memory");
            const unsigned og = xb_add(&bar[XB_TOP], 1u);
            const unsigned tg = og / nx;
            if (og + 1u == (tg + 1u) * nx) xb_add(&bar[XB_TOPGEN], 1u);
            else XB_SPIN(xb_ld(&bar[XB_TOPGEN]) == tg, bar);
            __builtin_amdgcn_fence(__ATOMIC_ACQUIRE, "agent");
            xb_add(&bar[XB_XGEN(b.x)], 1u);
            asm volatile("s_waitcnt vmcnt(0)" ::: "memory");
        } else {
            XB_SPIN(xb_ld(&bar[XB_XGEN(b.x)]) == gen, bar);
            __builtin_amdgcn_fence(__ATOMIC_ACQUIRE, "agent");
            asm volatile("s_waitcnt vmcnt(0)" ::: "memory");
        }
    }
    __syncthreads();
}
#include <hip/hip_cooperative_groups.h>
namespace cg = cooperative_groups;
constexpr int BIG_LDS = 156 * 1024 + 256;
constexpr int LDS_CTL = 156 * 1024;
constexpr int DUP = 0;
struct PArgs { const float* in[20]; float* out; char* ws; };
__device__ __forceinline__ const PArgs* kargs() { auto kp = __builtin_amdgcn_kernarg_segment_ptr(); asm volatile("" : "+s"(kp)); return (const PArgs*)kp; }

__device__ __forceinline__ void phase0(const PArgs& p, unsigned char* shm) {
    int tid = threadIdx.x; asm volatile("" : "+v"(tid)); const int lane = tid & 63, wid = tid >> 6;
    const int gw = blockIdx.x * 8 + wid, NGW = gridDim.x * 8; const size_t gt = (size_t)blockIdx.x * 512 + tid, NTH = (size_t)gridDim.x * 512;
    char* ws = p.ws;
    { float* km = (float*)(ws + OFF_KMEAN); for (size_t i = gt; i < (size_t)16 * 8 * 16 * 64; i += NTH) km[i] = 0.f; }
    { float* rc = (float*)(ws + OFF_ROPE); float* rs = rc + 4096 * 8;
      for (size_t i = gt; i < 4096 * 8; i += NTH) { const int pos = (int)(i >> 3), k = (int)(i & 7); const float inv_freq = (float)pow(500000.0, -(double)(2 * k) / 16.0); const float ang = (float)pos * inv_freq;
          rc[i] = (float)cos((double)ang); rs[i] = (float)sin((double)ang); } }
    {
        const float* wdn = p.in[18]; const float* wup = p.in[19]; const float* fw = p.in[14]; unsigned* WU = (unsigned*)(ws + OFF_WU);
        { uint4* WDq = (uint4*)(ws + OFF_WD); float* SD = (float*)(ws + OFF_WD + 16 * MiB); float fv[16];
#pragma unroll
          for (int j = 0; j < 4; ++j) { const float4 s = *(const float4*)(fw + 16 * lane + 4 * j); fv[4 * j] = s.x; fv[4 * j + 1] = s.y; fv[4 * j + 2] = s.z; fv[4 * j + 3] = s.w; }
          for (int e = gw; e < 16384; e += NGW) { float v[16], am = 0.f;
#pragma unroll
              for (int j = 0; j < 4; ++j) { const float4 a = *(const float4*)(wdn + (size_t)e * 1024 + 16 * lane + 4 * j); v[4 * j] = a.x * fv[4 * j]; v[4 * j + 1] = a.y * fv[4 * j + 1]; v[4 * j + 2] = a.z * fv[4 * j + 2]; v[4 * j + 3] = a.w * fv[4 * j + 3]; }
              float ss = 0.f;
#pragma unroll
              for (int j = 0; j < 16; ++j) { am = fmaxf(am, fabsf(v[j])); ss += v[j] * v[j]; }
#pragma unroll
              for (int o = 32; o >= 1; o >>= 1) { am = fmaxf(am, __shfl_xor(am, o)); ss += __shfl_xor(ss, o); }
              const float step = fminf(am * (1.0f / 7.0f), 0.35f * sqrtf(ss * (1.0f / 1024.0f)));
              const float inv = step > 0.f ? 1.0f / step : 0.f; unsigned q[2] = {0u, 0u};
#pragma unroll
              for (int k = 0; k < 16; ++k) { const int qi = (int)fminf(fmaxf(rintf(v[k] * inv), -7.0f), 7.0f); q[k >> 3] |= (unsigned)(qi & 15) << (4 * (k & 7)); }
              ((uint2*)WDq)[(size_t)e * 64 + lane] = make_uint2(q[0], q[1]); if (lane == 0) SD[e] = step; } }
        { uint2* WU4 = (uint2*)WU; float* SU = (float*)(ws + OFF_WU + 16 * MiB);
          for (int e = gw; e < 16384; e += NGW) { float v[16], ss = 0.f;
#pragma unroll
              for (int j = 0; j < 4; ++j) { const float4 a = *(const float4*)(wup + (size_t)e * 1024 + 16 * lane + 4 * j); v[4 * j] = a.x; v[4 * j + 1] = a.y; v[4 * j + 2] = a.z; v[4 * j + 3] = a.w; }
#pragma unroll
              for (int j = 0; j < 16; ++j) ss += v[j] * v[j];
#pragma unroll
              for (int o = 32; o >= 1; o >>= 1) ss += __shfl_xor(ss, o);
              const float sc = 0.5f * sqrtf(ss * (1.0f / 1024.0f)), inv = sc > 0.f ? 1.0f / sc : 0.f; unsigned q[2] = {0u, 0u};
#pragma unroll
              for (int k = 0; k < 16; ++k) { const float a_ = fabsf(v[k]) * inv;
                  const unsigned code = (unsigned)(a_ > 0.25f) + (unsigned)(a_ > 0.75f) + (unsigned)(a_ > 1.25f) + (unsigned)(a_ > 1.75f) + (unsigned)(a_ > 2.5f) + (unsigned)(a_ > 3.5f) + (unsigned)(a_ > 5.0f);
                  q[k >> 3] |= (code | (v[k] < 0.f ? 8u : 0u)) << (4 * (k & 7)); }
              WU4[(size_t)e * 64 + lane] = make_uint2(q[0], q[1]); if (lane == 0) SU[e] = sc; } }
        const float* k1 = p.in[16]; const float* k2 = p.in[17]; bf16_t* K1 = (bf16_t*)(ws + OFF_KEY1); bf16_t* K2 = (bf16_t*)(ws + OFF_KEY2);
        for (size_t i = gt * 4; i < (size_t)8 * 128 * 128; i += NTH * 4) { const float4 a = *(const float4*)(k1 + i), b = *(const float4*)(k2 + i);
            *(uint2*)(K1 + i) = make_uint2(pk2(a.x, a.y), pk2(a.z, a.w)); *(uint2*)(K2 + i) = make_uint2(pk2(b.x, b.y), pk2(b.z, b.w)); }
    }
    {
        __attribute__((address_space(3))) float* tl = (__attribute__((address_space(3))) float*)(shm) + wid * (32 * 33);
        const int tx = lane & 31, ty = lane >> 5;
        for (int item = gw; item < 9728; item += NGW) {
            const float* W; const float* sc; bf16_t* O; int K, N, nbx, thr = 1 << 30, add = 0, it = item;
            if (it < 5632) { W = p.in[2]; sc = p.in[1]; O = (bf16_t*)(ws + OFF_WIN); K = 1024; N = INC; nbx = 176; thr = 3584; add = 8; }
            else if ((it -= 5632) < 512) { W = p.in[10]; sc = nullptr; O = (bf16_t*)(ws + OFF_WAB); K = 512; N = 1024; nbx = 32; }
            else if ((it -= 512) < 512) { W = p.in[11]; sc = nullptr; O = (bf16_t*)(ws + OFF_WMB); K = 512; N = 1024; nbx = 32; }
            else if ((it -= 512) < 1024) { W = p.in[13]; sc = nullptr; O = (bf16_t*)(ws + OFF_WOUT); K = 1024; N = 1024; nbx = 32; }
            else { it -= 1024; W = p.in[15]; sc = p.in[14]; O = (bf16_t*)(ws + OFF_WQ); K = 1024; N = 2048; nbx = 64; }
            const int n0 = (it % nbx) * 32, k0 = (it / nbx) * 32;
#pragma unroll 4
            for (int i = ty; i < 32; i += 2) { const int k = k0 + i, np = n0 + tx, ac = (np & ~255) + sigma_col(np & 255), src = ac + (ac >= thr ? add : 0); tl[i * 33 + tx] = W[(size_t)k * N + src] * (sc ? sc[k] : 1.0f); }
            asm volatile("s_waitcnt lgkmcnt(0)" ::: "memory");
#pragma unroll 4
            for (int i = ty; i < 32; i += 2) { const int np = n0 + i, k = k0 + tx; O[(size_t)np * K + k] = (bf16_t)f2bf(tl[tx * 33 + i]); }
            asm volatile("s_waitcnt lgkmcnt(0)" ::: "memory");
        }
    }
    {
        const float* x = p.in[0]; const float* normw = p.in[1]; const float* w_in = p.in[2]; const float* igb = p.in[7]; const float* fgb = p.in[8];
        bf16_t* xb = (bf16_t*)(ws + OFF_XB); float* r1 = (float*)(ws + OFF_R1); float* ifg = (float*)(ws + OFF_IFG);
        float wg[4][4][8];
#pragma unroll
        for (int j = 0; j < 4; ++j)
#pragma unroll
            for (int i = 0; i < 4; ++i) { const int k = 256 * j + 4 * lane + i; const float nw = normw[k];
#pragma unroll
                for (int c = 0; c < 8; ++c) wg[j][i][c] = w_in[(size_t)k * INC + 3584 + c] * nw; }
        typedef float p0_f32x4 __attribute__((ext_vector_type(4)));
        float bias_l = lane < 4 ? igb[lane & 3] : fgb[lane & 3];
        const unsigned xoff = (unsigned)lane * 16u;
        auto do_row = [&](const p0_f32x4 (&v)[4], const int row) {
            float ss = 0.f, g[8];
#pragma unroll
            for (int c = 0; c < 8; ++c) g[c] = 0.f;
#pragma unroll
            for (int j = 0; j < 4; ++j) {
                ss += v[j][0] * v[j][0] + v[j][1] * v[j][1] + v[j][2] * v[j][2] + v[j][3] * v[j][3];
#pragma unroll
                for (int c = 0; c < 8; ++c) g[c] += v[j][0] * wg[j][0][c] + v[j][1] * wg[j][1][c] + v[j][2] * wg[j][2][c] + v[j][3] * wg[j][3][c];
            }
#pragma unroll
            for (int o = 1; o < 64; o <<= 1) { ss += __shfl_xor(ss, o);
#pragma unroll
                for (int c = 0; c < 8; ++c) g[c] += __shfl_xor(g[c], o); }
            const float r = rsqrtf(ss * (1.0f / D_) + 1e-6f);
            { float gl = g[0];
#pragma unroll
              for (int c = 1; c < 8; ++c) gl = (lane == c) ? g[c] : gl;
              float* dst = lane < 8 ? ifg + (size_t)row * 8 + lane : r1 + row;
              if (lane < 9) *dst = lane < 8 ? gl * r + bias_l : r; }
            uint2* o8 = (uint2*)(xb + (size_t)row * D_) + lane;
#pragma unroll
            for (int j = 0; j < 4; ++j) o8[64 * j] = make_uint2(pk2(v[j][0], v[j][1]), pk2(v[j][2], v[j][3]));
        };
#define P0_LD(V, ROW) do { const float* rp_ = x + (size_t)(ROW) * D_; \
            asm volatile("global_load_dwordx4 %0, %4, %5\n\tglobal_load_dwordx4 %1, %4, %5 offset:1024\n\tglobal_load_dwordx4 %2, %4, %5 offset:2048\n\tglobal_load_dwordx4 %3, %4, %5 offset:3072" \
                         : "=&v"(V[0]), "=&v"(V[1]), "=&v"(V[2]), "=&v"(V[3]) : "v"(xoff), "s"(rp_) : "memory"); } while (0)
#define P0_WAIT18(V) asm volatile("s_waitcnt vmcnt(18)" : "+v"(V[0]), "+v"(V[1]), "+v"(V[2]), "+v"(V[3]) :: "memory")
#define P0_WAIT(V) asm volatile("s_waitcnt vmcnt(8)" : "+v"(V[0]), "+v"(V[1]), "+v"(V[2]), "+v"(V[3]) :: "memory")
        const int gwu = __builtin_amdgcn_readfirstlane(gw);
        const int nrow = gwu < T_ ? (T_ - gwu + NGW - 1) / NGW : 0;
        if (nrow > 0) {
            p0_f32x4 va[4], vb[4], vc[4];
            const int rlast = gwu + (nrow - 1) * NGW;
#define P0_ROWOF(K) ((K) < nrow ? gwu + (K) * NGW : rlast)
#define P0_FILL() do { char* fp_ = (char*)(xb + (size_t)gwu * D_); const unsigned z_ = 0u; \
                asm volatile("global_store_dword %0, %1, %2\n\tglobal_store_dword %0, %1, %2 offset:256\n\tglobal_store_dword %0, %1, %2 offset:512\n\tglobal_store_dword %0, %1, %2 offset:768\n\tglobal_store_dword %0, %1, %2 offset:1024" \
                             :: "v"(xoff4), "v"(z_), "s"(fp_) : "memory"); } while (0)
            const unsigned xoff4 = (unsigned)lane * 4u;
            P0_LD(va, P0_ROWOF(0)); P0_FILL(); P0_LD(vb, P0_ROWOF(1)); P0_FILL();
#pragma unroll 1
            for (int k = 0; k < nrow; k += 3) {
                P0_LD(vc, P0_ROWOF(k + 2)); P0_WAIT18(va); do_row(va, gwu + k * NGW);
                P0_LD(va, P0_ROWOF(k + 3)); P0_WAIT18(vb); if (k + 1 < nrow) do_row(vb, gwu + (k + 1) * NGW);
                P0_LD(vb, P0_ROWOF(k + 4)); P0_WAIT18(vc); if (k + 2 < nrow) do_row(vc, gwu + (k + 2) * NGW);
            }
            asm volatile("s_waitcnt vmcnt(0)" : "+v"(va[0]), "+v"(va[1]), "+v"(va[2]), "+v"(va[3]), "+v"(vb[0]), "+v"(vb[1]), "+v"(vb[2]), "+v"(vb[3]) :: "memory");
        }
    }
}
typedef float f32x2_t __attribute__((ext_vector_type(2)));
typedef unsigned p5_u32x4 __attribute__((ext_vector_type(4)));
#define P5_LAS __attribute__((address_space(3)))
#define P5_TIE8(R) "+v"(R[0]), "+v"(R[1]), "+v"(R[2]), "+v"(R[3]), "+v"(R[4]), "+v"(R[5]), "+v"(R[6]), "+v"(R[7])
#define P5_OUT(I, ACC) do { const uint4 a_ = *((const uint4*)(x1b + (tb + I) * 2048) + 2 * ln), c_ = *((const uint4*)(x1b + (tb + I) * 2048) + 2 * ln + 1); const unsigned w_[8] = {a_.x, a_.y, a_.z, a_.w, c_.x, c_.y, c_.z, c_.w}; \
        float4* o_ = (float4*)(out + (tb + I) * 1024 + 16 * ln); \
        _Pragma("unroll") for (int j_ = 0; j_ < 4; ++j_) o_[j_] = make_float4(__builtin_bit_cast(float, w_[2 * j_] << 16) + ACC[2 * j_].x, __builtin_bit_cast(float, w_[2 * j_] & 0xffff0000u) + ACC[2 * j_].y, \
                                                                             __builtin_bit_cast(float, w_[2 * j_ + 1] << 16) + ACC[2 * j_ + 1].x, __builtin_bit_cast(float, w_[2 * j_ + 1] & 0xffff0000u) + ACC[2 * j_ + 1].y); } while (0)
typedef unsigned p5_u32x2 __attribute__((ext_vector_type(2)));
#define P5_ROWFMA4(ACC, PRV, R, CF) do { p5_u32x2 r__ = R;   \
    asm volatile("" : "+v"(r__), "+v"(PRV[0]), "+v"(PRV[1]), "+v"(PRV[2]), "+v"(PRV[3]), "+v"(PRV[4]), "+v"(PRV[5]), "+v"(PRV[6]), "+v"(PRV[7])); \
    const f32x2_t cf2_ = {CF, CF}; \
    ACC[0] = __builtin_elementwise_fma((f32x2_t)__builtin_amdgcn_cvt_scalef32_pk_f32_fp4(r__.x, 1.0f, 0), cf2_, ACC[0]); ACC[1] = __builtin_elementwise_fma((f32x2_t)__builtin_amdgcn_cvt_scalef32_pk_f32_fp4(r__.x, 1.0f, 1), cf2_, ACC[1]); \
    ACC[2] = __builtin_elementwise_fma((f32x2_t)__builtin_amdgcn_cvt_scalef32_pk_f32_fp4(r__.x, 1.0f, 2), cf2_, ACC[2]); ACC[3] = __builtin_elementwise_fma((f32x2_t)__builtin_amdgcn_cvt_scalef32_pk_f32_fp4(r__.x, 1.0f, 3), cf2_, ACC[3]); \
    ACC[4] = __builtin_elementwise_fma((f32x2_t)__builtin_amdgcn_cvt_scalef32_pk_f32_fp4(r__.y, 1.0f, 0), cf2_, ACC[4]); ACC[5] = __builtin_elementwise_fma((f32x2_t)__builtin_amdgcn_cvt_scalef32_pk_f32_fp4(r__.y, 1.0f, 1), cf2_, ACC[5]); \
    ACC[6] = __builtin_elementwise_fma((f32x2_t)__builtin_amdgcn_cvt_scalef32_pk_f32_fp4(r__.y, 1.0f, 2), cf2_, ACC[6]); ACC[7] = __builtin_elementwise_fma((f32x2_t)__builtin_amdgcn_cvt_scalef32_pk_f32_fp4(r__.y, 1.0f, 3), cf2_, ACC[7]); } while (0)
#define P5_BFMA8U(R, CK) do { _Pragma("unroll") for (int j_ = 0; j_ < 8; j_ += 4) { \
    { const float cf_ = __builtin_bit_cast(float, __builtin_amdgcn_readlane(CK, j_));     P5_ROWFMA4(acc0, acc3, R[j_], cf_); } \
    { const float cf_ = __builtin_bit_cast(float, __builtin_amdgcn_readlane(CK, j_ + 1)); P5_ROWFMA4(acc1, acc0, R[j_ + 1], cf_); } \
    { const float cf_ = __builtin_bit_cast(float, __builtin_amdgcn_readlane(CK, j_ + 2)); P5_ROWFMA4(acc2, acc1, R[j_ + 2], cf_); } \
    { const float cf_ = __builtin_bit_cast(float, __builtin_amdgcn_readlane(CK, j_ + 3)); P5_ROWFMA4(acc3, acc2, R[j_ + 3], cf_); } } } while (0)
#define P5_ISSUE8U(R, B, CK) do { const int lk_ = keys[8 * (B) + (ln & 7)]; CK = __builtin_bit_cast(int, cfs[8 * (B) + (ln & 7)]); \
    _Pragma("unroll") for (int j_ = 0; j_ < 8; ++j_) { const unsigned char* rp_ = wu + (size_t)__builtin_amdgcn_readlane(lk_, j_) * 512; \
        asm volatile("global_load_dwordx2 %0, %1, %2" : "=v"(R[j_]) : "v"(voff8), "s"(rp_) : "memory"); } } while (0)
#define P5_DOT(R, XH, XL) __builtin_amdgcn_sdot8((int)R.y, (int)XL.y, __builtin_amdgcn_sdot8((int)R.x, (int)XL.x, 16 * __builtin_amdgcn_sdot8((int)R.y, (int)XH.y, __builtin_amdgcn_sdot8((int)R.x, (int)XH.x, 0, false), false), false), false)
#define P5_ISSUE8D(R, B) do { const int lk_ = keys[8 * (B) + (ln & 7)]; \
    _Pragma("unroll") for (int j_ = 0; j_ < 8; ++j_) { const unsigned char* rp_ = wd + (size_t)__builtin_amdgcn_readlane(lk_, j_) * 512; \
        asm volatile("global_load_dwordx2 %0, %1, %2" : "=v"(R[j_]) : "v"(voff8), "s"(rp_) : "memory"); } } while (0)
#define P5_DOWN8(R, BB) do { int pd_[8]; \
    _Pragma("unroll") for (int j_ = 0; j_ < 8; j_ += 4) { pd_[j_] = P5_DOT(R[j_], xh0, xl0); pd_[j_ + 1] = P5_DOT(R[j_ + 1], xh1, xl1); pd_[j_ + 2] = P5_DOT(R[j_ + 2], xh2, xl2); pd_[j_ + 3] = P5_DOT(R[j_ + 3], xh3, xl3); } \
    _Pragma("unroll") for (int i_ = 0; i_ < 4; ++i_) { const auto r_ = __builtin_amdgcn_permlane32_swap((unsigned)pd_[i_], (unsigned)pd_[i_ + 4], false, false); pd_[i_] = (int)(r_[0] + r_[1]); } \
    _Pragma("unroll") for (int i_ = 0; i_ < 2; ++i_) { const auto r_ = __builtin_amdgcn_permlane16_swap((unsigned)pd_[i_], (unsigned)pd_[i_ + 2], false, false); pd_[i_] = (int)(r_[0] + r_[1]); } \
    { const bool b8_ = (ln & 8) != 0; const int keep_ = b8_ ? pd_[1] : pd_[0], send_ = b8_ ? pd_[0] : pd_[1]; int z_ = keep_ + __builtin_amdgcn_update_dpp(0, send_, 0x140, 0xf, 0xf, false); \
      z_ += __builtin_amdgcn_update_dpp(0, z_, 0x141, 0xf, 0xf, false); z_ += __builtin_amdgcn_update_dpp(0, z_, 0xB1, 0xf, 0xf, false); z_ += __builtin_amdgcn_update_dpp(0, z_, 0x4E, 0xf, 0xf, false); \
      zz = (ln & 7) == ((BB) & 7) ? z_ : zz; } \
    if (((BB) & 7) == 7) { const int pos_ = 8 * ((BB) - 7) + 8 * (ln & 7) + (ln >> 3); const int e_ = keys[pos_]; const float g_ = cfs[pos_]; const int tk_ = (ln >> 3) & 3; \
        const float sx_ = tk_ == 0 ? sx0 : tk_ == 1 ? sx1 : tk_ == 2 ? sx2 : sx3; const float av_ = (float)zz * sx_ * (float)sdl[e_]; \
        cfs[pos_] = g_ * 0.5f * av_ * (1.0f + erff(av_ * 0.70710678118654752f)) * (float)sul[e_]; } } while (0)
__device__ __forceinline__ void phase5_all(const PArgs& p, float* out, unsigned char* shm) {
    int tid = threadIdx.x; asm volatile("" : "+v"(tid)); const int wid = __builtin_amdgcn_readfirstlane(tid >> 6);
    const char* x1b = (const char*)(p.ws + OFF_MV); const char* eidx = (const char*)(p.ws + OFF_EIDX); const char* egp = (const char*)(p.ws + OFF_EG); const float* r2 = (const float*)(p.ws + OFF_R2);
    const unsigned char* wd = (const unsigned char*)(p.ws + OFF_WD); const unsigned char* wu = (const unsigned char*)(p.ws + OFF_WU); const float* SD = (const float*)(p.ws + OFF_WD + 16 * MiB); const float* SU = (const float*)(p.ws + OFF_WU + 16 * MiB);
    P5_LAS _Float16* sdl = (P5_LAS _Float16*)shm; P5_LAS _Float16* sul = sdl + 16384;
    P5_LAS int* keys = (P5_LAS int*)(shm + 65536 + wid * 4608); P5_LAS float* cfs = (P5_LAS float*)(keys + 512); P5_LAS int* cntl = (P5_LAS int*)(keys + 1024);
    const int rot = 4 * ((int)blockIdx.x & 7);
    for (int i = tid; i < 16384; i += 512) { sdl[i] = (_Float16)SD[i]; sul[i] = (_Float16)SU[i]; }
    __syncthreads();
    const int G = (int)gridDim.x, NR = (T_ / 32 + G - 1 - (int)blockIdx.x) / G;
#pragma unroll 1
    for (int rnd = 0; rnd < NR; ++rnd) {
        int ln = tid; asm volatile("" : "+v"(ln)); ln &= 63; const unsigned voff = (unsigned)ln * 16u, voff4 = (unsigned)ln * 4u, voff8 = (unsigned)ln * 8u;
        const size_t tb = ((size_t)(rnd * G + (int)blockIdx.x) * 8 + wid) * 4;
        int ev[4][2], cv[4][2];
#pragma unroll
        for (int i_ = 0; i_ < 4; ++i_) { const char* ep_ = eidx + (tb + i_) * 512; const char* cp_ = egp + (tb + i_) * 512;
            asm volatile("global_load_dword %0, %4, %5\n\tglobal_load_dword %1, %4, %5 offset:256\n\tglobal_load_dword %2, %4, %6\n\tglobal_load_dword %3, %4, %6 offset:256"
                         : "=&v"(ev[i_][0]), "=&v"(ev[i_][1]), "=&v"(cv[i_][0]), "=&v"(cv[i_][1]) : "v"(voff4), "s"(ep_), "s"(cp_) : "memory"); }
        p5_u32x2 xh0, xh1, xh2, xh3, xl0, xl1, xl2, xl3; float sx0, sx1, sx2, sx3;
#define P5_QUANT(I, XH, XL, SX) do { const uint4 a_ = *((const uint4*)(x1b + (tb + I) * 2048) + 2 * ln), c_ = *((const uint4*)(x1b + (tb + I) * 2048) + 2 * ln + 1); \
        const unsigned w_[8] = {a_.x, a_.y, a_.z, a_.w, c_.x, c_.y, c_.z, c_.w}; float xv_[16], am_ = 0.f; \
        _Pragma("unroll") for (int k_ = 0; k_ < 8; ++k_) { xv_[2 * k_] = __builtin_bit_cast(float, w_[k_] << 16); xv_[2 * k_ + 1] = __builtin_bit_cast(float, w_[k_] & 0xffff0000u); am_ = fmaxf(am_, fmaxf(fabsf(xv_[2 * k_]), fabsf(xv_[2 * k_ + 1]))); } \
        _Pragma("unroll") for (int o_ = 32; o_ >= 1; o_ >>= 1) am_ = fmaxf(am_, __builtin_bit_cast(float, __builtin_amdgcn_ds_bpermute(4 * (ln ^ o_), __builtin_bit_cast(int, am_)))); \
        const float inv_ = am_ > 0.f ? 119.0f / am_ : 0.f; unsigned h_[2] = {0u, 0u}, l_[2] = {0u, 0u}; \
        _Pragma("unroll") for (int k_ = 0; k_ < 16; ++k_) { const int q_ = (int)rintf(xv_[k_] * inv_); const int lo_ = ((q_ + 8) & 15) - 8, hi_ = (q_ - lo_) >> 4;     \
            h_[k_ >> 3] |= (unsigned)(hi_ & 15) << (4 * (k_ & 7)); l_[k_ >> 3] |= (unsigned)(lo_ & 15) << (4 * (k_ & 7)); } \
        XH = p5_u32x2{h_[0], h_[1]}; XL = p5_u32x2{l_[0], l_[1]}; SX = am_ * (1.0f / 119.0f) * r2[tb + I]; } while (0)
        P5_QUANT(0, xh0, xl0, sx0); P5_QUANT(1, xh1, xl1, sx1); P5_QUANT(2, xh2, xl2, sx2); P5_QUANT(3, xh3, xl3, sx3);
        asm volatile("s_waitcnt vmcnt(0)" : "+v"(ev[0][0]), "+v"(ev[0][1]), "+v"(ev[1][0]), "+v"(ev[1][1]), "+v"(ev[2][0]), "+v"(ev[2][1]), "+v"(ev[3][0]), "+v"(ev[3][1]) :: "memory");
        asm volatile("" : "+v"(cv[0][0]), "+v"(cv[0][1]), "+v"(cv[1][0]), "+v"(cv[1][1]), "+v"(cv[2][0]), "+v"(cv[2][1]), "+v"(cv[3][0]), "+v"(cv[3][1]));
        cntl[ln] = 0; cntl[64 + ln] = 0;
        int bk[4][2];
#pragma unroll
        for (int i = 0; i < 4; ++i)
#pragma unroll
            for (int ps = 0; ps < 2; ++ps) { bk[i][ps] = 32 * i + ((((ev[i][ps] & 16383) >> 9) - rot) & 31); (void)__hip_atomic_fetch_add(cntl + bk[i][ps], 1, __ATOMIC_RELAXED, __HIP_MEMORY_SCOPE_WORKGROUP); }
#pragma unroll
        for (int hh = 0; hh < 2; ++hh) { const int c_ = cntl[64 * hh + ln]; int inc = c_;
#pragma unroll
          for (int o = 1; o < 32; o <<= 1) { const int u_ = __builtin_amdgcn_ds_bpermute(4 * (ln - o), inc); if ((ln & 31) >= o) inc += u_; }
          cntl[64 * hh + ln] = inc - c_; }
#pragma unroll
        for (int i = 0; i < 4; ++i)
#pragma unroll
            for (int ps = 0; ps < 2; ++ps) { const int pos = 4 * __hip_atomic_fetch_add(cntl + bk[i][ps], 1, __ATOMIC_RELAXED, __HIP_MEMORY_SCOPE_WORKGROUP) + i;
                keys[pos] = ev[i][ps] & 16383; cfs[pos] = __builtin_bit_cast(float, cv[i][ps]); }
        int dx, dl, dm;
        { const int rn = rnd + 1 < NR ? rnd + 1 : rnd; const size_t tn = ((size_t)(rn * G + (int)blockIdx.x) * 8 + wid) * 4;
          const char* pe = eidx + tn * 512; const char* pc = egp + tn * 512; const char* px = x1b + tn * 2048;
          asm volatile("global_load_dword %0, %3, %5\n\tglobal_load_dword %1, %4, %6\n\tglobal_load_dword %2, %4, %7" : "=&v"(dx), "=&v"(dl), "=&v"(dm) : "v"(ln * 128), "v"((ln & 15) * 128), "s"(px), "s"(pe), "s"(pc) : "memory"); }
        p5_u32x2 ua[8], ub[8], uc[8]; int cka, ckb, ckc;
        {
            int zz = 0;
            p5_u32x2 da[8], db[8], dc[8];
            P5_ISSUE8D(da, 0); P5_ISSUE8D(db, 1); P5_ISSUE8D(dc, 2);
#pragma unroll 1
            for (int b = 0; b < 60; b += 3) {
                asm volatile("s_waitcnt vmcnt(16)" : P5_TIE8(da) :: "memory"); P5_DOWN8(da, b); P5_ISSUE8D(da, b + 3);
                asm volatile("s_waitcnt vmcnt(16)" : P5_TIE8(db) :: "memory"); P5_DOWN8(db, b + 1); P5_ISSUE8D(db, b + 4);
                asm volatile("s_waitcnt vmcnt(16)" : P5_TIE8(dc) :: "memory"); P5_DOWN8(dc, b + 2); P5_ISSUE8D(dc, b + 5);
            }
            asm volatile("s_waitcnt vmcnt(16)" : P5_TIE8(da) :: "memory"); P5_DOWN8(da, 60); P5_ISSUE8D(da, 63);
            P5_ISSUE8U(ua, 0, cka); P5_ISSUE8U(ub, 1, ckb); P5_ISSUE8U(uc, 2, ckc);
            asm volatile("s_waitcnt vmcnt(40)" : P5_TIE8(db) :: "memory"); P5_DOWN8(db, 61);
            asm volatile("s_waitcnt vmcnt(32)" : P5_TIE8(dc) :: "memory"); P5_DOWN8(dc, 62);
            asm volatile("s_waitcnt vmcnt(24)" : P5_TIE8(da) :: "memory"); P5_DOWN8(da, 63);
            asm volatile("" : "+v"(dx), "+v"(dl), "+v"(dm));
        }
        f32x2_t acc0[8], acc1[8], acc2[8], acc3[8];
#pragma unroll
        for (int i = 0; i < 8; ++i) { acc0[i] = (f32x2_t){0.f, 0.f}; acc1[i] = acc0[i]; acc2[i] = acc0[i]; acc3[i] = acc0[i]; }
#pragma unroll 1
        for (int b = 0; b < 60; b += 3) {
            asm volatile("s_waitcnt vmcnt(16)" : P5_TIE8(ua) :: "memory"); P5_BFMA8U(ua, cka); P5_ISSUE8U(ua, b + 3, cka);
            asm volatile("s_waitcnt vmcnt(16)" : P5_TIE8(ub) :: "memory"); P5_BFMA8U(ub, ckb); P5_ISSUE8U(ub, b + 4, ckb);
            asm volatile("s_waitcnt vmcnt(16)" : P5_TIE8(uc) :: "memory"); P5_BFMA8U(uc, ckc); P5_ISSUE8U(uc, b + 5, ckc);
        }
        asm volatile("s_waitcnt vmcnt(16)" : P5_TIE8(ua) :: "memory"); P5_BFMA8U(ua, cka); P5_ISSUE8U(ua, 63, cka);
        asm volatile("s_waitcnt vmcnt(16)" : P5_TIE8(ub) :: "memory"); P5_BFMA8U(ub, ckb);
        asm volatile("s_waitcnt vmcnt(8)" : P5_TIE8(uc) :: "memory"); P5_BFMA8U(uc, ckc);
        asm volatile("s_waitcnt vmcnt(0)" : P5_TIE8(ua) :: "memory"); P5_BFMA8U(ua, cka);
        P5_OUT(0, acc0); P5_OUT(1, acc1); P5_OUT(2, acc2); P5_OUT(3, acc3);
    }
}

__global__ __launch_bounds__(512, 2) void k_mega(PArgs p_unused) {
    extern __shared__ __attribute__((aligned(16))) unsigned char shm[];
    cg::grid_group grid = cg::this_grid();
    PG8_LAS unsigned char* lds = (PG8_LAS unsigned char*)shm;
    volatile __attribute__((address_space(3))) unsigned* lctl = (volatile __attribute__((address_space(3))) unsigned*)(lds + LDS_CTL);
    if (threadIdx.x < 64) lctl[threadIdx.x] = 0u;
    __syncthreads();
    const XcdBarrier xbar = xcd_barrier_post((unsigned*)(kargs()->ws + OFF_CTL), lctl);
    for (int rep_ = 0; rep_ < (DUP == 10 ? 2 : 1); ++rep_) { const PArgs p = *kargs(); phase0(p, shm); if (DUP == 10) grid.sync(); }
    grid.sync();
    for (int rep_ = 0; rep_ < (DUP == 1 ? 2 : 1); ++rep_) {
        const PArgs& p = *kargs();
        pg8::SchedGrid S; S.init(p.ws + OFF_XB, p.ws + OFF_WIN, nullptr, nullptr, T_, 5632, 1024, 1, (int)gridDim.x, (int)blockIdx.x);
        pg8::EpiInProj E; E.r1 = (const float*)(p.ws + OFF_R1); E.qnw = p.in[3]; E.knw = p.in[4]; E.ropec = (const float*)(p.ws + OFF_ROPE); E.ropes = E.ropec + 4096 * 8; E.merge_b = p.in[12]; E.ws = p.ws; E.kmean = (float*)(p.ws + OFF_KMEAN); E.skip_km = rep_;
        pg8::gemm_phase<pg8::EpiInProj, pg8::SchedGrid, true, true>(lds, 1024, S, E);
        if (DUP == 1) grid.sync();
    }
    xcd_barrier(xbar);
    {
        const PArgs& p = *kargs();
        const attn_body::AttnTensors AT{(const attn_body::bf16*)(p.ws + OFF_Q), (const attn_body::bf16*)(p.ws + OFF_K), (const attn_body::bf16*)(p.ws + OFF_V), (attn_body::bf16*)(p.ws + OFF_XB), (const float*)(p.ws + OFF_KMEAN)};
        mlstm::Args A; A.mq = (const bf16_t*)(p.ws + OFF_MQ); A.mk = (const bf16_t*)(p.ws + OFF_MK); A.mv = (const bf16_t*)(p.ws + OFF_MV); A.mosig = (const bf16_t*)(p.ws + OFF_MO);
        A.ifg = (const float*)(p.ws + OFF_IFG); A.conv_w = p.in[5]; A.conv_b = p.in[6]; A.nw = p.in[9]; A.sca = (float*)(p.ws + OFF_SCA); A.scm = (float*)(p.ws + OFF_SCM); A.scb = (float*)(p.ws + OFF_SCB);
        A.hm = (bf16_t*)(p.ws + OFF_XB + 64 * MiB);
        for (int rep_ = 0; rep_ < (DUP == 3 ? 2 : 1); ++rep_) for (int u = blockIdx.x; u < 64; u += gridDim.x) mlstm::unit(u >> 2, u & 3, A, (ML_LAS unsigned char*)shm);
        attn_body::QueueOrder S; S.ctr = (unsigned*)(p.ws + OFF_CTL) + 8192; S.slot = lctl + 16;
        attn_body::attn_phase<attn_body::QueueOrder>((char*)shm, AT, S);
    }
    xcd_barrier(xbar);
    for (int rep_ = 0; rep_ < (DUP == 4 ? 2 : 1); ++rep_) {
        const PArgs& p = *kargs();
        pg8::SchedGrid S; S.init(p.ws + OFF_XB, p.ws + OFF_WAB, p.ws + OFF_XB + 64 * MiB, p.ws + OFF_WMB, T_, 1024, 512, 2, (int)gridDim.x, (int)blockIdx.x);
        pg8::EpiBranch E; E.ga = (const bf16_t*)(p.ws + OFF_GA); E.gm = (const bf16_t*)(p.ws + OFF_GM); E.y = (bf16_t*)(p.ws + OFF_MQ);
        pg8::gemm_phase<pg8::EpiBranch, pg8::SchedGrid, true, true>(lds, 512, S, E);
        if (DUP == 4) grid.sync();
    }
    xcd_barrier(xbar);
    for (int rep_ = 0; rep_ < (DUP == 5 ? 2 : 1); ++rep_) {
        const PArgs& p = *kargs();
        pg8::SchedGrid S; S.init(p.ws + OFF_MQ, p.ws + OFF_WOUT, nullptr, nullptr, T_, 1024, 1024, 1, (int)gridDim.x, (int)blockIdx.x);
        pg8::EpiOut E; E.x = p.in[0]; E.out = p.out; E.x1b = (bf16_t*)(p.ws + OFF_MV); E.rowss = (float*)(p.ws + OFF_ROWSS);
        pg8::gemm_phase<pg8::EpiOut, pg8::SchedGrid, true, true>(lds, 1024, S, E);
        if (DUP == 5) grid.sync();
    }
    xcd_barrier(xbar);
    for (int rep_ = 0; rep_ < (DUP == 6 ? 2 : 1); ++rep_) {
        const PArgs& p = *kargs();
        peer::Args A; A.rowss = (const float*)(p.ws + OFF_ROWSS); A.key1 = (const bf16_t*)(p.ws + OFF_KEY1); A.key2 = (const bf16_t*)(p.ws + OFF_KEY2); A.r2out = (float*)(p.ws + OFF_R2);
        A.eidx = (int*)(p.ws + OFF_EIDX); A.eg = (float*)(p.ws + OFF_EG);
        for (int u = blockIdx.x; u < 2048; u += gridDim.x) peer::unit(u >> 3, u & 7, (const bf16_t*)(p.ws + OFF_MV), (const bf16_t*)(p.ws + OFF_WQ), A, lds);
    }
    xcd_barrier(xbar);
    { const PArgs& p = *kargs(); phase5_all(p, p.out, shm); }
}

extern "C" void kernel_launch(void* const* d_in, const int* in_sizes, int n_in, void* d_out, int out_size, void* d_ws, size_t ws_size, hipStream_t stream) {
    static int grid_blocks = 0;
    if (!grid_blocks) {
        if (n_in != 20 || in_sizes[0] != T_ * D_ || out_size != T_ * D_ || ws_size < WS_NEED) { fprintf(stderr, "kernel_launch: unexpected shapes n_in %d in0 %d out %d ws %zu\n", n_in, n_in > 0 ? in_sizes[0] : -1, out_size, ws_size); grid_blocks = -1; return; }
        if (hipFuncSetAttribute((const void*)k_mega, hipFuncAttributeMaxDynamicSharedMemorySize, BIG_LDS) != hipSuccess) { fprintf(stderr, "hipFuncSetAttribute failed\n"); grid_blocks = -1; return; }
        int dev = 0, cus = 0, per_cu = 0;
        hipGetDevice(&dev); hipDeviceGetAttribute(&cus, hipDeviceAttributeMultiprocessorCount, dev);
        hipOccupancyMaxActiveBlocksPerMultiprocessor(&per_cu, (const void*)k_mega, 512, BIG_LDS);
        if (per_cu < 1) { fprintf(stderr, "kernel_launch: occupancy query reports %d blocks per CU\n", per_cu); per_cu = 1; }
        grid_blocks = cus;
        if (grid_blocks != 256) fprintf(stderr, "kernel_launch: %d CUs (expected 256)\n", grid_blocks);
    }
    if (grid_blocks < 0) return;
    PArgs pa{}; for (int i = 0; i < 20; ++i) pa.in[i] = (const float*)d_in[i]; pa.out = (float*)d_out; pa.ws = (char*)d_ws;
    hipMemsetAsync((char*)d_ws + OFF_CTL, 0, CTL_BYTES, stream);
    void* args[] = {&pa};
    hipError_t e = hipLaunchCooperativeKernel((void*)k_mega, dim3(grid_blocks), dim3(512), args, BIG_LDS, stream);
    if (e != hipSuccess) fprintf(stderr, "cooperative launch failed: %s (grid %d)\n", hipGetErrorString(e), grid_blocks);
}
```

```cpp
#include <hip/hip_runtime.h>
#include <cstdio>
#include <cstdint>
#include <cmath>
typedef unsigned short bf16_t;
constexpr int T_ = 65536, D_ = 1024, B_ = 16, S_ = 4096;
constexpr int INC = 5640;
constexpr size_t MiB = 1ull << 20;
constexpr size_t OFF_XB = 0;
constexpr size_t OFF_Q = 128 * MiB, OFF_K = 192 * MiB, OFF_V = 256 * MiB;
constexpr size_t OFF_MQ = 320 * MiB, OFF_MK = 384 * MiB, OFF_MV = 448 * MiB, OFF_MO = 512 * MiB;
constexpr size_t OFF_GA = 576 * MiB, OFF_GM = 704 * MiB;
constexpr size_t OFF_W = 832 * MiB;
constexpr size_t OFF_WIN = OFF_W;
constexpr size_t OFF_WAB = OFF_WIN + (size_t)5632 * 1024 * 2;
constexpr size_t OFF_WMB = OFF_WAB + (size_t)1024 * 512 * 2;
constexpr size_t OFF_WOUT = OFF_WMB + (size_t)1024 * 512 * 2;
constexpr size_t OFF_WQ = OFF_WOUT + (size_t)1024 * 1024 * 2;
constexpr size_t OFF_KEY1 = OFF_WQ + (size_t)2048 * 1024 * 2;
constexpr size_t OFF_KEY2 = OFF_KEY1 + (size_t)8 * 128 * 128 * 2;
constexpr size_t OFF_WD = OFF_KEY2 + (size_t)8 * 128 * 128 * 2;
constexpr size_t OFF_WU = OFF_WD + (size_t)16384 * 1024 * 2;
constexpr size_t OFF_WEND = OFF_WU + (size_t)16384 * 1024 * 2;
constexpr size_t OFF_MISC = 920 * MiB;
static_assert(OFF_WEND <= OFF_MISC, "weights overflow");
constexpr size_t OFF_R1 = OFF_MISC;
constexpr size_t OFF_R2 = OFF_R1 + (size_t)T_ * 4;
constexpr size_t OFF_IFG = OFF_R2 + (size_t)T_ * 4;
constexpr size_t OFF_KMEAN = OFF_IFG + (size_t)T_ * 8 * 4;
constexpr size_t OFF_ROPE = OFF_KMEAN + (size_t)16 * 8 * 16 * 64 * 4;
constexpr size_t OFF_SCA = OFF_ROPE + (size_t)2 * 4096 * 8 * 4;
constexpr size_t OFF_SCM = OFF_SCA + (size_t)16 * 4 * 4096 * 4;
constexpr size_t OFF_SCB = OFF_SCM + (size_t)16 * 4 * 4096 * 4;
constexpr size_t OFF_CTL = 926 * MiB + 512 * 1024, CTL_BYTES = 64 * 1024;
constexpr size_t OFF_ROWSS = 927 * MiB;
constexpr size_t OFF_EIDX = 932 * MiB;
constexpr size_t OFF_EG = 964 * MiB;
constexpr size_t WS_NEED = 996 * MiB;
static_assert(OFF_SCB + (size_t)16 * 4 * 4096 * 4 <= OFF_CTL && OFF_CTL + CTL_BYTES <= OFF_ROWSS, "misc overflow");

__device__ __forceinline__ unsigned f2bf(float f) { unsigned u = __builtin_bit_cast(unsigned, f); return (u + 0x7fffu + ((u >> 16) & 1u)) >> 16; }
__device__ __forceinline__ float bf2f(unsigned short b) { return __builtin_bit_cast(float, ((unsigned)b) << 16); }
__device__ __forceinline__ unsigned pk2(float lo, float hi) { return f2bf(lo) | (f2bf(hi) << 16); }
__device__ __forceinline__ float sigmoidf_(float v) { return 1.0f / (1.0f + __expf(-v)); }
namespace pg8 {
#define PG8_LAS __attribute__((address_space(3)))
typedef unsigned short bf16_t;
typedef short bf16x8 __attribute__((ext_vector_type(8)));
typedef float f32x4 __attribute__((ext_vector_type(4)));
typedef unsigned u32x4 __attribute__((ext_vector_type(4)));
constexpr int BM = 256, BK = 64, HALF = 128, HTB = HALF * BK * 2  , STAGE_BYTES = 8 * HTB, NXCD = 8, WGM = 4;

__host__ __device__ __forceinline__ int lds_byte(int r, int c) { const int st = (r >> 4) * 2 + (c >> 5), rr = r & 15, cc = c & 31, ob = rr * 64 + cc * 2; return st * 1024 + (ob ^ (((ob >> 9) & 1) << 5)); }
__host__ __device__ __forceinline__ void stage_rc(int b, int& R, int& C) { const int st = b / 1024, sb = b % 1024, swz = sb ^ (((sb >> 9) & 1) << 5); R = (st >> 1) * 16 + swz / 64; C = (st & 1) * 32 + (swz % 64) / 2; }
__host__ __device__ __forceinline__ int perm32(int rho) { const int n = rho >> 4, i = rho & 15; return 8 * (i >> 2) + 4 * n + (i & 3); }

struct Unit { int pm, pn, seg, pad; const char* A; const char* B; };

__device__ __forceinline__ unsigned cvt_pk_bf16(float lo, float hi) { unsigned r; asm volatile("v_cvt_pk_bf16_f32 %0, %1, %2" : "=v"(r) : "v"(lo), "v"(hi)); return r; }
typedef float f32x2 __attribute__((ext_vector_type(2)));
__device__ __forceinline__ f32x2 gelu_pk(f32x2 v) {
    const f32x2 av = __builtin_elementwise_abs(v), d = av * 0.2316418882f + 1.0f;
    f32x2 t; t.x = __builtin_amdgcn_rcpf(d.x); t.y = __builtin_amdgcn_rcpf(d.y);
    f32x2 q = t * 0.5307027145f + (-0.7265760135f); q = q * t + 0.7107068705f; q = q * t + (-0.142248368f); q = q * t + 0.127414796f; q = q * t;
    const f32x2 s = (v * v) * (-0.72134752044f);
    f32x2 e; e.x = __builtin_amdgcn_exp2f(s.x); e.y = __builtin_amdgcn_exp2f(s.y);
    const f32x2 m = v * (q * e), r = v - m;
    f32x2 o; o.x = v.x < 0.f ? m.x : r.x; o.y = v.y < 0.f ? m.y : r.y; return o;
}

template <class Epi, class Sched, bool ALIGN_EPI = false, bool SP2 = false>
__device__ __forceinline__ void gemm_phase(PG8_LAS unsigned char* lds, const int K, const Sched& S, const Epi& E) {
    int tid = threadIdx.x; asm volatile("" : "+v"(tid));
    const int wid = __builtin_amdgcn_readfirstlane(tid >> 6), lane = tid & 63, wr = wid >> 2, wc = wid & 3, fr = lane & 15, fq = lane >> 4;
    const int nt = K / BK;
    unsigned voffA[2], voffB[2];
#pragma unroll
    for (int i = 0; i < 2; ++i) { int R, C; stage_rc(tid * 16 + i * 8192, R, C); const int Rb = Epi::PERM ? ((R & ~31) + perm32(R & 31)) : R;
        voffA[i] = (unsigned)(R * K + C) * 2u; voffB[i] = (unsigned)(Rb * K + C) * 2u; }
    const size_t kstep = (size_t)(BK * 2);
    const size_t hstep = (size_t)HALF * K * 2;
        const unsigned ldsw = (unsigned)wid * 1024u;
    const int aoff = lds_byte(wr * 64 + fr, fq * 8), boff = lds_byte(wc * 32 + fr, fq * 8);
#define PG8_SA(b, h) (((b) * 2 + (h)) * HTB)
#define PG8_SB(b, h) ((4 + (b) * 2 + (h)) * HTB)
#define PG8_STAGE(bufoff, gbase, voff) do { _Pragma("unroll") for (int _i = 0; _i < 2; ++_i) \
        __builtin_amdgcn_global_load_lds((const unsigned*)((const char*)(gbase) + (voff)[_i]), (PG8_LAS unsigned*)(lds + (bufoff) + ldsw + _i * 8192), 16, 0, 0); } while (0)
#define PG8_LDA(dst, b, h) do { _Pragma("unroll") for (int m = 0; m < 4; ++m) _Pragma("unroll") for (int k = 0; k < 2; ++k) dst[m][k] = *(const PG8_LAS bf16x8*)(lds + PG8_SA(b, h) + aoff + m * 2048 + k * 1024); } while (0)
#define PG8_LDB(dst, b, h) do { _Pragma("unroll") for (int n = 0; n < 2; ++n) _Pragma("unroll") for (int k = 0; k < 2; ++k) dst[n][k] = *(const PG8_LAS bf16x8*)(lds + PG8_SB(b, h) + boff + n * 2048 + k * 1024); } while (0)
#define PG8_MMA(ai, bj, At, Bt) do { __builtin_amdgcn_s_setprio(1); _Pragma("unroll") for (int m = 0; m < 4; ++m) _Pragma("unroll") for (int n = 0; n < 2; ++n) _Pragma("unroll") for (int k = 0; k < 2; ++k) \
        acc[ai][bj][m][n] = __builtin_amdgcn_mfma_f32_16x16x32_bf16(Bt[n][k], At[m][k], acc[ai][bj][m][n], 0, 0, 0); __builtin_amdgcn_s_setprio(0); } while (0)
#define PG8_WAIT_V(n) asm volatile("s_waitcnt vmcnt(" #n ")" ::: "memory")
#define PG8_WAIT_L(n) asm volatile("s_waitcnt lgkmcnt(" #n ")" ::: "memory")
#define PG8_BAR __builtin_amdgcn_s_barrier()
#define PG8_SCHED __builtin_amdgcn_sched_barrier(0)
    Unit cur, nxt; int ui = 0;
    if (!S.next(0, cur)) return;
    f32x4 acc[2][2][4][2];
#pragma unroll
    for (int a = 0; a < 2; ++a)
#pragma unroll
        for (int b = 0; b < 2; ++b)
#pragma unroll
            for (int m = 0; m < 4; ++m)
#pragma unroll
                for (int n = 0; n < 2; ++n) acc[a][b][m][n] = (f32x4){0.f, 0.f, 0.f, 0.f};
    bf16x8 At[4][2], B0[2][2], B1[2][2];
    const char* cA = cur.A; const char* cB = cur.B;
    S.a_ready(cur);
    if constexpr (SP2) {
        PG8_STAGE(PG8_SB(0, 0), cB, voffB); PG8_STAGE(PG8_SB(0, 1), cB + hstep, voffB); PG8_STAGE(PG8_SA(0, 0), cA, voffA); PG8_STAGE(PG8_SA(0, 1), cA + hstep, voffA);
        if (wr == 1) PG8_BAR;
        PG8_WAIT_V(2); PG8_BAR;
        PG8_STAGE(PG8_SB(1, 0), cB + kstep, voffB); PG8_STAGE(PG8_SA(1, 0), cA + kstep, voffA); PG8_STAGE(PG8_SB(1, 1), cB + hstep + kstep, voffB);
        PG8_WAIT_V(6); PG8_BAR;
    } else {
        PG8_STAGE(PG8_SB(0, 0), cB, voffB); PG8_STAGE(PG8_SA(0, 0), cA, voffA); PG8_STAGE(PG8_SB(0, 1), cB + hstep, voffB); PG8_STAGE(PG8_SA(0, 1), cA + hstep, voffA);
        if (wr == 1) PG8_BAR;
        PG8_WAIT_V(4); PG8_BAR;
        PG8_STAGE(PG8_SB(1, 0), cB + kstep, voffB); PG8_STAGE(PG8_SA(1, 0), cA + kstep, voffA); PG8_STAGE(PG8_SB(1, 1), cB + hstep + kstep, voffB);
        PG8_WAIT_V(6); PG8_BAR;
    }
    for (;;) {
        const bool has_next = S.next(ui + 1, nxt);
        const char* nA = has_next ? nxt.A : cA; const char* nB = has_next ? nxt.B : cB;
        for (int t = 0; t < nt; t += 2) {
            const bool last = (t == nt - 2);
            const char* a1 = cA + (size_t)(t + 1) * kstep;
            const char* a2 = last ? nA : cA + (size_t)(t + 2) * kstep; const char* b2 = last ? nB : cB + (size_t)(t + 2) * kstep;
            const char* a3 = a2 + kstep; const char* b3 = b2 + kstep;
            if (last && has_next) S.a_ready(nxt);
            if constexpr (SP2) {
            PG8_LDB(B0, 0, 0); PG8_LDB(B1, 0, 1); PG8_SCHED; PG8_LDA(At, 0, 0); PG8_STAGE(PG8_SA(1, 1), a1 + hstep, voffA);
            PG8_WAIT_V(8); PG8_WAIT_L(0); PG8_BAR; PG8_MMA(0, 0, At, B0); PG8_MMA(0, 1, At, B1); PG8_BAR; PG8_SCHED;
            PG8_LDA(At, 0, 1); PG8_STAGE(PG8_SB(0, 0), b2, voffB); PG8_STAGE(PG8_SB(0, 1), b2 + hstep, voffB); PG8_STAGE(PG8_SA(0, 0), a2, voffA);
            PG8_WAIT_V(8); PG8_WAIT_L(0); PG8_BAR; PG8_MMA(1, 0, At, B0); PG8_MMA(1, 1, At, B1); PG8_BAR; PG8_SCHED;
            PG8_LDB(B0, 1, 0); PG8_LDB(B1, 1, 1); PG8_SCHED; PG8_LDA(At, 1, 0); PG8_STAGE(PG8_SA(0, 1), a2 + hstep, voffA);
            PG8_WAIT_V(8); PG8_WAIT_L(0); PG8_BAR; PG8_MMA(0, 0, At, B0); PG8_MMA(0, 1, At, B1); PG8_BAR; PG8_SCHED;
            PG8_LDA(At, 1, 1); PG8_STAGE(PG8_SB(1, 0), b3, voffB); PG8_STAGE(PG8_SB(1, 1), b3 + hstep, voffB); PG8_STAGE(PG8_SA(1, 0), a3, voffA);
            PG8_WAIT_V(8); PG8_WAIT_L(0); PG8_BAR; PG8_MMA(1, 0, At, B0); PG8_MMA(1, 1, At, B1); PG8_BAR; PG8_SCHED;
            } else {
            PG8_LDB(B0, 0, 0); PG8_SCHED; PG8_LDA(At, 0, 0); PG8_STAGE(PG8_SA(1, 1), a1 + hstep, voffA);
            PG8_WAIT_L(8); PG8_BAR; PG8_WAIT_L(0); PG8_MMA(0, 0, At, B0); PG8_BAR; PG8_SCHED;
            PG8_LDB(B1, 0, 1); PG8_STAGE(PG8_SB(0, 0), b2, voffB);
            PG8_BAR; PG8_WAIT_L(0); PG8_MMA(0, 1, At, B1); PG8_BAR;
            PG8_LDA(At, 0, 1); PG8_STAGE(PG8_SA(0, 0), a2, voffA);
            PG8_BAR; PG8_WAIT_L(0); PG8_MMA(1, 0, At, B0); PG8_BAR; PG8_SCHED;
            PG8_STAGE(PG8_SB(0, 1), b2 + hstep, voffB);
            PG8_WAIT_V(6); PG8_BAR; PG8_MMA(1, 1, At, B1); PG8_BAR;
            PG8_LDB(B0, 1, 0); PG8_SCHED; PG8_LDA(At, 1, 0); PG8_STAGE(PG8_SA(0, 1), a2 + hstep, voffA);
            PG8_WAIT_L(8); PG8_BAR; PG8_WAIT_L(0); PG8_MMA(0, 0, At, B0); PG8_BAR; PG8_SCHED;
            PG8_LDB(B1, 1, 1); PG8_STAGE(PG8_SB(1, 0), b3, voffB);
            PG8_BAR; PG8_WAIT_L(0); PG8_MMA(0, 1, At, B1); PG8_BAR;
            PG8_LDA(At, 1, 1); PG8_STAGE(PG8_SA(1, 0), a3, voffA);
            PG8_BAR; PG8_WAIT_L(0); PG8_MMA(1, 0, At, B0); PG8_BAR; PG8_SCHED;
            PG8_STAGE(PG8_SB(1, 1), b3 + hstep, voffB);
            PG8_WAIT_V(6); PG8_BAR; PG8_MMA(1, 1, At, B1); PG8_BAR;
            }
        }
        if constexpr (ALIGN_EPI) { if (wr == 0) PG8_BAR; }
        if constexpr (!Epi::AFTER_DRAIN) { E(acc, cur, wr, wc, fr, fq); S.done(cur); }
        if (!has_next) break;
        if (E.zero_after(cur)) {
#pragma unroll
        for (int a = 0; a < 2; ++a)
#pragma unroll
            for (int b = 0; b < 2; ++b)
#pragma unroll
                for (int m = 0; m < 4; ++m)
#pragma unroll
                    for (int n = 0; n < 2; ++n) acc[a][b][m][n] = (f32x4){0.f, 0.f, 0.f, 0.f};
        }
        cur = nxt; cA = nA; cB = nB; ++ui;
        if constexpr (ALIGN_EPI) { if (wr == 1) PG8_BAR; }
    }
    PG8_WAIT_V(0);
    if constexpr (!ALIGN_EPI) { if (wr == 0) PG8_BAR; }
    PG8_BAR;
    if constexpr (Epi::AFTER_DRAIN) { E.fused(acc, cur, wr, wc, fr, fq, lds, wid, lane); S.done(cur); }
#undef PG8_SA
#undef PG8_SB
#undef PG8_STAGE
#undef PG8_LDA
#undef PG8_LDB
#undef PG8_MMA
#undef PG8_WAIT_V
#undef PG8_WAIT_L
#undef PG8_BAR
#undef PG8_SCHED
}
}
__host__ __device__ __forceinline__ int sigma_col(int rho) { const int j = rho & 3, fq = (rho >> 2) & 3, n = (rho >> 4) & 1, wc = (rho >> 5) & 3, bj = rho >> 7; return wc * 64 + bj * 32 + fq * 8 + n * 4 + j; }
namespace pg8 {
struct SchedGrid {
    const char* A0; const char* B0; const char* A1; const char* B1; size_t tstep; int nM, nN, nwg, G, c, segs, pad;
    __device__ __forceinline__ void init(const void* A0_, const void* B0_, const void* A1_, const void* B1_, int M, int N, int K, int segs_, int G_, int c_) {
        A0 = (const char*)A0_; B0 = (const char*)B0_; A1 = (const char*)A1_; B1 = (const char*)B1_; tstep = (size_t)BM * K * 2; nM = M / BM; nN = N / BM; nwg = nM * nN; G = G_; c = c_; segs = segs_; pad = 0; }
    __device__ __forceinline__ bool next(int i, Unit& u) const {
        const int seg = (segs == 2) ? (i & 1) : 0, it = (segs == 2) ? (i >> 1) : i;
        const long L = (long)it * G + c; if (L >= nwg) return false;
        int wgid = (int)L; { const int q = nwg / NXCD, r = nwg % NXCD, xcd = wgid % NXCD, off = wgid / NXCD; wgid = (xcd < r ? xcd * (q + 1) : r * (q + 1) + (xcd - r) * q) + off; }
        const int nig = WGM * nN, gid = wgid / nig, fm = gid * WGM, gsz = (nM - fm) < WGM ? (nM - fm) : WGM;
        u.pm = fm + ((wgid % nig) % gsz); u.pn = (wgid % nig) / gsz; u.seg = seg; u.pad = 0;
        u.A = (seg ? A1 : A0) + (size_t)u.pm * tstep; u.B = (seg ? B1 : B0) + (size_t)u.pn * tstep; return true;
    }
    __device__ __forceinline__ void a_ready(const Unit&) const {}
    __device__ __forceinline__ void done(const Unit&) const {}
};
__device__ __forceinline__ u32x4 pack8(const f32x4& a, const f32x4& b) { u32x4 w; w.x = cvt_pk_bf16(a[0], a[1]); w.y = cvt_pk_bf16(a[2], a[3]); w.z = cvt_pk_bf16(b[0], b[1]); w.w = cvt_pk_bf16(b[2], b[3]); return w; }
__device__ __forceinline__ float bflo(unsigned w) { return __builtin_bit_cast(float, w << 16); }
__device__ __forceinline__ float bfhi(unsigned w) { return __builtin_bit_cast(float, w & 0xffff0000u); }
__device__ __forceinline__ float sigm(float v) { return __builtin_amdgcn_rcpf(1.0f + __expf(-v)); }

struct EpiInProj {
    static constexpr bool PERM = false, AFTER_DRAIN = false;
    const float* r1; const float* qnw; const float* knw; const float* ropec; const float* ropes; const float* merge_b; char* ws; float* kmean; int skip_km;
    __device__ __forceinline__ bool zero_after(const Unit&) const { return true; }
    __device__ __forceinline__ void operator()(f32x4 (&acc)[2][2][4][2], const Unit& u, int wr, int wc, int fr, int fq) const {
        const int pn = u.pn, rowb = u.pm * BM + wr * 64 + fr;
        if (pn < 4) {
            const bool isq = pn < 2; const float* nw = isq ? qnw : knw; const float sc = isq ? 0.125f * 1.4426950408889634f : 1.0f;
            bf16_t* dst = (bf16_t*)(ws + (isq ? OFF_Q : OFF_K)) + (pn & 1) * 256 + wc * 64 + 8 * fq;
            f32x4 nwv[2][2], ks[2][2];
#pragma unroll
            for (int bj = 0; bj < 2; ++bj)
#pragma unroll
                for (int n = 0; n < 2; ++n) { nwv[bj][n] = *(const f32x4*)(nw + 32 * bj + 8 * fq + 4 * n); ks[bj][n] = (f32x4){0.f, 0.f, 0.f, 0.f}; }
#pragma unroll
            for (int ai = 0; ai < 2; ++ai)
#pragma unroll
                for (int m = 0; m < 4; ++m) {
                    const int row = rowb + ai * HALF + m * 16; const float r = r1[row]; const int pos = row & 4095;
                    f32x4 v[2][2]; float ss = 0.f;
#pragma unroll
                    for (int bj = 0; bj < 2; ++bj)
#pragma unroll
                        for (int n = 0; n < 2; ++n) { v[bj][n] = acc[ai][bj][m][n] * r; ss += (v[bj][n][0] * v[bj][n][0] + v[bj][n][1] * v[bj][n][1]) + (v[bj][n][2] * v[bj][n][2] + v[bj][n][3] * v[bj][n][3]); }
                    ss += __shfl_xor(ss, 16); ss += __shfl_xor(ss, 32);
                    const float rstd = rsqrtf(ss * (1.0f / 64.0f) + 1e-6f);
#pragma unroll
                    for (int bj = 0; bj < 2; ++bj)
#pragma unroll
                        for (int n = 0; n < 2; ++n) v[bj][n] = v[bj][n] * rstd * nwv[bj][n];
#pragma unroll
                    for (int n = 0; n < 2; ++n) {
                        const f32x4 cs = *(const f32x4*)(ropec + pos * 8 + 4 * n), sn = *(const f32x4*)(ropes + pos * 8 + 4 * n);
#pragma unroll
                        for (int j = 0; j < 4; ++j) { const float mine = v[0][n][j], oth = __shfl_xor(mine, 16);
                            const float rot = (fq == 0) ? (mine * cs[j] - oth * sn[j]) : (mine * cs[j] + oth * sn[j]);
                            v[0][n][j] = (fq < 2) ? rot : mine; }
                    }
#pragma unroll
                    for (int bj = 0; bj < 2; ++bj) {
                        const u32x4 w = pack8(v[bj][0] * sc, v[bj][1] * sc);
                        *(u32x4*)(dst + (size_t)row * 512 + 32 * bj) = w;
                        if (!isq) { ks[bj][0] += (f32x4){bflo(w.x), bfhi(w.x), bflo(w.y), bfhi(w.y)}; ks[bj][1] += (f32x4){bflo(w.z), bfhi(w.z), bflo(w.w), bfhi(w.w)}; }
                    }
                }
            if (!isq) {
#pragma unroll
                for (int bj = 0; bj < 2; ++bj)
#pragma unroll
                    for (int n = 0; n < 2; ++n)
#pragma unroll
                        for (int j = 0; j < 4; ++j) { float s = ks[bj][n][j]; s += __shfl_xor(s, 1); s += __shfl_xor(s, 2); s += __shfl_xor(s, 4); s += __shfl_xor(s, 8); ks[bj][n][j] = s; }
                if (fr == 0 && !skip_km) {
                    const int b = u.pm >> 4, blk = u.pm & 15, head = (pn & 1) * 4 + wc;
                    float* km = kmean + ((size_t)(b * 8 + head) * 16 + blk) * 64 + 8 * fq;
#pragma unroll
                    for (int bj = 0; bj < 2; ++bj)
#pragma unroll
                        for (int n = 0; n < 2; ++n)
#pragma unroll
                            for (int j = 0; j < 4; ++j) atomicAdd(km + 32 * bj + 4 * n + j, ks[bj][n][j] * (1.0f / 256.0f));
                }
            }
        } else {
            size_t off; int ld = 512, cb, type = 2; const float* bias = nullptr;
            if (pn < 6) { off = OFF_V; cb = (pn - 4) * 256; } else if (pn < 8) { off = OFF_MQ; cb = (pn - 6) * 256; } else if (pn < 10) { off = OFF_MK; cb = (pn - 8) * 256; }
            else if (pn < 12) { off = OFF_MV; cb = (pn - 10) * 256; } else if (pn < 14) { off = OFF_MO; cb = (pn - 12) * 256; type = 3; }
            else if (pn < 18) { off = OFF_GA; cb = (pn - 14) * 256; ld = 1024; type = 4; bias = merge_b + cb; } else { off = OFF_GM; cb = (pn - 18) * 256; ld = 1024; type = 4; bias = merge_b + 1024 + cb; }
            const int cl = wc * 64 + 8 * fq;
            bf16_t* dst = (bf16_t*)(ws + off) + cb + cl;
            f32x4 bv[2][2];
#pragma unroll
            for (int bj = 0; bj < 2; ++bj)
#pragma unroll
                for (int n = 0; n < 2; ++n) bv[bj][n] = (type == 4) ? *(const f32x4*)(bias + cl + 32 * bj + 4 * n) : (f32x4){0.f, 0.f, 0.f, 0.f};
#pragma unroll
            for (int ai = 0; ai < 2; ++ai)
#pragma unroll
                for (int m = 0; m < 4; ++m) {
                    const int row = rowb + ai * HALF + m * 16; const float r = r1[row];
#pragma unroll
                    for (int bj = 0; bj < 2; ++bj) {
                        f32x4 v0 = acc[ai][bj][m][0] * r + bv[bj][0], v1 = acc[ai][bj][m][1] * r + bv[bj][1];
                        if (type >= 3) {
#pragma unroll
                            for (int j = 0; j < 4; ++j) { v0[j] = sigm(v0[j]); v1[j] = sigm(v1[j]); } }
                        *(u32x4*)(dst + (size_t)row * ld + 32 * bj) = pack8(v0, v1);
                    }
                }
        }
    }
};
struct EpiBranch {
    static constexpr bool PERM = false, AFTER_DRAIN = false;
    const bf16_t* ga; const bf16_t* gm; bf16_t* y;
    __device__ __forceinline__ bool zero_after(const Unit& u) const { return u.seg == 1; }
    __device__ __forceinline__ void operator()(f32x4 (&acc)[2][2][4][2], const Unit& u, int wr, int wc, int fr, int fq) const {
        const int rowb = u.pm * BM + wr * 64 + fr, col0 = u.pn * BM + wc * 64 + 8 * fq;
#pragma unroll
        for (int ai = 0; ai < 2; ++ai)
#pragma unroll
            for (int m = 0; m < 4; ++m) {
                const size_t ro = (size_t)(rowb + ai * HALF + m * 16) * 1024 + col0;
#pragma unroll
                for (int bj = 0; bj < 2; ++bj) {
                    const u32x4 gmw = *(const u32x4*)(gm + ro + 32 * bj);
                    const f32x4 m0 = (f32x4){bflo(gmw.x), bfhi(gmw.x), bflo(gmw.y), bfhi(gmw.y)}, m1 = (f32x4){bflo(gmw.z), bfhi(gmw.z), bflo(gmw.w), bfhi(gmw.w)};
                    if (u.seg == 0) {
                        const u32x4 gaw = *(const u32x4*)(ga + ro + 32 * bj);
                        const f32x4 a0 = (f32x4){bflo(gaw.x), bfhi(gaw.x), bflo(gaw.y), bfhi(gaw.y)}, a1 = (f32x4){bflo(gaw.z), bfhi(gaw.z), bflo(gaw.w), bfhi(gaw.w)};
#pragma unroll
                        for (int j = 0; j < 4; ++j) { acc[ai][bj][m][0][j] *= a0[j] * __builtin_amdgcn_rcpf(m0[j]); acc[ai][bj][m][1][j] *= a1[j] * __builtin_amdgcn_rcpf(m1[j]); }
                    } else {
                        *(u32x4*)(y + ro + 32 * bj) = pack8(acc[ai][bj][m][0] * m0, acc[ai][bj][m][1] * m1);
                    }
                }
            }
    }
};
struct EpiOut {
    static constexpr bool PERM = false, AFTER_DRAIN = false;
    const float* x; float* out; bf16_t* x1b; float* rowss;
    __device__ __forceinline__ bool zero_after(const Unit&) const { return true; }
    __device__ __forceinline__ void operator()(f32x4 (&acc)[2][2][4][2], const Unit& u, int wr, int wc, int fr, int fq) const {
        const int rowb = u.pm * BM + wr * 64 + fr, col0 = u.pn * BM + wc * 64 + 8 * fq;
#pragma unroll
        for (int ai = 0; ai < 2; ++ai)
#pragma unroll
            for (int m = 0; m < 4; ++m) {
                const int row = rowb + ai * HALF + m * 16; const size_t ro = (size_t)row * 1024 + col0; float ss = 0.f;
#pragma unroll
                for (int bj = 0; bj < 2; ++bj) {
                    const f32x4 v0 = acc[ai][bj][m][0] + *(const f32x4*)(x + ro + 32 * bj), v1 = acc[ai][bj][m][1] + *(const f32x4*)(x + ro + 32 * bj + 4);
                    *(u32x4*)(x1b + ro + 32 * bj) = pack8(v0, v1);
                    ss += (v0[0] * v0[0] + v0[1] * v0[1]) + (v0[2] * v0[2] + v0[3] * v0[3]) + (v1[0] * v1[0] + v1[1] * v1[1]) + (v1[2] * v1[2] + v1[3] * v1[3]);
                }
                ss += __shfl_xor(ss, 16); ss += __shfl_xor(ss, 32);
                if (fq == 0) rowss[(size_t)row * 16 + u.pn * 4 + wc] = ss;
            }
    }
};
}
#include <hip/hip_bf16.h>
#include <cmath>
namespace attn_body {
using bf16=__hip_bfloat16;
using bf16x8=__attribute__((ext_vector_type(8)))short;
using s16x4=__attribute__((ext_vector_type(4)))short;
using f32x16=__attribute__((ext_vector_type(16)))float;
using u32x4=__attribute__((ext_vector_type(4)))unsigned;
using f32x4_t=__attribute__((ext_vector_type(4)))float;
constexpr int BATCH=16,NHEAD=8,SEQ=4096,D=64,DM=NHEAD*D;
constexpr int NW=8,QBLK=32,QB=QBLK*NW,KVBLK=64,NQB=SEQ/QB;
constexpr int ATTN_PITCH=DM, ATTN_UNIT_ROWS=QB;
__device__ __forceinline__ int crow(int r,int hi){return (r&3)+8*(r>>2)+4*hi;}
#define SBAR() __builtin_amdgcn_sched_barrier(0)
__device__ __forceinline__ void cmask(f32x16&p0,f32x16&p1,int jb,int qrel,int hi){
  const float NEG=-INFINITY; int kb=64*jb+4*hi;
  #pragma unroll
  for(int r=0;r<16;++r){int kv=kb+(r&3)+8*(r>>2); if(kv>qrel)p0[r]=NEG; if(kv+32>qrel)p1[r]=NEG;}
}

constexpr int NSLOT=3, SLOTB=8192;
constexpr int LDS_K=0, LDS_V=NSLOT*SLOTB, LDS_WS=2*NSLOT*SLOTB, LDS_OST=LDS_WS+NW*64*4, LDS_BYTES=LDS_OST+NW*4096;
constexpr float C2=0.125f*1.4426950408889634f;
__device__ __forceinline__ void glds16(const void*gsrc,unsigned lds_dst){unsigned keep;
  asm volatile("s_mov_b32 %0, m0\n\ts_mov_b32 m0, %2\n\ts_nop 0\n\tglobal_load_lds_dwordx4 %1, off\n\ts_mov_b32 m0, %0":"=&s"(keep):"v"(gsrc),"s"(lds_dst):"memory");}
__device__ __forceinline__ float max3f(float a,float b,float c){float r;asm("v_max3_f32 %0, %1, %2, %3":"=v"(r):"v"(a),"v"(b),"v"(c));return r;}
__device__ __forceinline__ float max2f(float a,float b){float r;asm("v_max_f32_e32 %0, %1, %2":"=v"(r):"v"(a),"v"(b));return r;}
__device__ __forceinline__ float fadd_s(float a,float b){float r;asm("v_add_f32_e32 %0, %1, %2":"=v"(r):"v"(a),"v"(b));return r;}
__device__ __forceinline__ float fsub_s(float a,float b){float r;asm("v_sub_f32_e32 %0, %1, %2":"=v"(r):"v"(a),"v"(b));return r;}
typedef float f32x2_t __attribute__((ext_vector_type(2))); typedef __bf16 bf16x2_t __attribute__((ext_vector_type(2)));
__device__ __forceinline__ unsigned cvtpk_s(float lo,float hi){f32x2_t v={lo,hi};bf16x2_t b=__builtin_convertvector(v,bf16x2_t);return __builtin_bit_cast(unsigned,b);}
#define WAIT_BAR(N) asm volatile("s_waitcnt vmcnt(" #N ") lgkmcnt(0)\n\ts_barrier":::"memory")

__device__ __forceinline__ void qkt(f32x16&p0,f32x16&p1,const char*Kslot,const bf16x8*qr,const f32x16&negm,int r32,int hi){
  const char*kb=Kslot+hi*1024+r32*16;
  #pragma unroll
  for(int d0=0;d0<4;++d0){
    const bf16x8 b0=*reinterpret_cast<const bf16x8*>(kb+d0*2048);
    const bf16x8 b1=*reinterpret_cast<const bf16x8*>(kb+d0*2048+512);
    if(d0==0){p0=__builtin_amdgcn_mfma_f32_32x32x16_bf16(b0,qr[0],negm,0,0,0);p1=__builtin_amdgcn_mfma_f32_32x32x16_bf16(b1,qr[0],negm,0,0,0);}
    else{p0=__builtin_amdgcn_mfma_f32_32x32x16_bf16(b0,qr[d0],p0,0,0,0);p1=__builtin_amdgcn_mfma_f32_32x32x16_bf16(b1,qr[d0],p1,0,0,0);}}
}
typedef __attribute__((address_space(3))) const char* lds_cptr;
typedef short v4i16_t __attribute__((ext_vector_type(4)));
__device__ __forceinline__ void kload8(bf16x8*kf,lds_cptr kp){
  kf[0]=*(const __attribute__((address_space(3))) bf16x8*)(kp);      kf[1]=*(const __attribute__((address_space(3))) bf16x8*)(kp+512);
  kf[2]=*(const __attribute__((address_space(3))) bf16x8*)(kp+2048); kf[3]=*(const __attribute__((address_space(3))) bf16x8*)(kp+2560);
  kf[4]=*(const __attribute__((address_space(3))) bf16x8*)(kp+4096); kf[5]=*(const __attribute__((address_space(3))) bf16x8*)(kp+4608);
  kf[6]=*(const __attribute__((address_space(3))) bf16x8*)(kp+6144); kf[7]=*(const __attribute__((address_space(3))) bf16x8*)(kp+6656);
}
__device__ __forceinline__ void kload2(bf16x8*kf,lds_cptr kp,int j){ kf[2*j]=*(const __attribute__((address_space(3))) bf16x8*)(kp+j*2048); kf[2*j+1]=*(const __attribute__((address_space(3))) bf16x8*)(kp+j*2048+512); }
__device__ __forceinline__ s16x4 vtr(lds_cptr p){ return __builtin_bit_cast(s16x4,__builtin_amdgcn_ds_read_tr16_b64_v4i16((__attribute__((address_space(3))) v4i16_t*)p)); }
__device__ __forceinline__ float rowmax(const f32x16&p0,const f32x16&p1){
  float a=max3f(p0[0],p0[1],p1[0]),b=max3f(p0[2],p0[3],p1[1]);a=max3f(a,p1[2],p1[3]);
  #pragma unroll
  for(int r=4;r<16;r+=4){a=max3f(a,p0[r],p0[r+1]);b=max3f(b,p0[r+2],p0[r+3]);a=max3f(a,p1[r],p1[r+1]);b=max3f(b,p1[r+2],p1[r+3]);}
  const float m=max2f(a,b);
  auto rr=__builtin_amdgcn_permlane32_swap(__float_as_uint(m),__float_as_uint(m),false,false);
  return max2f(__uint_as_float(rr[0]),__uint_as_float(rr[1]));
}
__device__ __forceinline__ void pv(f32x16*o,int vb,bf16x8 pa0,bf16x8 pa1,bf16x8 pa2,bf16x8 pa3){
  #pragma unroll
  for(int d0=0;d0<2;++d0){s16x4 lo[4],hi[4];
    #pragma unroll
    for(int ks=0;ks<4;++ks){
      asm volatile("ds_read_b64_tr_b16 %0,%1 offset:%c2":"=&v"(lo[ks]):"v"(vb),"i"(d0*4096+ks*1024):"memory");
      asm volatile("ds_read_b64_tr_b16 %0,%1 offset:%c2":"=&v"(hi[ks]):"v"(vb),"i"(d0*4096+ks*1024+512):"memory");}
    asm volatile("s_waitcnt lgkmcnt(0)":::"memory");SBAR();
    #define PK(k) (bf16x8){lo[k][0],lo[k][1],lo[k][2],lo[k][3],hi[k][0],hi[k][1],hi[k][2],hi[k][3]}
    o[d0]=__builtin_amdgcn_mfma_f32_32x32x16_bf16(pa0,PK(0),o[d0],0,0,0);
    o[d0]=__builtin_amdgcn_mfma_f32_32x32x16_bf16(pa1,PK(1),o[d0],0,0,0);
    o[d0]=__builtin_amdgcn_mfma_f32_32x32x16_bf16(pa2,PK(2),o[d0],0,0,0);
    o[d0]=__builtin_amdgcn_mfma_f32_32x32x16_bf16(pa3,PK(3),o[d0],0,0,0);
    #undef PK
  }
}

#ifndef ATTN_STORE16
#define ATTN_STORE16(p,v) (*(u32x4*)(p)=(v))
#endif
template<int THRL> __device__ __forceinline__ void attn_unit(int b,int h,int qb,const bf16*Q,const bf16*__restrict__ K,const bf16*__restrict__ V,bf16*O,char*shm){
  int tid=threadIdx.x; asm volatile("":"+v"(tid)); const int lane=tid&63,r32=lane&31,hi=lane>>5; const int wid=__builtin_amdgcn_readfirstlane(tid>>6);
  const long rowbase=(long)b*SEQ; const int q0=qb*QB;
  const bf16*Qw=Q+(rowbase+q0+wid*QBLK)*DM+h*D;
  const bf16*Kh=K+rowbase*DM+h*D,*Vh=V+rowbase*DM+h*D;
  const unsigned lds0=(unsigned)(uintptr_t)shm;
  float*wsf=(float*)(shm+LDS_WS)+wid*64;
  const bf16*ksrc=Kh+(long)lane*DM+wid*8;
  const bf16*vsrc=Vh+(long)(16*(wid&3)+(lane>>2))*DM+(wid>>2)*32+(lane&3)*8;
  const unsigned kdst=lds0+LDS_K+wid*1024, vdst=lds0+LDS_V+wid*1024;
  #define TM(t) (((t)<4)?(NT-4+(t)):((t)-4))
  #define DMA_K(t,slot) glds16(ksrc+(long)TM(t)*KVBLK*DM,(unsigned)__builtin_amdgcn_readfirstlane(kdst+(slot)))
  #define DMA_V(t,slot) glds16(vsrc+(long)TM(t)*KVBLK*DM,(unsigned)__builtin_amdgcn_readfirstlane(vdst+(slot)))
  const int vb0=(int)(lds0+LDS_V)+((lane>>4)&1)*32+(lane&3)*8+(4*hi+((lane&15)>>2))*64;
  const char*Kbase=shm+LDS_K; bf16x8 kf[8];
  const lds_cptr shm3=(lds_cptr)shm; const lds_cptr kp0=shm3+LDS_K+hi*1024+r32*16; const lds_cptr vp0=shm3+LDS_V+((lane>>4)&1)*32+(lane&3)*8+(4*hi+((lane&15)>>2))*64;
  const int NT=(q0+QB)/KVBLK;
  DMA_K(0,0);DMA_V(0,0);DMA_K(1,SLOTB);
  bf16x8 qr[4];
  #pragma unroll
  for(int d0=0;d0<4;++d0)qr[d0]=*reinterpret_cast<const bf16x8*>(&Qw[(long)r32*DM+d0*16+hi*8]);
  #define SELK(tt) (((tt)<4)||((((const unsigned*)(shm+LDS_BYTES))[wid*QBLK+r32]>>(((tt)-4)>>2))&1u))
  float mhat=0.f,l_reg=0.f;f32x16 o[2];o[0]=f32x16{};o[1]=f32x16{};f32x16 negm=f32x16{};asm volatile("":"+v"(negm));
  const int qrel=wid*QBLK+r32;
  #define CMASK(P0,P1,t) do{int jb_=(t); if(jb_<4)cmask(P0,P1,jb_,qrel,hi); else { const bool keep_=SELK(jb_); _Pragma("unroll") for(int r=0;r<16;++r){P0[r]=keep_?P0[r]:-INFINITY;P1[r]=keep_?P1[r]:-INFINITY;} } }while(0)
  bool resc=false;
  #define START(P0,P1) do{ const float rm=rowmax(P0,P1); resc=false; \
    { const float dl=rm; mhat=fadd_s(mhat,dl); \
      _Pragma("unroll") for(int r=0;r<16;++r){P0[r]=fsub_s(P0[r],dl);P1[r]=fsub_s(P1[r],dl);} \
      _Pragma("unroll") for(int r=0;r<16;++r)negm[r]=-mhat; asm volatile("":"+v"(negm)); } \
    _Pragma("unroll") for(int r=0;r<16;++r)P0[r]=__builtin_amdgcn_exp2f(P0[r]); }while(0)
  #define RESC() do{ if(resc){ asm volatile("s_waitcnt lgkmcnt(0)":::"memory"); \
      _Pragma("unroll") for(int d_=0;d_<2;++d_) _Pragma("unroll") for(int r=0;r<16;++r)o[d_][r]*=wsf[crow(r,hi)]; } }while(0)
  f32x16 pA0,pA1,pB0,pB1;
  int sl_prev=0,sl_cur=0,sl_next=SLOTB;
  #define ROT() do{sl_prev=sl_cur;sl_cur=sl_next;sl_next=(sl_next==(NSLOT-1)*SLOTB)?0:sl_next+SLOTB;}while(0)
  DMA_K(2,2*SLOTB);
  WAIT_BAR(3);
  qkt(pA0,pA1,Kbase,qr,negm,r32,hi);asm volatile("s_nop 15\n\ts_nop 7":"+v"(pA0),"+v"(pA1));CMASK(pA0,pA1,0);
  START(pA0,pA1);
  _Pragma("unroll") for(int r=0;r<16;++r)pA1[r]=__builtin_amdgcn_exp2f(pA1[r]);
  WAIT_BAR(0);
  DMA_K(3,0);DMA_V(1,SLOTB);
  ROT();
  kload8(kf,kp0+sl_cur);
  WAIT_BAR(2);
  s16x4 vlo[8],vhi[8]; u32x4 pw0,pw1,pw2,pw3;
  #define PKW(P,B) cvtpk_s(P[B],P[B+1])
  #define PAF(k) __builtin_bit_cast(bf16x8,pw##k)
  #define VFR(i) (bf16x8){vlo[i][0],vlo[i][1],vlo[i][2],vlo[i][3],vhi[i][0],vhi[i][1],vhi[i][2],vhi[i][3]}
  #define PIN(x) asm volatile("":"+v"(x))
  #define MX3(a,b,c) __builtin_fmaxf(__builtin_fmaxf((a),(b)),(c))
  #define GAPA(MF,A0,A1,A2,A3,W0,W1,PW) do{ MF; sacc+=A0; sacc+=A1; sacc+=A2; sacc+=A3; PIN(sacc); W0; W1; PIN(PW); SBAR(); }while(0)
  #define EX(v) __builtin_amdgcn_exp2f(v)
  #define GAPB(MF,X,B) do{ MF; X[B]=EX(X[B]); X[B+1]=EX(X[B+1]); X[B+2]=EX(X[B+2]); X[B+3]=EX(X[B+3]); PIN(X); SBAR(); }while(0)
  #define VRD(i) do{ vlo[i]=vtr(vp_+(((i)>>2)*4096+((i)&3)*1024)); vhi[i]=vtr(vp_+(((i)>>2)*4096+((i)&3)*1024+512)); }while(0)
  #define KRD(G,j) do{ if(G){ kload2(kf,kp0+sl_next,j); SBAR(); } }while(0)
  #define STEP(C0,C1,P0,P1,t,GK,GV,GL) do{ SBAR(); \
    const lds_cptr vp_=vp0+sl_prev; \
    VRD(0); SBAR(); float sacc=(P0[0]+P0[1]); \
    GAPA(C0=__builtin_amdgcn_mfma_f32_32x32x16_bf16(kf[0],qr[0],negm,0,0,0), P0[2],P0[3],P0[4],P0[5],     pw0[0]=PKW(P0,0), pw0[1]=PKW(P0,2), pw0); \
    VRD(4); SBAR(); GAPA(C1=__builtin_amdgcn_mfma_f32_32x32x16_bf16(kf[1],qr[0],negm,0,0,0), P0[6],P0[7],P0[8],P0[9],     pw0[2]=PKW(P0,4), pw0[3]=PKW(P0,6), pw0); \
    VRD(1); SBAR(); GAPA(C0=__builtin_amdgcn_mfma_f32_32x32x16_bf16(kf[2],qr[1],C0,0,0,0),   P0[10],P0[11],P0[12],P0[13], pw1[0]=PKW(P0,8), pw1[1]=PKW(P0,10), pw1); \
    VRD(5); SBAR(); GAPA(C1=__builtin_amdgcn_mfma_f32_32x32x16_bf16(kf[3],qr[1],C1,0,0,0),   P0[14],P0[15],P1[0],P1[1],   pw1[2]=PKW(P0,12),pw1[3]=PKW(P0,14), pw1); \
    VRD(2); SBAR(); GAPA(C0=__builtin_amdgcn_mfma_f32_32x32x16_bf16(kf[4],qr[2],C0,0,0,0),   P1[2],P1[3],P1[4],P1[5],     pw2[0]=PKW(P1,0), pw2[1]=PKW(P1,2), pw2); \
    VRD(6); SBAR(); GAPA(C1=__builtin_amdgcn_mfma_f32_32x32x16_bf16(kf[5],qr[2],C1,0,0,0),   P1[6],P1[7],P1[8],P1[9],     pw2[2]=PKW(P1,4), pw2[3]=PKW(P1,6), pw2); \
    VRD(3); SBAR(); GAPA(C0=__builtin_amdgcn_mfma_f32_32x32x16_bf16(kf[6],qr[3],C0,0,0,0),   P1[10],P1[11],P1[12],P1[13], pw3[0]=PKW(P1,8), pw3[1]=PKW(P1,10), pw3); \
    VRD(7); SBAR(); GAPA(C1=__builtin_amdgcn_mfma_f32_32x32x16_bf16(kf[7],qr[3],C1,0,0,0),   P1[14],P1[15],0.f,0.f,       pw3[2]=PKW(P1,12),pw3[3]=PKW(P1,14), pw3); \
    l_reg+=sacc; \
    if(GK){DMA_K((t)+3,sl_cur);} if(GV){DMA_V((t)+1,sl_next);} \
    CMASK(C0,C1,t); \
    { float a=MX3(C0[0],C0[1],C1[0]),b=MX3(C0[2],C0[3],C1[1]); a=MX3(a,C1[2],C1[3]); \
      _Pragma("unroll") for(int r=4;r<16;r+=4){a=MX3(a,C0[r],C0[r+1]);b=MX3(b,C0[r+2],C0[r+3]);a=MX3(a,C1[r],C1[r+1]);b=MX3(b,C1[r+2],C1[r+3]);} \
      float rm=__builtin_fmaxf(a,b); { auto rr=__builtin_amdgcn_permlane32_swap(__float_as_uint(rm),__float_as_uint(rm),false,false); rm=__builtin_fmaxf(__uint_as_float(rr[0]),__uint_as_float(rr[1])); } \
      resc=false; \
      if(__builtin_expect(__any(rm>(float)THRL),0)){ const float dl=__builtin_fmaxf(rm,0.f); mhat+=dl; \
        _Pragma("unroll") for(int r=0;r<16;++r){C0[r]-=dl;C1[r]-=dl;} \
        _Pragma("unroll") for(int r=0;r<16;++r)negm[r]=-mhat; asm volatile("":"+v"(negm)); \
        const float f=__builtin_amdgcn_exp2f(-dl); l_reg*=f; if(hi==0)wsf[r32]=f; resc=true; } } \
    SBAR(); \
    GAPB(o[0]=__builtin_amdgcn_mfma_f32_32x32x16_bf16(PAF(0),VFR(0),o[0],0,0,0), C0,0); \
    GAPB(o[1]=__builtin_amdgcn_mfma_f32_32x32x16_bf16(PAF(0),VFR(4),o[1],0,0,0), C0,4); \
    KRD(GL,0); GAPB(o[0]=__builtin_amdgcn_mfma_f32_32x32x16_bf16(PAF(1),VFR(1),o[0],0,0,0), C0,8); \
    KRD(GL,1); GAPB(o[1]=__builtin_amdgcn_mfma_f32_32x32x16_bf16(PAF(1),VFR(5),o[1],0,0,0), C0,12); \
    KRD(GL,2); GAPB(o[0]=__builtin_amdgcn_mfma_f32_32x32x16_bf16(PAF(2),VFR(2),o[0],0,0,0), C1,0); \
    KRD(GL,3); GAPB(o[1]=__builtin_amdgcn_mfma_f32_32x32x16_bf16(PAF(2),VFR(6),o[1],0,0,0), C1,4); \
    GAPB(o[0]=__builtin_amdgcn_mfma_f32_32x32x16_bf16(PAF(3),VFR(3),o[0],0,0,0), C1,8); \
    GAPB(o[1]=__builtin_amdgcn_mfma_f32_32x32x16_bf16(PAF(3),VFR(7),o[1],0,0,0), C1,12); \
    }while(0)
  int t=1;
  for(;t+5<NT;t+=2){
    STEP(pB0,pB1,pA0,pA1,t,true,true,true);     WAIT_BAR(2); RESC(); ROT();
    STEP(pA0,pA1,pB0,pB1,t+1,true,true,true);   WAIT_BAR(2); RESC(); ROT();
  }
  #define ENDW(tt) do{ if((tt)+3<NT){WAIT_BAR(2);} else if((tt)+2<NT){WAIT_BAR(1);} else {WAIT_BAR(0);} }while(0)
  for(;t+1<NT;t+=2){
    STEP(pB0,pB1,pA0,pA1,t,(t+3<NT),(t+1<NT),(t+1<NT));       ENDW(t);   RESC(); ROT();
    STEP(pA0,pA1,pB0,pB1,t+1,(t+4<NT),(t+2<NT),(t+2<NT));     ENDW(t+1); RESC(); ROT();
  }
  STEP(pB0,pB1,pA0,pA1,NT-1,false,false,false); RESC();
  { float sacc=pB0[0]+pB0[1]; _Pragma("unroll") for(int r=2;r<16;++r)sacc+=pB0[r]; _Pragma("unroll") for(int r=0;r<16;++r)sacc+=pB1[r]; l_reg+=sacc;
    pw0=(u32x4){PKW(pB0,0),PKW(pB0,2),PKW(pB0,4),PKW(pB0,6)};pw1=(u32x4){PKW(pB0,8),PKW(pB0,10),PKW(pB0,12),PKW(pB0,14)};pw2=(u32x4){PKW(pB1,0),PKW(pB1,2),PKW(pB1,4),PKW(pB1,6)};pw3=(u32x4){PKW(pB1,8),PKW(pB1,10),PKW(pB1,12),PKW(pB1,14)};
    SBAR(); pv(o,vb0+sl_cur,PAF(0),PAF(1),PAF(2),PAF(3)); }
  #undef PKW
  #undef PAF
  #undef VFR
  #undef PIN
  #undef MX3
  #undef GAPA
  #undef GAPB
  #undef EX
  #undef VRD
  #undef KRD
  #undef STEP
  #undef ENDW
  {auto rr=__builtin_amdgcn_permlane32_swap(__float_as_uint(l_reg),__float_as_uint(l_reg),false,false);l_reg=__uint_as_float(rr[0])+__uint_as_float(rr[1]);}
  if(hi==0)wsf[32+r32]=l_reg;asm volatile("s_waitcnt lgkmcnt(0)":::"memory");
  float rli[16];
  #pragma unroll
  for(int r=0;r<16;++r)rli[r]=__builtin_amdgcn_rcpf(wsf[32+crow(r,hi)]);
  bf16*Ow=O+(rowbase+q0+wid*QBLK)*DM+h*D;
  { bf16*stg=(bf16*)(shm+LDS_OST)+wid*2048;
    #pragma unroll
    for(int r=0;r<16;++r){const int orow=crow(r,hi);
      #pragma unroll
      for(int d0=0;d0<2;++d0)stg[orow*64+d0*32+r32]=__float2bfloat16(o[d0][r]*rli[r]);}
    asm volatile("s_waitcnt lgkmcnt(0)":::"memory");
    #pragma unroll
    for(int i=0;i<4;++i){const int row=i*8+(lane>>3),ch=lane&7; const u32x4 v=*(const u32x4*)(stg+row*64+ch*8); ATTN_STORE16(Ow+(long)row*DM+ch*8,v);} }
  asm volatile("s_waitcnt lgkmcnt(0)\n\ts_barrier":::"memory");
  #undef DMA_K
  #undef TM
  #undef SELK
  #undef DMA_V
  #undef CMASK
  #undef START
  #undef RESC
  #undef ROT
}

__device__ __forceinline__ void moba_gate(int b,int h,int qb,const bf16*Q,const float*__restrict__ kmean,char*shm){
  int tid=threadIdx.x; asm volatile("":"+v"(tid));
  if(tid<QB){
    unsigned selmask=0u;
    if(qb>0){
      const unsigned short*qrow=(const unsigned short*)Q+((long)b*SEQ+qb*QB+tid)*DM+h*D;
      const float*kmb=kmean+(long)((b*NHEAD+h)*16)*64;
      float g0=-INFINITY,g1=-INFINITY,g2=-INFINITY; int i0=-1,i1=-1,i2=-1;
      for(int n=0;n<qb;++n){
        float g=0.f;
        #pragma unroll
        for(int c=0;c<8;++c){
          const u32x4 qv=*reinterpret_cast<const u32x4*>(qrow+c*8);
          const f32x4_t ka=*reinterpret_cast<const f32x4_t*>(kmb+n*64+c*8), kb=*reinterpret_cast<const f32x4_t*>(kmb+n*64+c*8+4);
          g+=__builtin_bit_cast(float,qv.x<<16)*ka[0]; g+=__builtin_bit_cast(float,qv.x&0xffff0000u)*ka[1];
          g+=__builtin_bit_cast(float,qv.y<<16)*ka[2]; g+=__builtin_bit_cast(float,qv.y&0xffff0000u)*ka[3];
          g+=__builtin_bit_cast(float,qv.z<<16)*kb[0]; g+=__builtin_bit_cast(float,qv.z&0xffff0000u)*kb[1];
          g+=__builtin_bit_cast(float,qv.w<<16)*kb[2]; g+=__builtin_bit_cast(float,qv.w&0xffff0000u)*kb[3];
        }
        if(g>g0){g2=g1;i2=i1;g1=g0;i1=i0;g0=g;i0=n;} else if(g>g1){g2=g1;i2=i1;g1=g;i1=n;} else if(g>g2){g2=g;i2=n;}
      }
      if(i0>=0)selmask|=1u<<i0; if(i1>=0)selmask|=1u<<i1; if(i2>=0)selmask|=1u<<i2;
    }
    { int t2=tid; asm volatile("":"+v"(t2)); ((unsigned*)(shm+LDS_BYTES))[t2]=selmask; }
  }
  asm volatile("s_waitcnt lgkmcnt(0)\n\ts_barrier":::"memory");
}
constexpr int ATTN_LDS_BYTES=LDS_BYTES;
struct AttnTensors { const bf16* Q; const bf16* K; const bf16* V; bf16* O; const float* kmean; };
struct AttnUnit { int bh; int qb; };
struct StaticOrder {
  int vcu;
  __device__ __forceinline__ explicit StaticOrder(int grid,int block):vcu((block%8)*(grid/8)+block/8){}
  __device__ __forceinline__ bool next(int i,AttnUnit&u)const{ if(i>=8)return false; const int half=vcu&1; u.bh=vcu>>1;
    const int pr=3-(i>>1);
    u.qb=(i&1)?(half?(4*pr+1):(4*pr)):(half?(4*pr+2):(4*pr+3)); return true; }
  __device__ __forceinline__ void a_ready(const AttnUnit&)const{}
  __device__ __forceinline__ void done(const AttnUnit&)const{}
};
struct QueueOrder {
  unsigned* ctr; volatile __attribute__((address_space(3))) unsigned* slot;
  __device__ __forceinline__ bool next(int,AttnUnit&u)const{
    if(threadIdx.x==0)*slot=__hip_atomic_fetch_add(ctr,1u,__ATOMIC_RELAXED,__HIP_MEMORY_SCOPE_AGENT);
    __syncthreads(); const unsigned k=*slot; __syncthreads();
    if(k>=2048u)return false; u.qb=15-(int)(k>>7); u.bh=(int)(k&127u); return true; }
  __device__ __forceinline__ void a_ready(const AttnUnit&)const{}
  __device__ __forceinline__ void done(const AttnUnit&)const{}
};
template<class Sched,int THRL=8> __device__ __forceinline__ void attn_phase(char*lds,const AttnTensors&T,const Sched&S){
  AttnUnit u;
  for(int i=0;S.next(i,u);++i){ S.a_ready(u); moba_gate(u.bh/NHEAD,u.bh%NHEAD,u.qb,T.Q,T.kmean,lds); attn_unit<THRL>(u.bh/NHEAD,u.bh%NHEAD,u.qb,T.Q,T.K,T.V,T.O,lds); S.done(u); }
}
#undef SBAR
#undef WAIT_BAR
}
namespace mlstm {
#define ML_LAS __attribute__((address_space(3)))
typedef short bf16x8 __attribute__((ext_vector_type(8)));
typedef short s16x4 __attribute__((ext_vector_type(4)));
typedef float f32x4 __attribute__((ext_vector_type(4)));
typedef unsigned u32x4 __attribute__((ext_vector_type(4)));
typedef unsigned u32x2 __attribute__((ext_vector_type(2)));
constexpr int PQ = 272, PV = 336, PA = 144;
constexpr int O_QC = 0, O_KC = O_QC + 64 * PQ, O_HST = O_KC + 64 * PQ, O_VP = O_HST + 64 * PQ, O_VW = O_VP + 64 * PV, O_ST = O_VW + 64 * PV, O_AM = O_ST + 128 * PV,
              O_CW = O_AM + 64 * PA, O_EX = O_CW + 2 * 5 * 128 * 4, O_SCR = O_EX + 3 * 64 * 4, O_CH = O_SCR + 64 * 4, LDS_END = O_CH + 2 * 4 * 64 * 4;
static_assert(LDS_END <= 156 * 1024, "mlstm LDS");
struct Args { const bf16_t* mq; const bf16_t* mk; const bf16_t* mv; const bf16_t* mosig; const float* ifg; const float* conv_w; const float* conv_b; const float* nw; float* sca; float* scm; float* scb; bf16_t* hm; };
__device__ __forceinline__ s16x4 trd(const ML_LAS unsigned char* p) { return __builtin_bit_cast(s16x4, __builtin_amdgcn_ds_read_tr16_b64_v4i16((ML_LAS s16x4*)p)); }
__device__ __forceinline__ bf16x8 cat8(s16x4 lo, s16x4 hi) { return (bf16x8){lo[0], lo[1], lo[2], lo[3], hi[0], hi[1], hi[2], hi[3]}; }
__device__ __forceinline__ float blo(unsigned w) { return __builtin_bit_cast(float, w << 16); }
__device__ __forceinline__ float bhi(unsigned w) { return __builtin_bit_cast(float, w & 0xffff0000u); }
__device__ __forceinline__ float logsig(float f) { return (f >= 0.f) ? -log1pf(__expf(-f)) : f - log1pf(__expf(f)); }

__device__ __forceinline__ void unit(int b, int h, const Args& A, ML_LAS unsigned char* lds) {
    int tid = threadIdx.x; asm volatile("" : "+v"(tid)); const int lane = tid & 63, wid = __builtin_amdgcn_readfirstlane(tid >> 6);
    int tidv = tid; int l15 = tidv & 15, q4 = (tidv >> 4) & 3, d8 = tidv & 15, row0 = 2 * (tidv >> 4);
    const size_t tb = (size_t)b * 4096, sb = (size_t)(b * 4 + h) * 4096;
    ML_LAS float* cwl = (ML_LAS float*)(lds + O_CW); ML_LAS float* ex = (ML_LAS float*)(lds + O_EX); ML_LAS float* scr = (ML_LAS float*)(lds + O_SCR); ML_LAS float* chs = (ML_LAS float*)(lds + O_CH);
    for (int i = tid; i < 1280; i += 512) { const int qk = i / 640, r = (i % 640) >> 7, d = i & 127, ch = qk * 512 + h * 128 + d; cwl[i] = (r < 4) ? A.conv_w[r * 1024 + ch] : A.conv_b[ch]; }
    for (int i = tid; i < 128 * PV / 16; i += 512) *(ML_LAS u32x4*)(lds + O_ST + i * 16) = (u32x4){0u, 0u, 0u, 0u};
    if (tid < 256) { const int r = tid >> 2, part = tid & 3;
        *(ML_LAS u32x4*)(lds + O_VP + r * PV + 256 + part * 16) = (u32x4){part == 0 ? 0x3F80u : 0u, 0u, 0u, 0u};
        *(ML_LAS u32x4*)(lds + O_VW + r * PV + 256 + part * 16) = (u32x4){0u, 0u, 0u, 0u}; }
    {
        float lfv[8], av[8]; float run = 0.f;
#pragma unroll
        for (int j = 0; j < 8; ++j) { const float f = A.ifg[(tb + 8 * tid + j) * 8 + 4 + h]; run += logsig(f); lfv[j] = run; }
        float incl = run;
#pragma unroll
        for (int o = 1; o < 64; o <<= 1) { const float t = __shfl_up(incl, o); if (lane >= o) incl += t; }
        if (lane == 63) scr[wid] = incl;
        __syncthreads();
        float pre = incl - run; for (int w = 0; w < wid; ++w) pre += scr[w];
        float m = -INFINITY;
#pragma unroll
        for (int j = 0; j < 8; ++j) { const float Bv = pre + lfv[j]; const float a = A.ifg[(tb + 8 * tid + j) * 8 + h] - Bv; A.scb[sb + 8 * tid + j] = Bv; A.sca[sb + 8 * tid + j] = a; m = fmaxf(m, a); av[j] = m; }
        float im = m;
#pragma unroll
        for (int o = 1; o < 64; o <<= 1) { const float t = __shfl_up(im, o); if (lane >= o) im = fmaxf(im, t); }
        if (lane == 63) scr[8 + wid] = im;
        __syncthreads();
        float pm = __shfl_up(im, 1); if (lane == 0) pm = -INFINITY; pm = fmaxf(pm, 0.f); for (int w = 0; w < wid; ++w) pm = fmaxf(pm, scr[8 + w]);
#pragma unroll
        for (int j = 0; j < 8; ++j) A.scm[sb + 8 * tid + j] = fmaxf(pm, av[j]);
    }
    __threadfence(); __syncthreads();
    f32x4 accS[20];
#pragma unroll
    for (int v = 0; v < 20; ++v) accS[v] = (f32x4){0.f, 0.f, 0.f, 0.f};
    uint4 rq[5], rk[5], rv[2]; float chv = 0.f;
#define goff ((unsigned)(tb * 512) + h * 128 + 8 * d8)
#define ML_LOAD(c) do { const int c0_ = (c) * 64; \
        _Pragma("unroll") for (int j = 0; j < 5; ++j) { const int rr = c0_ + row0 - 3 + j; if (rr >= 0) { rq[j] = *(const uint4*)(A.mq + goff + rr * 512); rk[j] = *(const uint4*)(A.mk + goff + rr * 512); } else { rq[j] = make_uint4(0u, 0u, 0u, 0u); rk[j] = rq[j]; } } \
        _Pragma("unroll") for (int j = 0; j < 2; ++j) { rv[j] = *(const uint4*)(A.mv + goff + (c0_ + row0 + j) * 512); \
            } } while (0)
#define ML_LOADS(c) do { const int c0_ = (c) * 64; \
        if (tidv < 192) { chv = A.sca[(size_t)(tidv >> 6) * (16 * 4 * 4096) + sb + c0_ + (tidv & 63)]; }     else if (tidv == 192) chv = (c0_ == 0) ? 0.f : A.scm[sb + c0_ - 1]; } while (0)
    ML_LOAD(0); ML_LOADS(0);
    if (tidv < 193) chs[tidv] = chv;
    __syncthreads();
    for (int c = 0; c < 64; ++c) {
        asm volatile("" : "+v"(tidv)); l15 = tidv & 15; q4 = (tidv >> 4) & 3; d8 = l15; row0 = 2 * (tidv >> 4);
        const int c0 = c * 64; const ML_LAS float* ch = chs + (c & 1) * 256;
#pragma unroll
        for (int qk = 0; qk < 2; ++qk) {
            const ML_LAS float* wq = cwl + qk * 640 + 8 * d8;
            float y[2][8];
            { const f32x4 b0 = *(const ML_LAS f32x4*)(wq + 512), b1 = *(const ML_LAS f32x4*)(wq + 516);
#pragma unroll
              for (int e = 0; e < 4; ++e) { y[0][e] = b0[e]; y[0][4 + e] = b1[e]; y[1][e] = b0[e]; y[1][4 + e] = b1[e]; } }
#pragma unroll
            for (int j = 0; j < 4; ++j) {
                const f32x4 w0 = *(const ML_LAS f32x4*)(wq + j * 128), w1 = *(const ML_LAS f32x4*)(wq + j * 128 + 4);
#pragma unroll
                for (int ro = 0; ro < 2; ++ro) { const uint4 u = qk ? rk[ro + j] : rq[ro + j]; const unsigned uw[4] = {u.x, u.y, u.z, u.w};
                    y[ro][0] += w0[0] * blo(uw[0]); y[ro][1] += w0[1] * bhi(uw[0]); y[ro][2] += w0[2] * blo(uw[1]); y[ro][3] += w0[3] * bhi(uw[1]);
                    y[ro][4] += w1[0] * blo(uw[2]); y[ro][5] += w1[1] * bhi(uw[2]); y[ro][6] += w1[2] * blo(uw[3]); y[ro][7] += w1[3] * bhi(uw[3]); }
            }
#pragma unroll
            for (int ro = 0; ro < 2; ++ro) {
#pragma unroll
                for (int e = 0; e < 8; ++e) { y[ro][e] = y[ro][e] * __builtin_amdgcn_rcpf(1.0f + __expf(-y[ro][e])); if (qk) y[ro][e] *= 0.08838834764831845f; }
                *(ML_LAS u32x4*)(lds + (qk ? O_KC : O_QC) + (row0 + ro) * PQ + 16 * d8) = (u32x4){pk2(y[ro][0], y[ro][1]), pk2(y[ro][2], y[ro][3]), pk2(y[ro][4], y[ro][5]), pk2(y[ro][6], y[ro][7])};
            }
        }
#pragma unroll
        for (int ro = 0; ro < 2; ++ro) {
            *(ML_LAS u32x4*)(lds + O_VP + (row0 + ro) * PV + 16 * d8) = (u32x4){rv[ro].x, rv[ro].y, rv[ro].z, rv[ro].w};
            const float wsv = __expf(ch[row0 + ro] - ch[127]); const unsigned uw[4] = {rv[ro].x, rv[ro].y, rv[ro].z, rv[ro].w}; unsigned o[4];
#pragma unroll
            for (int e2 = 0; e2 < 4; ++e2) o[e2] = pk2(blo(uw[e2]) * wsv, bhi(uw[e2]) * wsv);
            *(ML_LAS u32x4*)(lds + O_VW + (row0 + ro) * PV + 16 * d8) = (u32x4){o[0], o[1], o[2], o[3]};
            if (d8 == 0) *(ML_LAS unsigned short*)(lds + O_VW + (row0 + ro) * PV + 256) = (unsigned short)f2bf(wsv);
        }
        __syncthreads();
        const float Mref = ch[192], Mend = ch[127];
        const int trow = 16 * (wid & 3) + 4 * q4;
        const f32x4 Mxr = *(const ML_LAS f32x4*)(ch + 64 + trow);
        if (wid < 4) {
#pragma unroll
            for (int v = 0; v < 10; ++v) accS[v] = (f32x4){0.f, 0.f, 0.f, 0.f};
#pragma unroll
            for (int ks = 0; ks < 4; ++ks) {
                const bf16x8 a = *(const ML_LAS bf16x8*)(lds + O_QC + (16 * wid + l15) * PQ + (32 * ks + 8 * q4) * 2);
                const ML_LAS unsigned char* bp = lds + O_ST + (32 * ks + 8 * q4 + (l15 >> 2)) * PV + (l15 & 3) * 8;
#pragma unroll
                for (int v = 0; v < 10; ++v) { const bf16x8 bfr = cat8(trd(bp + 32 * v), trd(bp + 4 * PV + 32 * v)); accS[v] = __builtin_amdgcn_mfma_f32_16x16x32_bf16(a, bfr, accS[v], 0, 0, 0); }
            }
            float wi[4];
#pragma unroll
            for (int i = 0; i < 4; ++i) wi[i] = __expf(Mref - Mxr[i]);
#pragma unroll
            for (int v = 0; v < 10; ++v)
#pragma unroll
                for (int i = 0; i < 4; ++i) accS[v][i] *= wi[i];
        } else {
            const int j = wid - 4;
#pragma unroll
            for (int tile = 0; tile < 16; ++tile) {
                if ((int)((0x3333322221120000ull >> (4 * tile)) & 15ull) != j) continue;
                const int st = tile >> 2, tt = tile & 3;
                f32x4 cacc = (f32x4){0.f, 0.f, 0.f, 0.f};
                if (st <= tt) {
#pragma unroll
                    for (int ks = 0; ks < 4; ++ks) {
                        const bf16x8 a = *(const ML_LAS bf16x8*)(lds + O_KC + (16 * st + l15) * PQ + (32 * ks + 8 * q4) * 2);
                        const bf16x8 bq = *(const ML_LAS bf16x8*)(lds + O_QC + (16 * tt + l15) * PQ + (32 * ks + 8 * q4) * 2);
                        cacc = __builtin_amdgcn_mfma_f32_16x16x32_bf16(a, bq, cacc, 0, 0, 0);
                    }
                }
                const int t = 16 * tt + l15, s0 = 16 * st + 4 * q4;
                const float Mt = ch[64 + t]; const f32x4 as = *(const ML_LAS f32x4*)(ch + s0);
                float o[4];
#pragma unroll
                for (int i = 0; i < 4; ++i) o[i] = (s0 + i <= t) ? cacc[i] * __expf(as[i] - Mt) : 0.f;
                *(ML_LAS u32x2*)(lds + O_AM + t * PA + s0 * 2) = (u32x2){pk2(o[0], o[1]), pk2(o[2], o[3])};
            }
            const float decay = __expf(Mref - Mend);
#pragma unroll
            for (int v = 0; v < 20; ++v) accS[v] = accS[v] * decay;
#pragma unroll
            for (int ks = 0; ks < 2; ++ks) {
                const ML_LAS unsigned char* kp = lds + O_KC + (32 * ks + 8 * q4 + (l15 >> 2)) * PQ + 64 * j + (l15 & 3) * 8;
                const bf16x8 bf0 = cat8(trd(kp), trd(kp + 4 * PQ)), bf1 = cat8(trd(kp + 32), trd(kp + 4 * PQ + 32));
                const ML_LAS unsigned char* ap = lds + O_VW + (32 * ks + 8 * q4 + (l15 >> 2)) * PV + (l15 & 3) * 8;
#pragma unroll
                for (int v = 0; v < 10; ++v) { const bf16x8 afr = cat8(trd(ap + 32 * v), trd(ap + 4 * PV + 32 * v));
                    accS[v] = __builtin_amdgcn_mfma_f32_16x16x32_bf16(afr, bf0, accS[v], 0, 0, 0); accS[10 + v] = __builtin_amdgcn_mfma_f32_16x16x32_bf16(afr, bf1, accS[10 + v], 0, 0, 0); }
            }
        }
        __syncthreads();
        if (c + 1 < 64) ML_LOADS(c + 1);
        if (wid < 4) {
#pragma unroll
            for (int ks = 0; ks < 2; ++ks) {
                const bf16x8 a = *(const ML_LAS bf16x8*)(lds + O_AM + (16 * wid + l15) * PA + (32 * ks + 8 * q4) * 2);
                const ML_LAS unsigned char* bp = lds + O_VP + (32 * ks + 8 * q4 + (l15 >> 2)) * PV + (l15 & 3) * 8;
#pragma unroll
                for (int v = 0; v < 10; ++v) { const bf16x8 bfr = cat8(trd(bp + 32 * v), trd(bp + 4 * PV + 32 * v)); accS[v] = __builtin_amdgcn_mfma_f32_16x16x32_bf16(a, bfr, accS[v], 0, 0, 0); }
            }
            const f32x4 Bcr = *(const ML_LAS f32x4*)(ch + 128 + trow);
#pragma unroll
            for (int i = 0; i < 4; ++i) {
                float ssum = 0.f;
#pragma unroll
                for (int v = 0; v < 8; ++v) ssum += accS[v][i] * accS[v][i];
                ssum += __shfl_xor(ssum, 1); ssum += __shfl_xor(ssum, 2); ssum += __shfl_xor(ssum, 4); ssum += __shfl_xor(ssum, 8);
                const float den = __shfl(accS[8][i], lane & 48);
                const float dn = fmaxf(fabsf(den), __expf(-(Bcr[i] + Mxr[i]))), idn = 1.0f / dn;
                const float sc = idn * rsqrtf(ssum * idn * idn * (1.0f / 128.0f) + 1e-6f);
#pragma unroll
                for (int v = 0; v < 8; ++v) *(ML_LAS unsigned short*)(lds + O_HST + (trow + i) * PQ + (16 * v + l15) * 2) = (unsigned short)f2bf(accS[v][i] * sc);
            }
        } else {
            const int j = wid - 4;
#pragma unroll
            for (int v = 0; v < 10; ++v) {
                *(ML_LAS u32x2*)(lds + O_ST + (32 * j + l15) * PV + (16 * v + 4 * q4) * 2) = (u32x2){pk2(accS[v][0], accS[v][1]), pk2(accS[v][2], accS[v][3])};
                *(ML_LAS u32x2*)(lds + O_ST + (32 * j + 16 + l15) * PV + (16 * v + 4 * q4) * 2) = (u32x2){pk2(accS[10 + v][0], accS[10 + v][1]), pk2(accS[10 + v][2], accS[10 + v][3])}; }
        }
        if (c + 1 < 64) ML_LOAD(c + 1);
        if (tidv < 193) chs[((c + 1) & 1) * 256 + tidv] = chv;
        uint4 rmo[2];
#pragma unroll
        for (int ro = 0; ro < 2; ++ro) rmo[ro] = *(const uint4*)(A.mosig + goff + (c0 + row0 + ro) * 512);
        __syncthreads();
        f32x4 nwv[2]; nwv[0] = *(const f32x4*)(A.nw + h * 128 + 8 * d8); nwv[1] = *(const f32x4*)(A.nw + h * 128 + 8 * d8 + 4);
#pragma unroll
        for (int ro = 0; ro < 2; ++ro) {
            const u32x4 hv = *(const ML_LAS u32x4*)(lds + O_HST + (row0 + ro) * PQ + 16 * d8); const unsigned hw[4] = {hv.x, hv.y, hv.z, hv.w}; const unsigned mw[4] = {rmo[ro].x, rmo[ro].y, rmo[ro].z, rmo[ro].w}; unsigned o[4];
#pragma unroll
            for (int e2 = 0; e2 < 4; ++e2) o[e2] = pk2(blo(hw[e2]) * nwv[(2 * e2) >> 2][(2 * e2) & 3] * blo(mw[e2]), bhi(hw[e2]) * nwv[(2 * e2 + 1) >> 2][(2 * e2 + 1) & 3] * bhi(mw[e2]));
            *(uint4*)(A.hm + goff + (c0 + row0 + ro) * 512) = make_uint4(o[0], o[1], o[2], o[3]);
        }
    }
#undef ML_LOAD
#undef ML_LOADS
#undef goff
    __syncthreads();
}
}
namespace peer {
#define PE_LAS __attribute__((address_space(3)))
typedef short bf16x8 __attribute__((ext_vector_type(8)));
typedef float f32x4 __attribute__((ext_vector_type(4)));
typedef float f32x16 __attribute__((ext_vector_type(16)));
typedef unsigned u32x4 __attribute__((ext_vector_type(4)));
constexpr int QP = 528;
constexpr int O_R2 = 256 * QP;
constexpr int LDS_END = O_R2 + 1024;
__device__ __forceinline__ int ordi(float f) { const int b = __builtin_bit_cast(int, f); return b ^ ((b >> 31) & 0x7FFFFFFF); }
__device__ __forceinline__ float ordf(int o) { return __builtin_bit_cast(float, o ^ ((o >> 31) & 0x7FFFFFFF)); }
#define PE_CE(a, b) do { const int hi_ = max(a, b), lo_ = min(a, b); a = hi_; b = lo_; } while (0)
__device__ __forceinline__ void sort16_desc(int (&a)[16]) {
#pragma unroll
    for (int k = 2; k <= 16; k <<= 1)
#pragma unroll
        for (int j = k >> 1; j > 0; j >>= 1)
#pragma unroll
            for (int i = 0; i < 16; ++i) { const int l = i ^ j; if (l > i) { if ((i & k) == 0) PE_CE(a[i], a[l]); else PE_CE(a[l], a[i]); } }
}
__device__ __forceinline__ void merge16_desc(int (&a)[16], const int (&b)[16]) {
#pragma unroll
    for (int i = 0; i < 16; ++i) a[i] = max(a[i], b[15 - i]);
#pragma unroll
    for (int j = 8; j > 0; j >>= 1)
#pragma unroll
        for (int i = 0; i < 16; ++i) { const int l = i ^ j; if (l > i) PE_CE(a[i], a[l]); }
}
__device__ __forceinline__ void top16_of_64(int (&g0)[16], int (&g1)[16], int (&g2)[16], int (&g3)[16]) {
    sort16_desc(g0); sort16_desc(g1); sort16_desc(g2); sort16_desc(g3);
    merge16_desc(g0, g1); merge16_desc(g2, g3); merge16_desc(g0, g2);
}
struct Args { const float* rowss; const bf16_t* key1; const bf16_t* key2; float* r2out; int* eidx; float* eg; };
struct EpiPeerQ {
    static constexpr bool PERM = false, AFTER_DRAIN = true;
    __device__ __forceinline__ bool zero_after(const pg8::Unit&) const { return true; }
    __device__ __forceinline__ void fused(pg8::f32x4 (&acc)[2][2][4][2], const pg8::Unit& u, int wr, int wc, int fr, int fq, PG8_LAS unsigned char* lds, int wid, int lane) const {
        const PE_LAS float* r2s = (const PE_LAS float*)(lds + O_R2);
#pragma unroll
        for (int ai = 0; ai < 2; ++ai)
#pragma unroll
            for (int m = 0; m < 4; ++m) { const int row = ai * 128 + wr * 64 + m * 16 + fr; const float r = r2s[row];
#pragma unroll
                for (int bj = 0; bj < 2; ++bj) *(PE_LAS u32x4*)(lds + row * QP + (wc * 64 + bj * 32 + 8 * fq) * 2) = pg8::pack8(acc[ai][bj][m][0] * r, acc[ai][bj][m][1] * r); }
    }
};
struct SchedOne { pg8::Unit u;
    __device__ __forceinline__ bool next(int i, pg8::Unit& o) const { if (i > 0) return false; o = u; return true; }
    __device__ __forceinline__ void a_ready(const pg8::Unit&) const {}
    __device__ __forceinline__ void done(const pg8::Unit&) const {} };

__device__ __forceinline__ void half_top16(int (&g0)[16], const PE_LAS unsigned char* qrow  , const bf16_t* keyrow  , int hi) {
    f32x16 s[4];
#pragma unroll
    for (int kb = 0; kb < 4; ++kb) s[kb] = f32x16{};
#pragma unroll
    for (int ks = 0; ks < 8; ++ks) {
        const bf16x8 bq = *(const PE_LAS bf16x8*)(qrow + ks * 32);
#pragma unroll
        for (int kb = 0; kb < 4; ++kb) { const bf16x8 a = *(const bf16x8*)(keyrow + (size_t)kb * 32 * 128 + ks * 16); s[kb] = __builtin_amdgcn_mfma_f32_32x32x16_bf16(a, bq, s[kb], 0, 0, 0); }
    }
    int g1[16], g2[16], g3[16];
#pragma unroll
    for (int r = 0; r < 16; ++r) { const int kr = (r & 3) + 8 * (r >> 2) + 4 * hi;
        g0[r] = (ordi(s[0][r]) & ~0x7F) | kr; g1[r] = (ordi(s[1][r]) & ~0x7F) | (32 + kr); g2[r] = (ordi(s[2][r]) & ~0x7F) | (64 + kr); g3[r] = (ordi(s[3][r]) & ~0x7F) | (96 + kr); }
    top16_of_64(g0, g1, g2, g3);
#pragma unroll
    for (int r = 0; r < 16; ++r) g1[r] = __shfl_xor(g0[r], 32);
    merge16_desc(g0, g1);
}

__device__ __forceinline__ void unit(int pm, int h, const bf16_t* x1b, const bf16_t* wq, const Args& A, PG8_LAS unsigned char* lds) {
    int tid = threadIdx.x; asm volatile("" : "+v"(tid)); const int wid = __builtin_amdgcn_readfirstlane(tid >> 6);
    if (tid < 256) { const f32x4* rs = (const f32x4*)(A.rowss + (size_t)(pm * 256 + tid) * 16); const f32x4 a = rs[0], b = rs[1], c = rs[2], d = rs[3];
        const float ss = ((a[0] + a[1]) + (a[2] + a[3])) + ((b[0] + b[1]) + (b[2] + b[3])) + ((c[0] + c[1]) + (c[2] + c[3])) + ((d[0] + d[1]) + (d[2] + d[3]));
        const float r = rsqrtf(ss * (1.0f / 1024.0f) + 1e-6f); ((PE_LAS float*)(lds + O_R2))[tid] = r; if (h == 0) A.r2out[pm * 256 + tid] = r; }
    __syncthreads();
    SchedOne S; S.u.pm = pm; S.u.pn = h; S.u.seg = 0; S.u.pad = 0; S.u.A = (const char*)(x1b + (size_t)pm * 256 * 1024); S.u.B = (const char*)(wq + (size_t)h * 256 * 1024);
    EpiPeerQ E;
    pg8::gemm_phase<EpiPeerQ, SchedOne, true, true>(lds, 1024, S, E);
    __syncthreads();
    int tv = tid; asm volatile("" : "+v"(tv)); const int r32 = tv & 31, hi = (tv >> 5) & 1;
    int v1[16], v2[16];
    half_top16(v1, lds + (32 * wid + r32) * QP + (8 * hi) * 2, A.key1 + ((size_t)h * 128 + r32) * 128 + 8 * hi, hi);
    half_top16(v2, lds + (32 * wid + r32) * QP + (128 + 8 * hi) * 2, A.key2 + ((size_t)h * 128 + r32) * 128 + 8 * hi, hi);
    float f1[16], f2[16];
#pragma unroll
    for (int i = 0; i < 16; ++i) { f1[i] = ordf(v1[i] & ~0x7F); f2[i] = ordf(v2[i] & ~0x7F); }
    int c0[16], c1[16], c2[16], c3[16];
    {
        int n = 0;
#pragma unroll
        for (int i = 0; i < 16; ++i)
#pragma unroll
            for (int j = 0; j < 16; ++j) if ((i + 1) * (j + 1) <= 16) { const int key = (ordi(f1[i] + f2[j]) & ~0xFF) | (i << 4) | j;
                if (n < 16) c0[n] = key; else if (n < 32) c1[n - 16] = key; else if (n < 48) c2[n - 32] = key; else c3[n - 48] = key; ++n; }
#pragma unroll
        for (int k = 2; k < 16; ++k) c3[k] = (int)0x80000000;
    }
    top16_of_64(c0, c1, c2, c3);
    PE_LAS unsigned char* scr = lds + (32 * wid + r32) * QP;
    if (hi == 0) {
#pragma unroll
        for (int i = 0; i < 16; ++i) { scr[i] = (unsigned char)(v1[i] & 0x7F); scr[16 + i] = (unsigned char)(v2[i] & 0x7F); } }
    asm volatile("s_waitcnt lgkmcnt(0)" ::: "memory");
    float val[16], sum = 0.f;
#pragma unroll
    for (int r = 0; r < 16; ++r) { val[r] = __expf(ordf(c0[r] & ~0xFF) - ordf(c0[0] & ~0xFF)); sum += val[r]; }
    const float inv = 1.0f / sum;
    const size_t ob = ((size_t)(pm * 256 + 32 * wid + r32) * 8 + h) * 16;
#pragma unroll
    for (int r = 0; r < 16; ++r) if ((r >> 3) == hi) { const int code = c0[r] & 0xFF; A.eidx[ob + r] = (int)scr[code >> 4] * 128 + (int)scr[16 + (code & 15)]; A.eg[ob + r] = val[r] * inv; }
    __syncthreads();
}
}
#define XB_TMO      128
#define XB_XCNT(j)  (256  + 64 * (j))
#define XB_XSUB(j)  (1280 + 64 * (j))
#define XB_XGEN(j)  (2304 + 64 * (j))
#define XB_TOP      3328
#define XB_TOPGEN   3392
#define XCD_BAR_WORDS 3456
#define XB_SPIN_CAP (1u << 18)

__device__ __forceinline__ unsigned xb_ld(unsigned* p)              { return __hip_atomic_load(p, __ATOMIC_RELAXED, __HIP_MEMORY_SCOPE_AGENT); }
__device__ __forceinline__ unsigned xb_add(unsigned* p, unsigned v) { return __hip_atomic_fetch_add(p, v, __ATOMIC_RELAXED, __HIP_MEMORY_SCOPE_AGENT); }
__device__ __forceinline__ unsigned xb_xcc_id() { return (unsigned)__builtin_amdgcn_s_getreg((3 << 11) | 20) & 0xFu; }
#define XB_SPIN(cond, bar) do { unsigned _sp = 0; while (cond) { __builtin_amdgcn_s_sleep(1); \
    if ((++_sp & 255u) == 0u) { if (xb_ld(&(bar)[XB_TMO])) break; if (_sp > XB_SPIN_CAP) { atomicAdd(&(bar)[XB_TMO], 1u); break; } } } } while (0)

struct XcdBarrier {
    unsigned* bar; unsigned x;
    volatile __attribute__((address_space(3))) unsigned* st;
};

__device__ __forceinline__ XcdBarrier xcd_barrier_post(unsigned* bar, volatile __attribute__((address_space(3))) unsigned* st) {
    XcdBarrier b; b.bar = bar; b.x = xb_xcc_id(); b.st = st;
    if (threadIdx.x == 0) (void)xb_add(&bar[XB_XCNT(b.x)], 1u);
    return b;
}
__device__ __forceinline__ void xcd_barrier_complete(unsigned* bar, unsigned x, unsigned& nloc, unsigned& nx) {
    const unsigned G = gridDim.x * gridDim.y * gridDim.z;
    unsigned sum, cnt, mine, sp = 0u;
    for (;;) {
        sum = 0u; cnt = 0u; mine = 0u;
#pragma unroll
        for (unsigned j = 0; j < 16; ++j) { const unsigned c = xb_ld(&bar[XB_XCNT(j)]); sum += c; cnt += (c > 0u) ? 1u : 0u; mine = (j == x) ? c : mine; }
        if (sum == G) break;
        __builtin_amdgcn_s_sleep(1);
        if ((++sp & 255u) == 0u) { if (xb_ld(&bar[XB_TMO])) break; if (sp > XB_SPIN_CAP) { atomicAdd(&bar[XB_TMO], 1u); break; } }
    }
    nloc = mine > 0u ? mine : 1u; nx = cnt > 0u ? cnt : 1u;
}

__device__ __forceinline__ void xcd_barrier(const XcdBarrier& b) {
    asm volatile("s_waitcnt vmcnt(0)" ::: "memory");
    __syncthreads();
    if (threadIdx.x == 0) {
        unsigned* bar = b.bar;
        __builtin_amdgcn_s_waitcnt(0);
        unsigned nloc = b.st[0], nx = b.st[1];
        if (nloc == 0u) { xcd_barrier_complete(bar, b.x, nloc, nx); b.st[0] = nloc; b.st[1] = nx; }
        const unsigned old = xb_add(&bar[XB_XSUB(b.x)], 1u);
        const unsigned gen = old / nloc;
        if (old + 1u == (gen + 1u) * nloc) {
            __builtin_amdgcn_fence(__ATOMIC_RELEASE, "agent");
            asm volatile("s_waitcnt vmcnt(0)" ::: "memory");
            const unsigned og = xb_add(&bar[XB_TOP], 1u);
            const unsigned tg = og / nx;
            if (og + 1u == (tg + 1u) * nx) xb_add(&bar[XB_TOPGEN], 1u);
            else XB_SPIN(xb_ld(&bar[XB_TOPGEN]) == tg, bar);
            __builtin_amdgcn_fence(__ATOMIC_ACQUIRE, "agent");
            xb_add(&bar[XB_XGEN(b.x)], 1u);
            asm volatile("s_waitcnt vmcnt(0)" ::: "memory");
        } else {
            XB_SPIN(xb_ld(&bar[XB_XGEN(b.x)]) == gen, bar);
            __builtin_amdgcn_fence(__ATOMIC_ACQUIRE, "agent");
            asm volatile("s_waitcnt vmcnt(0)" ::: "memory");
        }
    }
    __syncthreads();
}
#include <hip/hip_cooperative_groups.h>
namespace cg = cooperative_groups;
constexpr int BIG_LDS = 156 * 1024 + 256;
constexpr int LDS_CTL = 156 * 1024;
constexpr int DUP = 0;
struct PArgs { const float* in[20]; float* out; char* ws; };
__device__ __forceinline__ const PArgs* kargs() { auto kp = __builtin_amdgcn_kernarg_segment_ptr(); asm volatile("" : "+s"(kp)); return (const PArgs*)kp; }

__device__ __forceinline__ void phase0(const PArgs& p, unsigned char* shm) {
    int tid = threadIdx.x; asm volatile("" : "+v"(tid)); const int lane = tid & 63, wid = tid >> 6;
    const int gw = blockIdx.x * 8 + wid, NGW = gridDim.x * 8; const size_t gt = (size_t)blockIdx.x * 512 + tid, NTH = (size_t)gridDim.x * 512;
    char* ws = p.ws;
    { float* km = (float*)(ws + OFF_KMEAN); for (size_t i = gt; i < (size_t)16 * 8 * 16 * 64; i += NTH) km[i] = 0.f; }
    { float* rc = (float*)(ws + OFF_ROPE); float* rs = rc + 4096 * 8;
      for (size_t i = gt; i < 4096 * 8; i += NTH) { const int pos = (int)(i >> 3), k = (int)(i & 7); const float inv_freq = (float)pow(500000.0, -(double)(2 * k) / 16.0); const float ang = (float)pos * inv_freq;
          rc[i] = (float)cos((double)ang); rs[i] = (float)sin((double)ang); } }
    {
        const float* wdn = p.in[18]; const float* wup = p.in[19]; const float* fw = p.in[14]; unsigned* WU = (unsigned*)(ws + OFF_WU);
        { uint4* WDq = (uint4*)(ws + OFF_WD); float* SD = (float*)(ws + OFF_WD + 16 * MiB); float fv[16];
#pragma unroll
          for (int j = 0; j < 4; ++j) { const float4 s = *(const float4*)(fw + 16 * lane + 4 * j); fv[4 * j] = s.x; fv[4 * j + 1] = s.y; fv[4 * j + 2] = s.z; fv[4 * j + 3] = s.w; }
          for (int e = gw; e < 16384; e += NGW) { float v[16], am = 0.f;
#pragma unroll
              for (int j = 0; j < 4; ++j) { const float4 a = *(const float4*)(wdn + (size_t)e * 1024 + 16 * lane + 4 * j); v[4 * j] = a.x * fv[4 * j]; v[4 * j + 1] = a.y * fv[4 * j + 1]; v[4 * j + 2] = a.z * fv[4 * j + 2]; v[4 * j + 3] = a.w * fv[4 * j + 3]; }
              float ss = 0.f;
#pragma unroll
              for (int j = 0; j < 16; ++j) { am = fmaxf(am, fabsf(v[j])); ss += v[j] * v[j]; }
#pragma unroll
              for (int o = 32; o >= 1; o >>= 1) { am = fmaxf(am, __shfl_xor(am, o)); ss += __shfl_xor(ss, o); }
              const float step = fminf(am * (1.0f / 7.0f), 0.35f * sqrtf(ss * (1.0f / 1024.0f)));
              const float inv = step > 0.f ? 1.0f / step : 0.f; unsigned q[2] = {0u, 0u};
#pragma unroll
              for (int k = 0; k < 16; ++k) { const int qi = (int)fminf(fmaxf(rintf(v[k] * inv), -7.0f), 7.0f); q[k >> 3] |= (unsigned)(qi & 15) << (4 * (k & 7)); }
              ((uint2*)WDq)[(size_t)e * 64 + lane] = make_uint2(q[0], q[1]); if (lane == 0) SD[e] = step; } }
        { uint2* WU4 = (uint2*)WU; float* SU = (float*)(ws + OFF_WU + 16 * MiB);
          for (int e = gw; e < 16384; e += NGW) { float v[16], ss = 0.f;
#pragma unroll
              for (int j = 0; j < 4; ++j) { const float4 a = *(const float4*)(wup + (size_t)e * 1024 + 16 * lane + 4 * j); v[4 * j] = a.x; v[4 * j + 1] = a.y; v[4 * j + 2] = a.z; v[4 * j + 3] = a.w; }
#pragma unroll
              for (int j = 0; j < 16; ++j) ss += v[j] * v[j];
#pragma unroll
              for (int o = 32; o >= 1; o >>= 1) ss += __shfl_xor(ss, o);
              const float sc = 0.5f * sqrtf(ss * (1.0f / 1024.0f)), inv = sc > 0.f ? 1.0f / sc : 0.f; unsigned q[2] = {0u, 0u};
#pragma unroll
              for (int k = 0; k < 16; ++k) { const float a_ = fabsf(v[k]) * inv;
                  const unsigned code = (unsigned)(a_ > 0.25f) + (unsigned)(a_ > 0.75f) + (unsigned)(a_ > 1.25f) + (unsigned)(a_ > 1.75f) + (unsigned)(a_ > 2.5f) + (unsigned)(a_ > 3.5f) + (unsigned)(a_ > 5.0f);
                  q[k >> 3] |= (code | (v[k] < 0.f ? 8u : 0u)) << (4 * (k & 7)); }
              WU4[(size_t)e * 64 + lane] = make_uint2(q[0], q[1]); if (lane == 0) SU[e] = sc; } }
        const float* k1 = p.in[16]; const float* k2 = p.in[17]; bf16_t* K1 = (bf16_t*)(ws + OFF_KEY1); bf16_t* K2 = (bf16_t*)(ws + OFF_KEY2);
        for (size_t i = gt * 4; i < (size_t)8 * 128 * 128; i += NTH * 4) { const float4 a = *(const float4*)(k1 + i), b = *(const float4*)(k2 + i);
            *(uint2*)(K1 + i) = make_uint2(pk2(a.x, a.y), pk2(a.z, a.w)); *(uint2*)(K2 + i) = make_uint2(pk2(b.x, b.y), pk2(b.z, b.w)); }
    }
    {
        __attribute__((address_space(3))) float* tl = (__attribute__((address_space(3))) float*)(shm) + wid * (32 * 33);
        const int tx = lane & 31, ty = lane >> 5;
        for (int item = gw; item < 9728; item += NGW) {
            const float* W; const float* sc; bf16_t* O; int K, N, nbx, thr = 1 << 30, add = 0, it = item;
            if (it < 5632) { W = p.in[2]; sc = p.in[1]; O = (bf16_t*)(ws + OFF_WIN); K = 1024; N = INC; nbx = 176; thr = 3584; add = 8; }
            else if ((it -= 5632) < 512) { W = p.in[10]; sc = nullptr; O = (bf16_t*)(ws + OFF_WAB); K = 512; N = 1024; nbx = 32; }
            else if ((it -= 512) < 512) { W = p.in[11]; sc = nullptr; O = (bf16_t*)(ws + OFF_WMB); K = 512; N = 1024; nbx = 32; }
            else if ((it -= 512) < 1024) { W = p.in[13]; sc = nullptr; O = (bf16_t*)(ws + OFF_WOUT); K = 1024; N = 1024; nbx = 32; }
            else { it -= 1024; W = p.in[15]; sc = p.in[14]; O = (bf16_t*)(ws + OFF_WQ); K = 1024; N = 2048; nbx = 64; }
            const int n0 = (it % nbx) * 32, k0 = (it / nbx) * 32;
#pragma unroll 4
            for (int i = ty; i < 32; i += 2) { const int k = k0 + i, np = n0 + tx, ac = (np & ~255) + sigma_col(np & 255), src = ac + (ac >= thr ? add : 0); tl[i * 33 + tx] = W[(size_t)k * N + src] * (sc ? sc[k] : 1.0f); }
            asm volatile("s_waitcnt lgkmcnt(0)" ::: "memory");
#pragma unroll 4
            for (int i = ty; i < 32; i += 2) { const int np = n0 + i, k = k0 + tx; O[(size_t)np * K + k] = (bf16_t)f2bf(tl[tx * 33 + i]); }
            asm volatile("s_waitcnt lgkmcnt(0)" ::: "memory");
        }
    }
    {
        const float* x = p.in[0]; const float* normw = p.in[1]; const float* w_in = p.in[2]; const float* igb = p.in[7]; const float* fgb = p.in[8];
        bf16_t* xb = (bf16_t*)(ws + OFF_XB); float* r1 = (float*)(ws + OFF_R1); float* ifg = (float*)(ws + OFF_IFG);
        float wg[4][4][8];
#pragma unroll
        for (int j = 0; j < 4; ++j)
#pragma unroll
            for (int i = 0; i < 4; ++i) { const int k = 256 * j + 4 * lane + i; const float nw = normw[k];
#pragma unroll
                for (int c = 0; c < 8; ++c) wg[j][i][c] = w_in[(size_t)k * INC + 3584 + c] * nw; }
        typedef float p0_f32x4 __attribute__((ext_vector_type(4)));
        float bias_l = (lane >> 2) < 4 ? igb[(lane >> 2) & 3] : fgb[(lane >> 2) & 3];
        const unsigned xoff = (unsigned)lane * 16u;
        auto do_row = [&](const p0_f32x4 (&v)[4], const int row) {
            float ss = 0.f, g[8];
#pragma unroll
            for (int c = 0; c < 8; ++c) g[c] = 0.f;
#pragma unroll
            for (int j = 0; j < 4; ++j) {
                ss += v[j][0] * v[j][0] + v[j][1] * v[j][1] + v[j][2] * v[j][2] + v[j][3] * v[j][3];
#pragma unroll
                for (int c = 0; c < 8; ++c) g[c] += v[j][0] * wg[j][0][c] + v[j][1] * wg[j][1][c] + v[j][2] * wg[j][2][c] + v[j][3] * wg[j][3][c];
            }
            float pd[8];
            { const auto r_ = __builtin_amdgcn_permlane32_swap(__float_as_uint(g[0]), __float_as_uint(ss), false, false); pd[0] = __uint_as_float(r_[0]) + __uint_as_float(r_[1]); }
#pragma unroll
            for (int i = 1; i < 8; ++i) { const auto r_ = __builtin_amdgcn_permlane32_swap(__float_as_uint(g[i]), __float_as_uint(g[i]), false, false); pd[i] = __uint_as_float(r_[0]) + __uint_as_float(r_[1]); }
#pragma unroll
            for (int i = 0; i < 4; ++i) { const auto r_ = __builtin_amdgcn_permlane16_swap(__float_as_uint(pd[i]), __float_as_uint(pd[i + 4]), false, false); pd[i] = __uint_as_float(r_[0]) + __uint_as_float(r_[1]); }
            { const bool b8 = (lane & 8) != 0, b4 = (lane & 4) != 0;
#pragma unroll
              for (int i = 0; i < 2; ++i) { const float keep = b8 ? pd[i + 2] : pd[i], send = b8 ? pd[i] : pd[i + 2]; pd[i] = keep + __int_as_float(__builtin_amdgcn_update_dpp(0, __float_as_int(send), 0x140, 0xf, 0xf, false)); }
              const float keep = b4 ? pd[1] : pd[0], send = b4 ? pd[0] : pd[1]; pd[0] = keep + __int_as_float(__builtin_amdgcn_update_dpp(0, __float_as_int(send), 0x141, 0xf, 0xf, false)); }
            float z = pd[0]; z += __int_as_float(__builtin_amdgcn_update_dpp(0, __float_as_int(z), 0xB1, 0xf, 0xf, false)); z += __int_as_float(__builtin_amdgcn_update_dpp(0, __float_as_int(z), 0x4E, 0xf, 0xf, false));
            const float sst = __int_as_float(__builtin_amdgcn_readlane(__float_as_int(z), 32));
            const float r = rsqrtf(sst * (1.0f / D_) + 1e-6f);
            { float* dst = lane < 32 ? ifg + (size_t)row * 8 + (lane >> 2) : r1 + row;
              if ((lane & 3) == 0 && lane <= 32) *dst = lane < 32 ? z * r + bias_l : r; }
            uint2* o8 = (uint2*)(xb + (size_t)row * D_) + lane;
#pragma unroll
            for (int j = 0; j < 4; ++j) o8[64 * j] = make_uint2(pk2(v[j][0], v[j][1]), pk2(v[j][2], v[j][3]));
        };
#define P0_LD(V, ROW) do { const float* rp_ = x + (size_t)(ROW) * D_; \
            asm volatile("global_load_dwordx4 %0, %4, %5\n\tglobal_load_dwordx4 %1, %4, %5 offset:1024\n\tglobal_load_dwordx4 %2, %4, %5 offset:2048\n\tglobal_load_dwordx4 %3, %4, %5 offset:3072" \
                         : "=&v"(V[0]), "=&v"(V[1]), "=&v"(V[2]), "=&v"(V[3]) : "v"(xoff), "s"(rp_) : "memory"); } while (0)
#define P0_WAIT18(V) asm volatile("s_waitcnt vmcnt(18)" : "+v"(V[0]), "+v"(V[1]), "+v"(V[2]), "+v"(V[3]) :: "memory")
#define P0_WAIT(V) asm volatile("s_waitcnt vmcnt(8)" : "+v"(V[0]), "+v"(V[1]), "+v"(V[2]), "+v"(V[3]) :: "memory")
        const int gwu = __builtin_amdgcn_readfirstlane(gw);
        const int nrow = gwu < T_ ? (T_ - gwu + NGW - 1) / NGW : 0;
        if (nrow > 0) {
            p0_f32x4 va[4], vb[4], vc[4];
            const int rlast = gwu + (nrow - 1) * NGW;
#define P0_ROWOF(K) ((K) < nrow ? gwu + (K) * NGW : rlast)
#define P0_FILL() do { char* fp_ = (char*)(xb + (size_t)gwu * D_); const unsigned z_ = 0u; \
                asm volatile("global_store_dword %0, %1, %2\n\tglobal_store_dword %0, %1, %2 offset:256\n\tglobal_store_dword %0, %1, %2 offset:512\n\tglobal_store_dword %0, %1, %2 offset:768\n\tglobal_store_dword %0, %1, %2 offset:1024" \
                             :: "v"(xoff4), "v"(z_), "s"(fp_) : "memory"); } while (0)
            const unsigned xoff4 = (unsigned)lane * 4u;
            P0_LD(va, P0_ROWOF(0)); P0_FILL(); P0_LD(vb, P0_ROWOF(1)); P0_FILL();
#pragma unroll 1
            for (int k = 0; k < nrow; k += 3) {
                P0_LD(vc, P0_ROWOF(k + 2)); P0_WAIT18(va); do_row(va, gwu + k * NGW);
                P0_LD(va, P0_ROWOF(k + 3)); P0_WAIT18(vb); if (k + 1 < nrow) do_row(vb, gwu + (k + 1) * NGW);
                P0_LD(vb, P0_ROWOF(k + 4)); P0_WAIT18(vc); if (k + 2 < nrow) do_row(vc, gwu + (k + 2) * NGW);
            }
            asm volatile("s_waitcnt vmcnt(0)" : "+v"(va[0]), "+v"(va[1]), "+v"(va[2]), "+v"(va[3]), "+v"(vb[0]), "+v"(vb[1]), "+v"(vb[2]), "+v"(vb[3]) :: "memory");
        }
    }
}
typedef float f32x2_t __attribute__((ext_vector_type(2)));
typedef unsigned p5_u32x4 __attribute__((ext_vector_type(4)));
#define P5_LAS __attribute__((address_space(3)))
#define P5_TIE8(R) "+v"(R[0]), "+v"(R[1]), "+v"(R[2]), "+v"(R[3]), "+v"(R[4]), "+v"(R[5]), "+v"(R[6]), "+v"(R[7])
#define P5_OUT(I, ACC) do { const uint4 a_ = *((const uint4*)(x1b + (tb + I) * 2048) + 2 * ln), c_ = *((const uint4*)(x1b + (tb + I) * 2048) + 2 * ln + 1); const unsigned w_[8] = {a_.x, a_.y, a_.z, a_.w, c_.x, c_.y, c_.z, c_.w}; \
        float4* o_ = (float4*)(out + (tb + I) * 1024 + 16 * ln); \
        _Pragma("unroll") for (int j_ = 0; j_ < 4; ++j_) o_[j_] = make_float4(__builtin_bit_cast(float, w_[2 * j_] << 16) + ACC[2 * j_].x, __builtin_bit_cast(float, w_[2 * j_] & 0xffff0000u) + ACC[2 * j_].y, \
                                                                             __builtin_bit_cast(float, w_[2 * j_ + 1] << 16) + ACC[2 * j_ + 1].x, __builtin_bit_cast(float, w_[2 * j_ + 1] & 0xffff0000u) + ACC[2 * j_ + 1].y); } while (0)
typedef unsigned p5_u32x2 __attribute__((ext_vector_type(2)));
#define P5_ROWFMA4(ACC, PRV, R, CF) do { p5_u32x2 r__ = R;   \
    asm volatile("" : "+v"(r__), "+v"(PRV[0]), "+v"(PRV[1]), "+v"(PRV[2]), "+v"(PRV[3]), "+v"(PRV[4]), "+v"(PRV[5]), "+v"(PRV[6]), "+v"(PRV[7])); \
    const f32x2_t cf2_ = {CF, CF}; \
    ACC[0] = __builtin_elementwise_fma((f32x2_t)__builtin_amdgcn_cvt_scalef32_pk_f32_fp4(r__.x, 1.0f, 0), cf2_, ACC[0]); ACC[1] = __builtin_elementwise_fma((f32x2_t)__builtin_amdgcn_cvt_scalef32_pk_f32_fp4(r__.x, 1.0f, 1), cf2_, ACC[1]); \
    ACC[2] = __builtin_elementwise_fma((f32x2_t)__builtin_amdgcn_cvt_scalef32_pk_f32_fp4(r__.x, 1.0f, 2), cf2_, ACC[2]); ACC[3] = __builtin_elementwise_fma((f32x2_t)__builtin_amdgcn_cvt_scalef32_pk_f32_fp4(r__.x, 1.0f, 3), cf2_, ACC[3]); \
    ACC[4] = __builtin_elementwise_fma((f32x2_t)__builtin_amdgcn_cvt_scalef32_pk_f32_fp4(r__.y, 1.0f, 0), cf2_, ACC[4]); ACC[5] = __builtin_elementwise_fma((f32x2_t)__builtin_amdgcn_cvt_scalef32_pk_f32_fp4(r__.y, 1.0f, 1), cf2_, ACC[5]); \
    ACC[6] = __builtin_elementwise_fma((f32x2_t)__builtin_amdgcn_cvt_scalef32_pk_f32_fp4(r__.y, 1.0f, 2), cf2_, ACC[6]); ACC[7] = __builtin_elementwise_fma((f32x2_t)__builtin_amdgcn_cvt_scalef32_pk_f32_fp4(r__.y, 1.0f, 3), cf2_, ACC[7]); } while (0)
#define P5_BFMA8U(R, CK) do { _Pragma("unroll") for (int j_ = 0; j_ < 8; j_ += 4) { \
    { const float cf_ = __builtin_bit_cast(float, __builtin_amdgcn_readlane(CK, j_));     P5_ROWFMA4(acc0, acc3, R[j_], cf_); } \
    { const float cf_ = __builtin_bit_cast(float, __builtin_amdgcn_readlane(CK, j_ + 1)); P5_ROWFMA4(acc1, acc0, R[j_ + 1], cf_); } \
    { const float cf_ = __builtin_bit_cast(float, __builtin_amdgcn_readlane(CK, j_ + 2)); P5_ROWFMA4(acc2, acc1, R[j_ + 2], cf_); } \
    { const float cf_ = __builtin_bit_cast(float, __builtin_amdgcn_readlane(CK, j_ + 3)); P5_ROWFMA4(acc3, acc2, R[j_ + 3], cf_); } } } while (0)
#define P5_ISSUE8U(R, B, CK) do { const int lk_ = keys[8 * (B) + (ln & 7)]; CK = __builtin_bit_cast(int, cfs[8 * (B) + (ln & 7)]); \
    _Pragma("unroll") for (int j_ = 0; j_ < 8; ++j_) { const unsigned char* rp_ = wu + (size_t)__builtin_amdgcn_readlane(lk_, j_) * 512; \
        asm volatile("global_load_dwordx2 %0, %1, %2" : "=v"(R[j_]) : "v"(voff8), "s"(rp_) : "memory"); } } while (0)
#define P5_DOT(R, XH, XL) __builtin_amdgcn_sdot8((int)R.y, (int)XL.y, __builtin_amdgcn_sdot8((int)R.x, (int)XL.x, 16 * __builtin_amdgcn_sdot8((int)R.y, (int)XH.y, __builtin_amdgcn_sdot8((int)R.x, (int)XH.x, 0, false), false), false), false)
#define P5_ISSUE8D(R, B) do { const int lk_ = keys[8 * (B) + (ln & 7)]; \
    _Pragma("unroll") for (int j_ = 0; j_ < 8; ++j_) { const unsigned char* rp_ = wd + (size_t)__builtin_amdgcn_readlane(lk_, j_) * 512; \
        asm volatile("global_load_dwordx2 %0, %1, %2" : "=v"(R[j_]) : "v"(voff8), "s"(rp_) : "memory"); } } while (0)
#define P5_DOWN8(R, BB) do { int pd_[8]; \
    _Pragma("unroll") for (int j_ = 0; j_ < 8; j_ += 4) { pd_[j_] = P5_DOT(R[j_], xh0, xl0); pd_[j_ + 1] = P5_DOT(R[j_ + 1], xh1, xl1); pd_[j_ + 2] = P5_DOT(R[j_ + 2], xh2, xl2); pd_[j_ + 3] = P5_DOT(R[j_ + 3], xh3, xl3); } \
    _Pragma("unroll") for (int i_ = 0; i_ < 4; ++i_) { const auto r_ = __builtin_amdgcn_permlane32_swap((unsigned)pd_[i_], (unsigned)pd_[i_ + 4], false, false); pd_[i_] = (int)(r_[0] + r_[1]); } \
    _Pragma("unroll") for (int i_ = 0; i_ < 2; ++i_) { const auto r_ = __builtin_amdgcn_permlane16_swap((unsigned)pd_[i_], (unsigned)pd_[i_ + 2], false, false); pd_[i_] = (int)(r_[0] + r_[1]); } \
    { const bool b8_ = (ln & 8) != 0; const int keep_ = b8_ ? pd_[1] : pd_[0], send_ = b8_ ? pd_[0] : pd_[1]; int z_ = keep_ + __builtin_amdgcn_update_dpp(0, send_, 0x140, 0xf, 0xf, false); \
      z_ += __builtin_amdgcn_update_dpp(0, z_, 0x141, 0xf, 0xf, false); z_ += __builtin_amdgcn_update_dpp(0, z_, 0xB1, 0xf, 0xf, false); z_ += __builtin_amdgcn_update_dpp(0, z_, 0x4E, 0xf, 0xf, false); \
      zz = (ln & 7) == ((BB) & 7) ? z_ : zz; } \
    if (((BB) & 7) == 7) { const int pos_ = 8 * ((BB) - 7) + 8 * (ln & 7) + (ln >> 3); const int e_ = keys[pos_]; const float g_ = cfs[pos_]; const int tk_ = (ln >> 3) & 3; \
        const float sx_ = tk_ == 0 ? sx0 : tk_ == 1 ? sx1 : tk_ == 2 ? sx2 : sx3; const float av_ = (float)zz * sx_ * (float)sdl[e_]; \
        cfs[pos_] = g_ * 0.5f * av_ * (1.0f + erff(av_ * 0.70710678118654752f)) * (float)sul[e_]; } } while (0)
__device__ __forceinline__ void phase5_all(const PArgs& p, float* out, unsigned char* shm) {
    int tid = threadIdx.x; asm volatile("" : "+v"(tid)); const int wid = __builtin_amdgcn_readfirstlane(tid >> 6);
    const char* x1b = (const char*)(p.ws + OFF_MV); const char* eidx = (const char*)(p.ws + OFF_EIDX); const char* egp = (const char*)(p.ws + OFF_EG); const float* r2 = (const float*)(p.ws + OFF_R2);
    const unsigned char* wd = (const unsigned char*)(p.ws + OFF_WD); const unsigned char* wu = (const unsigned char*)(p.ws + OFF_WU); const float* SD = (const float*)(p.ws + OFF_WD + 16 * MiB); const float* SU = (const float*)(p.ws + OFF_WU + 16 * MiB);
    P5_LAS _Float16* sdl = (P5_LAS _Float16*)shm; P5_LAS _Float16* sul = sdl + 16384;
    P5_LAS int* keys = (P5_LAS int*)(shm + 65536 + wid * 4608); P5_LAS float* cfs = (P5_LAS float*)(keys + 512); P5_LAS int* cntl = (P5_LAS int*)(keys + 1024);
    const int rot = 4 * ((int)blockIdx.x & 7);
    for (int i = tid; i < 16384; i += 512) { sdl[i] = (_Float16)SD[i]; sul[i] = (_Float16)SU[i]; }
    __syncthreads();
    const int G = (int)gridDim.x, NR = (T_ / 32 + G - 1 - (int)blockIdx.x) / G;
#pragma unroll 1
    for (int rnd = 0; rnd < NR; ++rnd) {
        int ln = tid; asm volatile("" : "+v"(ln)); ln &= 63; const unsigned voff = (unsigned)ln * 16u, voff4 = (unsigned)ln * 4u, voff8 = (unsigned)ln * 8u;
        const size_t tb = ((size_t)(rnd * G + (int)blockIdx.x) * 8 + wid) * 4;
        int ev[4][2], cv[4][2];
#pragma unroll
        for (int i_ = 0; i_ < 4; ++i_) { const char* ep_ = eidx + (tb + i_) * 512; const char* cp_ = egp + (tb + i_) * 512;
            asm volatile("global_load_dword %0, %4, %5\n\tglobal_load_dword %1, %4, %5 offset:256\n\tglobal_load_dword %2, %4, %6\n\tglobal_load_dword %3, %4, %6 offset:256"
                         : "=&v"(ev[i_][0]), "=&v"(ev[i_][1]), "=&v"(cv[i_][0]), "=&v"(cv[i_][1]) : "v"(voff4), "s"(ep_), "s"(cp_) : "memory"); }
        p5_u32x2 xh0, xh1, xh2, xh3, xl0, xl1, xl2, xl3; float sx0, sx1, sx2, sx3;
#define P5_QUANT(I, XH, XL, SX) do { const uint4 a_ = *((const uint4*)(x1b + (tb + I) * 2048) + 2 * ln), c_ = *((const uint4*)(x1b + (tb + I) * 2048) + 2 * ln + 1); \
        const unsigned w_[8] = {a_.x, a_.y, a_.z, a_.w, c_.x, c_.y, c_.z, c_.w}; float xv_[16], am_ = 0.f; \
        _Pragma("unroll") for (int k_ = 0; k_ < 8; ++k_) { xv_[2 * k_] = __builtin_bit_cast(float, w_[k_] << 16); xv_[2 * k_ + 1] = __builtin_bit_cast(float, w_[k_] & 0xffff0000u); am_ = fmaxf(am_, fmaxf(fabsf(xv_[2 * k_]), fabsf(xv_[2 * k_ + 1]))); } \
        _Pragma("unroll") for (int o_ = 32; o_ >= 1; o_ >>= 1) am_ = fmaxf(am_, __builtin_bit_cast(float, __builtin_amdgcn_ds_bpermute(4 * (ln ^ o_), __builtin_bit_cast(int, am_)))); \
        const float inv_ = am_ > 0.f ? 119.0f / am_ : 0.f; unsigned h_[2] = {0u, 0u}, l_[2] = {0u, 0u}; \
        _Pragma("unroll") for (int k_ = 0; k_ < 16; ++k_) { const int q_ = (int)rintf(xv_[k_] * inv_); const int lo_ = ((q_ + 8) & 15) - 8, hi_ = (q_ - lo_) >> 4;     \
            h_[k_ >> 3] |= (unsigned)(hi_ & 15) << (4 * (k_ & 7)); l_[k_ >> 3] |= (unsigned)(lo_ & 15) << (4 * (k_ & 7)); } \
        XH = p5_u32x2{h_[0], h_[1]}; XL = p5_u32x2{l_[0], l_[1]}; SX = am_ * (1.0f / 119.0f) * r2[tb + I]; } while (0)
        P5_QUANT(0, xh0, xl0, sx0); P5_QUANT(1, xh1, xl1, sx1); P5_QUANT(2, xh2, xl2, sx2); P5_QUANT(3, xh3, xl3, sx3);
        asm volatile("s_waitcnt vmcnt(0)" : "+v"(ev[0][0]), "+v"(ev[0][1]), "+v"(ev[1][0]), "+v"(ev[1][1]), "+v"(ev[2][0]), "+v"(ev[2][1]), "+v"(ev[3][0]), "+v"(ev[3][1]) :: "memory");
        asm volatile("" : "+v"(cv[0][0]), "+v"(cv[0][1]), "+v"(cv[1][0]), "+v"(cv[1][1]), "+v"(cv[2][0]), "+v"(cv[2][1]), "+v"(cv[3][0]), "+v"(cv[3][1]));
        cntl[ln] = 0; cntl[64 + ln] = 0;
        int bk[4][2];
#pragma unroll
        for (int i = 0; i < 4; ++i)
#pragma unroll
            for (int ps = 0; ps < 2; ++ps) { bk[i][ps] = 32 * i + ((((ev[i][ps] & 16383) >> 9) - rot) & 31); (void)__hip_atomic_fetch_add(cntl + bk[i][ps], 1, __ATOMIC_RELAXED, __HIP_MEMORY_SCOPE_WORKGROUP); }
#pragma unroll
        for (int hh = 0; hh < 2; ++hh) { const int c_ = cntl[64 * hh + ln]; int inc = c_;
#pragma unroll
          for (int o = 1; o < 32; o <<= 1) { const int u_ = __builtin_amdgcn_ds_bpermute(4 * (ln - o), inc); if ((ln & 31) >= o) inc += u_; }
          cntl[64 * hh + ln] = inc - c_; }
#pragma unroll
        for (int i = 0; i < 4; ++i)
#pragma unroll
            for (int ps = 0; ps < 2; ++ps) { const int pos = 4 * __hip_atomic_fetch_add(cntl + bk[i][ps], 1, __ATOMIC_RELAXED, __HIP_MEMORY_SCOPE_WORKGROUP) + i;
                keys[pos] = ev[i][ps] & 16383; cfs[pos] = __builtin_bit_cast(float, cv[i][ps]); }
        int dx, dl, dm;
        { const int rn = rnd + 1 < NR ? rnd + 1 : rnd; const size_t tn = ((size_t)(rn * G + (int)blockIdx.x) * 8 + wid) * 4;
          const char* pe = eidx + tn * 512; const char* pc = egp + tn * 512; const char* px = x1b + tn * 2048;
          asm volatile("global_load_dword %0, %3, %5\n\tglobal_load_dword %1, %4, %6\n\tglobal_load_dword %2, %4, %7" : "=&v"(dx), "=&v"(dl), "=&v"(dm) : "v"(ln * 128), "v"((ln & 15) * 128), "s"(px), "s"(pe), "s"(pc) : "memory"); }
        p5_u32x2 ua[8], ub[8], uc[8]; int cka, ckb, ckc;
        {
            int zz = 0;
            p5_u32x2 da[8], db[8], dc[8];
            P5_ISSUE8D(da, 0); P5_ISSUE8D(db, 1); P5_ISSUE8D(dc, 2);
#pragma unroll 1
            for (int b = 0; b < 60; b += 3) {
                asm volatile("s_waitcnt vmcnt(16)" : P5_TIE8(da) :: "memory"); P5_DOWN8(da, b); P5_ISSUE8D(da, b + 3);
                asm volatile("s_waitcnt vmcnt(16)" : P5_TIE8(db) :: "memory"); P5_DOWN8(db, b + 1); P5_ISSUE8D(db, b + 4);
                asm volatile("s_waitcnt vmcnt(16)" : P5_TIE8(dc) :: "memory"); P5_DOWN8(dc, b + 2); P5_ISSUE8D(dc, b + 5);
            }
            asm volatile("s_waitcnt vmcnt(16)" : P5_TIE8(da) :: "memory"); P5_DOWN8(da, 60); P5_ISSUE8D(da, 63);
            P5_ISSUE8U(ua, 0, cka); P5_ISSUE8U(ub, 1, ckb); P5_ISSUE8U(uc, 2, ckc);
            asm volatile("s_waitcnt vmcnt(40)" : P5_TIE8(db) :: "memory"); P5_DOWN8(db, 61);
            asm volatile("s_waitcnt vmcnt(32)" : P5_TIE8(dc) :: "memory"); P5_DOWN8(dc, 62);
            asm volatile("s_waitcnt vmcnt(24)" : P5_TIE8(da) :: "memory"); P5_DOWN8(da, 63);
            asm volatile("" : "+v"(dx), "+v"(dl), "+v"(dm));
        }
        f32x2_t acc0[8], acc1[8], acc2[8], acc3[8];
#pragma unroll
        for (int i = 0; i < 8; ++i) { acc0[i] = (f32x2_t){0.f, 0.f}; acc1[i] = acc0[i]; acc2[i] = acc0[i]; acc3[i] = acc0[i]; }
#pragma unroll 1
        for (int b = 0; b < 60; b += 3) {
            asm volatile("s_waitcnt vmcnt(16)" : P5_TIE8(ua) :: "memory"); P5_BFMA8U(ua, cka); P5_ISSUE8U(ua, b + 3, cka);
            asm volatile("s_waitcnt vmcnt(16)" : P5_TIE8(ub) :: "memory"); P5_BFMA8U(ub, ckb); P5_ISSUE8U(ub, b + 4, ckb);
            asm volatile("s_waitcnt vmcnt(16)" : P5_TIE8(uc) :: "memory"); P5_BFMA8U(uc, ckc); P5_ISSUE8U(uc, b + 5, ckc);
        }
        asm volatile("s_waitcnt vmcnt(16)" : P5_TIE8(ua) :: "memory"); P5_BFMA8U(ua, cka); P5_ISSUE8U(ua, 63, cka);
        asm volatile("s_waitcnt vmcnt(16)" : P5_TIE8(ub) :: "memory"); P5_BFMA8U(ub, ckb);
        asm volatile("s_waitcnt vmcnt(8)" : P5_TIE8(uc) :: "memory"); P5_BFMA8U(uc, ckc);
        asm volatile("s_waitcnt vmcnt(0)" : P5_TIE8(ua) :: "memory"); P5_BFMA8U(ua, cka);
        P5_OUT(0, acc0); P5_OUT(1, acc1); P5_OUT(2, acc2); P5_OUT(3, acc3);
    }
}

__global__ __launch_bounds__(512, 2) void k_mega(PArgs p_unused) {
    extern __shared__ __attribute__((aligned(16))) unsigned char shm[];
    cg::grid_group grid = cg::this_grid();
    PG8_LAS unsigned char* lds = (PG8_LAS unsigned char*)shm;
    volatile __attribute__((address_space(3))) unsigned* lctl = (volatile __attribute__((address_space(3))) unsigned*)(lds + LDS_CTL);
    if (threadIdx.x < 64) lctl[threadIdx.x] = 0u;
    __syncthreads();
    const XcdBarrier xbar = xcd_barrier_post((unsigned*)(kargs()->ws + OFF_CTL), lctl);
    for (int rep_ = 0; rep_ < (DUP == 10 ? 2 : 1); ++rep_) { const PArgs p = *kargs(); phase0(p, shm); if (DUP == 10) grid.sync(); }
    grid.sync();
    for (int rep_ = 0; rep_ < (DUP == 1 ? 2 : 1); ++rep_) {
        const PArgs& p = *kargs();
        pg8::SchedGrid S; S.init(p.ws + OFF_XB, p.ws + OFF_WIN, nullptr, nullptr, T_, 5632, 1024, 1, (int)gridDim.x, (int)blockIdx.x);
        pg8::EpiInProj E; E.r1 = (const float*)(p.ws + OFF_R1); E.qnw = p.in[3]; E.knw = p.in[4]; E.ropec = (const float*)(p.ws + OFF_ROPE); E.ropes = E.ropec + 4096 * 8; E.merge_b = p.in[12]; E.ws = p.ws; E.kmean = (float*)(p.ws + OFF_KMEAN); E.skip_km = rep_;
        pg8::gemm_phase<pg8::EpiInProj, pg8::SchedGrid, true, true>(lds, 1024, S, E);
        if (DUP == 1) grid.sync();
    }
    xcd_barrier(xbar);
    {
        const PArgs& p = *kargs();
        const attn_body::AttnTensors AT{(const attn_body::bf16*)(p.ws + OFF_Q), (const attn_body::bf16*)(p.ws + OFF_K), (const attn_body::bf16*)(p.ws + OFF_V), (attn_body::bf16*)(p.ws + OFF_XB), (const float*)(p.ws + OFF_KMEAN)};
        mlstm::Args A; A.mq = (const bf16_t*)(p.ws + OFF_MQ); A.mk = (const bf16_t*)(p.ws + OFF_MK); A.mv = (const bf16_t*)(p.ws + OFF_MV); A.mosig = (const bf16_t*)(p.ws + OFF_MO);
        A.ifg = (const float*)(p.ws + OFF_IFG); A.conv_w = p.in[5]; A.conv_b = p.in[6]; A.nw = p.in[9]; A.sca = (float*)(p.ws + OFF_SCA); A.scm = (float*)(p.ws + OFF_SCM); A.scb = (float*)(p.ws + OFF_SCB);
        A.hm = (bf16_t*)(p.ws + OFF_XB + 64 * MiB);
        for (int rep_ = 0; rep_ < (DUP == 3 ? 2 : 1); ++rep_) for (int u = blockIdx.x; u < 64; u += gridDim.x) mlstm::unit(u >> 2, u & 3, A, (ML_LAS unsigned char*)shm);
        attn_body::QueueOrder S; S.ctr = (unsigned*)(p.ws + OFF_CTL) + 8192; S.slot = lctl + 16;
        attn_body::attn_phase<attn_body::QueueOrder>((char*)shm, AT, S);
    }
    xcd_barrier(xbar);
    for (int rep_ = 0; rep_ < (DUP == 4 ? 2 : 1); ++rep_) {
        const PArgs& p = *kargs();
        pg8::SchedGrid S; S.init(p.ws + OFF_XB, p.ws + OFF_WAB, p.ws + OFF_XB + 64 * MiB, p.ws + OFF_WMB, T_, 1024, 512, 2, (int)gridDim.x, (int)blockIdx.x);
        pg8::EpiBranch E; E.ga = (const bf16_t*)(p.ws + OFF_GA); E.gm = (const bf16_t*)(p.ws + OFF_GM); E.y = (bf16_t*)(p.ws + OFF_MQ);
        pg8::gemm_phase<pg8::EpiBranch, pg8::SchedGrid, true, true>(lds, 512, S, E);
        if (DUP == 4) grid.sync();
    }
    xcd_barrier(xbar);
    for (int rep_ = 0; rep_ < (DUP == 5 ? 2 : 1); ++rep_) {
        const PArgs& p = *kargs();
        pg8::SchedGrid S; S.init(p.ws + OFF_MQ, p.ws + OFF_WOUT, nullptr, nullptr, T_, 1024, 1024, 1, (int)gridDim.x, (int)blockIdx.x);
        pg8::EpiOut E; E.x = p.in[0]; E.out = p.out; E.x1b = (bf16_t*)(p.ws + OFF_MV); E.rowss = (float*)(p.ws + OFF_ROWSS);
        pg8::gemm_phase<pg8::EpiOut, pg8::SchedGrid, true, true>(lds, 1024, S, E);
        if (DUP == 5) grid.sync();
    }
    xcd_barrier(xbar);
    for (int rep_ = 0; rep_ < (DUP == 6 ? 2 : 1); ++rep_) {
        const PArgs& p = *kargs();
        peer::Args A; A.rowss = (const float*)(p.ws + OFF_ROWSS); A.key1 = (const bf16_t*)(p.ws + OFF_KEY1); A.key2 = (const bf16_t*)(p.ws + OFF_KEY2); A.r2out = (float*)(p.ws + OFF_R2);
        A.eidx = (int*)(p.ws + OFF_EIDX); A.eg = (float*)(p.ws + OFF_EG);
        for (int u = blockIdx.x; u < 2048; u += gridDim.x) peer::unit(u >> 3, u & 7, (const bf16_t*)(p.ws + OFF_MV), (const bf16_t*)(p.ws + OFF_WQ), A, lds);
    }
    xcd_barrier(xbar);
    { const PArgs& p = *kargs(); phase5_all(p, p.out, shm); }
}

extern "C" void kernel_launch(void* const* d_in, const int* in_sizes, int n_in, void* d_out, int out_size, void* d_ws, size_t ws_size, hipStream_t stream) {
    static int grid_blocks = 0;
    if (!grid_blocks) {
        if (n_in != 20 || in_sizes[0] != T_ * D_ || out_size != T_ * D_ || ws_size < WS_NEED) { fprintf(stderr, "kernel_launch: unexpected shapes n_in %d in0 %d out %d ws %zu\n", n_in, n_in > 0 ? in_sizes[0] : -1, out_size, ws_size); grid_blocks = -1; return; }
        if (hipFuncSetAttribute((const void*)k_mega, hipFuncAttributeMaxDynamicSharedMemorySize, BIG_LDS) != hipSuccess) { fprintf(stderr, "hipFuncSetAttribute failed\n"); grid_blocks = -1; return; }
        int dev = 0, cus = 0, per_cu = 0;
        hipGetDevice(&dev); hipDeviceGetAttribute(&cus, hipDeviceAttributeMultiprocessorCount, dev);
        hipOccupancyMaxActiveBlocksPerMultiprocessor(&per_cu, (const void*)k_mega, 512, BIG_LDS);
        if (per_cu < 1) { fprintf(stderr, "kernel_launch: occupancy query reports %d blocks per CU\n", per_cu); per_cu = 1; }
        grid_blocks = cus;
        if (grid_blocks != 256) fprintf(stderr, "kernel_launch: %d CUs (expected 256)\n", grid_blocks);
    }
    if (grid_blocks < 0) return;
    PArgs pa{}; for (int i = 0; i < 20; ++i) pa.in[i] = (const float*)d_in[i]; pa.out = (float*)d_out; pa.ws = (char*)d_ws;
    hipMemsetAsync((char*)d_ws + OFF_CTL, 0, CTL_BYTES, stream);
    void* args[] = {&pa};
    hipError_t e = hipLaunchCooperativeKernel((void*)k_mega, dim3(grid_blocks), dim3(512), args, BIG_LDS, stream);
    if (e != hipSuccess) fprintf(stderr, "cooperative launch failed: %s (grid %d)\n", hipGetErrorString(e), grid_blocks);
}
```

```cpp
#include <hip/hip_runtime.h>
#include <cstdio>
#include <cstdint>
#include <cmath>
typedef unsigned short bf16_t;
constexpr int T_ = 65536, D_ = 1024, B_ = 16, S_ = 4096;
constexpr int INC = 5640;
constexpr size_t MiB = 1ull << 20;
constexpr size_t OFF_XB = 0;
constexpr size_t OFF_Q = 128 * MiB, OFF_K = 192 * MiB, OFF_V = 256 * MiB;
constexpr size_t OFF_MQ = 320 * MiB, OFF_MK = 384 * MiB, OFF_MV = 448 * MiB, OFF_MO = 512 * MiB;
constexpr size_t OFF_GA = 576 * MiB, OFF_GM = 704 * MiB;
constexpr size_t OFF_W = 832 * MiB;
constexpr size_t OFF_WIN = OFF_W;
constexpr size_t OFF_WAB = OFF_WIN + (size_t)5632 * 1024 * 2;
constexpr size_t OFF_WMB = OFF_WAB + (size_t)1024 * 512 * 2;
constexpr size_t OFF_WOUT = OFF_WMB + (size_t)1024 * 512 * 2;
constexpr size_t OFF_WQ = OFF_WOUT + (size_t)1024 * 1024 * 2;
constexpr size_t OFF_KEY1 = OFF_WQ + (size_t)2048 * 1024 * 2;
constexpr size_t OFF_KEY2 = OFF_KEY1 + (size_t)8 * 128 * 128 * 2;
constexpr size_t OFF_WD = OFF_KEY2 + (size_t)8 * 128 * 128 * 2;
constexpr size_t OFF_WU = OFF_WD + (size_t)16384 * 1024 * 2;
constexpr size_t OFF_WEND = OFF_WU + (size_t)16384 * 1024 * 2;
constexpr size_t OFF_MISC = 920 * MiB;
static_assert(OFF_WEND <= OFF_MISC, "weights overflow");
constexpr size_t OFF_R1 = OFF_MISC;
constexpr size_t OFF_R2 = OFF_R1 + (size_t)T_ * 4;
constexpr size_t OFF_IFG = OFF_R2 + (size_t)T_ * 4;
constexpr size_t OFF_KMEAN = OFF_IFG + (size_t)T_ * 8 * 4;
constexpr size_t OFF_ROPE = OFF_KMEAN + (size_t)16 * 8 * 16 * 64 * 4;
constexpr size_t OFF_SCA = OFF_ROPE + (size_t)2 * 4096 * 8 * 4;
constexpr size_t OFF_SCM = OFF_SCA + (size_t)16 * 4 * 4096 * 4;
constexpr size_t OFF_SCB = OFF_SCM + (size_t)16 * 4 * 4096 * 4;
constexpr size_t OFF_CTL = 926 * MiB + 512 * 1024, CTL_BYTES = 64 * 1024;
constexpr size_t OFF_ROWSS = 927 * MiB;
constexpr size_t OFF_EIDX = 932 * MiB;
constexpr size_t OFF_EG = 964 * MiB;
constexpr size_t WS_NEED = 996 * MiB;
static_assert(OFF_SCB + (size_t)16 * 4 * 4096 * 4 <= OFF_CTL && OFF_CTL + CTL_BYTES <= OFF_ROWSS, "misc overflow");

__device__ __forceinline__ unsigned f2bf(float f) { unsigned u = __builtin_bit_cast(unsigned, f); return (u + 0x7fffu + ((u >> 16) & 1u)) >> 16; }
__device__ __forceinline__ float bf2f(unsigned short b) { return __builtin_bit_cast(float, ((unsigned)b) << 16); }
__device__ __forceinline__ unsigned pk2(float lo, float hi) { return f2bf(lo) | (f2bf(hi) << 16); }
__device__ __forceinline__ float sigmoidf_(float v) { return 1.0f / (1.0f + __expf(-v)); }
namespace pg8 {
#define PG8_LAS __attribute__((address_space(3)))
typedef unsigned short bf16_t;
typedef short bf16x8 __attribute__((ext_vector_type(8)));
typedef float f32x4 __attribute__((ext_vector_type(4)));
typedef unsigned u32x4 __attribute__((ext_vector_type(4)));
constexpr int BM = 256, BK = 64, HALF = 128, HTB = HALF * BK * 2  , STAGE_BYTES = 8 * HTB, NXCD = 8, WGM = 4;

__host__ __device__ __forceinline__ int lds_byte(int r, int c) { const int st = (r >> 4) * 2 + (c >> 5), rr = r & 15, cc = c & 31, ob = rr * 64 + cc * 2; return st * 1024 + (ob ^ (((ob >> 9) & 1) << 5)); }
__host__ __device__ __forceinline__ void stage_rc(int b, int& R, int& C) { const int st = b / 1024, sb = b % 1024, swz = sb ^ (((sb >> 9) & 1) << 5); R = (st >> 1) * 16 + swz / 64; C = (st & 1) * 32 + (swz % 64) / 2; }
__host__ __device__ __forceinline__ int perm32(int rho) { const int n = rho >> 4, i = rho & 15; return 8 * (i >> 2) + 4 * n + (i & 3); }

struct Unit { int pm, pn, seg, pad; const char* A; const char* B; };

__device__ __forceinline__ unsigned cvt_pk_bf16(float lo, float hi) { unsigned r; asm volatile("v_cvt_pk_bf16_f32 %0, %1, %2" : "=v"(r) : "v"(lo), "v"(hi)); return r; }
typedef float f32x2 __attribute__((ext_vector_type(2)));
__device__ __forceinline__ f32x2 gelu_pk(f32x2 v) {
    const f32x2 av = __builtin_elementwise_abs(v), d = av * 0.2316418882f + 1.0f;
    f32x2 t; t.x = __builtin_amdgcn_rcpf(d.x); t.y = __builtin_amdgcn_rcpf(d.y);
    f32x2 q = t * 0.5307027145f + (-0.7265760135f); q = q * t + 0.7107068705f; q = q * t + (-0.142248368f); q = q * t + 0.127414796f; q = q * t;
    const f32x2 s = (v * v) * (-0.72134752044f);
    f32x2 e; e.x = __builtin_amdgcn_exp2f(s.x); e.y = __builtin_amdgcn_exp2f(s.y);
    const f32x2 m = v * (q * e), r = v - m;
    f32x2 o; o.x = v.x < 0.f ? m.x : r.x; o.y = v.y < 0.f ? m.y : r.y; return o;
}

template <class Epi, class Sched, bool ALIGN_EPI = false, bool SP2 = false>
__device__ __forceinline__ void gemm_phase(PG8_LAS unsigned char* lds, const int K, const Sched& S, const Epi& E) {
    int tid = threadIdx.x; asm volatile("" : "+v"(tid));
    const int wid = __builtin_amdgcn_readfirstlane(tid >> 6), lane = tid & 63, wr = wid >> 2, wc = wid & 3, fr = lane & 15, fq = lane >> 4;
    const int nt = K / BK;
    __builtin_amdgcn_s_waitcnt(0x0F70);
    unsigned voffA[2], voffB[2];
#pragma unroll
    for (int i = 0; i < 2; ++i) { int R, C; stage_rc(tid * 16 + i * 8192, R, C); const int Rb = Epi::PERM ? ((R & ~31) + perm32(R & 31)) : R;
        voffA[i] = (unsigned)(R * K + C) * 2u; voffB[i] = (unsigned)(Rb * K + C) * 2u; }
    const size_t kstep = (size_t)(BK * 2);
    const size_t hstep = (size_t)HALF * K * 2;
        const unsigned ldsw = (unsigned)wid * 1024u;
    const int aoff = lds_byte(wr * 64 + fr, fq * 8), boff = lds_byte(wc * 32 + fr, fq * 8);
#define PG8_SA(b, h) (((b) * 2 + (h)) * HTB)
#define PG8_SB(b, h) ((4 + (b) * 2 + (h)) * HTB)
#define PG8_STAGE(bufoff, gbase, voff) do { _Pragma("unroll") for (int _i = 0; _i < 2; ++_i) \
        __builtin_amdgcn_global_load_lds((const unsigned*)((const char*)(gbase) + (voff)[_i]), (PG8_LAS unsigned*)(lds + (bufoff) + ldsw + _i * 8192), 16, 0, 0); } while (0)
#define PG8_LDA(dst, b, h) do { _Pragma("unroll") for (int m = 0; m < 4; ++m) _Pragma("unroll") for (int k = 0; k < 2; ++k) dst[m][k] = *(const PG8_LAS bf16x8*)(lds + PG8_SA(b, h) + aoff + m * 2048 + k * 1024); } while (0)
#define PG8_LDB(dst, b, h) do { _Pragma("unroll") for (int n = 0; n < 2; ++n) _Pragma("unroll") for (int k = 0; k < 2; ++k) dst[n][k] = *(const PG8_LAS bf16x8*)(lds + PG8_SB(b, h) + boff + n * 2048 + k * 1024); } while (0)
#define PG8_MMA(ai, bj, At, Bt) do { __builtin_amdgcn_s_setprio(1); _Pragma("unroll") for (int m = 0; m < 4; ++m) _Pragma("unroll") for (int n = 0; n < 2; ++n) _Pragma("unroll") for (int k = 0; k < 2; ++k) \
        acc[ai][bj][m][n] = __builtin_amdgcn_mfma_f32_16x16x32_bf16(Bt[n][k], At[m][k], acc[ai][bj][m][n], 0, 0, 0); __builtin_amdgcn_s_setprio(0); } while (0)
#define PG8_WAIT_V(n) asm volatile("s_waitcnt vmcnt(" #n ")" ::: "memory")
#define PG8_WAIT_L(n) asm volatile("s_waitcnt lgkmcnt(" #n ")" ::: "memory")
#define PG8_BAR __builtin_amdgcn_s_barrier()
#define PG8_SCHED __builtin_amdgcn_sched_barrier(0)
    Unit cur, nxt; int ui = 0;
    if (!S.next(0, cur)) return;
    f32x4 acc[2][2][4][2];
#pragma unroll
    for (int a = 0; a < 2; ++a)
#pragma unroll
        for (int b = 0; b < 2; ++b)
#pragma unroll
            for (int m = 0; m < 4; ++m)
#pragma unroll
                for (int n = 0; n < 2; ++n) acc[a][b][m][n] = (f32x4){0.f, 0.f, 0.f, 0.f};
    bf16x8 At[4][2], B0[2][2], B1[2][2];
    const char* cA = cur.A; const char* cB = cur.B;
    S.a_ready(cur);
    if constexpr (SP2) {
        PG8_STAGE(PG8_SB(0, 0), cB, voffB); PG8_STAGE(PG8_SB(0, 1), cB + hstep, voffB); PG8_STAGE(PG8_SA(0, 0), cA, voffA); PG8_STAGE(PG8_SA(0, 1), cA + hstep, voffA);
        if (wr == 1) PG8_BAR;
        PG8_WAIT_V(2); PG8_BAR;
        PG8_STAGE(PG8_SB(1, 0), cB + kstep, voffB); PG8_STAGE(PG8_SA(1, 0), cA + kstep, voffA); PG8_STAGE(PG8_SB(1, 1), cB + hstep + kstep, voffB);
        PG8_WAIT_V(6); PG8_BAR;
    } else {
        PG8_STAGE(PG8_SB(0, 0), cB, voffB); PG8_STAGE(PG8_SA(0, 0), cA, voffA); PG8_STAGE(PG8_SB(0, 1), cB + hstep, voffB); PG8_STAGE(PG8_SA(0, 1), cA + hstep, voffA);
        if (wr == 1) PG8_BAR;
        PG8_WAIT_V(4); PG8_BAR;
        PG8_STAGE(PG8_SB(1, 0), cB + kstep, voffB); PG8_STAGE(PG8_SA(1, 0), cA + kstep, voffA); PG8_STAGE(PG8_SB(1, 1), cB + hstep + kstep, voffB);
        PG8_WAIT_V(6); PG8_BAR;
    }
    for (;;) {
        const bool has_next = S.next(ui + 1, nxt);
        const char* nA = has_next ? nxt.A : cA; const char* nB = has_next ? nxt.B : cB;
        for (int t = 0; t < nt; t += 2) {
            const bool last = (t == nt - 2);
            const char* a1 = cA + (size_t)(t + 1) * kstep;
            const char* a2 = last ? nA : cA + (size_t)(t + 2) * kstep; const char* b2 = last ? nB : cB + (size_t)(t + 2) * kstep;
            const char* a3 = a2 + kstep; const char* b3 = b2 + kstep;
            if (last && has_next) S.a_ready(nxt);
            if constexpr (SP2) {
            PG8_LDB(B0, 0, 0); PG8_LDB(B1, 0, 1); PG8_SCHED; PG8_LDA(At, 0, 0); PG8_STAGE(PG8_SA(1, 1), a1 + hstep, voffA);
            PG8_WAIT_V(8); PG8_WAIT_L(0); PG8_BAR; PG8_MMA(0, 0, At, B0); PG8_MMA(0, 1, At, B1); PG8_BAR; PG8_SCHED;
            PG8_LDA(At, 0, 1); PG8_STAGE(PG8_SB(0, 0), b2, voffB); PG8_STAGE(PG8_SB(0, 1), b2 + hstep, voffB); PG8_STAGE(PG8_SA(0, 0), a2, voffA);
            PG8_WAIT_V(8); PG8_WAIT_L(0); PG8_BAR; PG8_MMA(1, 0, At, B0); PG8_MMA(1, 1, At, B1); PG8_BAR; PG8_SCHED;
            PG8_LDB(B0, 1, 0); PG8_LDB(B1, 1, 1); PG8_SCHED; PG8_LDA(At, 1, 0); PG8_STAGE(PG8_SA(0, 1), a2 + hstep, voffA);
            PG8_WAIT_V(8); PG8_WAIT_L(0); PG8_BAR; PG8_MMA(0, 0, At, B0); PG8_MMA(0, 1, At, B1); PG8_BAR; PG8_SCHED;
            PG8_LDA(At, 1, 1); PG8_STAGE(PG8_SB(1, 0), b3, voffB); PG8_STAGE(PG8_SB(1, 1), b3 + hstep, voffB); PG8_STAGE(PG8_SA(1, 0), a3, voffA);
            PG8_WAIT_V(8); PG8_WAIT_L(0); PG8_BAR; PG8_MMA(1, 0, At, B0); PG8_MMA(1, 1, At, B1); PG8_BAR; PG8_SCHED;
            } else {
            PG8_LDB(B0, 0, 0); PG8_SCHED; PG8_LDA(At, 0, 0); PG8_STAGE(PG8_SA(1, 1), a1 + hstep, voffA);
            PG8_WAIT_L(8); PG8_BAR; PG8_WAIT_L(0); PG8_MMA(0, 0, At, B0); PG8_BAR; PG8_SCHED;
            PG8_LDB(B1, 0, 1); PG8_STAGE(PG8_SB(0, 0), b2, voffB);
            PG8_BAR; PG8_WAIT_L(0); PG8_MMA(0, 1, At, B1); PG8_BAR;
            PG8_LDA(At, 0, 1); PG8_STAGE(PG8_SA(0, 0), a2, voffA);
            PG8_BAR; PG8_WAIT_L(0); PG8_MMA(1, 0, At, B0); PG8_BAR; PG8_SCHED;
            PG8_STAGE(PG8_SB(0, 1), b2 + hstep, voffB);
            PG8_WAIT_V(6); PG8_BAR; PG8_MMA(1, 1, At, B1); PG8_BAR;
            PG8_LDB(B0, 1, 0); PG8_SCHED; PG8_LDA(At, 1, 0); PG8_STAGE(PG8_SA(0, 1), a2 + hstep, voffA);
            PG8_WAIT_L(8); PG8_BAR; PG8_WAIT_L(0); PG8_MMA(0, 0, At, B0); PG8_BAR; PG8_SCHED;
            PG8_LDB(B1, 1, 1); PG8_STAGE(PG8_SB(1, 0), b3, voffB);
            PG8_BAR; PG8_WAIT_L(0); PG8_MMA(0, 1, At, B1); PG8_BAR;
            PG8_LDA(At, 1, 1); PG8_STAGE(PG8_SA(1, 0), a3, voffA);
            PG8_BAR; PG8_WAIT_L(0); PG8_MMA(1, 0, At, B0); PG8_BAR; PG8_SCHED;
            PG8_STAGE(PG8_SB(1, 1), b3 + hstep, voffB);
            PG8_WAIT_V(6); PG8_BAR; PG8_MMA(1, 1, At, B1); PG8_BAR;
            }
        }
        if constexpr (ALIGN_EPI) { if (wr == 0) PG8_BAR; }
        if constexpr (!Epi::AFTER_DRAIN) { E(acc, cur, wr, wc, fr, fq); S.done(cur); }
        if (!has_next) break;
        if (E.zero_after(cur)) {
#pragma unroll
        for (int a = 0; a < 2; ++a)
#pragma unroll
            for (int b = 0; b < 2; ++b)
#pragma unroll
                for (int m = 0; m < 4; ++m)
#pragma unroll
                    for (int n = 0; n < 2; ++n) acc[a][b][m][n] = (f32x4){0.f, 0.f, 0.f, 0.f};
        }
        cur = nxt; cA = nA; cB = nB; ++ui;
        if constexpr (ALIGN_EPI) { if (wr == 1) PG8_BAR; }
    }
    PG8_WAIT_V(0);
    if constexpr (!ALIGN_EPI) { if (wr == 0) PG8_BAR; }
    PG8_BAR;
    if constexpr (Epi::AFTER_DRAIN) { E.fused(acc, cur, wr, wc, fr, fq, lds, wid, lane); S.done(cur); }
#undef PG8_SA
#undef PG8_SB
#undef PG8_STAGE
#undef PG8_LDA
#undef PG8_LDB
#undef PG8_MMA
#undef PG8_WAIT_V
#undef PG8_WAIT_L
#undef PG8_BAR
#undef PG8_SCHED
}
}
__host__ __device__ __forceinline__ int sigma_col(int rho) { const int j = rho & 3, fq = (rho >> 2) & 3, n = (rho >> 4) & 1, wc = (rho >> 5) & 3, bj = rho >> 7; return wc * 64 + bj * 32 + fq * 8 + n * 4 + j; }
namespace pg8 {
struct SchedGrid {
    const char* A0; const char* B0; const char* A1; const char* B1; size_t tstep; int nM, nN, nwg, G, c, segs, pad;
    __device__ __forceinline__ void init(const void* A0_, const void* B0_, const void* A1_, const void* B1_, int M, int N, int K, int segs_, int G_, int c_) {
        A0 = (const char*)A0_; B0 = (const char*)B0_; A1 = (const char*)A1_; B1 = (const char*)B1_; tstep = (size_t)BM * K * 2; nM = M / BM; nN = N / BM; nwg = nM * nN; G = G_; c = c_; segs = segs_; pad = 0; }
    __device__ __forceinline__ bool next(int i, Unit& u) const {
        const int seg = (segs == 2) ? (i & 1) : 0, it = (segs == 2) ? (i >> 1) : i;
        const long L = (long)it * G + c; if (L >= nwg) return false;
        int wgid = (int)L; { const int q = nwg / NXCD, r = nwg % NXCD, xcd = wgid % NXCD, off = wgid / NXCD; wgid = (xcd < r ? xcd * (q + 1) : r * (q + 1) + (xcd - r) * q) + off; }
        const int nig = WGM * nN, gid = wgid / nig, fm = gid * WGM, gsz = (nM - fm) < WGM ? (nM - fm) : WGM;
        u.pm = fm + ((wgid % nig) % gsz); u.pn = ((wgid % nig) / gsz + (c & 7) * 3) % nN; u.seg = seg; u.pad = 0;
        u.A = (seg ? A1 : A0) + (size_t)u.pm * tstep; u.B = (seg ? B1 : B0) + (size_t)u.pn * tstep; return true;
    }
    __device__ __forceinline__ void a_ready(const Unit&) const {}
    __device__ __forceinline__ void done(const Unit&) const {}
};
__device__ __forceinline__ u32x4 pack8(const f32x4& a, const f32x4& b) { u32x4 w; w.x = cvt_pk_bf16(a[0], a[1]); w.y = cvt_pk_bf16(a[2], a[3]); w.z = cvt_pk_bf16(b[0], b[1]); w.w = cvt_pk_bf16(b[2], b[3]); return w; }
__device__ __forceinline__ float bflo(unsigned w) { return __builtin_bit_cast(float, w << 16); }
__device__ __forceinline__ float bfhi(unsigned w) { return __builtin_bit_cast(float, w & 0xffff0000u); }
__device__ __forceinline__ float sigm(float v) { return __builtin_amdgcn_rcpf(1.0f + __expf(-v)); }

struct EpiInProj {
    static constexpr bool PERM = false, AFTER_DRAIN = false; static constexpr int MIN_VM = 16;
    const float* r1; const float* qnw; const float* knw; const float* ropec; const float* ropes; const float* merge_b; char* ws; float* kmean; int skip_km;
    __device__ __forceinline__ bool zero_after(const Unit&) const { return true; }
    __device__ __forceinline__ void operator()(f32x4 (&acc)[2][2][4][2], const Unit& u, int wr, int wc, int fr, int fq) const {
        const int pn = u.pn, rowb = u.pm * BM + wr * 64 + fr;
        if (pn < 4) {
            const bool isq = pn < 2; const float* nw = isq ? qnw : knw; const float sc = isq ? 0.125f * 1.4426950408889634f : 1.0f;
            bf16_t* dst = (bf16_t*)(ws + (isq ? OFF_Q : OFF_K)) + (pn & 1) * 256 + wc * 64 + 8 * fq;
            f32x4 nwv[2][2], ks[2][2];
#pragma unroll
            for (int bj = 0; bj < 2; ++bj)
#pragma unroll
                for (int n = 0; n < 2; ++n) { nwv[bj][n] = *(const f32x4*)(nw + 32 * bj + 8 * fq + 4 * n); ks[bj][n] = (f32x4){0.f, 0.f, 0.f, 0.f}; }
            float rr[8];
#pragma unroll
            for (int i = 0; i < 8; ++i) rr[i] = r1[rowb + (i >> 2) * HALF + (i & 3) * 16];
            f32x4 csn[2], snn[2];
#pragma unroll
            for (int n = 0; n < 2; ++n) { const int pos0 = rowb & 4095; csn[n] = *(const f32x4*)(ropec + pos0 * 8 + 4 * n); snn[n] = *(const f32x4*)(ropes + pos0 * 8 + 4 * n); }
#pragma unroll
            for (int ai = 0; ai < 2; ++ai)
#pragma unroll
                for (int m = 0; m < 4; ++m) {
                    const int row = rowb + ai * HALF + m * 16; const float r = rr[ai * 4 + m];
                    f32x4 csv[2] = {csn[0], csn[1]}, snv[2] = {snn[0], snn[1]};
                    if (ai * 4 + m < 7) { const int i1 = ai * 4 + m + 1, pos1 = (rowb + (i1 >> 2) * HALF + (i1 & 3) * 16) & 4095;
#pragma unroll
                        for (int n = 0; n < 2; ++n) { csn[n] = *(const f32x4*)(ropec + pos1 * 8 + 4 * n); snn[n] = *(const f32x4*)(ropes + pos1 * 8 + 4 * n); } }
                    f32x4 v[2][2]; float ss = 0.f;
#pragma unroll
                    for (int bj = 0; bj < 2; ++bj)
#pragma unroll
                        for (int n = 0; n < 2; ++n) { v[bj][n] = acc[ai][bj][m][n] * r; ss += (v[bj][n][0] * v[bj][n][0] + v[bj][n][1] * v[bj][n][1]) + (v[bj][n][2] * v[bj][n][2] + v[bj][n][3] * v[bj][n][3]); }
                    ss += __shfl_xor(ss, 16); ss += __shfl_xor(ss, 32);
                    const float rstd = rsqrtf(ss * (1.0f / 64.0f) + 1e-6f);
#pragma unroll
                    for (int bj = 0; bj < 2; ++bj)
#pragma unroll
                        for (int n = 0; n < 2; ++n) v[bj][n] = v[bj][n] * rstd * nwv[bj][n];
#pragma unroll
                    for (int n = 0; n < 2; ++n) {
                        const f32x4 cs = csv[n], sn = snv[n];
#pragma unroll
                        for (int j = 0; j < 4; ++j) { const float mine = v[0][n][j], oth = __shfl_xor(mine, 16);
                            const float rot = (fq == 0) ? (mine * cs[j] - oth * sn[j]) : (mine * cs[j] + oth * sn[j]);
                            v[0][n][j] = (fq < 2) ? rot : mine; }
                    }
#pragma unroll
                    for (int bj = 0; bj < 2; ++bj) {
                        const u32x4 w = pack8(v[bj][0] * sc, v[bj][1] * sc);
                        *(u32x4*)(dst + (size_t)row * 512 + 32 * bj) = w;
                        if (!isq) { ks[bj][0] += (f32x4){bflo(w.x), bfhi(w.x), bflo(w.y), bfhi(w.y)}; ks[bj][1] += (f32x4){bflo(w.z), bfhi(w.z), bflo(w.w), bfhi(w.w)}; }
                    }
                }
            if (!isq) {
#pragma unroll
                for (int bj = 0; bj < 2; ++bj)
#pragma unroll
                    for (int n = 0; n < 2; ++n)
#pragma unroll
                        for (int j = 0; j < 4; ++j) { float s = ks[bj][n][j]; s += __shfl_xor(s, 1); s += __shfl_xor(s, 2); s += __shfl_xor(s, 4); s += __shfl_xor(s, 8); ks[bj][n][j] = s; }
                if (fr == 0 && !skip_km) {
                    const int b = u.pm >> 4, blk = u.pm & 15, head = (pn & 1) * 4 + wc;
                    float* km = kmean + ((size_t)(b * 8 + head) * 16 + blk) * 64 + 8 * fq;
#pragma unroll
                    for (int bj = 0; bj < 2; ++bj)
#pragma unroll
                        for (int n = 0; n < 2; ++n)
#pragma unroll
                            for (int j = 0; j < 4; ++j) atomicAdd(km + 32 * bj + 4 * n + j, ks[bj][n][j] * (1.0f / 256.0f));
                }
            }
        } else {
            size_t off; int ld = 512, cb, type = 2; const float* bias = nullptr;
            if (pn < 6) { off = OFF_V; cb = (pn - 4) * 256; } else if (pn < 8) { off = OFF_MQ; cb = (pn - 6) * 256; } else if (pn < 10) { off = OFF_MK; cb = (pn - 8) * 256; }
            else if (pn < 12) { off = OFF_MV; cb = (pn - 10) * 256; } else if (pn < 14) { off = OFF_MO; cb = (pn - 12) * 256; type = 3; }
            else if (pn < 18) { off = OFF_GA; cb = (pn - 14) * 256; ld = 1024; type = 4; bias = merge_b + cb; } else { off = OFF_GM; cb = (pn - 18) * 256; ld = 1024; type = 4; bias = merge_b + 1024 + cb; }
            const int cl = wc * 64 + 8 * fq;
            bf16_t* dst = (bf16_t*)(ws + off) + cb + cl;
            f32x4 bv[2][2];
#pragma unroll
            for (int bj = 0; bj < 2; ++bj)
#pragma unroll
                for (int n = 0; n < 2; ++n) bv[bj][n] = (type == 4) ? *(const f32x4*)(bias + cl + 32 * bj + 4 * n) : (f32x4){0.f, 0.f, 0.f, 0.f};
            float rr[8];
#pragma unroll
            for (int i = 0; i < 8; ++i) rr[i] = r1[rowb + (i >> 2) * HALF + (i & 3) * 16];
#pragma unroll
            for (int ai = 0; ai < 2; ++ai)
#pragma unroll
                for (int m = 0; m < 4; ++m) {
                    const int row = rowb + ai * HALF + m * 16; const float r = rr[ai * 4 + m];
#pragma unroll
                    for (int bj = 0; bj < 2; ++bj) {
                        f32x4 v0 = acc[ai][bj][m][0] * r + bv[bj][0], v1 = acc[ai][bj][m][1] * r + bv[bj][1];
                        if (type >= 3) {
#pragma unroll
                            for (int j = 0; j < 4; ++j) { v0[j] = sigm(v0[j]); v1[j] = sigm(v1[j]); } }
                        *(u32x4*)(dst + (size_t)row * ld + 32 * bj) = pack8(v0, v1);
                    }
                }
        }
    }
};
struct EpiBranch {
    static constexpr bool PERM = false, AFTER_DRAIN = false; static constexpr int MIN_VM = 16;
    const bf16_t* ga; const bf16_t* gm; bf16_t* y;
    __device__ __forceinline__ bool zero_after(const Unit& u) const { return u.seg == 1; }
    __device__ __forceinline__ void operator()(f32x4 (&acc)[2][2][4][2], const Unit& u, int wr, int wc, int fr, int fq) const {
        const int rowb = u.pm * BM + wr * 64 + fr, col0 = u.pn * BM + wc * 64 + 8 * fq;
        if (u.seg == 0) {
#pragma unroll
            for (int ai = 0; ai < 2; ++ai)
#pragma unroll
                for (int m = 0; m < 4; ++m) {
                    const size_t ro = (size_t)(rowb + ai * HALF + m * 16) * 1024 + col0;
#pragma unroll
                    for (int bj = 0; bj < 2; ++bj) {
                        const u32x4 gmw = *(const u32x4*)(gm + ro + 32 * bj);
                        const f32x4 m0 = (f32x4){bflo(gmw.x), bfhi(gmw.x), bflo(gmw.y), bfhi(gmw.y)}, m1 = (f32x4){bflo(gmw.z), bfhi(gmw.z), bflo(gmw.w), bfhi(gmw.w)};
                        const u32x4 gaw = *(const u32x4*)(ga + ro + 32 * bj);
                        const f32x4 a0 = (f32x4){bflo(gaw.x), bfhi(gaw.x), bflo(gaw.y), bfhi(gaw.y)}, a1 = (f32x4){bflo(gaw.z), bfhi(gaw.z), bflo(gaw.w), bfhi(gaw.w)};
#pragma unroll
                        for (int j = 0; j < 4; ++j) { acc[ai][bj][m][0][j] *= a0[j] * __builtin_amdgcn_rcpf(m0[j]); acc[ai][bj][m][1][j] *= a1[j] * __builtin_amdgcn_rcpf(m1[j]); }
                    }
                }
        } else {
            u32x4 g[4][2], w[4][2];
#pragma unroll
            for (int m = 0; m < 4; ++m)
#pragma unroll
                for (int bj = 0; bj < 2; ++bj) g[m][bj] = *(const u32x4*)(gm + (size_t)(rowb + m * 16) * 1024 + col0 + 32 * bj);
#pragma unroll
            for (int ai = 0; ai < 2; ++ai) {
#pragma unroll
                for (int m = 0; m < 4; ++m)
#pragma unroll
                    for (int bj = 0; bj < 2; ++bj) { const u32x4 gmw = g[m][bj];
                        const f32x4 m0 = (f32x4){bflo(gmw.x), bfhi(gmw.x), bflo(gmw.y), bfhi(gmw.y)}, m1 = (f32x4){bflo(gmw.z), bfhi(gmw.z), bflo(gmw.w), bfhi(gmw.w)};
                        w[m][bj] = pack8(acc[ai][bj][m][0] * m0, acc[ai][bj][m][1] * m1); }
                if (ai == 0) {
#pragma unroll
                    for (int m = 0; m < 4; ++m)
#pragma unroll
                        for (int bj = 0; bj < 2; ++bj) g[m][bj] = *(const u32x4*)(gm + (size_t)(rowb + HALF + m * 16) * 1024 + col0 + 32 * bj);
                }
#pragma unroll
                for (int m = 0; m < 4; ++m)
#pragma unroll
                    for (int bj = 0; bj < 2; ++bj) *(u32x4*)(y + (size_t)(rowb + ai * HALF + m * 16) * 1024 + col0 + 32 * bj) = w[m][bj];
            }
        }
    }
};
struct EpiOut {
    static constexpr bool PERM = false, AFTER_DRAIN = false; static constexpr int MIN_VM = 16;
    const bf16_t* xb; float* out; bf16_t* x1b; float* rowss;
    __device__ __forceinline__ bool zero_after(const Unit&) const { return true; }
    __device__ __forceinline__ void operator()(f32x4 (&acc)[2][2][4][2], const Unit& u, int wr, int wc, int fr, int fq) const {
        const int rowb = u.pm * BM + wr * 64 + fr, col0 = u.pn * BM + wc * 64 + 8 * fq;
        u32x4 xv[4][2], w[4][2]; float ssv[4];
#pragma unroll
        for (int m = 0; m < 4; ++m)
#pragma unroll
            for (int bj = 0; bj < 2; ++bj) xv[m][bj] = *(const u32x4*)(xb + (size_t)(rowb + m * 16) * 1024 + col0 + 32 * bj);
#pragma unroll
        for (int ai = 0; ai < 2; ++ai) {
#pragma unroll
            for (int m = 0; m < 4; ++m) { float ss = 0.f;
#pragma unroll
                for (int bj = 0; bj < 2; ++bj) {
                    const u32x4 xw = xv[m][bj];
                    const f32x4 v0 = acc[ai][bj][m][0] + (f32x4){bflo(xw.x), bfhi(xw.x), bflo(xw.y), bfhi(xw.y)}, v1 = acc[ai][bj][m][1] + (f32x4){bflo(xw.z), bfhi(xw.z), bflo(xw.w), bfhi(xw.w)};
                    w[m][bj] = pack8(v0, v1);
                    ss += (v0[0] * v0[0] + v0[1] * v0[1]) + (v0[2] * v0[2] + v0[3] * v0[3]) + (v1[0] * v1[0] + v1[1] * v1[1]) + (v1[2] * v1[2] + v1[3] * v1[3]);
                }
                ss += __shfl_xor(ss, 16); ss += __shfl_xor(ss, 32); ssv[m] = ss; }
            if (ai == 0) {
#pragma unroll
                for (int m = 0; m < 4; ++m)
#pragma unroll
                    for (int bj = 0; bj < 2; ++bj) xv[m][bj] = *(const u32x4*)(xb + (size_t)(rowb + HALF + m * 16) * 1024 + col0 + 32 * bj);
            }
#pragma unroll
            for (int m = 0; m < 4; ++m) { const int row = rowb + ai * HALF + m * 16; const size_t ro = (size_t)row * 1024 + col0;
#pragma unroll
                for (int bj = 0; bj < 2; ++bj) *(u32x4*)(x1b + ro + 32 * bj) = w[m][bj];
                if (fq == 0) rowss[(size_t)row * 16 + u.pn * 4 + wc] = ssv[m]; }
        }
    }
};
}
#include <hip/hip_bf16.h>
#include <cmath>
namespace attn_body {
using bf16=__hip_bfloat16;
using bf16x8=__attribute__((ext_vector_type(8)))short;
using s16x4=__attribute__((ext_vector_type(4)))short;
using f32x16=__attribute__((ext_vector_type(16)))float;
using u32x4=__attribute__((ext_vector_type(4)))unsigned;
using f32x4_t=__attribute__((ext_vector_type(4)))float;
constexpr int BATCH=16,NHEAD=8,SEQ=4096,D=64,DM=NHEAD*D;
constexpr int NW=8,QBLK=32,QB=QBLK*NW,KVBLK=64,NQB=SEQ/QB;
constexpr int ATTN_PITCH=DM, ATTN_UNIT_ROWS=QB;
__device__ __forceinline__ int crow(int r,int hi){return (r&3)+8*(r>>2)+4*hi;}
#define SBAR() __builtin_amdgcn_sched_barrier(0)
__device__ __forceinline__ void cmask(f32x16&p0,f32x16&p1,int jb,int qrel,int hi){
  const float NEG=-INFINITY; int kb=64*jb+4*hi;
  #pragma unroll
  for(int r=0;r<16;++r){int kv=kb+(r&3)+8*(r>>2); if(kv>qrel)p0[r]=NEG; if(kv+32>qrel)p1[r]=NEG;}
}

constexpr int NSLOT=3, SLOTB=8192;
constexpr int LDS_K=0, LDS_V=NSLOT*SLOTB, LDS_WS=2*NSLOT*SLOTB, LDS_OST=LDS_WS+NW*64*4, LDS_BYTES=LDS_OST+NW*4096;
constexpr float C2=0.125f*1.4426950408889634f;
__device__ __forceinline__ void glds16(const void*gsrc,unsigned lds_dst){unsigned keep;
  asm volatile("s_mov_b32 %0, m0\n\ts_mov_b32 m0, %2\n\ts_nop 0\n\tglobal_load_lds_dwordx4 %1, off\n\ts_mov_b32 m0, %0":"=&s"(keep):"v"(gsrc),"s"(lds_dst):"memory");}
__device__ __forceinline__ float max3f(float a,float b,float c){float r;asm("v_max3_f32 %0, %1, %2, %3":"=v"(r):"v"(a),"v"(b),"v"(c));return r;}
__device__ __forceinline__ float max2f(float a,float b){float r;asm("v_max_f32_e32 %0, %1, %2":"=v"(r):"v"(a),"v"(b));return r;}
__device__ __forceinline__ float fadd_s(float a,float b){float r;asm("v_add_f32_e32 %0, %1, %2":"=v"(r):"v"(a),"v"(b));return r;}
__device__ __forceinline__ float fsub_s(float a,float b){float r;asm("v_sub_f32_e32 %0, %1, %2":"=v"(r):"v"(a),"v"(b));return r;}
typedef float f32x2_t __attribute__((ext_vector_type(2))); typedef __bf16 bf16x2_t __attribute__((ext_vector_type(2)));
__device__ __forceinline__ unsigned cvtpk_s(float lo,float hi){f32x2_t v={lo,hi};bf16x2_t b=__builtin_convertvector(v,bf16x2_t);return __builtin_bit_cast(unsigned,b);}
#define WAIT_BAR(N) asm volatile("s_waitcnt vmcnt(" #N ") lgkmcnt(0)\n\ts_barrier":::"memory")

__device__ __forceinline__ void qkt(f32x16&p0,f32x16&p1,const char*Kslot,const bf16x8*qr,const f32x16&negm,int r32,int hi){
  const char*kb=Kslot+hi*1024+r32*16;
  #pragma unroll
  for(int d0=0;d0<4;++d0){
    const bf16x8 b0=*reinterpret_cast<const bf16x8*>(kb+d0*2048);
    const bf16x8 b1=*reinterpret_cast<const bf16x8*>(kb+d0*2048+512);
    if(d0==0){p0=__builtin_amdgcn_mfma_f32_32x32x16_bf16(b0,qr[0],negm,0,0,0);p1=__builtin_amdgcn_mfma_f32_32x32x16_bf16(b1,qr[0],negm,0,0,0);}
    else{p0=__builtin_amdgcn_mfma_f32_32x32x16_bf16(b0,qr[d0],p0,0,0,0);p1=__builtin_amdgcn_mfma_f32_32x32x16_bf16(b1,qr[d0],p1,0,0,0);}}
}
typedef __attribute__((address_space(3))) const char* lds_cptr;
typedef short v4i16_t __attribute__((ext_vector_type(4)));
__device__ __forceinline__ void kload8(bf16x8*kf,lds_cptr kp){
  kf[0]=*(const __attribute__((address_space(3))) bf16x8*)(kp);      kf[1]=*(const __attribute__((address_space(3))) bf16x8*)(kp+512);
  kf[2]=*(const __attribute__((address_space(3))) bf16x8*)(kp+2048); kf[3]=*(const __attribute__((address_space(3))) bf16x8*)(kp+2560);
  kf[4]=*(const __attribute__((address_space(3))) bf16x8*)(kp+4096); kf[5]=*(const __attribute__((address_space(3))) bf16x8*)(kp+4608);
  kf[6]=*(const __attribute__((address_space(3))) bf16x8*)(kp+6144); kf[7]=*(const __attribute__((address_space(3))) bf16x8*)(kp+6656);
}
__device__ __forceinline__ void kload2(bf16x8*kf,lds_cptr kp,int j){ kf[2*j]=*(const __attribute__((address_space(3))) bf16x8*)(kp+j*2048); kf[2*j+1]=*(const __attribute__((address_space(3))) bf16x8*)(kp+j*2048+512); }
__device__ __forceinline__ s16x4 vtr(lds_cptr p){ return __builtin_bit_cast(s16x4,__builtin_amdgcn_ds_read_tr16_b64_v4i16((__attribute__((address_space(3))) v4i16_t*)p)); }
__device__ __forceinline__ float rowmax(const f32x16&p0,const f32x16&p1){
  float a=max3f(p0[0],p0[1],p1[0]),b=max3f(p0[2],p0[3],p1[1]);a=max3f(a,p1[2],p1[3]);
  #pragma unroll
  for(int r=4;r<16;r+=4){a=max3f(a,p0[r],p0[r+1]);b=max3f(b,p0[r+2],p0[r+3]);a=max3f(a,p1[r],p1[r+1]);b=max3f(b,p1[r+2],p1[r+3]);}
  const float m=max2f(a,b);
  auto rr=__builtin_amdgcn_permlane32_swap(__float_as_uint(m),__float_as_uint(m),false,false);
  return max2f(__uint_as_float(rr[0]),__uint_as_float(rr[1]));
}
__device__ __forceinline__ void pv(f32x16*o,int vb,bf16x8 pa0,bf16x8 pa1,bf16x8 pa2,bf16x8 pa3){
  #pragma unroll
  for(int d0=0;d0<2;++d0){s16x4 lo[4],hi[4];
    #pragma unroll
    for(int ks=0;ks<4;++ks){
      asm volatile("ds_read_b64_tr_b16 %0,%1 offset:%c2":"=&v"(lo[ks]):"v"(vb),"i"(d0*4096+ks*1024):"memory");
      asm volatile("ds_read_b64_tr_b16 %0,%1 offset:%c2":"=&v"(hi[ks]):"v"(vb),"i"(d0*4096+ks*1024+512):"memory");}
    asm volatile("s_waitcnt lgkmcnt(0)":::"memory");SBAR();
    #define PK(k) (bf16x8){lo[k][0],lo[k][1],lo[k][2],lo[k][3],hi[k][0],hi[k][1],hi[k][2],hi[k][3]}
    o[d0]=__builtin_amdgcn_mfma_f32_32x32x16_bf16(pa0,PK(0),o[d0],0,0,0);
    o[d0]=__builtin_amdgcn_mfma_f32_32x32x16_bf16(pa1,PK(1),o[d0],0,0,0);
    o[d0]=__builtin_amdgcn_mfma_f32_32x32x16_bf16(pa2,PK(2),o[d0],0,0,0);
    o[d0]=__builtin_amdgcn_mfma_f32_32x32x16_bf16(pa3,PK(3),o[d0],0,0,0);
    #undef PK
  }
}

#ifndef ATTN_STORE16
#define ATTN_STORE16(p,v) (*(u32x4*)(p)=(v))
#endif
template<int THRL> __device__ __forceinline__ void attn_unit(int b,int h,int qb,const bf16*Q,const bf16*__restrict__ K,const bf16*__restrict__ V,bf16*O,char*shm){
  int tid=threadIdx.x; asm volatile("":"+v"(tid)); const int lane=tid&63,r32=lane&31,hi=lane>>5; const int wid=__builtin_amdgcn_readfirstlane(tid>>6);
  const long rowbase=(long)b*SEQ; const int q0=qb*QB;
  const bf16*Qw=Q+(rowbase+q0+wid*QBLK)*DM+h*D;
  const bf16*Kh=K+rowbase*DM+h*D,*Vh=V+rowbase*DM+h*D;
  const unsigned lds0=(unsigned)(uintptr_t)shm;
  float*wsf=(float*)(shm+LDS_WS)+wid*64;
  const bf16*ksrc=Kh+(long)lane*DM+wid*8;
  const bf16*vsrc=Vh+(long)(16*(wid&3)+(lane>>2))*DM+(wid>>2)*32+(lane&3)*8;
  const unsigned kdst=lds0+LDS_K+wid*1024, vdst=lds0+LDS_V+wid*1024;
  #define TM(t) (((t)<4)?(NT-4+(t)):((t)-4))
  #define DMA_K(t,slot) glds16(ksrc+(long)TM(t)*KVBLK*DM,(unsigned)__builtin_amdgcn_readfirstlane(kdst+(slot)))
  #define DMA_V(t,slot) glds16(vsrc+(long)TM(t)*KVBLK*DM,(unsigned)__builtin_amdgcn_readfirstlane(vdst+(slot)))
  const int vb0=(int)(lds0+LDS_V)+((lane>>4)&1)*32+(lane&3)*8+(4*hi+((lane&15)>>2))*64;
  const char*Kbase=shm+LDS_K; bf16x8 kf[8];
  const lds_cptr shm3=(lds_cptr)shm; const lds_cptr kp0=shm3+LDS_K+hi*1024+r32*16; const lds_cptr vp0=shm3+LDS_V+((lane>>4)&1)*32+(lane&3)*8+(4*hi+((lane&15)>>2))*64;
  const int NT=(q0+QB)/KVBLK;
  DMA_K(0,0);DMA_V(0,0);DMA_K(1,SLOTB);
  bf16x8 qr[4];
  #pragma unroll
  for(int d0=0;d0<4;++d0)qr[d0]=*reinterpret_cast<const bf16x8*>(&Qw[(long)r32*DM+d0*16+hi*8]);
  #define SELK(tt) (((tt)<4)||((((const unsigned*)(shm+LDS_BYTES))[wid*QBLK+r32]>>(((tt)-4)>>2))&1u))
  float mhat=0.f,l_reg=0.f;f32x16 o[2];o[0]=f32x16{};o[1]=f32x16{};f32x16 negm=f32x16{};asm volatile("":"+v"(negm));
  const int qrel=wid*QBLK+r32;
  #define CMASK(P0,P1,t) do{int jb_=(t); if(jb_<4)cmask(P0,P1,jb_,qrel,hi); else { const bool keep_=SELK(jb_); _Pragma("unroll") for(int r=0;r<16;++r){P0[r]=keep_?P0[r]:-INFINITY;P1[r]=keep_?P1[r]:-INFINITY;} } }while(0)
  bool resc=false;
  #define START(P0,P1) do{ const float rm=rowmax(P0,P1); resc=false; \
    { const float dl=rm; mhat=fadd_s(mhat,dl); \
      _Pragma("unroll") for(int r=0;r<16;++r){P0[r]=fsub_s(P0[r],dl);P1[r]=fsub_s(P1[r],dl);} \
      _Pragma("unroll") for(int r=0;r<16;++r)negm[r]=-mhat; asm volatile("":"+v"(negm)); } \
    _Pragma("unroll") for(int r=0;r<16;++r)P0[r]=__builtin_amdgcn_exp2f(P0[r]); }while(0)
  #define RESC() do{ if(resc){ asm volatile("s_waitcnt lgkmcnt(0)":::"memory"); \
      _Pragma("unroll") for(int d_=0;d_<2;++d_) _Pragma("unroll") for(int r=0;r<16;++r)o[d_][r]*=wsf[crow(r,hi)]; } }while(0)
  f32x16 pA0,pA1,pB0,pB1;
  int sl_prev=0,sl_cur=0,sl_next=SLOTB;
  #define ROT() do{sl_prev=sl_cur;sl_cur=sl_next;sl_next=(sl_next==(NSLOT-1)*SLOTB)?0:sl_next+SLOTB;}while(0)
  DMA_K(2,2*SLOTB);
  WAIT_BAR(3);
  qkt(pA0,pA1,Kbase,qr,negm,r32,hi);asm volatile("s_nop 15\n\ts_nop 7":"+v"(pA0),"+v"(pA1));CMASK(pA0,pA1,0);
  START(pA0,pA1);
  _Pragma("unroll") for(int r=0;r<16;++r)pA1[r]=__builtin_amdgcn_exp2f(pA1[r]);
  WAIT_BAR(0);
  DMA_K(3,0);DMA_V(1,SLOTB);
  ROT();
  kload8(kf,kp0+sl_cur);
  WAIT_BAR(2);
  s16x4 vlo[8],vhi[8]; u32x4 pw0,pw1,pw2,pw3;
  #define PKW(P,B) cvtpk_s(P[B],P[B+1])
  #define PAF(k) __builtin_bit_cast(bf16x8,pw##k)
  #define VFR(i) (bf16x8){vlo[i][0],vlo[i][1],vlo[i][2],vlo[i][3],vhi[i][0],vhi[i][1],vhi[i][2],vhi[i][3]}
  #define PIN(x) asm volatile("":"+v"(x))
  #define MX3(a,b,c) __builtin_fmaxf(__builtin_fmaxf((a),(b)),(c))
  #define GAPA(MF,A0,A1,A2,A3,W0,W1,PW) do{ MF; sacc+=A0; sacc+=A1; sacc+=A2; sacc+=A3; PIN(sacc); W0; W1; PIN(PW); SBAR(); }while(0)
  #define EX(v) __builtin_amdgcn_exp2f(v)
  #define GAPB(MF,X,B) do{ MF; X[B]=EX(X[B]); X[B+1]=EX(X[B+1]); X[B+2]=EX(X[B+2]); X[B+3]=EX(X[B+3]); PIN(X); SBAR(); }while(0)
  #define VRD(i) do{ vlo[i]=vtr(vp_+(((i)>>2)*4096+((i)&3)*1024)); vhi[i]=vtr(vp_+(((i)>>2)*4096+((i)&3)*1024+512)); }while(0)
  #define KRD(G,j) do{ if(G){ kload2(kf,kp0+sl_next,j); SBAR(); } }while(0)
  #define STEP(C0,C1,P0,P1,t,GK,GV,GL) do{ SBAR(); \
    const lds_cptr vp_=vp0+sl_prev; \
    VRD(0); SBAR(); float sacc=(P0[0]+P0[1]); \
    GAPA(C0=__builtin_amdgcn_mfma_f32_32x32x16_bf16(kf[0],qr[0],negm,0,0,0), P0[2],P0[3],P0[4],P0[5],     pw0[0]=PKW(P0,0), pw0[1]=PKW(P0,2), pw0); \
    VRD(4); SBAR(); GAPA(C1=__builtin_amdgcn_mfma_f32_32x32x16_bf16(kf[1],qr[0],negm,0,0,0), P0[6],P0[7],P0[8],P0[9],     pw0[2]=PKW(P0,4), pw0[3]=PKW(P0,6), pw0); \
    VRD(1); SBAR(); GAPA(C0=__builtin_amdgcn_mfma_f32_32x32x16_bf16(kf[2],qr[1],C0,0,0,0),   P0[10],P0[11],P0[12],P0[13], pw1[0]=PKW(P0,8), pw1[1]=PKW(P0,10), pw1); \
    VRD(5); SBAR(); GAPA(C1=__builtin_amdgcn_mfma_f32_32x32x16_bf16(kf[3],qr[1],C1,0,0,0),   P0[14],P0[15],P1[0],P1[1],   pw1[2]=PKW(P0,12),pw1[3]=PKW(P0,14), pw1); \
    VRD(2); SBAR(); GAPA(C0=__builtin_amdgcn_mfma_f32_32x32x16_bf16(kf[4],qr[2],C0,0,0,0),   P1[2],P1[3],P1[4],P1[5],     pw2[0]=PKW(P1,0), pw2[1]=PKW(P1,2), pw2); \
    VRD(6); SBAR(); GAPA(C1=__builtin_amdgcn_mfma_f32_32x32x16_bf16(kf[5],qr[2],C1,0,0,0),   P1[6],P1[7],P1[8],P1[9],     pw2[2]=PKW(P1,4), pw2[3]=PKW(P1,6), pw2); \
    VRD(3); SBAR(); GAPA(C0=__builtin_amdgcn_mfma_f32_32x32x16_bf16(kf[6],qr[3],C0,0,0,0),   P1[10],P1[11],P1[12],P1[13], pw3[0]=PKW(P1,8), pw3[1]=PKW(P1,10), pw3); \
    VRD(7); SBAR(); GAPA(C1=__builtin_amdgcn_mfma_f32_32x32x16_bf16(kf[7],qr[3],C1,0,0,0),   P1[14],P1[15],0.f,0.f,       pw3[2]=PKW(P1,12),pw3[3]=PKW(P1,14), pw3); \
    l_reg+=sacc; \
    if(GK){DMA_K((t)+3,sl_cur);} if(GV){DMA_V((t)+1,sl_next);} \
    CMASK(C0,C1,t); \
    { float a=MX3(C0[0],C0[1],C1[0]),b=MX3(C0[2],C0[3],C1[1]); a=MX3(a,C1[2],C1[3]); \
      _Pragma("unroll") for(int r=4;r<16;r+=4){a=MX3(a,C0[r],C0[r+1]);b=MX3(b,C0[r+2],C0[r+3]);a=MX3(a,C1[r],C1[r+1]);b=MX3(b,C1[r+2],C1[r+3]);} \
      float rm=__builtin_fmaxf(a,b); { auto rr=__builtin_amdgcn_permlane32_swap(__float_as_uint(rm),__float_as_uint(rm),false,false); rm=__builtin_fmaxf(__uint_as_float(rr[0]),__uint_as_float(rr[1])); } \
      resc=false; \
      if(__builtin_expect(__any(rm>(float)THRL),0)){ const float dl=__builtin_fmaxf(rm,0.f); mhat+=dl; \
        _Pragma("unroll") for(int r=0;r<16;++r){C0[r]-=dl;C1[r]-=dl;} \
        _Pragma("unroll") for(int r=0;r<16;++r)negm[r]=-mhat; asm volatile("":"+v"(negm)); \
        const float f=__builtin_amdgcn_exp2f(-dl); l_reg*=f; if(hi==0)wsf[r32]=f; resc=true; } } \
    SBAR(); \
    GAPB(o[0]=__builtin_amdgcn_mfma_f32_32x32x16_bf16(PAF(0),VFR(0),o[0],0,0,0), C0,0); \
    GAPB(o[1]=__builtin_amdgcn_mfma_f32_32x32x16_bf16(PAF(0),VFR(4),o[1],0,0,0), C0,4); \
    KRD(GL,0); GAPB(o[0]=__builtin_amdgcn_mfma_f32_32x32x16_bf16(PAF(1),VFR(1),o[0],0,0,0), C0,8); \
    KRD(GL,1); GAPB(o[1]=__builtin_amdgcn_mfma_f32_32x32x16_bf16(PAF(1),VFR(5),o[1],0,0,0), C0,12); \
    KRD(GL,2); GAPB(o[0]=__builtin_amdgcn_mfma_f32_32x32x16_bf16(PAF(2),VFR(2),o[0],0,0,0), C1,0); \
    KRD(GL,3); GAPB(o[1]=__builtin_amdgcn_mfma_f32_32x32x16_bf16(PAF(2),VFR(6),o[1],0,0,0), C1,4); \
    GAPB(o[0]=__builtin_amdgcn_mfma_f32_32x32x16_bf16(PAF(3),VFR(3),o[0],0,0,0), C1,8); \
    GAPB(o[1]=__builtin_amdgcn_mfma_f32_32x32x16_bf16(PAF(3),VFR(7),o[1],0,0,0), C1,12); \
    }while(0)
  int t=1;
  for(;t+5<NT;t+=2){
    STEP(pB0,pB1,pA0,pA1,t,true,true,true);     WAIT_BAR(2); RESC(); ROT();
    STEP(pA0,pA1,pB0,pB1,t+1,true,true,true);   WAIT_BAR(2); RESC(); ROT();
  }
  #define ENDW(tt) do{ if((tt)+3<NT){WAIT_BAR(2);} else if((tt)+2<NT){WAIT_BAR(1);} else {WAIT_BAR(0);} }while(0)
  for(;t+1<NT;t+=2){
    STEP(pB0,pB1,pA0,pA1,t,(t+3<NT),(t+1<NT),(t+1<NT));       ENDW(t);   RESC(); ROT();
    STEP(pA0,pA1,pB0,pB1,t+1,(t+4<NT),(t+2<NT),(t+2<NT));     ENDW(t+1); RESC(); ROT();
  }
  STEP(pB0,pB1,pA0,pA1,NT-1,false,false,false); RESC();
  { float sacc=pB0[0]+pB0[1]; _Pragma("unroll") for(int r=2;r<16;++r)sacc+=pB0[r]; _Pragma("unroll") for(int r=0;r<16;++r)sacc+=pB1[r]; l_reg+=sacc;
    pw0=(u32x4){PKW(pB0,0),PKW(pB0,2),PKW(pB0,4),PKW(pB0,6)};pw1=(u32x4){PKW(pB0,8),PKW(pB0,10),PKW(pB0,12),PKW(pB0,14)};pw2=(u32x4){PKW(pB1,0),PKW(pB1,2),PKW(pB1,4),PKW(pB1,6)};pw3=(u32x4){PKW(pB1,8),PKW(pB1,10),PKW(pB1,12),PKW(pB1,14)};
    SBAR(); pv(o,vb0+sl_cur,PAF(0),PAF(1),PAF(2),PAF(3)); }
  #undef PKW
  #undef PAF
  #undef VFR
  #undef PIN
  #undef MX3
  #undef GAPA
  #undef GAPB
  #undef EX
  #undef VRD
  #undef KRD
  #undef STEP
  #undef ENDW
  {auto rr=__builtin_amdgcn_permlane32_swap(__float_as_uint(l_reg),__float_as_uint(l_reg),false,false);l_reg=__uint_as_float(rr[0])+__uint_as_float(rr[1]);}
  if(hi==0)wsf[32+r32]=l_reg;asm volatile("s_waitcnt lgkmcnt(0)":::"memory");
  float rli[16];
  #pragma unroll
  for(int r=0;r<16;++r)rli[r]=__builtin_amdgcn_rcpf(wsf[32+crow(r,hi)]);
  bf16*Ow=O+(rowbase+q0+wid*QBLK)*DM+h*D;
  { bf16*stg=(bf16*)(shm+LDS_OST)+wid*2048;
    #pragma unroll
    for(int r=0;r<16;++r){const int orow=crow(r,hi);
      #pragma unroll
      for(int d0=0;d0<2;++d0)stg[orow*64+d0*32+r32]=__float2bfloat16(o[d0][r]*rli[r]);}
    asm volatile("s_waitcnt lgkmcnt(0)":::"memory");
    #pragma unroll
    for(int i=0;i<4;++i){const int row=i*8+(lane>>3),ch=lane&7; const u32x4 v=*(const u32x4*)(stg+row*64+ch*8); ATTN_STORE16(Ow+(long)row*DM+ch*8,v);} }
  asm volatile("s_waitcnt lgkmcnt(0)\n\ts_barrier":::"memory");
  #undef DMA_K
  #undef TM
  #undef SELK
  #undef DMA_V
  #undef CMASK
  #undef START
  #undef RESC
  #undef ROT
}

__device__ __forceinline__ void moba_gate(int b,int h,int qb,const bf16*Q,const float*__restrict__ kmean,char*shm){
  int tid=threadIdx.x; asm volatile("":"+v"(tid));
  if(tid<QB){
    unsigned selmask=0u;
    if(qb>0){
      const unsigned short*qrow=(const unsigned short*)Q+((long)b*SEQ+qb*QB+tid)*DM+h*D;
      const float*kmb=kmean+(long)((b*NHEAD+h)*16)*64;
      float g0=-INFINITY,g1=-INFINITY,g2=-INFINITY; int i0=-1,i1=-1,i2=-1;
      for(int n=0;n<qb;++n){
        float g=0.f;
        #pragma unroll
        for(int c=0;c<8;++c){
          const u32x4 qv=*reinterpret_cast<const u32x4*>(qrow+c*8);
          const f32x4_t ka=*reinterpret_cast<const f32x4_t*>(kmb+n*64+c*8), kb=*reinterpret_cast<const f32x4_t*>(kmb+n*64+c*8+4);
          g+=__builtin_bit_cast(float,qv.x<<16)*ka[0]; g+=__builtin_bit_cast(float,qv.x&0xffff0000u)*ka[1];
          g+=__builtin_bit_cast(float,qv.y<<16)*ka[2]; g+=__builtin_bit_cast(float,qv.y&0xffff0000u)*ka[3];
          g+=__builtin_bit_cast(float,qv.z<<16)*kb[0]; g+=__builtin_bit_cast(float,qv.z&0xffff0000u)*kb[1];
          g+=__builtin_bit_cast(float,qv.w<<16)*kb[2]; g+=__builtin_bit_cast(float,qv.w&0xffff0000u)*kb[3];
        }
        if(g>g0){g2=g1;i2=i1;g1=g0;i1=i0;g0=g;i0=n;} else if(g>g1){g2=g1;i2=i1;g1=g;i1=n;} else if(g>g2){g2=g;i2=n;}
      }
      if(i0>=0)selmask|=1u<<i0; if(i1>=0)selmask|=1u<<i1; if(i2>=0)selmask|=1u<<i2;
    }
    { int t2=tid; asm volatile("":"+v"(t2)); ((unsigned*)(shm+LDS_BYTES))[t2]=selmask; }
  }
  asm volatile("s_waitcnt lgkmcnt(0)\n\ts_barrier":::"memory");
}
constexpr int ATTN_LDS_BYTES=LDS_BYTES;
struct AttnTensors { const bf16* Q; const bf16* K; const bf16* V; bf16* O; const float* kmean; };
struct AttnUnit { int bh; int qb; };
struct StaticOrder {
  int vcu;
  __device__ __forceinline__ explicit StaticOrder(int grid,int block):vcu((block%8)*(grid/8)+block/8){}
  __device__ __forceinline__ bool next(int i,AttnUnit&u)const{ if(i>=8)return false; const int half=vcu&1; u.bh=vcu>>1;
    const int pr=3-(i>>1);
    u.qb=(i&1)?(half?(4*pr+1):(4*pr)):(half?(4*pr+2):(4*pr+3)); return true; }
  __device__ __forceinline__ void a_ready(const AttnUnit&)const{}
  __device__ __forceinline__ void done(const AttnUnit&)const{}
};
struct QueueOrder {
  unsigned* ctr; volatile __attribute__((address_space(3))) unsigned* slot;
  __device__ __forceinline__ bool next(int,AttnUnit&u)const{
    if(threadIdx.x==0)*slot=__hip_atomic_fetch_add(ctr,1u,__ATOMIC_RELAXED,__HIP_MEMORY_SCOPE_AGENT);
    __syncthreads(); const unsigned k=*slot; __syncthreads();
    if(k>=2048u)return false; u.qb=15-(int)(k>>7); u.bh=(int)(k&127u); return true; }
  __device__ __forceinline__ void a_ready(const AttnUnit&)const{}
  __device__ __forceinline__ void done(const AttnUnit&)const{}
};
template<class Sched,int THRL=8> __device__ __forceinline__ void attn_phase(char*lds,const AttnTensors&T,const Sched&S){
  AttnUnit u;
  for(int i=0;S.next(i,u);++i){ S.a_ready(u); moba_gate(u.bh/NHEAD,u.bh%NHEAD,u.qb,T.Q,T.kmean,lds); attn_unit<THRL>(u.bh/NHEAD,u.bh%NHEAD,u.qb,T.Q,T.K,T.V,T.O,lds); S.done(u); }
}
#undef SBAR
#undef WAIT_BAR
}
namespace mlstm {
#define ML_LAS __attribute__((address_space(3)))
typedef short bf16x8 __attribute__((ext_vector_type(8)));
typedef short s16x4 __attribute__((ext_vector_type(4)));
typedef float f32x4 __attribute__((ext_vector_type(4)));
typedef unsigned u32x4 __attribute__((ext_vector_type(4)));
typedef unsigned u32x2 __attribute__((ext_vector_type(2)));
constexpr int PQ = 272, PV = 336, PA = 144;
constexpr int O_QC = 0, O_KC = O_QC + 64 * PQ, O_HST = O_KC + 64 * PQ, O_VP = O_HST + 64 * PQ, O_VW = O_VP + 64 * PV, O_ST = O_VW + 64 * PV, O_AM = O_ST + 128 * PV,
              O_CW = O_AM + 64 * PA, O_EX = O_CW + 2 * 5 * 128 * 4, O_SCR = O_EX + 3 * 64 * 4, O_CH = O_SCR + 64 * 4, LDS_END = O_CH + 2 * 4 * 64 * 4;
static_assert(LDS_END <= 156 * 1024, "mlstm LDS");
struct Args { const bf16_t* mq; const bf16_t* mk; const bf16_t* mv; const bf16_t* mosig; const float* ifg; const float* conv_w; const float* conv_b; const float* nw; float* sca; float* scm; float* scb; bf16_t* hm; };
__device__ __forceinline__ s16x4 trd(const ML_LAS unsigned char* p) { return __builtin_bit_cast(s16x4, __builtin_amdgcn_ds_read_tr16_b64_v4i16((ML_LAS s16x4*)p)); }
__device__ __forceinline__ bf16x8 cat8(s16x4 lo, s16x4 hi) { return (bf16x8){lo[0], lo[1], lo[2], lo[3], hi[0], hi[1], hi[2], hi[3]}; }
__device__ __forceinline__ float blo(unsigned w) { return __builtin_bit_cast(float, w << 16); }
__device__ __forceinline__ float bhi(unsigned w) { return __builtin_bit_cast(float, w & 0xffff0000u); }
__device__ __forceinline__ float logsig(float f) { return (f >= 0.f) ? -log1pf(__expf(-f)) : f - log1pf(__expf(f)); }

__device__ __forceinline__ void unit(int b, int h, const Args& A, ML_LAS unsigned char* lds) {
    int tid = threadIdx.x; asm volatile("" : "+v"(tid)); const int lane = tid & 63, wid = __builtin_amdgcn_readfirstlane(tid >> 6);
    int tidv = tid; int l15 = tidv & 15, q4 = (tidv >> 4) & 3, d8 = tidv & 15, row0 = 2 * (tidv >> 4);
    const size_t tb = (size_t)b * 4096, sb = (size_t)(b * 4 + h) * 4096;
    ML_LAS float* cwl = (ML_LAS float*)(lds + O_CW); ML_LAS float* ex = (ML_LAS float*)(lds + O_EX); ML_LAS float* scr = (ML_LAS float*)(lds + O_SCR); ML_LAS float* chs = (ML_LAS float*)(lds + O_CH);
    for (int i = tid; i < 1280; i += 512) { const int qk = i / 640, r = (i % 640) >> 7, d = i & 127, ch = qk * 512 + h * 128 + d; cwl[i] = (r < 4) ? A.conv_w[r * 1024 + ch] : A.conv_b[ch]; }
    for (int i = tid; i < 128 * PV / 16; i += 512) *(ML_LAS u32x4*)(lds + O_ST + i * 16) = (u32x4){0u, 0u, 0u, 0u};
    if (tid < 256) { const int r = tid >> 2, part = tid & 3;
        *(ML_LAS u32x4*)(lds + O_VP + r * PV + 256 + part * 16) = (u32x4){part == 0 ? 0x3F80u : 0u, 0u, 0u, 0u};
        *(ML_LAS u32x4*)(lds + O_VW + r * PV + 256 + part * 16) = (u32x4){0u, 0u, 0u, 0u}; }
    {
        float lfv[8], av[8]; float run = 0.f;
#pragma unroll
        for (int j = 0; j < 8; ++j) { const float f = A.ifg[(tb + 8 * tid + j) * 8 + 4 + h]; run += logsig(f); lfv[j] = run; }
        float incl = run;
#pragma unroll
        for (int o = 1; o < 64; o <<= 1) { const float t = __shfl_up(incl, o); if (lane >= o) incl += t; }
        if (lane == 63) scr[wid] = incl;
        __syncthreads();
        float pre = incl - run; for (int w = 0; w < wid; ++w) pre += scr[w];
        float m = -INFINITY;
#pragma unroll
        for (int j = 0; j < 8; ++j) { const float Bv = pre + lfv[j]; const float a = A.ifg[(tb + 8 * tid + j) * 8 + h] - Bv; A.scb[sb + 8 * tid + j] = Bv; A.sca[sb + 8 * tid + j] = a; m = fmaxf(m, a); av[j] = m; }
        float im = m;
#pragma unroll
        for (int o = 1; o < 64; o <<= 1) { const float t = __shfl_up(im, o); if (lane >= o) im = fmaxf(im, t); }
        if (lane == 63) scr[8 + wid] = im;
        __syncthreads();
        float pm = __shfl_up(im, 1); if (lane == 0) pm = -INFINITY; pm = fmaxf(pm, 0.f); for (int w = 0; w < wid; ++w) pm = fmaxf(pm, scr[8 + w]);
#pragma unroll
        for (int j = 0; j < 8; ++j) A.scm[sb + 8 * tid + j] = fmaxf(pm, av[j]);
    }
    __threadfence(); __syncthreads();
    f32x4 accS[20];
#pragma unroll
    for (int v = 0; v < 20; ++v) accS[v] = (f32x4){0.f, 0.f, 0.f, 0.f};
    uint4 rq[5], rk[5], rv[2]; float chv = 0.f;
#define goff ((unsigned)(tb * 512) + h * 128 + 8 * d8)
#define ML_LOAD(c) do { const int c0_ = (c) * 64; \
        _Pragma("unroll") for (int j = 0; j < 5; ++j) { const int rr = c0_ + row0 - 3 + j; if (rr >= 0) { rq[j] = *(const uint4*)(A.mq + goff + rr * 512); rk[j] = *(const uint4*)(A.mk + goff + rr * 512); } else { rq[j] = make_uint4(0u, 0u, 0u, 0u); rk[j] = rq[j]; } } \
        _Pragma("unroll") for (int j = 0; j < 2; ++j) { rv[j] = *(const uint4*)(A.mv + goff + (c0_ + row0 + j) * 512); \
            } } while (0)
#define ML_LOADS(c) do { const int c0_ = (c) * 64; \
        if (tidv < 192) { chv = A.sca[(size_t)(tidv >> 6) * (16 * 4 * 4096) + sb + c0_ + (tidv & 63)]; }     else if (tidv == 192) chv = (c0_ == 0) ? 0.f : A.scm[sb + c0_ - 1]; } while (0)
    ML_LOAD(0); ML_LOADS(0);
    if (tidv < 193) chs[tidv] = chv;
    __syncthreads();
    for (int c = 0; c < 64; ++c) {
        asm volatile("" : "+v"(tidv)); l15 = tidv & 15; q4 = (tidv >> 4) & 3; d8 = l15; row0 = 2 * (tidv >> 4);
        const int c0 = c * 64; const ML_LAS float* ch = chs + (c & 1) * 256;
#pragma unroll
        for (int qk = 0; qk < 2; ++qk) {
            const ML_LAS float* wq = cwl + qk * 640 + 8 * d8;
            float y[2][8];
            { const f32x4 b0 = *(const ML_LAS f32x4*)(wq + 512), b1 = *(const ML_LAS f32x4*)(wq + 516);
#pragma unroll
              for (int e = 0; e < 4; ++e) { y[0][e] = b0[e]; y[0][4 + e] = b1[e]; y[1][e] = b0[e]; y[1][4 + e] = b1[e]; } }
#pragma unroll
            for (int j = 0; j < 4; ++j) {
                const f32x4 w0 = *(const ML_LAS f32x4*)(wq + j * 128), w1 = *(const ML_LAS f32x4*)(wq + j * 128 + 4);
#pragma unroll
                for (int ro = 0; ro < 2; ++ro) { const uint4 u = qk ? rk[ro + j] : rq[ro + j]; const unsigned uw[4] = {u.x, u.y, u.z, u.w};
                    y[ro][0] += w0[0] * blo(uw[0]); y[ro][1] += w0[1] * bhi(uw[0]); y[ro][2] += w0[2] * blo(uw[1]); y[ro][3] += w0[3] * bhi(uw[1]);
                    y[ro][4] += w1[0] * blo(uw[2]); y[ro][5] += w1[1] * bhi(uw[2]); y[ro][6] += w1[2] * blo(uw[3]); y[ro][7] += w1[3] * bhi(uw[3]); }
            }
#pragma unroll
            for (int ro = 0; ro < 2; ++ro) {
#pragma unroll
                for (int e = 0; e < 8; ++e) { y[ro][e] = y[ro][e] * __builtin_amdgcn_rcpf(1.0f + __expf(-y[ro][e])); if (qk) y[ro][e] *= 0.08838834764831845f; }
                *(ML_LAS u32x4*)(lds + (qk ? O_KC : O_QC) + (row0 + ro) * PQ + 16 * d8) = (u32x4){pk2(y[ro][0], y[ro][1]), pk2(y[ro][2], y[ro][3]), pk2(y[ro][4], y[ro][5]), pk2(y[ro][6], y[ro][7])};
            }
        }
#pragma unroll
        for (int ro = 0; ro < 2; ++ro) {
            *(ML_LAS u32x4*)(lds + O_VP + (row0 + ro) * PV + 16 * d8) = (u32x4){rv[ro].x, rv[ro].y, rv[ro].z, rv[ro].w};
            const float wsv = __expf(ch[row0 + ro] - ch[127]); const unsigned uw[4] = {rv[ro].x, rv[ro].y, rv[ro].z, rv[ro].w}; unsigned o[4];
#pragma unroll
            for (int e2 = 0; e2 < 4; ++e2) o[e2] = pk2(blo(uw[e2]) * wsv, bhi(uw[e2]) * wsv);
            *(ML_LAS u32x4*)(lds + O_VW + (row0 + ro) * PV + 16 * d8) = (u32x4){o[0], o[1], o[2], o[3]};
            if (d8 == 0) *(ML_LAS unsigned short*)(lds + O_VW + (row0 + ro) * PV + 256) = (unsigned short)f2bf(wsv);
        }
        __syncthreads();
        const float Mref = ch[192], Mend = ch[127];
        const int trow = 16 * (wid & 3) + 4 * q4;
        const f32x4 Mxr = *(const ML_LAS f32x4*)(ch + 64 + trow);
        if (wid < 4) {
#pragma unroll
            for (int v = 0; v < 10; ++v) accS[v] = (f32x4){0.f, 0.f, 0.f, 0.f};
#pragma unroll
            for (int ks = 0; ks < 4; ++ks) {
                const bf16x8 a = *(const ML_LAS bf16x8*)(lds + O_QC + (16 * wid + l15) * PQ + (32 * ks + 8 * q4) * 2);
                const ML_LAS unsigned char* bp = lds + O_ST + (32 * ks + 8 * q4 + (l15 >> 2)) * PV + (l15 & 3) * 8;
#pragma unroll
                for (int v = 0; v < 10; ++v) { const bf16x8 bfr = cat8(trd(bp + 32 * v), trd(bp + 4 * PV + 32 * v)); accS[v] = __builtin_amdgcn_mfma_f32_16x16x32_bf16(a, bfr, accS[v], 0, 0, 0); }
            }
            float wi[4];
#pragma unroll
            for (int i = 0; i < 4; ++i) wi[i] = __expf(Mref - Mxr[i]);
#pragma unroll
            for (int v = 0; v < 10; ++v)
#pragma unroll
                for (int i = 0; i < 4; ++i) accS[v][i] *= wi[i];
        } else {
            const int j = wid - 4;
#pragma unroll
            for (int tile = 0; tile < 16; ++tile) {
                if ((int)((0x3333322221120000ull >> (4 * tile)) & 15ull) != j) continue;
                const int st = tile >> 2, tt = tile & 3;
                f32x4 cacc = (f32x4){0.f, 0.f, 0.f, 0.f};
                if (st <= tt) {
#pragma unroll
                    for (int ks = 0; ks < 4; ++ks) {
                        const bf16x8 a = *(const ML_LAS bf16x8*)(lds + O_KC + (16 * st + l15) * PQ + (32 * ks + 8 * q4) * 2);
                        const bf16x8 bq = *(const ML_LAS bf16x8*)(lds + O_QC + (16 * tt + l15) * PQ + (32 * ks + 8 * q4) * 2);
                        cacc = __builtin_amdgcn_mfma_f32_16x16x32_bf16(a, bq, cacc, 0, 0, 0);
                    }
                }
                const int t = 16 * tt + l15, s0 = 16 * st + 4 * q4;
                const float Mt = ch[64 + t]; const f32x4 as = *(const ML_LAS f32x4*)(ch + s0);
                float o[4];
#pragma unroll
                for (int i = 0; i < 4; ++i) o[i] = (s0 + i <= t) ? cacc[i] * __expf(as[i] - Mt) : 0.f;
                *(ML_LAS u32x2*)(lds + O_AM + t * PA + s0 * 2) = (u32x2){pk2(o[0], o[1]), pk2(o[2], o[3])};
            }
            const float decay = __expf(Mref - Mend);
#pragma unroll
            for (int v = 0; v < 20; ++v) accS[v] = accS[v] * decay;
#pragma unroll
            for (int ks = 0; ks < 2; ++ks) {
                const ML_LAS unsigned char* kp = lds + O_KC + (32 * ks + 8 * q4 + (l15 >> 2)) * PQ + 64 * j + (l15 & 3) * 8;
                const bf16x8 bf0 = cat8(trd(kp), trd(kp + 4 * PQ)), bf1 = cat8(trd(kp + 32), trd(kp + 4 * PQ + 32));
                const ML_LAS unsigned char* ap = lds + O_VW + (32 * ks + 8 * q4 + (l15 >> 2)) * PV + (l15 & 3) * 8;
#pragma unroll
                for (int v = 0; v < 10; ++v) { const bf16x8 afr = cat8(trd(ap + 32 * v), trd(ap + 4 * PV + 32 * v));
                    accS[v] = __builtin_amdgcn_mfma_f32_16x16x32_bf16(afr, bf0, accS[v], 0, 0, 0); accS[10 + v] = __builtin_amdgcn_mfma_f32_16x16x32_bf16(afr, bf1, accS[10 + v], 0, 0, 0); }
            }
        }
        __syncthreads();
        if (c + 1 < 64) ML_LOADS(c + 1);
        if (wid < 4) {
#pragma unroll
            for (int ks = 0; ks < 2; ++ks) {
                const bf16x8 a = *(const ML_LAS bf16x8*)(lds + O_AM + (16 * wid + l15) * PA + (32 * ks + 8 * q4) * 2);
                const ML_LAS unsigned char* bp = lds + O_VP + (32 * ks + 8 * q4 + (l15 >> 2)) * PV + (l15 & 3) * 8;
#pragma unroll
                for (int v = 0; v < 10; ++v) { const bf16x8 bfr = cat8(trd(bp + 32 * v), trd(bp + 4 * PV + 32 * v)); accS[v] = __builtin_amdgcn_mfma_f32_16x16x32_bf16(a, bfr, accS[v], 0, 0, 0); }
            }
            const f32x4 Bcr = *(const ML_LAS f32x4*)(ch + 128 + trow);
#pragma unroll
            for (int i = 0; i < 4; ++i) {
                float ssum = 0.f;
#pragma unroll
                for (int v = 0; v < 8; ++v) ssum += accS[v][i] * accS[v][i];
                ssum += __shfl_xor(ssum, 1); ssum += __shfl_xor(ssum, 2); ssum += __shfl_xor(ssum, 4); ssum += __shfl_xor(ssum, 8);
                const float den = __shfl(accS[8][i], lane & 48);
                const float dn = fmaxf(fabsf(den), __expf(-(Bcr[i] + Mxr[i]))), idn = 1.0f / dn;
                const float sc = idn * rsqrtf(ssum * idn * idn * (1.0f / 128.0f) + 1e-6f);
#pragma unroll
                for (int v = 0; v < 8; ++v) *(ML_LAS unsigned short*)(lds + O_HST + (trow + i) * PQ + (16 * v + l15) * 2) = (unsigned short)f2bf(accS[v][i] * sc);
            }
        } else {
            const int j = wid - 4;
#pragma unroll
            for (int v = 0; v < 10; ++v) {
                *(ML_LAS u32x2*)(lds + O_ST + (32 * j + l15) * PV + (16 * v + 4 * q4) * 2) = (u32x2){pk2(accS[v][0], accS[v][1]), pk2(accS[v][2], accS[v][3])};
                *(ML_LAS u32x2*)(lds + O_ST + (32 * j + 16 + l15) * PV + (16 * v + 4 * q4) * 2) = (u32x2){pk2(accS[10 + v][0], accS[10 + v][1]), pk2(accS[10 + v][2], accS[10 + v][3])}; }
        }
        if (c + 1 < 64) ML_LOAD(c + 1);
        if (tidv < 193) chs[((c + 1) & 1) * 256 + tidv] = chv;
        uint4 rmo[2];
#pragma unroll
        for (int ro = 0; ro < 2; ++ro) rmo[ro] = *(const uint4*)(A.mosig + goff + (c0 + row0 + ro) * 512);
        __syncthreads();
        f32x4 nwv[2]; nwv[0] = *(const f32x4*)(A.nw + h * 128 + 8 * d8); nwv[1] = *(const f32x4*)(A.nw + h * 128 + 8 * d8 + 4);
#pragma unroll
        for (int ro = 0; ro < 2; ++ro) {
            const u32x4 hv = *(const ML_LAS u32x4*)(lds + O_HST + (row0 + ro) * PQ + 16 * d8); const unsigned hw[4] = {hv.x, hv.y, hv.z, hv.w}; const unsigned mw[4] = {rmo[ro].x, rmo[ro].y, rmo[ro].z, rmo[ro].w}; unsigned o[4];
#pragma unroll
            for (int e2 = 0; e2 < 4; ++e2) o[e2] = pk2(blo(hw[e2]) * nwv[(2 * e2) >> 2][(2 * e2) & 3] * blo(mw[e2]), bhi(hw[e2]) * nwv[(2 * e2 + 1) >> 2][(2 * e2 + 1) & 3] * bhi(mw[e2]));
            *(uint4*)(A.hm + goff + (c0 + row0 + ro) * 512) = make_uint4(o[0], o[1], o[2], o[3]);
        }
    }
#undef ML_LOAD
#undef ML_LOADS
#undef goff
    __syncthreads();
}
}
namespace peer {
#define PE_LAS __attribute__((address_space(3)))
typedef short bf16x8 __attribute__((ext_vector_type(8)));
typedef float f32x4 __attribute__((ext_vector_type(4)));
typedef float f32x16 __attribute__((ext_vector_type(16)));
typedef unsigned u32x4 __attribute__((ext_vector_type(4)));
constexpr int QP = 528;
constexpr int O_R2 = 256 * QP;
constexpr int LDS_END = O_R2 + 1024;
__device__ __forceinline__ int ordi(float f) { const int b = __builtin_bit_cast(int, f); return b ^ ((b >> 31) & 0x7FFFFFFF); }
__device__ __forceinline__ float ordf(int o) { return __builtin_bit_cast(float, o ^ ((o >> 31) & 0x7FFFFFFF)); }
#define PE_CE(a, b) do { const int hi_ = max(a, b), lo_ = min(a, b); a = hi_; b = lo_; } while (0)
__device__ __forceinline__ void sort16_desc(int (&a)[16]) {
#pragma unroll
    for (int k = 2; k <= 16; k <<= 1)
#pragma unroll
        for (int j = k >> 1; j > 0; j >>= 1)
#pragma unroll
            for (int i = 0; i < 16; ++i) { const int l = i ^ j; if (l > i) { if ((i & k) == 0) PE_CE(a[i], a[l]); else PE_CE(a[l], a[i]); } }
}
__device__ __forceinline__ void merge16_desc(int (&a)[16], const int (&b)[16]) {
#pragma unroll
    for (int i = 0; i < 16; ++i) a[i] = max(a[i], b[15 - i]);
#pragma unroll
    for (int j = 8; j > 0; j >>= 1)
#pragma unroll
        for (int i = 0; i < 16; ++i) { const int l = i ^ j; if (l > i) PE_CE(a[i], a[l]); }
}
__device__ __forceinline__ void top16_of_64(int (&g0)[16], int (&g1)[16], int (&g2)[16], int (&g3)[16]) {
    sort16_desc(g0); sort16_desc(g1); sort16_desc(g2); sort16_desc(g3);
    merge16_desc(g0, g1); merge16_desc(g2, g3); merge16_desc(g0, g2);
}
struct Args { const float* rowss; const bf16_t* key1; const bf16_t* key2; float* r2out; int* eidx; float* eg; };
struct EpiPeerQ {
    static constexpr bool PERM = false, AFTER_DRAIN = true; static constexpr int MIN_VM = 0;
    __device__ __forceinline__ bool zero_after(const pg8::Unit&) const { return true; }
    __device__ __forceinline__ void fused(pg8::f32x4 (&acc)[2][2][4][2], const pg8::Unit& u, int wr, int wc, int fr, int fq, PG8_LAS unsigned char* lds, int wid, int lane) const {
        const PE_LAS float* r2s = (const PE_LAS float*)(lds + O_R2);
#pragma unroll
        for (int ai = 0; ai < 2; ++ai)
#pragma unroll
            for (int m = 0; m < 4; ++m) { const int row = ai * 128 + wr * 64 + m * 16 + fr; const float r = r2s[row];
#pragma unroll
                for (int bj = 0; bj < 2; ++bj) *(PE_LAS u32x4*)(lds + row * QP + (wc * 64 + bj * 32 + 8 * fq) * 2) = pg8::pack8(acc[ai][bj][m][0] * r, acc[ai][bj][m][1] * r); }
    }
};
struct SchedOne { pg8::Unit u;
    __device__ __forceinline__ bool next(int i, pg8::Unit& o) const { if (i > 0) return false; o = u; return true; }
    __device__ __forceinline__ void a_ready(const pg8::Unit&) const {}
    __device__ __forceinline__ void done(const pg8::Unit&) const {} };

__device__ __forceinline__ void half_top16(int (&g0)[16], const PE_LAS unsigned char* qrow  , const bf16_t* keyrow  , int hi) {
    f32x16 s[4];
#pragma unroll
    for (int kb = 0; kb < 4; ++kb) s[kb] = f32x16{};
#pragma unroll
    for (int ks = 0; ks < 8; ++ks) {
        const bf16x8 bq = *(const PE_LAS bf16x8*)(qrow + ks * 32);
#pragma unroll
        for (int kb = 0; kb < 4; ++kb) { const bf16x8 a = *(const bf16x8*)(keyrow + (size_t)kb * 32 * 128 + ks * 16); s[kb] = __builtin_amdgcn_mfma_f32_32x32x16_bf16(a, bq, s[kb], 0, 0, 0); }
    }
    int g1[16], g2[16], g3[16];
#pragma unroll
    for (int r = 0; r < 16; ++r) { const int kr = (r & 3) + 8 * (r >> 2) + 4 * hi;
        g0[r] = (ordi(s[0][r]) & ~0x7F) | kr; g1[r] = (ordi(s[1][r]) & ~0x7F) | (32 + kr); g2[r] = (ordi(s[2][r]) & ~0x7F) | (64 + kr); g3[r] = (ordi(s[3][r]) & ~0x7F) | (96 + kr); }
    top16_of_64(g0, g1, g2, g3);
#pragma unroll
    for (int r = 0; r < 16; ++r) g1[r] = __shfl_xor(g0[r], 32);
    merge16_desc(g0, g1);
}

__device__ __forceinline__ void unit(int pm, int h, const bf16_t* x1b, const bf16_t* wq, const Args& A, PG8_LAS unsigned char* lds) {
    int tid = threadIdx.x; asm volatile("" : "+v"(tid)); const int wid = __builtin_amdgcn_readfirstlane(tid >> 6);
    if (tid < 256) { const f32x4* rs = (const f32x4*)(A.rowss + (size_t)(pm * 256 + tid) * 16); const f32x4 a = rs[0], b = rs[1], c = rs[2], d = rs[3];
        const float ss = ((a[0] + a[1]) + (a[2] + a[3])) + ((b[0] + b[1]) + (b[2] + b[3])) + ((c[0] + c[1]) + (c[2] + c[3])) + ((d[0] + d[1]) + (d[2] + d[3]));
        const float r = rsqrtf(ss * (1.0f / 1024.0f) + 1e-6f); ((PE_LAS float*)(lds + O_R2))[tid] = r; if (h == 0) A.r2out[pm * 256 + tid] = r; }
    __syncthreads();
    SchedOne S; S.u.pm = pm; S.u.pn = h; S.u.seg = 0; S.u.pad = 0; S.u.A = (const char*)(x1b + (size_t)pm * 256 * 1024); S.u.B = (const char*)(wq + (size_t)h * 256 * 1024);
    EpiPeerQ E;
    pg8::gemm_phase<EpiPeerQ, SchedOne, true, true>(lds, 1024, S, E);
    __syncthreads();
    int tv = tid; asm volatile("" : "+v"(tv)); const int r32 = tv & 31, hi = (tv >> 5) & 1;
    int v1[16], v2[16];
    half_top16(v1, lds + (32 * wid + r32) * QP + (8 * hi) * 2, A.key1 + ((size_t)h * 128 + r32) * 128 + 8 * hi, hi);
    half_top16(v2, lds + (32 * wid + r32) * QP + (128 + 8 * hi) * 2, A.key2 + ((size_t)h * 128 + r32) * 128 + 8 * hi, hi);
    float f1[16], f2[16];
#pragma unroll
    for (int i = 0; i < 16; ++i) { f1[i] = ordf(v1[i] & ~0x7F); f2[i] = ordf(v2[i] & ~0x7F); }
    int c0[16], c1[16], c2[16], c3[16];
    {
        int n = 0;
#pragma unroll
        for (int i = 0; i < 16; ++i)
#pragma unroll
            for (int j = 0; j < 16; ++j) if ((i + 1) * (j + 1) <= 16) { const int key = (ordi(f1[i] + f2[j]) & ~0xFF) | (i << 4) | j;
                if (n < 16) c0[n] = key; else if (n < 32) c1[n - 16] = key; else if (n < 48) c2[n - 32] = key; else c3[n - 48] = key; ++n; }
#pragma unroll
        for (int k = 2; k < 16; ++k) c3[k] = (int)0x80000000;
    }
    top16_of_64(c0, c1, c2, c3);
    PE_LAS unsigned char* scr = lds + (32 * wid + r32) * QP;
    if (hi == 0) {
#pragma unroll
        for (int i = 0; i < 16; ++i) { scr[i] = (unsigned char)(v1[i] & 0x7F); scr[16 + i] = (unsigned char)(v2[i] & 0x7F); } }
    asm volatile("s_waitcnt lgkmcnt(0)" ::: "memory");
    float val[16], sum = 0.f;
#pragma unroll
    for (int r = 0; r < 16; ++r) { val[r] = __expf(ordf(c0[r] & ~0xFF) - ordf(c0[0] & ~0xFF)); sum += val[r]; }
    const float inv = 1.0f / sum;
    const size_t ob = ((size_t)(pm * 256 + 32 * wid + r32) * 8 + h) * 16;
#pragma unroll
    for (int r = 0; r < 16; ++r) if ((r >> 3) == hi) { const int code = c0[r] & 0xFF; A.eidx[ob + r] = (int)scr[code >> 4] * 128 + (int)scr[16 + (code & 15)]; A.eg[ob + r] = val[r] * inv; }
    __syncthreads();
}
}
#define XB_TMO      128
#define XB_XCNT(j)  (256  + 64 * (j))
#define XB_XSUB(j)  (1280 + 64 * (j))
#define XB_XGEN(j)  (2304 + 64 * (j))
#define XB_TOP      3328
#define XB_TOPGEN   3392
#define XCD_BAR_WORDS 3456
#define XB_SPIN_CAP (1u << 18)

__device__ __forceinline__ unsigned xb_ld(unsigned* p)              { return __hip_atomic_load(p, __ATOMIC_RELAXED, __HIP_MEMORY_SCOPE_AGENT); }
__device__ __forceinline__ unsigned xb_add(unsigned* p, unsigned v) { return __hip_atomic_fetch_add(p, v, __ATOMIC_RELAXED, __HIP_MEMORY_SCOPE_AGENT); }
__device__ __forceinline__ unsigned xb_xcc_id() { return (unsigned)__builtin_amdgcn_s_getreg((3 << 11) | 20) & 0xFu; }
#define XB_SPIN(cond, bar) do { unsigned _sp = 0; while (cond) { __builtin_amdgcn_s_sleep(1); \
    if ((++_sp & 255u) == 0u) { if (xb_ld(&(bar)[XB_TMO])) break; if (_sp > XB_SPIN_CAP) { atomicAdd(&(bar)[XB_TMO], 1u); break; } } } } while (0)

struct XcdBarrier {
    unsigned* bar; unsigned x;
    volatile __attribute__((address_space(3))) unsigned* st;
};

__device__ __forceinline__ XcdBarrier xcd_barrier_post(unsigned* bar, volatile __attribute__((address_space(3))) unsigned* st) {
    XcdBarrier b; b.bar = bar; b.x = xb_xcc_id(); b.st = st;
    if (threadIdx.x == 0) (void)xb_add(&bar[XB_XCNT(b.x)], 1u);
    return b;
}
__device__ __forceinline__ void xcd_barrier_complete(unsigned* bar, unsigned x, unsigned& nloc, unsigned& nx) {
    const unsigned G = gridDim.x * gridDim.y * gridDim.z;
    unsigned sum, cnt, mine, sp = 0u;
    for (;;) {
        sum = 0u; cnt = 0u; mine = 0u;
#pragma unroll
        for (unsigned j = 0; j < 16; ++j) { const unsigned c = xb_ld(&bar[XB_XCNT(j)]); sum += c; cnt += (c > 0u) ? 1u : 0u; mine = (j == x) ? c : mine; }
        if (sum == G) break;
        __builtin_amdgcn_s_sleep(1);
        if ((++sp & 255u) == 0u) { if (xb_ld(&bar[XB_TMO])) break; if (sp > XB_SPIN_CAP) { atomicAdd(&bar[XB_TMO], 1u); break; } }
    }
    nloc = mine > 0u ? mine : 1u; nx = cnt > 0u ? cnt : 1u;
}

__device__ __forceinline__ void xcd_barrier(const XcdBarrier& b) {
    asm volatile("s_waitcnt vmcnt(0)" ::: "memory");
    __syncthreads();
    if (threadIdx.x == 0) {
        unsigned* bar = b.bar;
        __builtin_amdgcn_s_waitcnt(0);
        unsigned nloc = b.st[0], nx = b.st[1];
        if (nloc == 0u) { xcd_barrier_complete(bar, b.x, nloc, nx); b.st[0] = nloc; b.st[1] = nx; }
        const unsigned old = xb_add(&bar[XB_XSUB(b.x)], 1u);
        const unsigned gen = old / nloc;
        if (old + 1u == (gen + 1u) * nloc) {
            __builtin_amdgcn_fence(__ATOMIC_RELEASE, "agent");
            asm volatile("s_waitcnt vmcnt(0)" ::: "memory");
            const unsigned og = xb_add(&bar[XB_TOP], 1u);
            const unsigned tg = og / nx;
            if (og + 1u == (tg + 1u) * nx) xb_add(&bar[XB_TOPGEN], 1u);
            else XB_SPIN(xb_ld(&bar[XB_TOPGEN]) == tg, bar);
            __builtin_amdgcn_fence(__ATOMIC_ACQUIRE, "agent");
            xb_add(&bar[XB_XGEN(b.x)], 1u);
            asm volatile("s_waitcnt vmcnt(0)" ::: "memory");
        } else {
            XB_SPIN(xb_ld(&bar[XB_XGEN(b.x)]) == gen, bar);
            __builtin_amdgcn_fence(__ATOMIC_ACQUIRE, "agent");
            asm volatile("s_waitcnt vmcnt(0)" ::: "memory");
        }
    }
    __syncthreads();
}
#include <hip/hip_cooperative_groups.h>
namespace cg = cooperative_groups;
constexpr int BIG_LDS = 156 * 1024 + 256;
constexpr int LDS_CTL = 156 * 1024;
constexpr int DUP = 0;
struct PArgs { const float* in[20]; float* out; char* ws; };
__device__ __forceinline__ const PArgs* kargs() { auto kp = __builtin_amdgcn_kernarg_segment_ptr(); asm volatile("" : "+s"(kp)); return (const PArgs*)kp; }

__device__ __forceinline__ void phase0(const PArgs& p, unsigned char* shm) {
    int tid = threadIdx.x; asm volatile("" : "+v"(tid)); const int lane = tid & 63, wid = tid >> 6;
    const int gw = blockIdx.x * 8 + wid, NGW = gridDim.x * 8; const size_t gt = (size_t)blockIdx.x * 512 + tid, NTH = (size_t)gridDim.x * 512;
    char* ws = p.ws;
    { float* km = (float*)(ws + OFF_KMEAN); for (size_t i = gt; i < (size_t)16 * 8 * 16 * 64; i += NTH) km[i] = 0.f; }
    { float* rc = (float*)(ws + OFF_ROPE); float* rs = rc + 4096 * 8;
      for (size_t i = gt; i < 4096 * 8; i += NTH) { const int pos = (int)(i >> 3), k = (int)(i & 7); const float inv_freq = (float)pow(500000.0, -(double)(2 * k) / 16.0); const float ang = (float)pos * inv_freq;
          rc[i] = (float)cos((double)ang); rs[i] = (float)sin((double)ang); } }
    {
        const float* wdn = p.in[18]; const float* wup = p.in[19]; const float* fw = p.in[14]; unsigned* WU = (unsigned*)(ws + OFF_WU);
        { uint4* WDq = (uint4*)(ws + OFF_WD); float* SD = (float*)(ws + OFF_WD + 16 * MiB); float fv[16];
#pragma unroll
          for (int j = 0; j < 4; ++j) { const float4 s = *(const float4*)(fw + 16 * lane + 4 * j); fv[4 * j] = s.x; fv[4 * j + 1] = s.y; fv[4 * j + 2] = s.z; fv[4 * j + 3] = s.w; }
          for (int e = gw; e < 16384; e += NGW) { float v[16], am = 0.f;
#pragma unroll
              for (int j = 0; j < 4; ++j) { const float4 a = *(const float4*)(wdn + (size_t)e * 1024 + 16 * lane + 4 * j); v[4 * j] = a.x * fv[4 * j]; v[4 * j + 1] = a.y * fv[4 * j + 1]; v[4 * j + 2] = a.z * fv[4 * j + 2]; v[4 * j + 3] = a.w * fv[4 * j + 3]; }
              float ss = 0.f;
#pragma unroll
              for (int j = 0; j < 16; ++j) { am = fmaxf(am, fabsf(v[j])); ss += v[j] * v[j]; }
#pragma unroll
              for (int o = 32; o >= 1; o >>= 1) { am = fmaxf(am, __shfl_xor(am, o)); ss += __shfl_xor(ss, o); }
              const float step = fminf(am * (1.0f / 7.0f), 0.35f * sqrtf(ss * (1.0f / 1024.0f)));
              const float inv = step > 0.f ? 1.0f / step : 0.f; unsigned q[2] = {0u, 0u};
#pragma unroll
              for (int k = 0; k < 16; ++k) { const int qi = (int)fminf(fmaxf(rintf(v[k] * inv), -7.0f), 7.0f); q[k >> 3] |= (unsigned)(qi & 15) << (4 * (k & 7)); }
              ((uint2*)WDq)[(size_t)e * 64 + lane] = make_uint2(q[0], q[1]); if (lane == 0) SD[e] = step; } }
        { uint2* WU4 = (uint2*)WU; float* SU = (float*)(ws + OFF_WU + 16 * MiB);
          for (int e = gw; e < 16384; e += NGW) { float v[16], ss = 0.f, am = 0.f;
#pragma unroll
              for (int j = 0; j < 4; ++j) { const float4 a = *(const float4*)(wup + (size_t)e * 1024 + 16 * lane + 4 * j); v[4 * j] = a.x; v[4 * j + 1] = a.y; v[4 * j + 2] = a.z; v[4 * j + 3] = a.w; }
#pragma unroll
              for (int j = 0; j < 16; ++j) { ss += v[j] * v[j]; am = fmaxf(am, fabsf(v[j])); }
#pragma unroll
              for (int o = 32; o >= 1; o >>= 1) { ss += __shfl_xor(ss, o); am = fmaxf(am, __shfl_xor(am, o)); }
              const float step = fminf(am * (1.0f / 7.0f), 0.35f * sqrtf(ss * (1.0f / 1024.0f))), inv = step > 0.f ? 1.0f / step : 0.f; unsigned q[2] = {0u, 0u};
#pragma unroll
              for (int k = 0; k < 16; ++k) { const int qi = (int)fminf(fmaxf(rintf(v[k] * inv), -7.0f), 7.0f); const int j = k & 7, np = j < 4 ? 2 * j : 2 * (j - 4) + 1;
                  q[k >> 3] |= (unsigned)(j < 4 ? qi + 8 : (qi & 15)) << (4 * np); }
              WU4[(size_t)e * 64 + lane] = make_uint2(q[0], q[1]); if (lane == 0) SU[e] = step; } }
        const float* k1 = p.in[16]; const float* k2 = p.in[17]; bf16_t* K1 = (bf16_t*)(ws + OFF_KEY1); bf16_t* K2 = (bf16_t*)(ws + OFF_KEY2);
        for (size_t i = gt * 4; i < (size_t)8 * 128 * 128; i += NTH * 4) { const float4 a = *(const float4*)(k1 + i), b = *(const float4*)(k2 + i);
            *(uint2*)(K1 + i) = make_uint2(pk2(a.x, a.y), pk2(a.z, a.w)); *(uint2*)(K2 + i) = make_uint2(pk2(b.x, b.y), pk2(b.z, b.w)); }
    }
    {
        __attribute__((address_space(3))) float* tl = (__attribute__((address_space(3))) float*)(shm) + wid * (32 * 33);
        const int tx = lane & 31, ty = lane >> 5;
        for (int item = gw; item < 9728; item += NGW) {
            const float* W; const float* sc; bf16_t* O; int K, N, nbx, thr = 1 << 30, add = 0, it = item;
            if (it < 5632) { W = p.in[2]; sc = p.in[1]; O = (bf16_t*)(ws + OFF_WIN); K = 1024; N = INC; nbx = 176; thr = 3584; add = 8; }
            else if ((it -= 5632) < 512) { W = p.in[10]; sc = nullptr; O = (bf16_t*)(ws + OFF_WAB); K = 512; N = 1024; nbx = 32; }
            else if ((it -= 512) < 512) { W = p.in[11]; sc = nullptr; O = (bf16_t*)(ws + OFF_WMB); K = 512; N = 1024; nbx = 32; }
            else if ((it -= 512) < 1024) { W = p.in[13]; sc = nullptr; O = (bf16_t*)(ws + OFF_WOUT); K = 1024; N = 1024; nbx = 32; }
            else { it -= 1024; W = p.in[15]; sc = p.in[14]; O = (bf16_t*)(ws + OFF_WQ); K = 1024; N = 2048; nbx = 64; }
            const int n0 = (it % nbx) * 32, k0 = (it / nbx) * 32;
#pragma unroll 4
            for (int i = ty; i < 32; i += 2) { const int k = k0 + i, np = n0 + tx, ac = (np & ~255) + sigma_col(np & 255), src = ac + (ac >= thr ? add : 0); tl[i * 33 + tx] = W[(size_t)k * N + src] * (sc ? sc[k] : 1.0f); }
            asm volatile("s_waitcnt lgkmcnt(0)" ::: "memory");
#pragma unroll 4
            for (int i = ty; i < 32; i += 2) { const int np = n0 + i, k = k0 + tx; O[(size_t)np * K + k] = (bf16_t)f2bf(tl[tx * 33 + i]); }
            asm volatile("s_waitcnt lgkmcnt(0)" ::: "memory");
        }
    }
    {
        const float* x = p.in[0]; const float* normw = p.in[1]; const float* w_in = p.in[2]; const float* igb = p.in[7]; const float* fgb = p.in[8];
        bf16_t* xb = (bf16_t*)(ws + OFF_XB); float* r1 = (float*)(ws + OFF_R1); float* ifg = (float*)(ws + OFF_IFG);
        float wg[4][4][8];
#pragma unroll
        for (int j = 0; j < 4; ++j)
#pragma unroll
            for (int i = 0; i < 4; ++i) { const int k = 256 * j + 4 * lane + i; const float nw = normw[k];
#pragma unroll
                for (int c = 0; c < 8; ++c) wg[j][i][c] = w_in[(size_t)k * INC + 3584 + c] * nw; }
        typedef float p0_f32x4 __attribute__((ext_vector_type(4)));
        float bias_l = (lane >> 2) < 4 ? igb[(lane >> 2) & 3] : fgb[(lane >> 2) & 3];
        const unsigned xoff = (unsigned)lane * 16u, xoff8 = (unsigned)lane * 8u;
        auto do_row = [&](const p0_f32x4 (&v)[4], const int row) {
            float ss = 0.f, g[8];
#pragma unroll
            for (int c = 0; c < 8; ++c) g[c] = 0.f;
#pragma unroll
            for (int j = 0; j < 4; ++j) {
                ss += v[j][0] * v[j][0] + v[j][1] * v[j][1] + v[j][2] * v[j][2] + v[j][3] * v[j][3];
#pragma unroll
                for (int c = 0; c < 8; ++c) g[c] += v[j][0] * wg[j][0][c] + v[j][1] * wg[j][1][c] + v[j][2] * wg[j][2][c] + v[j][3] * wg[j][3][c];
            }
            float pd[8];
            { const auto r_ = __builtin_amdgcn_permlane32_swap(__float_as_uint(g[0]), __float_as_uint(ss), false, false); pd[0] = __uint_as_float(r_[0]) + __uint_as_float(r_[1]); }
#pragma unroll
            for (int i = 1; i < 8; ++i) { const auto r_ = __builtin_amdgcn_permlane32_swap(__float_as_uint(g[i]), __float_as_uint(g[i]), false, false); pd[i] = __uint_as_float(r_[0]) + __uint_as_float(r_[1]); }
#pragma unroll
            for (int i = 0; i < 4; ++i) { const auto r_ = __builtin_amdgcn_permlane16_swap(__float_as_uint(pd[i]), __float_as_uint(pd[i + 4]), false, false); pd[i] = __uint_as_float(r_[0]) + __uint_as_float(r_[1]); }
            { const bool b8 = (lane & 8) != 0, b4 = (lane & 4) != 0;
#pragma unroll
              for (int i = 0; i < 2; ++i) { const float keep = b8 ? pd[i + 2] : pd[i], send = b8 ? pd[i] : pd[i + 2]; pd[i] = keep + __int_as_float(__builtin_amdgcn_update_dpp(0, __float_as_int(send), 0x140, 0xf, 0xf, false)); }
              const float keep = b4 ? pd[1] : pd[0], send = b4 ? pd[0] : pd[1]; pd[0] = keep + __int_as_float(__builtin_amdgcn_update_dpp(0, __float_as_int(send), 0x141, 0xf, 0xf, false)); }
            float z = pd[0]; z += __int_as_float(__builtin_amdgcn_update_dpp(0, __float_as_int(z), 0xB1, 0xf, 0xf, false)); z += __int_as_float(__builtin_amdgcn_update_dpp(0, __float_as_int(z), 0x4E, 0xf, 0xf, false));
            const float sst = __int_as_float(__builtin_amdgcn_readlane(__float_as_int(z), 32));
            const float r = rsqrtf(sst * (1.0f / D_) + 1e-6f);
            { float* dst = lane < 32 ? ifg + (size_t)row * 8 + (lane >> 2) : r1 + row; const float val = lane < 32 ? z * r + bias_l : r;
              if ((lane & 3) == 0 && lane <= 32) asm volatile("global_store_dword %0, %1, off" :: "v"(dst), "v"(val) : "memory"); }
            { typedef unsigned p0_u32x2 __attribute__((ext_vector_type(2))); const char* ob = (const char*)(xb + (size_t)row * D_);
              const p0_u32x2 w0 = {pk2(v[0][0], v[0][1]), pk2(v[0][2], v[0][3])}, w1 = {pk2(v[1][0], v[1][1]), pk2(v[1][2], v[1][3])}, w2 = {pk2(v[2][0], v[2][1]), pk2(v[2][2], v[2][3])}, w3 = {pk2(v[3][0], v[3][1]), pk2(v[3][2], v[3][3])};
              asm volatile("global_store_dwordx2 %0, %1, %5\n\tglobal_store_dwordx2 %0, %2, %5 offset:512\n\tglobal_store_dwordx2 %0, %3, %5 offset:1024\n\tglobal_store_dwordx2 %0, %4, %5 offset:1536"
                           :: "v"(xoff8), "v"(w0), "v"(w1), "v"(w2), "v"(w3), "s"(ob) : "memory"); }
        };
#define P0_LD(V, ROW) do { const float* rp_ = x + (size_t)(ROW) * D_; \
            asm volatile("global_load_dwordx4 %0, %4, %5\n\tglobal_load_dwordx4 %1, %4, %5 offset:1024\n\tglobal_load_dwordx4 %2, %4, %5 offset:2048\n\tglobal_load_dwordx4 %3, %4, %5 offset:3072" \
                         : "=&v"(V[0]), "=&v"(V[1]), "=&v"(V[2]), "=&v"(V[3]) : "v"(xoff), "s"(rp_) : "memory"); } while (0)
#define P0_WAIT18(V) asm volatile("s_waitcnt vmcnt(18)" : "+v"(V[0]), "+v"(V[1]), "+v"(V[2]), "+v"(V[3]) :: "memory")
#define P0_WAIT(V) asm volatile("s_waitcnt vmcnt(8)" : "+v"(V[0]), "+v"(V[1]), "+v"(V[2]), "+v"(V[3]) :: "memory")
        const int gwu = __builtin_amdgcn_readfirstlane(gw);
        const int nrow = gwu < T_ ? (T_ - gwu + NGW - 1) / NGW : 0;
        if (nrow > 0) {
            p0_f32x4 va[4], vb[4], vc[4];
            const int rlast = gwu + (nrow - 1) * NGW;
#define P0_ROWOF(K) ((K) < nrow ? gwu + (K) * NGW : rlast)
#define P0_FILL() do { char* fp_ = (char*)(xb + (size_t)gwu * D_); const unsigned z_ = 0u; \
                asm volatile("global_store_dword %0, %1, %2\n\tglobal_store_dword %0, %1, %2 offset:256\n\tglobal_store_dword %0, %1, %2 offset:512\n\tglobal_store_dword %0, %1, %2 offset:768\n\tglobal_store_dword %0, %1, %2 offset:1024" \
                             :: "v"(xoff4), "v"(z_), "s"(fp_) : "memory"); } while (0)
            const unsigned xoff4 = (unsigned)lane * 4u;
            P0_LD(va, P0_ROWOF(0)); P0_FILL(); P0_LD(vb, P0_ROWOF(1)); P0_FILL();
#pragma unroll 1
            for (int k = 0; k < nrow; k += 3) {
                P0_LD(vc, P0_ROWOF(k + 2)); P0_WAIT18(va); do_row(va, gwu + k * NGW);
                P0_LD(va, P0_ROWOF(k + 3)); P0_WAIT18(vb); if (k + 1 < nrow) do_row(vb, gwu + (k + 1) * NGW);
                P0_LD(vb, P0_ROWOF(k + 4)); P0_WAIT18(vc); if (k + 2 < nrow) do_row(vc, gwu + (k + 2) * NGW);
            }
            asm volatile("s_waitcnt vmcnt(0)" : "+v"(va[0]), "+v"(va[1]), "+v"(va[2]), "+v"(va[3]), "+v"(vb[0]), "+v"(vb[1]), "+v"(vb[2]), "+v"(vb[3]) :: "memory");
        }
    }
}
typedef float f32x2_t __attribute__((ext_vector_type(2)));
typedef unsigned p5_u32x4 __attribute__((ext_vector_type(4)));
#define P5_LAS __attribute__((address_space(3)))
#define P5_TIE8(R) "+v"(R[0]), "+v"(R[1]), "+v"(R[2]), "+v"(R[3]), "+v"(R[4]), "+v"(R[5]), "+v"(R[6]), "+v"(R[7])
#define P5_OUT(I, ACC, DELTA, QSUM) do { const float dl_ = ln < 32 ? (DELTA) : 0.0625f * (DELTA); const int qs_ = ln < 32 ? 8 * (QSUM) : 0;     \
        _Pragma("unroll") for (int g4_ = 0; g4_ < 4; ++g4_) { const int col_ = 32 * (ln & 31) + 8 * g4_ + 4 * (ln >> 5); \
            const uint2 xw_ = *(const uint2*)(x1b + (tb + I) * 2048 + 2 * col_); \
            *(float4*)(out + (tb + I) * 1024 + col_) = make_float4(__builtin_bit_cast(float, xw_.x << 16) + dl_ * (float)(ACC[4 * g4_] - qs_), __builtin_bit_cast(float, xw_.x & 0xffff0000u) + dl_ * (float)(ACC[4 * g4_ + 1] - qs_), \
                                                                   __builtin_bit_cast(float, xw_.y << 16) + dl_ * (float)(ACC[4 * g4_ + 2] - qs_), __builtin_bit_cast(float, xw_.y & 0xffff0000u) + dl_ * (float)(ACC[4 * g4_ + 3] - qs_)); } } while (0)
typedef unsigned p5_u32x2 __attribute__((ext_vector_type(2)));
typedef int p5_i32x4 __attribute__((ext_vector_type(4)));
typedef int p5_i32x16 __attribute__((ext_vector_type(16)));
#define P5_ROWMMA2(ACC, R, CQ) do { const p5_u32x4 r__ = R; const int t_ = ((CQ) & 0xFF) << ash;     \
    const p5_i32x4 a1_ = {adm1 == 0 ? t_ : 0, adm1 == 1 ? t_ : 0, adm1 == 2 ? t_ : 0, adm1 == 3 ? t_ : 0}, a2_ = {adm2 == 0 ? t_ : 0, adm2 == 1 ? t_ : 0, adm2 == 2 ? t_ : 0, adm2 == 3 ? t_ : 0}; \
    const p5_i32x4 b1_ = {(int)(r__.x & 0x0F0F0F0Fu), (int)(r__.x & 0xF0F0F0F0u), (int)(r__.y & 0x0F0F0F0Fu), (int)(r__.y & 0xF0F0F0F0u)}, \
                   b2_ = {(int)(r__.z & 0x0F0F0F0Fu), (int)(r__.z & 0xF0F0F0F0u), (int)(r__.w & 0x0F0F0F0Fu), (int)(r__.w & 0xF0F0F0F0u)};     \
    ACC = __builtin_amdgcn_mfma_i32_32x32x32_i8(a1_, b1_, ACC, 0, 0, 0); ACC = __builtin_amdgcn_mfma_i32_32x32x32_i8(a2_, b2_, ACC, 0, 0, 0); } while (0)
#define P5_BFMA8U(R, CK) do { P5_ROWMMA2(acc0, R[0], CK[0]); P5_ROWMMA2(acc1, R[1], CK[1]); P5_ROWMMA2(acc2, R[2], CK[2]); P5_ROWMMA2(acc3, R[3], CK[3]); } while (0)
#define P5_ISSUE8U(R, B, CK) do { const p5_i32x4 ek_ = *(const P5_LAS p5_i32x4*)(keys + 8 * (B) + hl4); CK = *(const P5_LAS p5_i32x4*)(cfi + 8 * (B) + hl4); \
    _Pragma("unroll") for (int j_ = 0; j_ < 4; ++j_) { const unsigned off_ = ((unsigned)ek_[j_] << 9) + voff16h; \
        asm volatile("global_load_dwordx4 %0, %1, %2" : "=v"(R[j_]) : "v"(off_), "s"(wu) : "memory"); } } while (0)
#define P5_DOT(R, XH, XL) __builtin_amdgcn_sdot8((int)R.w, (int)XL.w, __builtin_amdgcn_sdot8((int)R.z, (int)XL.z, __builtin_amdgcn_sdot8((int)R.y, (int)XL.y, __builtin_amdgcn_sdot8((int)R.x, (int)XL.x, \
    16 * __builtin_amdgcn_sdot8((int)R.w, (int)XH.w, __builtin_amdgcn_sdot8((int)R.z, (int)XH.z, __builtin_amdgcn_sdot8((int)R.y, (int)XH.y, __builtin_amdgcn_sdot8((int)R.x, (int)XH.x, 0, false), false), false), false), false), false), false), false)
#define P5_ISSUE8D(R, B) do { const p5_i32x4 ek_ = *(const P5_LAS p5_i32x4*)(keys + 8 * (B) + hl4); \
    _Pragma("unroll") for (int j_ = 0; j_ < 4; ++j_) { const unsigned off_ = ((unsigned)ek_[j_] << 9) + voff16h; \
        asm volatile("global_load_dwordx4 %0, %1, %2" : "=v"(R[j_]) : "v"(off_), "s"(wd) : "memory"); } } while (0)
#define P5_DOWN8(R, BB) do { int pd_[4]; \
    pd_[0] = P5_DOT(R[0], xh0, xl0); pd_[1] = P5_DOT(R[1], xh1, xl1); pd_[2] = P5_DOT(R[2], xh2, xl2); pd_[3] = P5_DOT(R[3], xh3, xl3); \
    _Pragma("unroll") for (int i_ = 0; i_ < 2; ++i_) { const auto r_ = __builtin_amdgcn_permlane16_swap((unsigned)pd_[i_], (unsigned)pd_[i_ + 2], false, false); pd_[i_] = (int)(r_[0] + r_[1]); } \
    { const bool b8_ = (ln & 8) != 0; const int keep_ = b8_ ? pd_[1] : pd_[0], send_ = b8_ ? pd_[0] : pd_[1]; int z_ = keep_ + __builtin_amdgcn_update_dpp(0, send_, 0x140, 0xf, 0xf, false); \
      z_ += __builtin_amdgcn_update_dpp(0, z_, 0x141, 0xf, 0xf, false); z_ += __builtin_amdgcn_update_dpp(0, z_, 0xB1, 0xf, 0xf, false); z_ += __builtin_amdgcn_update_dpp(0, z_, 0x4E, 0xf, 0xf, false); \
      zz = (ln & 7) == ((BB) & 7) ? z_ : zz; } \
    if (((BB) & 7) == 7) { const int pos_ = 8 * ((BB) - 7) + 8 * (ln & 7) + (ln >> 3); const int e_ = keys[pos_]; const float g_ = cfs[pos_]; const int tk_ = (ln >> 3) & 3; \
        const float sx_ = tk_ == 0 ? sx0 : tk_ == 1 ? sx1 : tk_ == 2 ? sx2 : sx3; const float av_ = (float)zz * sx_ * (float)sdl[e_]; \
        cfs[pos_] = g_ * 0.5f * av_ * (1.0f + erff(av_ * 0.70710678118654752f)) * (float)sul[e_]; } } while (0)
__device__ __forceinline__ void phase5_all(const PArgs& p, float* out, unsigned char* shm) {
    int tid = threadIdx.x; asm volatile("" : "+v"(tid)); const int wid = __builtin_amdgcn_readfirstlane(tid >> 6);
    const char* x1b = (const char*)(p.ws + OFF_MV); const char* eidx = (const char*)(p.ws + OFF_EIDX); const char* egp = (const char*)(p.ws + OFF_EG); const float* r2 = (const float*)(p.ws + OFF_R2);
    const unsigned char* wd = (const unsigned char*)(p.ws + OFF_WD); const unsigned char* wu = (const unsigned char*)(p.ws + OFF_WU); const float* SD = (const float*)(p.ws + OFF_WD + 16 * MiB); const float* SU = (const float*)(p.ws + OFF_WU + 16 * MiB);
    P5_LAS _Float16* sdl = (P5_LAS _Float16*)shm; P5_LAS _Float16* sul = sdl + 16384;
    P5_LAS int* keys = (P5_LAS int*)(shm + 65536 + wid * 4608); P5_LAS float* cfs = (P5_LAS float*)(keys + 512); P5_LAS int* cfi = (P5_LAS int*)cfs; P5_LAS int* cntl = (P5_LAS int*)(keys + 1024);
    const int rot = 4 * ((int)blockIdx.x & 7);
    for (int i = tid; i < 16384; i += 512) { sdl[i] = (_Float16)SD[i]; sul[i] = (_Float16)SU[i]; }
    __syncthreads();
    const int G = (int)gridDim.x, NR = (T_ / 32 + G - 1 - (int)blockIdx.x) / G;
#pragma unroll 1
    for (int rnd = 0; rnd < NR; ++rnd) {
        int ln = (int)__builtin_amdgcn_mbcnt_hi(~0u, __builtin_amdgcn_mbcnt_lo(~0u, 0u)); asm volatile("" : "+v"(ln));     const unsigned voff = (unsigned)ln * 16u, voff4 = (unsigned)ln * 4u, voff8 = (unsigned)ln * 8u, voff16h = (unsigned)(ln & 31) * 16u; const int hl4 = 4 * (ln >> 5);
        const size_t tb = ((size_t)(rnd * G + (int)blockIdx.x) * 8 + wid) * 4;
        int ev[4][2], cv[4][2];
#pragma unroll
        for (int i_ = 0; i_ < 4; ++i_) { const char* ep_ = eidx + (tb + i_) * 512; const char* cp_ = egp + (tb + i_) * 512;
            asm volatile("global_load_dword %0, %4, %5\n\tglobal_load_dword %1, %4, %5 offset:256\n\tglobal_load_dword %2, %4, %6\n\tglobal_load_dword %3, %4, %6 offset:256"
                         : "=&v"(ev[i_][0]), "=&v"(ev[i_][1]), "=&v"(cv[i_][0]), "=&v"(cv[i_][1]) : "v"(voff4), "s"(ep_), "s"(cp_) : "memory"); }
        p5_u32x4 xh0, xh1, xh2, xh3, xl0, xl1, xl2, xl3; float sx0, sx1, sx2, sx3;
#define P5_QUANT(I, XH, XL, SX) do { const uint4* xp_ = (const uint4*)(x1b + (tb + I) * 2048) + 2 * (2 * (ln & 31) + (ln >> 5)); const uint4 a_ = xp_[0], b_ = xp_[1]; \
        const unsigned w_[8] = {a_.x, a_.y, a_.z, a_.w, b_.x, b_.y, b_.z, b_.w}; float am_ = 0.f; \
        _Pragma("unroll") for (int k_ = 0; k_ < 8; ++k_) am_ = fmaxf(am_, fmaxf(fabsf(__builtin_bit_cast(float, w_[k_] << 16)), fabsf(__builtin_bit_cast(float, w_[k_] & 0xffff0000u)))); \
        _Pragma("unroll") for (int o_ = 32; o_ >= 1; o_ >>= 1) am_ = fmaxf(am_, __builtin_bit_cast(float, __builtin_amdgcn_ds_bpermute(4 * (ln ^ o_), __builtin_bit_cast(int, am_)))); \
        const float inv_ = am_ > 0.f ? 119.0f / am_ : 0.f; unsigned h_[2] = {0u, 0u}, l_[2] = {0u, 0u}; \
        _Pragma("unroll") for (int k_ = 0; k_ < 16; ++k_) { const float xf_ = __builtin_bit_cast(float, (k_ & 1) ? (w_[k_ >> 1] & 0xffff0000u) : (w_[k_ >> 1] << 16)); \
            const int q_ = (int)rintf(xf_ * inv_); const int lo_ = ((q_ + 8) & 15) - 8, hi_ = (q_ - lo_) >> 4;     \
            h_[k_ >> 3] |= (unsigned)(hi_ & 15) << (4 * (k_ & 7)); l_[k_ >> 3] |= (unsigned)(lo_ & 15) << (4 * (k_ & 7)); } \
        unsigned o0_ = h_[0], o1_ = h_[1], o2_ = l_[0], o3_ = l_[1]; asm volatile("" : "+v"(o0_), "+v"(o1_), "+v"(o2_), "+v"(o3_));     \
        const auto s0_ = __builtin_amdgcn_permlane32_swap(h_[0], o0_, false, false), s1_ = __builtin_amdgcn_permlane32_swap(h_[1], o1_, false, false), \
                   s2_ = __builtin_amdgcn_permlane32_swap(l_[0], o2_, false, false), s3_ = __builtin_amdgcn_permlane32_swap(l_[1], o3_, false, false);     \
        XH = p5_u32x4{s0_[0], s1_[0], s0_[1], s1_[1]}; XL = p5_u32x4{s2_[0], s3_[0], s2_[1], s3_[1]}; SX = am_ * (1.0f / 119.0f) * r2[tb + I]; } while (0)
        P5_QUANT(0, xh0, xl0, sx0); P5_QUANT(1, xh1, xl1, sx1); P5_QUANT(2, xh2, xl2, sx2); P5_QUANT(3, xh3, xl3, sx3);
        asm volatile("s_waitcnt vmcnt(0)" : "+v"(ev[0][0]), "+v"(ev[0][1]), "+v"(ev[1][0]), "+v"(ev[1][1]), "+v"(ev[2][0]), "+v"(ev[2][1]), "+v"(ev[3][0]), "+v"(ev[3][1]) :: "memory");
        asm volatile("" : "+v"(cv[0][0]), "+v"(cv[0][1]), "+v"(cv[1][0]), "+v"(cv[1][1]), "+v"(cv[2][0]), "+v"(cv[2][1]), "+v"(cv[3][0]), "+v"(cv[3][1]));
        cntl[ln] = 0; cntl[64 + ln] = 0;
        int bk[4][2];
#pragma unroll
        for (int i = 0; i < 4; ++i)
#pragma unroll
            for (int ps = 0; ps < 2; ++ps) { bk[i][ps] = 32 * i + ((((ev[i][ps] & 16383) >> 9) - rot) & 31); (void)__hip_atomic_fetch_add(cntl + bk[i][ps], 1, __ATOMIC_RELAXED, __HIP_MEMORY_SCOPE_WORKGROUP); }
#pragma unroll
        for (int hh = 0; hh < 2; ++hh) { const int c_ = cntl[64 * hh + ln]; int inc = c_;
#pragma unroll
          for (int o = 1; o < 32; o <<= 1) { const int u_ = __builtin_amdgcn_ds_bpermute(4 * (ln - o), inc); if ((ln & 31) >= o) inc += u_; }
          cntl[64 * hh + ln] = inc - c_; }
#pragma unroll
        for (int i = 0; i < 4; ++i)
#pragma unroll
            for (int ps = 0; ps < 2; ++ps) { const int pos = 4 * __hip_atomic_fetch_add(cntl + bk[i][ps], 1, __ATOMIC_RELAXED, __HIP_MEMORY_SCOPE_WORKGROUP) + i;
                keys[pos] = ev[i][ps] & 16383; cfs[pos] = __builtin_bit_cast(float, cv[i][ps]); }
        int dx, dl, dm;
        { const int rn = rnd + 1 < NR ? rnd + 1 : rnd; const size_t tn = ((size_t)(rn * G + (int)blockIdx.x) * 8 + wid) * 4;
          const char* pe = eidx + tn * 512; const char* pc = egp + tn * 512; const char* px = x1b + tn * 2048;
          asm volatile("global_load_dword %0, %3, %5\n\tglobal_load_dword %1, %4, %6\n\tglobal_load_dword %2, %4, %7" : "=&v"(dx), "=&v"(dl), "=&v"(dm) : "v"(ln * 128), "v"((ln & 15) * 128), "s"(px), "s"(pe), "s"(pc) : "memory"); }
        p5_u32x4 ua[4], ub[4], uc[4]; p5_i32x4 cka, ckb, ckc;
        {
            int zz = 0;
            p5_u32x4 da[4], db[4], dc[4];
#define P5_TIE4(R) "+v"(R[0]), "+v"(R[1]), "+v"(R[2]), "+v"(R[3])
            P5_ISSUE8D(da, 0); P5_ISSUE8D(db, 1); P5_ISSUE8D(dc, 2);
#pragma unroll 1
            for (int b = 0; b < 60; b += 3) {
                asm volatile("s_waitcnt vmcnt(8)" : P5_TIE4(da) :: "memory"); P5_DOWN8(da, b); P5_ISSUE8D(da, b + 3);
                asm volatile("s_waitcnt vmcnt(8)" : P5_TIE4(db) :: "memory"); P5_DOWN8(db, b + 1); P5_ISSUE8D(db, b + 4);
                asm volatile("s_waitcnt vmcnt(8)" : P5_TIE4(dc) :: "memory"); P5_DOWN8(dc, b + 2); P5_ISSUE8D(dc, b + 5);
            }
            asm volatile("s_waitcnt vmcnt(8)" : P5_TIE4(da) :: "memory"); P5_DOWN8(da, 60); P5_ISSUE8D(da, 63);
            P5_ISSUE8U(ua, 0, cka); P5_ISSUE8U(ub, 1, ckb); P5_ISSUE8U(uc, 2, ckc);
            asm volatile("s_waitcnt vmcnt(20)" : P5_TIE4(db) :: "memory"); P5_DOWN8(db, 61);
            asm volatile("s_waitcnt vmcnt(16)" : P5_TIE4(dc) :: "memory"); P5_DOWN8(dc, 62);
            asm volatile("s_waitcnt vmcnt(12)" : P5_TIE4(da) :: "memory"); P5_DOWN8(da, 63);
            asm volatile("" : "+v"(dx), "+v"(dl), "+v"(dm));
        }
        float dq0, dq1, dq2, dq3; int qs0, qs1, qs2, qs3;
        { float dqv[4]; int qsv[4];
#pragma unroll
          for (int i = 0; i < 4; ++i) { const float e0 = cfs[4 * ln + i], e1 = cfs[4 * (ln + 64) + i]; float am = fmaxf(fabsf(e0), fabsf(e1));
#pragma unroll
              for (int o = 32; o >= 1; o >>= 1) am = fmaxf(am, __builtin_bit_cast(float, __builtin_amdgcn_ds_bpermute(4 * (ln ^ o), __builtin_bit_cast(int, am))));
              const float inv = am > 0.f ? 127.0f / am : 0.f; const int q0 = (int)rintf(e0 * inv), q1 = (int)rintf(e1 * inv); int sm = q0 + q1;
#pragma unroll
              for (int o = 32; o >= 1; o >>= 1) sm += __builtin_amdgcn_ds_bpermute(4 * (ln ^ o), sm);
              cfi[4 * ln + i] = q0; cfi[4 * (ln + 64) + i] = q1; dqv[i] = am * (1.0f / 127.0f); qsv[i] = sm; }
#define P5_UNIF(X) __builtin_bit_cast(float, __builtin_amdgcn_readfirstlane(__builtin_bit_cast(int, X)))
          dq0 = P5_UNIF(dqv[0]); dq1 = P5_UNIF(dqv[1]); dq2 = P5_UNIF(dqv[2]); dq3 = P5_UNIF(dqv[3]);
          qs0 = __builtin_amdgcn_readfirstlane(qsv[0]); qs1 = __builtin_amdgcn_readfirstlane(qsv[1]); qs2 = __builtin_amdgcn_readfirstlane(qsv[2]); qs3 = __builtin_amdgcn_readfirstlane(qsv[3]); }
        cka = *(const P5_LAS p5_i32x4*)(cfi + hl4); ckb = *(const P5_LAS p5_i32x4*)(cfi + 8 + hl4); ckc = *(const P5_LAS p5_i32x4*)(cfi + 16 + hl4);
        const int adm1 = (ln & 16) ? 4 : ((ln & 15) >> 2), adm2 = (ln & 16) ? ((ln & 15) >> 2) : 4, ash = 8 * (ln & 3), hi5 = ln >> 5;
        p5_i32x16 acc0 = {}, acc1 = {}, acc2 = {}, acc3 = {};
#pragma unroll 1
        for (int b = 0; b < 60; b += 3) {
            asm volatile("s_waitcnt vmcnt(8)" : P5_TIE4(ua) :: "memory"); P5_BFMA8U(ua, cka); P5_ISSUE8U(ua, b + 3, cka);
            asm volatile("s_waitcnt vmcnt(8)" : P5_TIE4(ub) :: "memory"); P5_BFMA8U(ub, ckb); P5_ISSUE8U(ub, b + 4, ckb);
            asm volatile("s_waitcnt vmcnt(8)" : P5_TIE4(uc) :: "memory"); P5_BFMA8U(uc, ckc); P5_ISSUE8U(uc, b + 5, ckc);
        }
        asm volatile("s_waitcnt vmcnt(8)" : P5_TIE4(ua) :: "memory"); P5_BFMA8U(ua, cka); P5_ISSUE8U(ua, 63, cka);
        asm volatile("s_waitcnt vmcnt(8)" : P5_TIE4(ub) :: "memory"); P5_BFMA8U(ub, ckb);
        asm volatile("s_waitcnt vmcnt(4)" : P5_TIE4(uc) :: "memory"); P5_BFMA8U(uc, ckc);
        asm volatile("s_waitcnt vmcnt(0)" : P5_TIE4(ua) :: "memory"); P5_BFMA8U(ua, cka);
        P5_OUT(0, acc0, dq0, qs0); P5_OUT(1, acc1, dq1, qs1); P5_OUT(2, acc2, dq2, qs2); P5_OUT(3, acc3, dq3, qs3);
    }
}

__global__ __launch_bounds__(512, 2) void k_mega(PArgs p_unused) {
    extern __shared__ __attribute__((aligned(16))) unsigned char shm[];
    cg::grid_group grid = cg::this_grid();
    PG8_LAS unsigned char* lds = (PG8_LAS unsigned char*)shm;
    volatile __attribute__((address_space(3))) unsigned* lctl = (volatile __attribute__((address_space(3))) unsigned*)(lds + LDS_CTL);
    if (threadIdx.x < 64) lctl[threadIdx.x] = 0u;
    __syncthreads();
    const XcdBarrier xbar = xcd_barrier_post((unsigned*)(kargs()->ws + OFF_CTL), lctl);
    for (int rep_ = 0; rep_ < (DUP == 10 ? 2 : 1); ++rep_) { const PArgs p = *kargs(); phase0(p, shm); if (DUP == 10) grid.sync(); }
    grid.sync();
    for (int rep_ = 0; rep_ < (DUP == 1 ? 2 : 1); ++rep_) {
        const PArgs& p = *kargs();
        pg8::SchedGrid S; S.init(p.ws + OFF_XB, p.ws + OFF_WIN, nullptr, nullptr, T_, 5632, 1024, 1, (int)gridDim.x, (int)blockIdx.x);
        pg8::EpiInProj E; E.r1 = (const float*)(p.ws + OFF_R1); E.qnw = p.in[3]; E.knw = p.in[4]; E.ropec = (const float*)(p.ws + OFF_ROPE); E.ropes = E.ropec + 4096 * 8; E.merge_b = p.in[12]; E.ws = p.ws; E.kmean = (float*)(p.ws + OFF_KMEAN); E.skip_km = rep_;
        pg8::gemm_phase<pg8::EpiInProj, pg8::SchedGrid, true, true>(lds, 1024, S, E);
        if (DUP == 1) grid.sync();
    }
    xcd_barrier(xbar);
    {
        const PArgs& p = *kargs();
        const attn_body::AttnTensors AT{(const attn_body::bf16*)(p.ws + OFF_Q), (const attn_body::bf16*)(p.ws + OFF_K), (const attn_body::bf16*)(p.ws + OFF_V), (attn_body::bf16*)(p.ws + OFF_Q), (const float*)(p.ws + OFF_KMEAN)};
        mlstm::Args A; A.mq = (const bf16_t*)(p.ws + OFF_MQ); A.mk = (const bf16_t*)(p.ws + OFF_MK); A.mv = (const bf16_t*)(p.ws + OFF_MV); A.mosig = (const bf16_t*)(p.ws + OFF_MO);
        A.ifg = (const float*)(p.ws + OFF_IFG); A.conv_w = p.in[5]; A.conv_b = p.in[6]; A.nw = p.in[9]; A.sca = (float*)(p.ws + OFF_SCA); A.scm = (float*)(p.ws + OFF_SCM); A.scb = (float*)(p.ws + OFF_SCB);
        A.hm = (bf16_t*)(p.ws + OFF_EIDX);
        for (int rep_ = 0; rep_ < (DUP == 3 ? 2 : 1); ++rep_) for (int u = blockIdx.x; u < 64; u += gridDim.x) mlstm::unit(u >> 2, u & 3, A, (ML_LAS unsigned char*)shm);
        attn_body::QueueOrder S; S.ctr = (unsigned*)(p.ws + OFF_CTL) + 8192; S.slot = lctl + 16;
        attn_body::attn_phase<attn_body::QueueOrder>((char*)shm, AT, S);
    }
    xcd_barrier(xbar);
    for (int rep_ = 0; rep_ < (DUP == 4 ? 2 : 1); ++rep_) {
        const PArgs& p = *kargs();
        pg8::SchedGrid S; S.init(p.ws + OFF_Q, p.ws + OFF_WAB, p.ws + OFF_EIDX, p.ws + OFF_WMB, T_, 1024, 512, 2, (int)gridDim.x, (int)blockIdx.x);
        pg8::EpiBranch E; E.ga = (const bf16_t*)(p.ws + OFF_GA); E.gm = (const bf16_t*)(p.ws + OFF_GM); E.y = (bf16_t*)(p.ws + OFF_MQ);
        pg8::gemm_phase<pg8::EpiBranch, pg8::SchedGrid, true, true>(lds, 512, S, E);
        if (DUP == 4) grid.sync();
    }
    xcd_barrier(xbar);
    for (int rep_ = 0; rep_ < (DUP == 5 ? 2 : 1); ++rep_) {
        const PArgs& p = *kargs();
        pg8::SchedGrid S; S.init(p.ws + OFF_MQ, p.ws + OFF_WOUT, nullptr, nullptr, T_, 1024, 1024, 1, (int)gridDim.x, (int)blockIdx.x);
        pg8::EpiOut E; E.xb = (const bf16_t*)(p.ws + OFF_XB); E.out = p.out; E.x1b = (bf16_t*)(p.ws + OFF_MV); E.rowss = (float*)(p.ws + OFF_ROWSS);
        pg8::gemm_phase<pg8::EpiOut, pg8::SchedGrid, true, true>(lds, 1024, S, E);
        if (DUP == 5) grid.sync();
    }
    xcd_barrier(xbar);
    for (int rep_ = 0; rep_ < (DUP == 6 ? 2 : 1); ++rep_) {
        const PArgs& p = *kargs();
        peer::Args A; A.rowss = (const float*)(p.ws + OFF_ROWSS); A.key1 = (const bf16_t*)(p.ws + OFF_KEY1); A.key2 = (const bf16_t*)(p.ws + OFF_KEY2); A.r2out = (float*)(p.ws + OFF_R2);
        A.eidx = (int*)(p.ws + OFF_EIDX); A.eg = (float*)(p.ws + OFF_EG);
        for (int u = blockIdx.x; u < 2048; u += gridDim.x) peer::unit(u >> 3, u & 7, (const bf16_t*)(p.ws + OFF_MV), (const bf16_t*)(p.ws + OFF_WQ), A, lds);
    }
    xcd_barrier(xbar);
    { const PArgs& p = *kargs(); phase5_all(p, p.out, shm); }
}

extern "C" void kernel_launch(void* const* d_in, const int* in_sizes, int n_in, void* d_out, int out_size, void* d_ws, size_t ws_size, hipStream_t stream) {
    static int grid_blocks = 0;
    if (!grid_blocks) {
        if (n_in != 20 || in_sizes[0] != T_ * D_ || out_size != T_ * D_ || ws_size < WS_NEED) { fprintf(stderr, "kernel_launch: unexpected shapes n_in %d in0 %d out %d ws %zu\n", n_in, n_in > 0 ? in_sizes[0] : -1, out_size, ws_size); grid_blocks = -1; return; }
        if (hipFuncSetAttribute((const void*)k_mega, hipFuncAttributeMaxDynamicSharedMemorySize, BIG_LDS) != hipSuccess) { fprintf(stderr, "hipFuncSetAttribute failed\n"); grid_blocks = -1; return; }
        int dev = 0, cus = 0, per_cu = 0;
        hipGetDevice(&dev); hipDeviceGetAttribute(&cus, hipDeviceAttributeMultiprocessorCount, dev);
        hipOccupancyMaxActiveBlocksPerMultiprocessor(&per_cu, (const void*)k_mega, 512, BIG_LDS);
        if (per_cu < 1) { fprintf(stderr, "kernel_launch: occupancy query reports %d blocks per CU\n", per_cu); per_cu = 1; }
        grid_blocks = cus;
        if (grid_blocks != 256) fprintf(stderr, "kernel_launch: %d CUs (expected 256)\n", grid_blocks);
    }
    if (grid_blocks < 0) return;
    PArgs pa{}; for (int i = 0; i < 20; ++i) pa.in[i] = (const float*)d_in[i]; pa.out = (float*)d_out; pa.ws = (char*)d_ws;
    hipMemsetAsync((char*)d_ws + OFF_CTL, 0, CTL_BYTES, stream);
    void* args[] = {&pa};
    hipError_t e = hipLaunchCooperativeKernel((void*)k_mega, dim3(grid_blocks), dim3(512), args, BIG_LDS, stream);
    if (e != hipSuccess) fprintf(stderr, "cooperative launch failed: %s (grid %d)\n", hipGetErrorString(e), grid_blocks);
}
```
